# Optimizing an MI355X kernel written in HIP

```python
import math
import jax, jax.numpy as jnp
from jax import lax
import numpy as np

D_MODEL = 1024
BATCH = 8
SEQ = 8192
DEPTH = 1

GRID_W = 64
CTX_LEN = 256
MIX_WIDTH = D_MODEL
SSM_WIDTH = MIX_WIDTH // 2
SSM_GROUP = 16
SSM_GROUPS = SSM_WIDTH // SSM_GROUP
SSM_STATE = 64
ATTN_WIDTH = MIX_WIDTH - SSM_WIDTH
DIFF_HEADS = 4
DIFF_HEAD_DIM = ATTN_WIDTH // (2 * DIFF_HEADS)
ROT_FREQS = DIFF_HEAD_DIM // 4
ROPE_BASE = 10000.0
IN_WIDTH = SSM_WIDTH + 3 * ATTN_WIDTH
D_FF = 128 * ((8 * D_MODEL // 3 + 127) // 128)
Q_BLOCK = 128
N_MOD = 9
EPS = 1e-6

kernel_name = 'hymba_s5_diffattn_macaron_dit'


def rms_norm(x, g):
    xf = x.astype(jnp.float32)
    y = xf * lax.rsqrt(jnp.mean(xf * xf, axis=-1, keepdims=True) + EPS)
    return (y * g.astype(jnp.float32)).astype(x.dtype)


def adaln(h, g, mod, i):
    return rms_norm(h, g) * (1.0 + mod[:, :, 3 * i + 1]) + mod[:, :, 3 * i]


def swiglu(h, w_in, w_out):
    gate, up = jnp.split(h @ w_in, 2, axis=-1)
    return (jax.nn.silu(gate) * up) @ w_out


def axial_rope_tables(rows):
    row = jnp.repeat(jnp.arange(rows, dtype=jnp.float32), GRID_W)
    col = jnp.tile(jnp.arange(GRID_W, dtype=jnp.float32), rows)
    inv_freq = ROPE_BASE ** (-jnp.arange(ROT_FREQS, dtype=jnp.float32) / ROT_FREQS)
    ang = jnp.stack([row[:, None] * inv_freq, col[:, None] * inv_freq], axis=1)
    return jnp.cos(ang), jnp.sin(ang)


def apply_axial_rope(t, cos, sin):
    ts = t.astype(jnp.float32).reshape(*t.shape[:-1], 2, 2, ROT_FREQS)
    x1 = ts[..., 0, :]
    x2 = ts[..., 1, :]
    cb = cos[None, :, None, None]
    sb = sin[None, :, None, None]
    out = jnp.stack([x1 * cb - x2 * sb, x2 * cb + x1 * sb], axis=-2)
    return out.reshape(t.shape).astype(t.dtype)


def cmul(ar, ai, br, bi):
    return ar * br - ai * bi, ar * bi + ai * br


def zoh_discretise(a_re, a_im, log_dt, b_re, b_im):
    dt = jnp.exp(log_dt)[:, None]
    mag = jnp.exp(dt * a_re)
    abar_re = mag * jnp.cos(dt * a_im)
    abar_im = mag * jnp.sin(dt * a_im)
    zr = abar_re - 1.0
    zi = abar_im
    den = a_re * a_re + a_im * a_im
    coef_re = (zr * a_re + zi * a_im) / den
    coef_im = (zi * a_re - zr * a_im) / den
    bbar_re, bbar_im = cmul(coef_re[..., None], coef_im[..., None], b_re, b_im)
    return abar_re, abar_im, bbar_re, bbar_im


def diag_scan(abar_re, abar_im, bu_re, bu_im, reverse):
    length = bu_re.shape[1]
    a_re = jnp.broadcast_to(abar_re, (1, length) + abar_re.shape)
    a_im = jnp.broadcast_to(abar_im, (1, length) + abar_im.shape)

    def combine(e1, e2):
        a1r, a1i, b1r, b1i = e1
        a2r, a2i, b2r, b2i = e2
        ar, ai = cmul(a2r, a2i, a1r, a1i)
        br, bi = cmul(a2r, a2i, b1r, b1i)
        return ar, ai, br + b2r, bi + b2i

    return lax.associative_scan(combine, (a_re, a_im, bu_re, bu_im), axis=1, reverse=reverse)


def s5_readout(h_re, h_im, c_re, c_im):
    return jnp.einsum('blgp,ghp->blgh', h_re, c_re) - jnp.einsum('blgp,ghp->blgh', h_im, c_im)


def s5_bidirectional(u_lat, u_ctx, a_re, a_im, log_dt, b_re, b_im, c_re, c_im, d_skip,
                     w_glu, b_glu, with_ctx_out):
    f32 = jnp.float32
    out_dtype = u_lat.dtype
    u_lat = u_lat.astype(f32)
    u_ctx = u_ctx.astype(f32)
    d_skip = d_skip.astype(f32)
    y_lat = d_skip * u_lat
    y_ctx = d_skip * u_ctx if with_ctx_out else None
    for direction in range(2):
        reverse = direction == 1
        abr, abi, bbr, bbi = zoh_discretise(a_re[direction].astype(f32), a_im[direction].astype(f32),
                                            log_dt[direction].astype(f32),
                                            b_re[direction].astype(f32), b_im[direction].astype(f32))
        cr = c_re[direction].astype(f32)
        ci = c_im[direction].astype(f32)
        buc_r = jnp.einsum('blgh,gph->blgp', u_ctx, bbr)
        buc_i = jnp.einsum('blgh,gph->blgp', u_ctx, bbi)
        _, _, hc_r, hc_i = diag_scan(abr, abi, buc_r, buc_i, reverse)
        end = 0 if reverse else -1
        h0_r = hc_r[:, end][:, None]
        h0_i = hc_i[:, end][:, None]
        bul_r = jnp.einsum('blgh,gph->blgp', u_lat, bbr)
        bul_i = jnp.einsum('blgh,gph->blgp', u_lat, bbi)
        ap_r, ap_i, hl_r, hl_i = diag_scan(abr, abi, bul_r, bul_i, reverse)
        carry_r, carry_i = cmul(ap_r, ap_i, h0_r, h0_i)
        y_lat = y_lat + s5_readout(hl_r + carry_r, hl_i + carry_i, cr, ci)
        if with_ctx_out:
            y_ctx = y_ctx + s5_readout(hc_r, hc_i, cr, ci)

    def glu(y):
        g = jax.nn.gelu(y).reshape(*y.shape[:2], SSM_WIDTH)
        return g * jax.nn.sigmoid(g @ w_glu.astype(f32) + b_glu.astype(f32))

    out_ctx = glu(y_ctx).astype(out_dtype) if with_ctx_out else None
    return glu(y_lat).astype(out_dtype), out_ctx


def diff_softmax_attend(q, k, v, lam):
    s = jnp.einsum('bqhcd,bkhcd->bhcqk', q, k).astype(jnp.float32) * (DIFF_HEAD_DIM ** -0.5)
    p = jax.nn.softmax(s, axis=-1)
    p_diff = p[:, :, 0] - lam * p[:, :, 1]
    return jnp.einsum('bhqk,bkhe->bqhe', p_diff.astype(v.dtype), v)


def differential_attention(q_lat, k_lat, v_lat, q_ctx, k_ctx, v_ctx, lam_q, lam_k, subln_g,
                           lam_init, with_ctx_out):
    f32 = jnp.float32
    lam = (jnp.exp(jnp.sum(lam_q[0].astype(f32) * lam_k[0].astype(f32)))
           - jnp.exp(jnp.sum(lam_q[1].astype(f32) * lam_k[1].astype(f32))) + lam_init)
    B, L = q_lat.shape[:2]
    k_all = jnp.concatenate([k_lat, k_ctx], axis=1)
    v_all = jnp.concatenate([v_lat, v_ctx], axis=1)
    nb = L // Q_BLOCK
    q_blocks = q_lat.reshape(B, nb, Q_BLOCK, DIFF_HEADS, 2, DIFF_HEAD_DIM).swapaxes(0, 1)
    o = lax.map(lambda qb: diff_softmax_attend(qb, k_all, v_all, lam), q_blocks)
    o_lat = o.swapaxes(0, 1).reshape(B, L, DIFF_HEADS, 2 * DIFF_HEAD_DIM)

    def finish(out):
        return (rms_norm(out, subln_g) * (1.0 - lam_init)).reshape(*out.shape[:2], ATTN_WIDTH)

    out_ctx = finish(diff_softmax_attend(q_ctx, k_ctx, v_ctx, lam)) if with_ctx_out else None
    return finish(o_lat), out_ctx


def split_mixer_inputs(p):
    b, n, _ = p.shape
    o1 = SSM_WIDTH
    o2 = o1 + ATTN_WIDTH
    o3 = o2 + ATTN_WIDTH
    u = p[..., :o1].reshape(b, n, SSM_GROUPS, SSM_GROUP)
    q = p[..., o1:o2].reshape(b, n, DIFF_HEADS, 2, DIFF_HEAD_DIM)
    k = p[..., o2:o3].reshape(b, n, DIFF_HEADS, 2, DIFF_HEAD_DIM)
    v = p[..., o3:].reshape(b, n, DIFF_HEADS, 2 * DIFF_HEAD_DIM)
    return u, q, k, v


def hybrid_mixer(h_lat, h_ctx, cos, sin, w_in, w_out, a_re, a_im, log_dt, b_re, b_im, c_re, c_im,
                 d_skip, w_glu, b_glu, lam_q, lam_k, subln_g, lam_init, with_ctx_out):
    u_lat, q_lat, k_lat, v_lat = split_mixer_inputs(h_lat @ w_in)
    u_ctx, q_ctx, k_ctx, v_ctx = split_mixer_inputs(h_ctx @ w_in)
    q_lat = apply_axial_rope(q_lat, cos, sin)
    k_lat = apply_axial_rope(k_lat, cos, sin)
    s_lat, s_ctx = s5_bidirectional(u_lat, u_ctx, a_re, a_im, log_dt, b_re, b_im, c_re, c_im,
                                    d_skip, w_glu, b_glu, with_ctx_out)
    a_lat, a_ctx = differential_attention(q_lat, k_lat, v_lat, q_ctx, k_ctx, v_ctx, lam_q, lam_k,
                                          subln_g, lam_init, with_ctx_out)
    y_lat = jnp.concatenate([s_lat, a_lat], axis=-1) @ w_out
    y_ctx = jnp.concatenate([s_ctx, a_ctx], axis=-1) @ w_out if with_ctx_out else None
    return y_lat, y_ctx


def setup_inputs(seed: int = 0) -> dict:
    key = jax.random.key(seed)
    ks = jax.random.split(key, 26)
    f32 = jnp.float32
    nrm = lambda k, shape, s: jax.random.normal(k, shape, f32) * s
    D, G, P, H = D_MODEL, SSM_GROUPS, SSM_STATE, SSM_GROUP
    a_im0 = math.pi * jnp.arange(P, dtype=f32)
    log_lo, log_hi = math.log(0.001), math.log(0.1)
    return {
        'x': nrm(ks[0], (BATCH, SEQ, D), 1.0),
        'c': nrm(ks[1], (BATCH, D), 1.0),
        'ctx': nrm(ks[2], (BATCH, CTX_LEN, D), 1.0),
        'c_ctx': nrm(ks[3], (D,), 1.0),
        'w_mod': nrm(ks[4], (DEPTH, D, N_MOD * D), 0.5 * D ** -0.5),
        'b_mod': nrm(ks[5], (DEPTH, N_MOD * D), 0.02),
        'norm_g': 1.0 + nrm(ks[6], (DEPTH, 3, D), 0.02),
        'ffn_w_in': nrm(ks[7], (DEPTH, 2, D, 2 * D_FF), D ** -0.5),
        'ffn_w_out': nrm(ks[8], (DEPTH, 2, D_FF, D), D_FF ** -0.5),
        'w_in': nrm(ks[9], (DEPTH, D, IN_WIDTH), D ** -0.5),
        'w_out': nrm(ks[10], (DEPTH, MIX_WIDTH, D), MIX_WIDTH ** -0.5),
        'ssm_a_re': -0.5 + nrm(ks[11], (DEPTH, 2, G, P), 0.01),
        'ssm_a_im': a_im0 + nrm(ks[12], (DEPTH, 2, G, P), 0.01),
        'ssm_log_dt': log_lo + (log_hi - log_lo) * jax.random.uniform(ks[13], (DEPTH, 2, G), f32),
        'ssm_b_re': nrm(ks[14], (DEPTH, 2, G, P, H), (2 * H) ** -0.5),
        'ssm_b_im': nrm(ks[15], (DEPTH, 2, G, P, H), (2 * H) ** -0.5),
        'ssm_c_re': nrm(ks[16], (DEPTH, 2, G, H, P), (2 * P) ** -0.5),
        'ssm_c_im': nrm(ks[17], (DEPTH, 2, G, H, P), (2 * P) ** -0.5),
        'ssm_d': nrm(ks[18], (DEPTH, G, H), 1.0),
        'w_glu': nrm(ks[19], (DEPTH, SSM_WIDTH, SSM_WIDTH), SSM_WIDTH ** -0.5),
        'b_glu': nrm(ks[20], (DEPTH, SSM_WIDTH), 0.02),
        'lam_q': nrm(ks[21], (DEPTH, 2, DIFF_HEAD_DIM), 0.1),
        'lam_k': nrm(ks[22], (DEPTH, 2, DIFF_HEAD_DIM), 0.1),
        'subln_g': 1.0 + nrm(ks[23], (DEPTH, 2 * DIFF_HEAD_DIM), 0.02),
        'final_g': 1.0 + nrm(ks[24], (D,), 0.02),
    }


def reference(x, c, ctx, c_ctx, w_mod, b_mod, norm_g, ffn_w_in, ffn_w_out, w_in, w_out,
              ssm_a_re, ssm_a_im, ssm_log_dt, ssm_b_re, ssm_b_im, ssm_c_re, ssm_c_im, ssm_d,
              w_glu, b_glu, lam_q, lam_k, subln_g, final_g):
    B, L, _ = x.shape
    rows = L // GRID_W
    cos, sin = axial_rope_tables(rows)
    silu_c = jax.nn.silu(c)
    silu_cc = jax.nn.silu(c_ctx)
    for l in range(DEPTH):
        update_ctx = l < DEPTH - 1
        lam_init = 0.8 - 0.6 * math.exp(-0.3 * l)
        mod_lat = (silu_c @ w_mod[l] + b_mod[l]).reshape(B, 1, N_MOD, D_MODEL)
        mod_ctx = (silu_cc @ w_mod[l] + b_mod[l]).reshape(1, 1, N_MOD, D_MODEL)
        x = x + 0.5 * mod_lat[:, :, 2] * swiglu(adaln(x, norm_g[l, 0], mod_lat, 0),
                                                ffn_w_in[l, 0], ffn_w_out[l, 0])
        ctx = ctx + 0.5 * mod_ctx[:, :, 2] * swiglu(adaln(ctx, norm_g[l, 0], mod_ctx, 0),
                                                    ffn_w_in[l, 0], ffn_w_out[l, 0])
        y_lat, y_ctx = hybrid_mixer(adaln(x, norm_g[l, 1], mod_lat, 1),
                                    adaln(ctx, norm_g[l, 1], mod_ctx, 1),
                                    cos, sin, w_in[l], w_out[l], ssm_a_re[l], ssm_a_im[l],
                                    ssm_log_dt[l], ssm_b_re[l], ssm_b_im[l], ssm_c_re[l],
                                    ssm_c_im[l], ssm_d[l], w_glu[l], b_glu[l], lam_q[l], lam_k[l],
                                    subln_g[l], lam_init, update_ctx)
        x = x + mod_lat[:, :, 5] * y_lat
        x = x + 0.5 * mod_lat[:, :, 8] * swiglu(adaln(x, norm_g[l, 2], mod_lat, 2),
                                                ffn_w_in[l, 1], ffn_w_out[l, 1])
        if update_ctx:
            ctx = ctx + mod_ctx[:, :, 5] * y_ctx
            ctx = ctx + 0.5 * mod_ctx[:, :, 8] * swiglu(adaln(ctx, norm_g[l, 2], mod_ctx, 2),
                                                        ffn_w_in[l, 1], ffn_w_out[l, 1])
    return rms_norm(x, final_g)
```

```cpp
#include <hip/hip_runtime.h>
#include <hip/hip_cooperative_groups.h>
#include <cstdio>
#include <cstdint>
namespace cg = cooperative_groups;
namespace pg8 {
#define PG8_LAS __attribute__((address_space(3)))
typedef unsigned short bf16_t;
typedef short bf16x8 __attribute__((ext_vector_type(8)));
typedef float f32x4 __attribute__((ext_vector_type(4)));
typedef unsigned u32x4 __attribute__((ext_vector_type(4)));
constexpr int BM = 256, BK = 64, HALF = 128, HTB = HALF * BK * 2  , STAGE_BYTES = 8 * HTB, NXCD = 8, WGM = 8;

__host__ __device__ __forceinline__ int lds_byte(int r, int c) { const int st = (r >> 4) * 2 + (c >> 5), rr = r & 15, cc = c & 31, ob = rr * 64 + cc * 2; return st * 1024 + (ob ^ (((ob >> 9) & 1) << 5)); }
__host__ __device__ __forceinline__ void stage_rc(int b, int& R, int& C) { const int st = b / 1024, sb = b % 1024, swz = sb ^ (((sb >> 9) & 1) << 5); R = (st >> 1) * 16 + swz / 64; C = (st & 1) * 32 + (swz % 64) / 2; }
__host__ __device__ __forceinline__ int perm32(int rho) { const int n = rho >> 4, i = rho & 15; return 8 * (i >> 2) + 4 * n + (i & 3); }

struct Unit { int pm, pn; };
struct Gemm { const bf16_t* A; const bf16_t* Bt; int M, N, K; };

__device__ __forceinline__ unsigned cvt_pk_bf16(float lo, float hi) { unsigned r; asm volatile("v_cvt_pk_bf16_f32 %0, %1, %2" : "=v"(r) : "v"(lo), "v"(hi)); return r; }
typedef float f32x2 __attribute__((ext_vector_type(2)));
typedef unsigned u32x2 __attribute__((ext_vector_type(2)));
constexpr int ROWS_B = 8448, TILES_B = 33, NROWS = 8 * ROWS_B;

struct TileOrder {
    int nM, nN, nwg, G, c, lat;
    __device__ __forceinline__ void init(int nM_, int nN_, int G_, int c_, int lat_) { nM = nM_; nN = nN_; nwg = nM_ * nN_; G = G_; c = c_; lat = lat_; }
    __device__ __forceinline__ bool next(int i, Unit& u) const {
        const long L = (long)i * G + c; if (L >= nwg) return false;
        int wgid = (int)L; { const int q = nwg / NXCD, r = nwg % NXCD, xcd = wgid % NXCD, off = wgid / NXCD; wgid = (xcd < r ? xcd * (q + 1) : r * (q + 1) + (xcd - r) * q) + off; }
        const int nig = WGM * nN, gid = wgid / nig, fm = gid * WGM, gsz = (nM - fm) < WGM ? (nM - fm) : WGM;
        const int lm = fm + ((wgid % nig) % gsz); u.pn = (wgid % nig) / gsz; u.pm = lat ? (lm >> 5) * TILES_B + (lm & 31) : lm; return true;
    }
    __device__ __forceinline__ void a_ready(const Unit&) const {}
    __device__ __forceinline__ void done(const Unit&) const {}
};

__device__ __forceinline__ float fast_sigmoid(float z) { return __builtin_amdgcn_rcpf(1.0f + __builtin_amdgcn_exp2f(-1.4426950408889634f * z)); }
__device__ __forceinline__ float bf_lo(unsigned w) { return __uint_as_float(w << 16); }
__device__ __forceinline__ float bf_hi(unsigned w) { return __uint_as_float(w & 0xffff0000u); }

struct EpiSwiglu {
    static constexpr bool PERM = true, AFTER_DRAIN = false;
    bf16_t* O; int ldc; const float* rss; const float* bias;
    __device__ __forceinline__ void operator()(const f32x4 (&acc)[2][2][4][2], const Unit& u, int wr, int wc, int fr, int fq) const {
        const int row0 = u.pm * BM + wr * 64 + fr, col0 = u.pn * HALF + wc * 32 + 8 * fq;
        f32x4 bv[2][2];
#pragma unroll
        for (int bj = 0; bj < 2; ++bj)
#pragma unroll
            for (int n = 0; n < 2; ++n) bv[bj][n] = rss ? *(const f32x4*)(bias + (u.pm / TILES_B) * 5632 + u.pn * BM + bj * HALF + wc * 32 + 8 * fq + 4 * n) : (f32x4){0.f, 0.f, 0.f, 0.f};
#pragma unroll
        for (int ai = 0; ai < 2; ++ai)
#pragma unroll
            for (int m = 0; m < 4; ++m) {
                bf16_t* rowp = O + (size_t)(row0 + ai * HALF + m * 16) * ldc + col0;
                float v[8];
                const float rstd = rss ? 1.0f / sqrtf(rss[row0 + ai * HALF + m * 16] * (1.0f / 1024.0f) + 1e-6f) : 1.0f;
#pragma unroll
                for (int n = 0; n < 2; ++n)
#pragma unroll
                    for (int e = 0; e < 4; ++e) { const float gt = acc[ai][0][m][n][e] * rstd + bv[0][n][e], up = acc[ai][1][m][n][e] * rstd + bv[1][n][e]; v[4 * n + e] = gt * fast_sigmoid(gt) * up; }
                u32x4 w; w.x = cvt_pk_bf16(v[0], v[1]); w.y = cvt_pk_bf16(v[2], v[3]); w.z = cvt_pk_bf16(v[4], v[5]); w.w = cvt_pk_bf16(v[6], v[7]);
                *(u32x4*)rowp = w;
            }
    }
};

struct EpiResid {
    static constexpr bool PERM = true, AFTER_DRAIN = false;
    const float* res_lat; const float* res_ctx; float* out_lat; float* out_ctx; const float* mod; int modoff; float scale;
    __device__ __forceinline__ void operator()(const f32x4 (&acc)[2][2][4][2], const Unit& u, int wr, int wc, int fr, int fq) const {
        const int b = u.pm / TILES_B, jt = u.pm - b * TILES_B;
        const float* rb; float* ob; const float* gv;
        if (jt < 32) { const size_t o = ((size_t)b * 8192 + (size_t)jt * 256) * 1024; rb = res_lat + o; ob = out_lat + o; gv = mod + b * 9216 + modoff; }
        else { const size_t o = (size_t)b * 256 * 1024; rb = res_ctx + o; ob = out_ctx + o; gv = mod + 8 * 9216 + modoff; }
        const int rl = wr * 64 + fr, col0 = u.pn * BM + wc * 32 + 8 * fq;
        f32x4 g[2][2];
#pragma unroll
        for (int bj = 0; bj < 2; ++bj)
#pragma unroll
            for (int n = 0; n < 2; ++n) g[bj][n] = *(const f32x4*)(gv + col0 + bj * HALF + 4 * n) * scale;
#pragma unroll
        for (int ai = 0; ai < 2; ++ai)
#pragma unroll
            for (int m = 0; m < 4; ++m) { const size_t ro = (size_t)(rl + ai * HALF + m * 16) * 1024 + col0;
#pragma unroll
                for (int bj = 0; bj < 2; ++bj)
#pragma unroll
                    for (int n = 0; n < 2; ++n) { const size_t p = ro + bj * HALF + 4 * n; const f32x4 x = *(const f32x4*)(rb + p); *(f32x4*)(ob + p) = x + g[bj][n] * acc[ai][bj][m][n]; } }
    }
};

struct EpiResidNorm {
    static constexpr bool PERM = true, AFTER_DRAIN = false;
    const float* res_lat; const float* res_ctx; float* out_lat; float* out_ctx; const float* mod; int gateoff; int half_gate; const float* ng; int scaleoff; bf16_t* XNo; float* rss;
    __device__ __forceinline__ void operator()(const f32x4 (&acc)[2][2][4][2], const Unit& u, int wr, int wc, int fr, int fq) const {
        const int b = u.pm / TILES_B, jt = u.pm - b * TILES_B;
        const float* rb; float* ob; const float* mv;
        if (jt < 32) { const size_t o = ((size_t)b * 8192 + (size_t)jt * 256) * 1024; rb = res_lat + o; ob = out_lat + o; mv = mod + b * 9216; }
        else { const size_t o = (size_t)b * 256 * 1024; rb = res_ctx + o; ob = out_ctx + o; mv = mod + 8 * 9216; }
        const int rl = wr * 64 + fr, col0 = u.pn * BM + wc * 32 + 8 * fq;
        const float scale = half_gate ? 0.5f : 1.0f;
        float q[2][4];
#pragma unroll
        for (int ai = 0; ai < 2; ++ai)
#pragma unroll
            for (int m = 0; m < 4; ++m) q[ai][m] = 0.f;
#pragma unroll
        for (int bj = 0; bj < 2; ++bj) {
            const int c = col0 + bj * HALF;
            const f32x4 g0 = *(const f32x4*)(mv + gateoff + c) * scale, g1 = *(const f32x4*)(mv + gateoff + c + 4) * scale;
            const f32x4 gs0 = *(const f32x4*)(ng + c) * (*(const f32x4*)(mv + scaleoff + c) + 1.0f), gs1 = *(const f32x4*)(ng + c + 4) * (*(const f32x4*)(mv + scaleoff + c + 4) + 1.0f);
#pragma unroll
            for (int ai = 0; ai < 2; ++ai)
#pragma unroll
                for (int m = 0; m < 4; ++m) { const int rr = rl + ai * HALF + m * 16; const size_t p = (size_t)rr * 1024 + c; const size_t prow = (size_t)u.pm * BM + rr;
                    const f32x4 y0 = *(const f32x4*)(rb + p) + g0 * acc[ai][bj][m][0], y1 = *(const f32x4*)(rb + p + 4) + g1 * acc[ai][bj][m][1];
                    *(f32x4*)(ob + p) = y0; *(f32x4*)(ob + p + 4) = y1;
                    q[ai][m] += (y0[0] * y0[0] + y0[1] * y0[1]) + (y0[2] * y0[2] + y0[3] * y0[3]) + (y1[0] * y1[0] + y1[1] * y1[1]) + (y1[2] * y1[2] + y1[3] * y1[3]);
                    const f32x4 z0 = y0 * gs0, z1 = y1 * gs1;
                    u32x4 w; w.x = cvt_pk_bf16(z0[0], z0[1]); w.y = cvt_pk_bf16(z0[2], z0[3]); w.z = cvt_pk_bf16(z1[0], z1[1]); w.w = cvt_pk_bf16(z1[2], z1[3]);
                    *(u32x4*)(XNo + prow * 1024 + c) = w; }
        }
#pragma unroll
        for (int ai = 0; ai < 2; ++ai)
#pragma unroll
            for (int m = 0; m < 4; ++m) { float t = q[ai][m]; t += __shfl_xor(t, 16); t += __shfl_xor(t, 32);
                if (fq == 0) __hip_atomic_fetch_add((__attribute__((address_space(1))) float*)(rss + (size_t)u.pm * BM + rl + ai * HALF + m * 16), t, __ATOMIC_RELAXED, __HIP_MEMORY_SCOPE_AGENT); }
    }
};

struct EpiInproj {
    static constexpr bool PERM = true, AFTER_DRAIN = false;
    bf16_t* U; bf16_t* Q; bf16_t* K; bf16_t* V; const float* rope; const float* rss; const float* bias;
    __device__ __forceinline__ void operator()(const f32x4 (&acc)[2][2][4][2], const Unit& u, int wr, int wc, int fr, int fq) const {
        const int sec = u.pn >> 1, jt = u.pm % TILES_B;
        bf16_t* base = sec == 0 ? U : sec == 1 ? Q : sec == 2 ? K : V;
        const bool dorope = (sec == 1 || sec == 2) && jt < 32;
        const float qs = sec == 1 ? 0.125f * 1.4426950408889634f : 1.0f;
        const int col0 = (u.pn & 1) * BM + wc * 32 + 8 * fq, axis = wc & 1;
        const float* bp = bias + (jt < 32 ? u.pm / TILES_B : 8) * 2048 + u.pn * BM + wc * 32 + 8 * fq;
        f32x4 bv[2][2];
#pragma unroll
        for (int bj = 0; bj < 2; ++bj)
#pragma unroll
            for (int n = 0; n < 2; ++n) bv[bj][n] = *(const f32x4*)(bp + bj * HALF + 4 * n);
#pragma unroll
        for (int ai = 0; ai < 2; ++ai)
#pragma unroll
            for (int m = 0; m < 4; ++m) {
                const int rowl = wr * 64 + fr + ai * HALF + m * 16;
                bf16_t* rowp = base + (size_t)(u.pm * BM + rowl) * 512 + col0;
                const float rstd = 1.0f / sqrtf(rss[u.pm * BM + rowl] * (1.0f / 1024.0f) + 1e-6f);
                f32x4 cs0 = {1.f, 0.f, 1.f, 0.f}, cs1 = {1.f, 0.f, 1.f, 0.f};
                if (dorope) { const int t = jt * 256 + rowl, pos = axis ? (t & 63) : (t >> 6); const float* rp = rope + (pos * 16 + 4 * fq) * 2; cs0 = *(const f32x4*)rp; cs1 = *(const f32x4*)(rp + 4); }
#pragma unroll
                for (int bj = 0; bj < 2; ++bj) {
                    const f32x4 a0 = acc[ai][bj][m][0] * rstd + bv[bj][0], a1 = acc[ai][bj][m][1] * rstd + bv[bj][1];
                    float o[8];
                    o[0] = a0[0] * cs0[0] - a0[1] * cs0[1]; o[1] = a0[1] * cs0[0] + a0[0] * cs0[1];
                    o[2] = a0[2] * cs0[2] - a0[3] * cs0[3]; o[3] = a0[3] * cs0[2] + a0[2] * cs0[3];
                    o[4] = a1[0] * cs1[0] - a1[1] * cs1[1]; o[5] = a1[1] * cs1[0] + a1[0] * cs1[1];
                    o[6] = a1[2] * cs1[2] - a1[3] * cs1[3]; o[7] = a1[3] * cs1[2] + a1[2] * cs1[3];
                    u32x4 w; w.x = cvt_pk_bf16(o[0] * qs, o[1] * qs); w.y = cvt_pk_bf16(o[2] * qs, o[3] * qs); w.z = cvt_pk_bf16(o[4] * qs, o[5] * qs); w.w = cvt_pk_bf16(o[6] * qs, o[7] * qs);
                    *(u32x4*)(rowp + bj * HALF) = w;
                }
            }
    }
};

struct EpiGlu {
    static constexpr bool PERM = true, AFTER_DRAIN = false;
    const bf16_t* Gb; const float* bglu; bf16_t* SA;
    __device__ __forceinline__ void operator()(const f32x4 (&acc)[2][2][4][2], const Unit& u, int wr, int wc, int fr, int fq) const {
        const int row0 = u.pm * BM + wr * 64 + fr, col0 = u.pn * BM + wc * 32 + 8 * fq;
        f32x4 bv[2][2];
#pragma unroll
        for (int bj = 0; bj < 2; ++bj)
#pragma unroll
            for (int n = 0; n < 2; ++n) bv[bj][n] = *(const f32x4*)(bglu + col0 + bj * HALF + 4 * n);
#pragma unroll
        for (int ai = 0; ai < 2; ++ai)
#pragma unroll
            for (int m = 0; m < 4; ++m) { const size_t row = (size_t)(row0 + ai * HALF + m * 16);
#pragma unroll
                for (int bj = 0; bj < 2; ++bj) {
                    const u32x4 gw = *(const u32x4*)(Gb + row * 512 + col0 + bj * HALF);
                    const f32x4 z0 = acc[ai][bj][m][0] + bv[bj][0], z1 = acc[ai][bj][m][1] + bv[bj][1];
                    u32x4 w;
                    w.x = cvt_pk_bf16(bf_lo(gw.x) * fast_sigmoid(z0[0]), bf_hi(gw.x) * fast_sigmoid(z0[1]));
                    w.y = cvt_pk_bf16(bf_lo(gw.y) * fast_sigmoid(z0[2]), bf_hi(gw.y) * fast_sigmoid(z0[3]));
                    w.z = cvt_pk_bf16(bf_lo(gw.z) * fast_sigmoid(z1[0]), bf_hi(gw.z) * fast_sigmoid(z1[1]));
                    w.w = cvt_pk_bf16(bf_lo(gw.w) * fast_sigmoid(z1[2]), bf_hi(gw.w) * fast_sigmoid(z1[3]));
                    *(u32x4*)(SA + row * 1024 + col0 + bj * HALF) = w;
                } }
    }
};

template <class Epi, class Sched, bool ALIGN_EPI = false, bool SP2 = false>
__device__ __forceinline__ void gemm_phase(PG8_LAS unsigned char* lds, const Gemm g, const Sched& S, const Epi& E) {
    int tid_ = threadIdx.x; asm volatile("" : "+v"(tid_));
    const int tid = tid_, wid = __builtin_amdgcn_readfirstlane(tid >> 6), lane = tid & 63, wr = wid >> 2, wc = wid & 3, fr = lane & 15, fq = lane >> 4;
    const int K = g.K, nt = K / BK;
    unsigned voffA[2], voffB[2];
#pragma unroll
    for (int i = 0; i < 2; ++i) { int R, C; stage_rc(tid * 16 + i * 8192, R, C); const int Rb = Epi::PERM ? ((R & ~31) + perm32(R & 31)) : R;
        voffA[i] = (unsigned)(R * K + C) * 2u; voffB[i] = (unsigned)(Rb * K + C) * 2u; }
    const size_t kstep = (size_t)(BK * 2);
    const size_t hstep = (size_t)HALF * K * 2;
    const size_t tstep = 2 * hstep;
    const unsigned ldsw = (unsigned)wid * 1024u;
    const int aoff = lds_byte(wr * 64 + fr, fq * 8), boff = lds_byte(wc * 32 + fr, fq * 8);
#define PG8_SA(b, h) (((b) * 2 + (h)) * HTB)
#define PG8_SB(b, h) ((4 + (b) * 2 + (h)) * HTB)
#define PG8_STAGE(bufoff, gbase, voff) do { _Pragma("unroll") for (int _i = 0; _i < 2; ++_i) \
        __builtin_amdgcn_global_load_lds((const unsigned*)((const char*)(gbase) + (voff)[_i]), (PG8_LAS unsigned*)(lds + (bufoff) + ldsw + _i * 8192), 16, 0, 0); } while (0)
#define PG8_LDA(dst, b, h) do { _Pragma("unroll") for (int m = 0; m < 4; ++m) _Pragma("unroll") for (int k = 0; k < 2; ++k) dst[m][k] = *(const PG8_LAS bf16x8*)(lds + PG8_SA(b, h) + aoff + m * 2048 + k * 1024); } while (0)
#define PG8_LDB(dst, b, h) do { _Pragma("unroll") for (int n = 0; n < 2; ++n) _Pragma("unroll") for (int k = 0; k < 2; ++k) dst[n][k] = *(const PG8_LAS bf16x8*)(lds + PG8_SB(b, h) + boff + n * 2048 + k * 1024); } while (0)
#define PG8_MMA(ai, bj, At, Bt) do { __builtin_amdgcn_s_setprio(1); _Pragma("unroll") for (int m = 0; m < 4; ++m) _Pragma("unroll") for (int n = 0; n < 2; ++n) _Pragma("unroll") for (int k = 0; k < 2; ++k) \
        acc[ai][bj][m][n] = __builtin_amdgcn_mfma_f32_16x16x32_bf16(Bt[n][k], At[m][k], acc[ai][bj][m][n], 0, 0, 0); __builtin_amdgcn_s_setprio(0); } while (0)
#define PG8_WAIT_V(n) asm volatile("s_waitcnt vmcnt(" #n ")" ::: "memory")
#define PG8_WAIT_L(n) asm volatile("s_waitcnt lgkmcnt(" #n ")" ::: "memory")
#define PG8_BAR __builtin_amdgcn_s_barrier()
#define PG8_SCHED __builtin_amdgcn_sched_barrier(0)
    Unit cur, nxt; int ui = 0;
    if (!S.next(0, cur)) return;
    f32x4 acc[2][2][4][2];
#pragma unroll
    for (int a = 0; a < 2; ++a)
#pragma unroll
        for (int b = 0; b < 2; ++b)
#pragma unroll
            for (int m = 0; m < 4; ++m)
#pragma unroll
                for (int n = 0; n < 2; ++n) acc[a][b][m][n] = (f32x4){0.f, 0.f, 0.f, 0.f};
    bf16x8 At[4][2], B0[2][2], B1[2][2];
    const char* cA = (const char*)g.A + (size_t)cur.pm * tstep; const char* cB = (const char*)g.Bt + (size_t)cur.pn * tstep;
    S.a_ready(cur);
    if constexpr (SP2) {
        PG8_STAGE(PG8_SB(0, 0), cB, voffB); PG8_STAGE(PG8_SB(0, 1), cB + hstep, voffB); PG8_STAGE(PG8_SA(0, 0), cA, voffA); PG8_STAGE(PG8_SA(0, 1), cA + hstep, voffA);
        if (wr == 1) PG8_BAR;
        PG8_WAIT_V(2); PG8_BAR;
        PG8_STAGE(PG8_SB(1, 0), cB + kstep, voffB); PG8_STAGE(PG8_SA(1, 0), cA + kstep, voffA); PG8_STAGE(PG8_SB(1, 1), cB + hstep + kstep, voffB);
        PG8_WAIT_V(6); PG8_BAR;
    } else {
        PG8_STAGE(PG8_SB(0, 0), cB, voffB); PG8_STAGE(PG8_SA(0, 0), cA, voffA); PG8_STAGE(PG8_SB(0, 1), cB + hstep, voffB); PG8_STAGE(PG8_SA(0, 1), cA + hstep, voffA);
        if (wr == 1) PG8_BAR;
        PG8_WAIT_V(4); PG8_BAR;
        PG8_STAGE(PG8_SB(1, 0), cB + kstep, voffB); PG8_STAGE(PG8_SA(1, 0), cA + kstep, voffA); PG8_STAGE(PG8_SB(1, 1), cB + hstep + kstep, voffB);
        PG8_WAIT_V(6); PG8_BAR;
    }
    for (;;) {
        const bool has_next = S.next(ui + 1, nxt);
        const char* nA = has_next ? (const char*)g.A + (size_t)nxt.pm * tstep : cA; const char* nB = has_next ? (const char*)g.Bt + (size_t)nxt.pn * tstep : cB;
        for (int t = 0; t < nt; t += 2) {
            const bool last = (t == nt - 2);
            const char* a1 = cA + (size_t)(t + 1) * kstep;
            const char* a2 = last ? nA : cA + (size_t)(t + 2) * kstep; const char* b2 = last ? nB : cB + (size_t)(t + 2) * kstep;
            const char* a3 = a2 + kstep; const char* b3 = b2 + kstep;
            if (last && has_next) S.a_ready(nxt);
            if constexpr (SP2) {
            PG8_LDB(B0, 0, 0); PG8_LDB(B1, 0, 1); PG8_SCHED; PG8_LDA(At, 0, 0); PG8_STAGE(PG8_SA(1, 1), a1 + hstep, voffA);
            PG8_WAIT_V(8); PG8_WAIT_L(0); PG8_BAR; PG8_MMA(0, 0, At, B0); PG8_MMA(0, 1, At, B1); PG8_BAR; PG8_SCHED;
            PG8_LDA(At, 0, 1); PG8_STAGE(PG8_SB(0, 0), b2, voffB); PG8_STAGE(PG8_SB(0, 1), b2 + hstep, voffB); PG8_STAGE(PG8_SA(0, 0), a2, voffA);
            PG8_WAIT_V(8); PG8_WAIT_L(0); PG8_BAR; PG8_MMA(1, 0, At, B0); PG8_MMA(1, 1, At, B1); PG8_BAR; PG8_SCHED;
            PG8_LDB(B0, 1, 0); PG8_LDB(B1, 1, 1); PG8_SCHED; PG8_LDA(At, 1, 0); PG8_STAGE(PG8_SA(0, 1), a2 + hstep, voffA);
            PG8_WAIT_V(8); PG8_WAIT_L(0); PG8_BAR; PG8_MMA(0, 0, At, B0); PG8_MMA(0, 1, At, B1); PG8_BAR; PG8_SCHED;
            PG8_LDA(At, 1, 1); PG8_STAGE(PG8_SB(1, 0), b3, voffB); PG8_STAGE(PG8_SB(1, 1), b3 + hstep, voffB); PG8_STAGE(PG8_SA(1, 0), a3, voffA);
            PG8_WAIT_V(8); PG8_WAIT_L(0); PG8_BAR; PG8_MMA(1, 0, At, B0); PG8_MMA(1, 1, At, B1); PG8_BAR; PG8_SCHED;
            } else {
            PG8_LDB(B0, 0, 0); PG8_SCHED; PG8_LDA(At, 0, 0); PG8_STAGE(PG8_SA(1, 1), a1 + hstep, voffA);
            PG8_WAIT_L(8); PG8_BAR; PG8_WAIT_L(0); PG8_MMA(0, 0, At, B0); PG8_BAR; PG8_SCHED;
            PG8_LDB(B1, 0, 1); PG8_STAGE(PG8_SB(0, 0), b2, voffB);
            PG8_BAR; PG8_WAIT_L(0); PG8_MMA(0, 1, At, B1); PG8_BAR;
            PG8_LDA(At, 0, 1); PG8_STAGE(PG8_SA(0, 0), a2, voffA);
            PG8_BAR; PG8_WAIT_L(0); PG8_MMA(1, 0, At, B0); PG8_BAR; PG8_SCHED;
            PG8_STAGE(PG8_SB(0, 1), b2 + hstep, voffB);
            PG8_WAIT_V(6); PG8_BAR; PG8_MMA(1, 1, At, B1); PG8_BAR;
            PG8_LDB(B0, 1, 0); PG8_SCHED; PG8_LDA(At, 1, 0); PG8_STAGE(PG8_SA(0, 1), a2 + hstep, voffA);
            PG8_WAIT_L(8); PG8_BAR; PG8_WAIT_L(0); PG8_MMA(0, 0, At, B0); PG8_BAR; PG8_SCHED;
            PG8_LDB(B1, 1, 1); PG8_STAGE(PG8_SB(1, 0), b3, voffB);
            PG8_BAR; PG8_WAIT_L(0); PG8_MMA(0, 1, At, B1); PG8_BAR;
            PG8_LDA(At, 1, 1); PG8_STAGE(PG8_SA(1, 0), a3, voffA);
            PG8_BAR; PG8_WAIT_L(0); PG8_MMA(1, 0, At, B0); PG8_BAR; PG8_SCHED;
            PG8_STAGE(PG8_SB(1, 1), b3 + hstep, voffB);
            PG8_WAIT_V(6); PG8_BAR; PG8_MMA(1, 1, At, B1); PG8_BAR;
            }
        }
        if constexpr (ALIGN_EPI) { if (wr == 0) PG8_BAR; }
        if constexpr (!Epi::AFTER_DRAIN) { E(acc, cur, wr, wc, fr, fq); S.done(cur); }
        if (!has_next) break;
#pragma unroll
        for (int a = 0; a < 2; ++a)
#pragma unroll
            for (int b = 0; b < 2; ++b)
#pragma unroll
                for (int m = 0; m < 4; ++m)
#pragma unroll
                    for (int n = 0; n < 2; ++n) acc[a][b][m][n] = (f32x4){0.f, 0.f, 0.f, 0.f};
        cur = nxt; cA = nA; cB = nB; ++ui;
        if constexpr (ALIGN_EPI) { if (wr == 1) PG8_BAR; }
    }
    PG8_WAIT_V(0);
    if constexpr (!ALIGN_EPI) { if (wr == 0) PG8_BAR; }
    PG8_BAR;
    if constexpr (Epi::AFTER_DRAIN) { E.fused(acc, cur, wr, wc, fr, fq, lds, wid, lane); S.done(cur); }
#undef PG8_SA
#undef PG8_SB
#undef PG8_STAGE
#undef PG8_LDA
#undef PG8_LDB
#undef PG8_MMA
#undef PG8_WAIT_V
#undef PG8_WAIT_L
#undef PG8_BAR
#undef PG8_SCHED
}
}

namespace attn {
typedef unsigned short bf16_t;
using bf16x8 = __attribute__((ext_vector_type(8))) short;
using s16x4  = __attribute__((ext_vector_type(4))) short;
using f32x16 = __attribute__((ext_vector_type(16))) float;
using u32x4  = __attribute__((ext_vector_type(4))) unsigned;
constexpr int NW = 8, QBLK = 32, KVBLK = 64;
constexpr float QSCALE = 0.125f * 1.4426950408889634f;
constexpr int LDQ = 512, LDK = 512, LDV = 512, LDO = 512;
constexpr int SHM_V = KVBLK * 128 * 2, SHM_K = KVBLK * 64 * 2, SHM_ATTN = 2 * SHM_V + 2 * SHM_K + NW * 64 * 4;
#define KSWZ64(row, colB) ((row) * 128 + ((colB) ^ ((((row) >> 1) & 7) << 4)))
#define SBAR() __builtin_amdgcn_sched_barrier(0)
__device__ __forceinline__ int crow(int r, int hi) { return (r & 3) + 8 * (r >> 2) + 4 * hi; }
__device__ __forceinline__ unsigned cvtpk(float lo, float hi) { unsigned r; asm volatile("v_cvt_pk_bf16_f32 %0, %1, %2" : "=v"(r) : "v"(lo), "v"(hi)); return r; }
constexpr float THR2 = 11.5f;
template <bool FIRST>
__device__ __forceinline__ void partialSM(f32x16& p0, f32x16& p1, float& m_reg, float& alpha) {
  if (!FIRST) { if (__builtin_expect(__any(m_reg != 0.f), 0)) {
#pragma unroll
      for (int r = 0; r < 16; ++r) { p0[r] -= m_reg; p1[r] -= m_reg; } } }
  float a = fmaxf(fmaxf(p0[0], p0[1]), p1[0]), b = fmaxf(fmaxf(p0[2], p0[3]), p1[1]); a = fmaxf(fmaxf(a, p1[2]), p1[3]);
#pragma unroll
  for (int r = 4; r < 16; r += 4) { a = fmaxf(fmaxf(a, p0[r]), p0[r + 1]); b = fmaxf(fmaxf(b, p0[r + 2]), p0[r + 3]); a = fmaxf(fmaxf(a, p1[r]), p1[r + 1]); b = fmaxf(fmaxf(b, p1[r + 2]), p1[r + 3]); }
  float pmax = fmaxf(a, b);
  { auto rr = __builtin_amdgcn_permlane32_swap(__float_as_uint(pmax), __float_as_uint(pmax), false, false);
    pmax = fmaxf(__uint_as_float(rr[0]), __uint_as_float(rr[1])); }
  alpha = 1.f;
  if (FIRST) {
    if (__builtin_expect(__any(fabsf(pmax) > THR2), 0)) { const float dl = fabsf(pmax) > THR2 ? pmax : 0.f; m_reg = dl;
#pragma unroll
      for (int r = 0; r < 16; ++r) { p0[r] -= dl; p1[r] -= dl; } }
  } else {
    if (__builtin_expect(__any(pmax > THR2), 0)) { const float dl = fmaxf(pmax, 0.f); m_reg += dl;
#pragma unroll
      for (int r = 0; r < 16; ++r) { p0[r] -= dl; p1[r] -= dl; }
      alpha = __builtin_amdgcn_exp2f(-dl); }
  }
#pragma unroll
  for (int r = 0; r < 16; ++r) p0[r] = __builtin_amdgcn_exp2f(p0[r]);
}
__device__ __forceinline__ void finishSM(f32x16& p0, f32x16& p1, bf16x8& pa0, bf16x8& pa1, bf16x8& pa2, bf16x8& pa3) {
#pragma unroll
  for (int r = 0; r < 16; ++r) p1[r] = __builtin_amdgcn_exp2f(p1[r]);
#define PK4(P, BASE, OUT) do { unsigned a0 = cvtpk(P[BASE + 0], P[BASE + 1]), a1 = cvtpk(P[BASE + 2], P[BASE + 3]);   \
    unsigned b0 = cvtpk(P[BASE + 4], P[BASE + 5]), b1 = cvtpk(P[BASE + 6], P[BASE + 7]);                              \
    auto r0 = __builtin_amdgcn_permlane32_swap(a0, b0, false, false); auto r1 = __builtin_amdgcn_permlane32_swap(a1, b1, false, false); \
    u32x4 w = {r0[0], r1[0], r0[1], r1[1]}; OUT = *reinterpret_cast<bf16x8*>(&w); } while (0)
  PK4(p0, 0, pa0); PK4(p0, 8, pa1); PK4(p1, 0, pa2); PK4(p1, 8, pa3);
#undef PK4
}
__device__ __forceinline__ void qkt(f32x16& p0, f32x16& p1, const char* Ks, const bf16x8* qr, int r32, int hi) {
  p0 = f32x16{}; p1 = f32x16{};
#pragma unroll
  for (int d0 = 0; d0 < 4; ++d0) { const int cb = (d0 * 16 + hi * 8) * 2;
    bf16x8 b0 = *reinterpret_cast<const bf16x8*>(Ks + KSWZ64(r32, cb));
    bf16x8 b1 = *reinterpret_cast<const bf16x8*>(Ks + KSWZ64(32 + r32, cb));
    p0 = __builtin_amdgcn_mfma_f32_32x32x16_bf16(b0, qr[d0], p0, 0, 0, 0);
    p1 = __builtin_amdgcn_mfma_f32_32x32x16_bf16(b1, qr[d0], p1, 0, 0, 0); }
}
__device__ __forceinline__ int v_st(int k, int c) { const int kk = (k & ~0xC) | ((k & 4) << 1) | ((k & 8) >> 1); return ((kk >> 3) * 4 + (c >> 5)) * 512 + ((kk & 7) * 32 + (c & 31)) * 2; }
__device__ __forceinline__ int v_rd_base(int lane) { return ((lane & 3) << 3) | (((lane >> 2) & 3) << 6) | (((lane >> 4) & 1) << 5) | (((lane >> 5) & 1) << 8); }
constexpr int v_rd_off(int d0, int ks, int half) { return d0 * 512 + ks * 4096 + half * 2048; }
template <int OFF> __device__ __forceinline__ s16x4 tr_read(int vb) {
  s16x4 r; asm volatile("ds_read_b64_tr_b16 %0, %1 offset:%2" : "=&v"(r) : "v"(vb), "i"(OFF) : "memory"); return r;
}
template <int D0> __device__ __forceinline__ void pv_one(f32x16& od, int vb, bf16x8 pa0, bf16x8 pa1, bf16x8 pa2, bf16x8 pa3) {
  const s16x4 l0 = tr_read<v_rd_off(D0, 0, 0)>(vb), h0 = tr_read<v_rd_off(D0, 0, 1)>(vb), l1 = tr_read<v_rd_off(D0, 1, 0)>(vb), h1 = tr_read<v_rd_off(D0, 1, 1)>(vb);
  const s16x4 l2 = tr_read<v_rd_off(D0, 2, 0)>(vb), h2 = tr_read<v_rd_off(D0, 2, 1)>(vb), l3 = tr_read<v_rd_off(D0, 3, 0)>(vb), h3 = tr_read<v_rd_off(D0, 3, 1)>(vb);
  asm volatile("s_waitcnt lgkmcnt(0)" ::: "memory"); SBAR();
#define PK(L, H) (bf16x8){L[0], L[1], L[2], L[3], H[0], H[1], H[2], H[3]}
  od = __builtin_amdgcn_mfma_f32_32x32x16_bf16(pa0, PK(l0, h0), od, 0, 0, 0);
  od = __builtin_amdgcn_mfma_f32_32x32x16_bf16(pa1, PK(l1, h1), od, 0, 0, 0);
  od = __builtin_amdgcn_mfma_f32_32x32x16_bf16(pa2, PK(l2, h2), od, 0, 0, 0);
  od = __builtin_amdgcn_mfma_f32_32x32x16_bf16(pa3, PK(l3, h3), od, 0, 0, 0);
#undef PK
}
__device__ __forceinline__ void pv_d0(f32x16* o, f32x16& osum, int vb, bf16x8 pa0, bf16x8 pa1, bf16x8 pa2, bf16x8 pa3) {
  { const bf16x8 ones = {16256, 16256, 16256, 16256, 16256, 16256, 16256, 16256};
    osum = __builtin_amdgcn_mfma_f32_32x32x16_bf16(pa0, ones, osum, 0, 0, 0); osum = __builtin_amdgcn_mfma_f32_32x32x16_bf16(pa1, ones, osum, 0, 0, 0);
    osum = __builtin_amdgcn_mfma_f32_32x32x16_bf16(pa2, ones, osum, 0, 0, 0); osum = __builtin_amdgcn_mfma_f32_32x32x16_bf16(pa3, ones, osum, 0, 0, 0); }
  pv_one<0>(o[0], vb, pa0, pa1, pa2, pa3); pv_one<1>(o[1], vb, pa0, pa1, pa2, pa3); pv_one<2>(o[2], vb, pa0, pa1, pa2, pa3); pv_one<3>(o[3], vb, pa0, pa1, pa2, pa3);
}
template <int COMP>
__device__ __forceinline__ void body(const bf16_t* __restrict__ Qb, const bf16_t* __restrict__ Kh, const bf16_t* __restrict__ Vh, float* Ob, bf16_t* __restrict__ SAo, float lam, const float* __restrict__ sg, int seq, char* lds) {
  int tid_ = threadIdx.x; asm volatile("" : "+v"(tid_));
  const int tid = tid_, wid = tid >> 6, lane = tid & 63, r32 = lane & 31, hi = lane >> 5;
  char* V_lds = lds; char* K_lds = lds + 4 * SHM_V;
  float* ws = (float*)(lds + 4 * SHM_V + 4 * SHM_K) + wid * 64; float* al_l = ws + 32;
  float m_reg = 0.f; f32x16 o[4] = {}; f32x16 osum = {}; bf16x8 qr[4];
  const bf16_t* Qw = Qb + (long)(wid * QBLK + r32) * LDQ + hi * 8;
#pragma unroll
  for (int d0 = 0; d0 < 4; ++d0) qr[d0] = *reinterpret_cast<const bf16x8*>(Qw + d0 * 16);
  const int sr = tid >> 4, sc = (tid & 15) * 8, vst0 = v_st(sr, sc), vst1 = v_st(32 + sr, sc);
  const int ksr = tid >> 3, ksc = (tid & 7) * 8, kst = KSWZ64(ksr, ksc * 2);
  const int vb0 = (int)(uintptr_t)V_lds + v_rd_base(lane);
  bf16x8 rvs0, rvs1, rks0;
#define SLOAD(k0) do { rvs0 = *reinterpret_cast<const bf16x8*>(&Vh[(long)((k0) + sr) * LDV + sc]); rvs1 = *reinterpret_cast<const bf16x8*>(&Vh[(long)((k0) + 32 + sr) * LDV + sc]); \
    rks0 = *reinterpret_cast<const bf16x8*>(&Kh[(long)((k0) + ksr) * LDK + ksc]); } while (0)
#define SWRITE(slot) do { *(bf16x8*)(V_lds + (slot) * SHM_V + vst0) = rvs0; *(bf16x8*)(V_lds + (slot) * SHM_V + vst1) = rvs1; *(bf16x8*)(K_lds + (slot) * SHM_K + kst) = rks0; } while (0)
#define RESC(a) do { if (__any((a) < 1.f)) { if (hi == 0) al_l[r32] = (a); asm volatile("s_waitcnt lgkmcnt(0)" ::: "memory"); \
    _Pragma("unroll") for (int r = 0; r < 16; ++r) { const float f_ = al_l[crow(r, hi)]; osum[r] *= f_; _Pragma("unroll") for (int d = 0; d < 4; ++d) o[d][r] *= f_; } } } while (0)
  f32x16 pA0, pA1, pB0, pB1; float alA, alB; bf16x8 pa0, pa1, pa2, pa3; const int NT = seq / KVBLK;
  SLOAD(0); SWRITE(0); SLOAD(KVBLK); __syncthreads();
  qkt(pA0, pA1, K_lds, qr, r32, hi); partialSM<true>(pA0, pA1, m_reg, alA);
  SWRITE(1); SLOAD(2 * KVBLK); __syncthreads();
  const int grp = __builtin_amdgcn_readfirstlane(wid >> 2);
#define ITER(X0, X1, Y0, Y1, alX, i) do { const int scur = (i) & 3, sp = ((i) - 1) & 3, sn = ((i) + 1) & 3; \
    SBAR(); qkt(X0, X1, K_lds + scur * SHM_K, qr, r32, hi); \
    finishSM(Y0, Y1, pa0, pa1, pa2, pa3); SBAR(); \
    if (grp) { SWRITE(sn); if ((i) + 2 < NT) SLOAD(((i) + 2) * KVBLK); __syncthreads(); } \
    pv_d0(o, osum, vb0 + sp * SHM_V, pa0, pa1, pa2, pa3); partialSM<false>(X0, X1, m_reg, alX); \
    RESC(alX); \
    if (!grp) { SWRITE(sn); if ((i) + 2 < NT) SLOAD(((i) + 2) * KVBLK); __syncthreads(); } } while (0)
  int i = 1;
  for (; i + 1 < NT; i += 2) {
    ITER(pB0, pB1, pA0, pA1, alB, i);
    ITER(pA0, pA1, pB0, pB1, alA, i + 1);
  }
  { const int scur = i & 3, sp = (i - 1) & 3;
  SBAR(); qkt(pB0, pB1, K_lds + scur * SHM_K, qr, r32, hi);
  finishSM(pA0, pA1, pa0, pa1, pa2, pa3); SBAR();
  pv_d0(o, osum, vb0 + sp * SHM_V, pa0, pa1, pa2, pa3); partialSM<false>(pB0, pB1, m_reg, alB);
  RESC(alB);
  finishSM(pB0, pB1, pa0, pa1, pa2, pa3); SBAR();
  pv_d0(o, osum, vb0 + scur * SHM_V, pa0, pa1, pa2, pa3); }
#undef ITER
  float rli[16];
#pragma unroll
  for (int r = 0; r < 16; ++r) rli[r] = __builtin_amdgcn_rcpf(osum[r]);
  float* Ow = Ob + (long)(wid * QBLK) * LDO;
  if (COMP == 0) {
#pragma unroll
    for (int r = 0; r < 16; ++r) { const int orow = crow(r, hi);
#pragma unroll
      for (int d0 = 0; d0 < 4; ++d0) Ow[(long)orow * LDO + d0 * 32 + r32] = o[d0][r] * rli[r]; }
  } else {
    float ss[16];
#pragma unroll
    for (int r = 0; r < 16; ++r) { const int orow = crow(r, hi); float q = 0.f;
#pragma unroll
      for (int d0 = 0; d0 < 4; ++d0) { const float d = Ow[(long)orow * LDO + d0 * 32 + r32] - lam * (o[d0][r] * rli[r]); o[d0][r] = d; q = fmaf(d, d, q); }
      ss[r] = q; }
#pragma unroll
    for (int r = 0; r < 16; ++r) { float q = ss[r]; q += __shfl_xor(q, 1); q += __shfl_xor(q, 2); q += __shfl_xor(q, 4); q += __shfl_xor(q, 8); q += __shfl_xor(q, 16);
      ss[r] = 1.0f / sqrtf(q * (1.0f / 128.0f) + 1e-6f); }
    float gsub[4];
#pragma unroll
    for (int d0 = 0; d0 < 4; ++d0) gsub[d0] = sg[d0 * 32 + r32] * 0.8f;
    bf16_t* Sw = SAo + (long)(wid * QBLK) * 1024;
#pragma unroll
    for (int r = 0; r < 16; ++r) { const int orow = crow(r, hi);
#pragma unroll
      for (int d0 = 0; d0 < 4; ++d0) { const float y = o[d0][r] * ss[r] * gsub[d0]; unsigned u = __builtin_bit_cast(unsigned, y); u = (u + 0x7fffu + ((u >> 16) & 1u)) >> 16;
        Sw[(long)orow * 1024 + d0 * 32 + r32] = (bf16_t)u; } }
  }
  asm volatile("s_waitcnt vmcnt(0) lgkmcnt(0)" ::: "memory"); __syncthreads();
#undef SLOAD
#undef SWRITE
#undef RESC
}
#undef SBAR
}

#define GAS __attribute__((address_space(1)))
#define LAS __attribute__((address_space(3)))
typedef unsigned short bf16;
typedef unsigned v4u __attribute__((ext_vector_type(4)));
typedef float f32x4 __attribute__((ext_vector_type(4)));
typedef float f32x16 __attribute__((ext_vector_type(16)));
typedef short bf16x8 __attribute__((ext_vector_type(8)));

constexpr int NWAVES = 8, NTHR = 512;
constexpr int DM = 1024, DFF = 2816, NB = 8, SEQ = 8192, CTXL = 256, NMODV = 9 * DM;
constexpr int ROWS_B = 8448, TILES_B = 33, NROWS = NB * ROWS_B;

constexpr size_t MiB = 1u << 20;
constexpr size_t WS_CTL = 0, CTL_ZERO_BYTES = 1 * MiB;
constexpr size_t WS_MOD = 4096;
constexpr size_t WS_BIAS1 = 352 * 1024, WS_BIAS2 = 640 * 1024;
constexpr size_t WS_RSS1 = 69 * MiB, WS_RSS2 = 69 * MiB + 512 * 1024;
constexpr size_t WS_BAR = 512 * 1024, BAR_ZERO_BYTES = 16384;
constexpr size_t WS_ABAR = 1 * MiB, WS_APOW = WS_ABAR + 32768, WS_BBT = WS_APOW + 32768, WS_CM = WS_BBT + 262144, WS_ROPE = WS_CM + 262144;
constexpr size_t WS_W1A = 2 * MiB, WS_W1B = 13 * MiB, WS_W2A = 19 * MiB, WS_W2B = 30 * MiB, WS_WIN = 36 * MiB, WS_WOUT = 40 * MiB, WS_WGLU = 42 * MiB;
constexpr size_t WS_E = 43 * MiB, WS_HIN = 52 * MiB, WS_XC = 61 * MiB;
constexpr size_t WS_XN = 70 * MiB;
constexpr size_t WS_ACT = 202 * MiB;
constexpr size_t WS_OATT = WS_ACT, WS_G = WS_ACT + 264 * MiB;
constexpr size_t WS_U = 565 * MiB, WS_Q = 631 * MiB, WS_K = 697 * MiB, WS_V = 763 * MiB, WS_END = 829 * MiB;
static_assert(WS_ROPE + 16384 <= WS_W1A && WS_W1A + (size_t)5632 * 1024 * 2 <= WS_W1B && WS_W1B + (size_t)1024 * 2816 * 2 <= WS_W2A && WS_W2A + (size_t)5632 * 1024 * 2 <= WS_W2B, "ws map 1");
static_assert(WS_W2B + (size_t)1024 * 2816 * 2 <= WS_WIN && WS_WIN + (size_t)2048 * 1024 * 2 <= WS_WOUT && WS_WOUT + (size_t)1024 * 1024 * 2 <= WS_WGLU && WS_WGLU + 512 * 512 * 2 <= WS_E, "ws map 2");
static_assert(WS_E + (size_t)8 * 33 * 64 * 64 * 8 <= WS_HIN && WS_HIN + (size_t)8 * 33 * 64 * 64 * 8 <= WS_XC && WS_XC + (size_t)2048 * 1024 * 4 <= WS_XN, "ws map 3");
static_assert(WS_XN + (size_t)NROWS * 1024 * 2 <= WS_ACT && WS_ACT + (size_t)NROWS * 2816 * 2 <= WS_U && WS_G + (size_t)NROWS * 512 * 2 <= WS_U && WS_OATT + (size_t)NROWS * 1024 * 4 <= WS_G, "ws map 4");
static_assert(WS_U + (size_t)NROWS * 512 * 2 <= WS_Q && WS_V + (size_t)NROWS * 512 * 2 <= WS_END, "ws map 5");

constexpr int LDS_BYTES = 139264;

#define LDS_WAIT() asm volatile("s_waitcnt lgkmcnt(0)" ::: "memory")
__device__ __forceinline__ unsigned f2bf(float f) { unsigned u = __builtin_bit_cast(unsigned, f); return (u + 0x7fffu + ((u >> 16) & 1u)) >> 16; }
__device__ __forceinline__ unsigned pk2(float lo, float hi) { return f2bf(lo) | (f2bf(hi) << 16); }
__device__ __forceinline__ float wave_sum(float v) {
#pragma unroll
    for (int o = 1; o < 64; o <<= 1) v += __shfl_xor(v, o);
    return v;
}

__device__ __forceinline__ double dexp(double x) {
    const double n = __builtin_rint(x * 1.4426950408889634074);
    const double r = __builtin_fma(-n, 1.9082149292705877e-10, __builtin_fma(-n, 0.693147180369123816490, x));
    double p = 1.0 / 87178291200.0;
    p = p * r + 1.0 / 6227020800.0; p = p * r + 1.0 / 479001600.0; p = p * r + 1.0 / 39916800.0; p = p * r + 1.0 / 3628800.0; p = p * r + 1.0 / 362880.0; p = p * r + 1.0 / 40320.0;
    p = p * r + 1.0 / 5040.0; p = p * r + 1.0 / 720.0; p = p * r + 1.0 / 120.0; p = p * r + 1.0 / 24.0; p = p * r + 1.0 / 6.0; p = p * r + 0.5; p = p * r + 1.0; p = p * r + 1.0;
    const long long e = (long long)n + 1023; const double s = __builtin_bit_cast(double, (unsigned long long)e << 52);
    return p * s;
}
__device__ __forceinline__ void dsincos(double y, double& s, double& c) {
    const double k = __builtin_rint(y * 0.15915494309189533577);
    double r = __builtin_fma(-k, 6.283185307179586232, y); r = __builtin_fma(-k, 2.4492935982947064e-16, r);
    const double q = r * 0.125, q2 = q * q;
    double sp = -1.0 / 1307674368000.0; sp = sp * q2 + 1.0 / 6227020800.0; sp = sp * q2 - 1.0 / 39916800.0; sp = sp * q2 + 1.0 / 362880.0; sp = sp * q2 - 1.0 / 5040.0; sp = sp * q2 + 1.0 / 120.0; sp = sp * q2 - 1.0 / 6.0; sp = sp * q2 + 1.0;
    double cp = 1.0 / 20922789888000.0; cp = cp * q2 - 1.0 / 87178291200.0; cp = cp * q2 + 1.0 / 479001600.0; cp = cp * q2 - 1.0 / 3628800.0; cp = cp * q2 + 1.0 / 40320.0; cp = cp * q2 - 1.0 / 720.0; cp = cp * q2 + 1.0 / 24.0; cp = cp * q2 - 0.5; cp = cp * q2 + 1.0;
    double ss = sp * q, cc = cp;
#pragma unroll
    for (int i = 0; i < 3; ++i) { const double s2 = 2.0 * ss * cc, c2 = cc * cc - ss * ss; ss = s2; cc = c2; }
    s = ss; c = cc;
}

__device__ __forceinline__ void transpose_item(const float* W, int K, int N, bf16* WT, int mode, LAS float* scr, int item, int lane) {
    const int nblk = N / 32, kb = item / nblk, nb = item % nblk, k0 = 64 * kb, n0 = 32 * nb;
    { const float* wp = W + (size_t)(k0 + (lane >> 5)) * N + n0 + (lane & 31); float v[32];
#pragma unroll
      for (int i = 0; i < 32; ++i) v[i] = wp[(size_t)(2 * i) * N];
#pragma unroll
      for (int i = 0; i < 32; ++i) scr[(2 * i + (lane >> 5)) * 33 + (lane & 31)] = v[i]; }
    LDS_WAIT(); asm volatile("" ::: "memory");
    const int c = lane & 7;
#pragma unroll
    for (int j = 0; j < 4; ++j) { const int n = (lane >> 3) + 8 * j; const LAS float* s = scr + (8 * c) * 33 + n;
        const int src = n0 + n; int drow = src;
        if (mode == 1) { const int up = src >= DFF ? 1 : 0, ff = src - up * DFF; drow = (ff >> 7) * 256 + up * 128 + (ff & 127); }
        else if (mode == 2) { if (src >= 512 && src < 1536) drow = n0 + 2 * (n & 15) + (n >> 4); }
        v4u o; o.x = pk2(s[0 * 33], s[1 * 33]); o.y = pk2(s[2 * 33], s[3 * 33]); o.z = pk2(s[4 * 33], s[5 * 33]); o.w = pk2(s[6 * 33], s[7 * 33]);
        *(v4u*)(WT + (size_t)drow * K + k0 + 8 * c) = o; }
    LDS_WAIT(); asm volatile("" ::: "memory");
}

template <int MODE>
__device__ __forceinline__ void norm_rows16(const float* src, bf16* dstb, float* dstf, const float* g, const float* shift, const float* scale, int lane) {
    f32x4 gs[4], sh[4];
#pragma unroll
    for (int j = 0; j < 4; ++j) { const int cidx = 4 * lane + 256 * j; const f32x4 gv = *(const f32x4*)(g + cidx);
        if (MODE == 0) { const f32x4 sc = *(const f32x4*)(scale + cidx); gs[j] = gv * (sc + 1.0f); sh[j] = *(const f32x4*)(shift + cidx); } else { gs[j] = gv; sh[j] = (f32x4){0.f, 0.f, 0.f, 0.f}; } }
#pragma unroll 2
    for (int r = 0; r < 16; ++r) {
        const f32x4* xr = (const f32x4*)(src + (size_t)r * DM) + lane;
        f32x4 v[4]; float s = 0.f;
#pragma unroll
        for (int j = 0; j < 4; ++j) { v[j] = xr[64 * j]; s += (v[j].x * v[j].x + v[j].y * v[j].y) + (v[j].z * v[j].z + v[j].w * v[j].w); }
        const float rstd = 1.0f / sqrtf(wave_sum(s) * (1.0f / DM) + 1e-6f);
        if (MODE == 0) {
            unsigned long long* o8 = (unsigned long long*)(dstb + (size_t)r * DM) + lane;
#pragma unroll
            for (int j = 0; j < 4; ++j) { const f32x4 y = v[j] * rstd * gs[j] + sh[j]; o8[64 * j] = (unsigned long long)pk2(y.x, y.y) | ((unsigned long long)pk2(y.z, y.w) << 32); }
        } else {
            f32x4* of = (f32x4*)(dstf + (size_t)r * DM) + lane;
#pragma unroll
            for (int j = 0; j < 4; ++j) of[64 * j] = v[j] * rstd * gs[j];
        }
    }
}

__device__ __forceinline__ int crow16(int r, int hi) { return (r & 3) + 8 * (r >> 2) + 4 * hi; }
typedef float f32x2_t __attribute__((ext_vector_type(2))); typedef __bf16 bf16x2_t __attribute__((ext_vector_type(2)));
__device__ __forceinline__ unsigned cvtpk2(float lo, float hi) { f32x2_t v = {lo, hi}; bf16x2_t b = __builtin_convertvector(v, bf16x2_t); return __builtin_bit_cast(unsigned, b); }

template <bool FULL>
__device__ __forceinline__ void s5_unit(LAS unsigned char* lds, int b, int c, int gq, const bf16* U, const float2* ABAR, const bf16* BBT, const bf16* CM,
                                        const float2* HIN, float2* E, const float* dskip, bf16* G, float* YF) {
    int tid_ = threadIdx.x; asm volatile("" : "+v"(tid_));
    const int lane = tid_ & 63, wave = __builtin_amdgcn_readfirstlane(tid_ >> 6);
    const int g = gq * 8 + wave, hi = lane >> 5, r32 = lane & 31;
    LAS unsigned* scr = (LAS unsigned*)(lds + wave * 8704);
    const size_t r0 = (size_t)b * ROWS_B + (size_t)c * 256;
    const bf16* ubase = U + (r0 + r32) * 512 + g * 16 + hi * 8;
    const int ch = lane & 15; const float dv = dskip[g * 16 + ch];
    const size_t obase = (r0 + (lane >> 4) * 4) * 512 + g * 16 + ch;
    LAS unsigned short* yt_l = (LAS unsigned short*)(lds + 69632 + wave * 8192) + ((lane >> 4) * 4) * 16 + ch;
#pragma unroll
    for (int dir = 0; dir < 2; ++dir) {
        const int dg = dir * 32 + g;
        const float2 ab = ABAR[dg * 64 + lane];
        bf16x8 bb[4], cm[4];
#pragma unroll
        for (int blk = 0; blk < 4; ++blk) bb[blk] = *(const bf16x8*)(BBT + ((size_t)(dg * 4 + blk) * 32 + r32) * 16 + hi * 8);
        if (FULL) {
#pragma unroll
            for (int ks = 0; ks < 4; ++ks) cm[ks] = *(const bf16x8*)(CM + ((size_t)dg * 16 + (lane & 15)) * 128 + ks * 32 + (lane >> 4) * 8);
        }
        const size_t sidx = ((((size_t)b * 33 + c) * 32 + g) * 2 + dir) * 64 + lane;
        float hr = 0.f, hm = 0.f;
        if (FULL) { const float2 h0 = HIN[sidx]; hr = h0.x; hm = h0.y; }
#define S5_TB(q) (dir == 0 ? ((q) < 8 ? (q) * 32 : 224) : ((q) < 8 ? (7 - (q)) * 32 : 0))
#define S5_LDU(dst, q) do { _Pragma("unroll") for (int mt = 0; mt < 2; ++mt) _Pragma("unroll") for (int j = 0; j < 4; ++j) dst[mt][j] = U[obase + (size_t)(S5_TB(q) + mt * 16 + j) * 512]; } while (0)
        bf16x8 a_0 = *(const bf16x8*)(ubase + (size_t)S5_TB(0) * 512), a_1 = *(const bf16x8*)(ubase + (size_t)S5_TB(1) * 512), a_2 = *(const bf16x8*)(ubase + (size_t)S5_TB(2) * 512);
        unsigned short u_0[2][4], u_1[2][4], u_2[2][4];
        if (FULL && dir == 1) { S5_LDU(u_0, 0); S5_LDU(u_1, 1); S5_LDU(u_2, 2); }
#pragma unroll 1
        for (int sb = 0; sb < 8; ++sb) {
            const int tb = dir == 0 ? sb * 32 : (7 - sb) * 32;
            const bf16x8 a = a_0; a_0 = a_1; a_1 = a_2; a_2 = *(const bf16x8*)(ubase + (size_t)S5_TB(sb + 3) * 512);
            unsigned short uvv[2][4];
            if (FULL && dir == 1) {
#pragma unroll
                for (int mt = 0; mt < 2; ++mt)
#pragma unroll
                    for (int j = 0; j < 4; ++j) { uvv[mt][j] = u_0[mt][j]; u_0[mt][j] = u_1[mt][j]; u_1[mt][j] = u_2[mt][j]; }
                S5_LDU(u_2, sb + 3);
            }
            const f32x16 z = {};
#pragma unroll
            for (int hf = 0; hf < 2; ++hf) {
                const f32x16 c0 = __builtin_amdgcn_mfma_f32_32x32x16_bf16(a, bb[hf], z, 0, 0, 0), c2 = __builtin_amdgcn_mfma_f32_32x32x16_bf16(a, bb[2 + hf], z, 0, 0, 0);
#pragma unroll
                for (int r = 0; r < 16; ++r) { const int row = crow16(r, hi); scr[row * 68 + hf * 32 + r32] = cvtpk2(c0[r], c2[r]); }
            }
            LDS_WAIT(); asm volatile("" ::: "memory");
#pragma unroll
            for (int half = 0; half < 2; ++half) {
                unsigned v[16];
#pragma unroll
                for (int q = 0; q < 16; ++q) { const int t = dir == 0 ? half * 16 + q : 31 - (half * 16 + q); v[q] = scr[t * 68 + lane]; }
#pragma unroll
                for (int q = 0; q < 16; ++q) { const int t = dir == 0 ? half * 16 + q : 31 - (half * 16 + q);
                    const float re = __uint_as_float(v[q] << 16), im = __uint_as_float(v[q] & 0xffff0000u);
                    const float nr = fmaf(ab.x, hr, fmaf(-ab.y, hm, re)), ni = fmaf(ab.x, hm, fmaf(ab.y, hr, im)); hr = nr; hm = ni;
                    if (FULL) scr[t * 68 + lane] = cvtpk2(hr, hm); }
                asm volatile("" ::: "memory");
            }
            if (FULL) {
                LDS_WAIT(); asm volatile("" ::: "memory");
                f32x4 yt[2];
#pragma unroll
                for (int mt = 0; mt < 2; ++mt) { yt[mt] = (f32x4){0.f, 0.f, 0.f, 0.f};
#pragma unroll
                    for (int ks = 0; ks < 4; ++ks) { const bf16x8 hf8 = *(const LAS bf16x8*)((const LAS unsigned char*)scr + (mt * 16 + (lane & 15)) * 272 + ks * 64 + (lane >> 4) * 16);
                        yt[mt] = __builtin_amdgcn_mfma_f32_16x16x32_bf16(hf8, cm[ks], yt[mt], 0, 0, 0); } }
#pragma unroll
                for (int mt = 0; mt < 2; ++mt)
#pragma unroll
                    for (int j = 0; j < 4; ++j) { LAS unsigned short* yp = yt_l + (tb + mt * 16 + j) * 16;
                        if (dir == 0) *yp = (unsigned short)f2bf(yt[mt][j]);
                        else { const float uv = __uint_as_float((unsigned)uvv[mt][j] << 16); const float yv = __uint_as_float((unsigned)*yp << 16) + yt[mt][j] + dv * uv;
                            const float zz = 1.5957691216057308f * (yv + 0.044715f * yv * yv * yv); *yp = (unsigned short)f2bf(yv * pg8::fast_sigmoid(zz)); } }
                LDS_WAIT(); asm volatile("" ::: "memory");
            }
        }
        if (!FULL) E[sidx] = make_float2(hr, hm);
    }
    if (FULL) {
        LDS_WAIT(); asm volatile("" ::: "memory");
        const LAS unsigned char* yb = (const LAS unsigned char*)(lds + 69632 + wave * 8192);
#pragma unroll
        for (int it = 0; it < 8; ++it) { const int row = it * 32 + (lane >> 1), hf = lane & 1;
            const v4u w = *(const LAS v4u*)(yb + row * 32 + hf * 16);
            *(v4u*)(G + (r0 + row) * 512 + g * 16 + hf * 8) = w; }
        LDS_WAIT(); asm volatile("" ::: "memory");
    }
}

__device__ __forceinline__ void cmulf(float ar, float ai, float br, float bi, float& cr, float& ci) { cr = ar * br - ai * bi; ci = ar * bi + ai * br; }
__device__ __forceinline__ void s5_unit_a(int b, int c, int gq, const bf16* U, const float2* ABAR, const bf16* BBT, float2* E) {
    int tid_ = threadIdx.x; asm volatile("" : "+v"(tid_));
    const int lane = tid_ & 63, wave = __builtin_amdgcn_readfirstlane(tid_ >> 6);
    const int g = gq * 8 + wave, hi = lane >> 5, r32 = lane & 31;
    const size_t r0 = (size_t)b * ROWS_B + (size_t)c * 256;
    const bf16* ubase = U + (r0 + r32) * 512 + g * 16 + hi * 8;
#pragma unroll
    for (int dir = 0; dir < 2; ++dir) {
        const int dg = dir * 32 + g;
        bf16x8 bb[4];
#pragma unroll
        for (int blk = 0; blk < 4; ++blk) bb[blk] = *(const bf16x8*)(BBT + ((size_t)(dg * 4 + blk) * 32 + r32) * 16 + hi * 8);
        float wr[2][16], wi[2][16], a32r[2], a32i[2];
#pragma unroll
        for (int hf = 0; hf < 2; ++hf) {
            const float2 ab = ABAR[dg * 64 + hf * 32 + r32];
            float qr[4], qi[4], orr[4], oi[4];
            qr[0] = 1.f; qi[0] = 0.f; qr[1] = ab.x; qi[1] = ab.y; cmulf(qr[1], qi[1], ab.x, ab.y, qr[2], qi[2]); cmulf(qr[2], qi[2], ab.x, ab.y, qr[3], qi[3]);
            float a4r, a4i; cmulf(qr[2], qi[2], qr[2], qi[2], a4r, a4i);
            orr[0] = 1.f; oi[0] = 0.f; cmulf(a4r, a4i, a4r, a4i, orr[1], oi[1]); cmulf(orr[1], oi[1], orr[1], oi[1], orr[2], oi[2]); cmulf(orr[2], oi[2], orr[1], oi[1], orr[3], oi[3]);
            cmulf(orr[2], oi[2], orr[2], oi[2], a32r[hf], a32i[hf]);
            const bool use4 = dir == 0 ? (hi == 0) : (hi != 0);
            const float br = use4 ? a4r : 1.f, bi = use4 ? a4i : 0.f;
#pragma unroll
            for (int r = 0; r < 16; ++r) { const int jq = dir == 0 ? 3 - (r & 3) : (r & 3), jo = dir == 0 ? 3 - (r >> 2) : (r >> 2);
                float tr, ti; cmulf(qr[jq], qi[jq], orr[jo], oi[jo], tr, ti); cmulf(tr, ti, br, bi, wr[hf][r], wi[hf][r]); }
        }
        float hr[2] = {0.f, 0.f}, hm[2] = {0.f, 0.f};
        bf16x8 a_0 = *(const bf16x8*)(ubase + (size_t)(dir == 0 ? 0 : 224) * 512), a_1 = *(const bf16x8*)(ubase + (size_t)(dir == 0 ? 32 : 192) * 512);
#pragma unroll 1
        for (int sb = 0; sb < 8; ++sb) {
            const bf16x8 a = a_0; a_0 = a_1;
            { const int q = sb + 2 < 8 ? sb + 2 : 7; a_1 = *(const bf16x8*)(ubase + (size_t)(dir == 0 ? q * 32 : (7 - q) * 32) * 512); }
            const f32x16 z = {};
#pragma unroll
            for (int hf = 0; hf < 2; ++hf) {
                const f32x16 cre = __builtin_amdgcn_mfma_f32_32x32x16_bf16(a, bb[hf], z, 0, 0, 0), cim = __builtin_amdgcn_mfma_f32_32x32x16_bf16(a, bb[2 + hf], z, 0, 0, 0);
                float er = 0.f, ei = 0.f;
#pragma unroll
                for (int r = 0; r < 16; ++r) { er = fmaf(wr[hf][r], cre[r], fmaf(-wi[hf][r], cim[r], er)); ei = fmaf(wr[hf][r], cim[r], fmaf(wi[hf][r], cre[r], ei)); }
                er += __shfl_xor(er, 32); ei += __shfl_xor(ei, 32);
                const float nr = fmaf(a32r[hf], hr[hf], fmaf(-a32i[hf], hm[hf], er)), ni = fmaf(a32r[hf], hm[hf], fmaf(a32i[hf], hr[hf], ei));
                hr[hf] = nr; hm[hf] = ni;
            }
        }
        const size_t sidx = ((((size_t)b * 33 + c) * 32 + g) * 2 + dir) * 64 + lane;
        E[sidx] = hi ? make_float2(hr[1], hm[1]) : make_float2(hr[0], hm[0]);
    }
}

typedef GAS unsigned gu32;
#define RLX_AGENT __ATOMIC_RELAXED, __HIP_MEMORY_SCOPE_AGENT
#define XB_TMO      128
#define XB_XCNT(j)  (256  + 64 * (j))
#define XB_XSUB(j)  (1280 + 64 * (j))
#define XB_XGEN(j)  (2304 + 64 * (j))
#define XB_TOP      3328
#define XB_TOPGEN   3392
#define XCD_BAR_WORDS 3456
#define XB_SPIN_CAP (1u << 18)

__device__ __forceinline__ unsigned xb_ld(unsigned* p)              { return __hip_atomic_load(p, __ATOMIC_RELAXED, __HIP_MEMORY_SCOPE_AGENT); }
__device__ __forceinline__ unsigned xb_add(unsigned* p, unsigned v) { return __hip_atomic_fetch_add(p, v, __ATOMIC_RELAXED, __HIP_MEMORY_SCOPE_AGENT); }
__device__ __forceinline__ unsigned xb_xcc_id() { return (unsigned)__builtin_amdgcn_s_getreg((3 << 11) | 20) & 0xFu; }
#define XB_SPIN(cond, bar) do { unsigned _sp = 0; while (cond) { __builtin_amdgcn_s_sleep(1); \
    if ((++_sp & 255u) == 0u) { if (xb_ld(&(bar)[XB_TMO])) break; if (_sp > XB_SPIN_CAP) { atomicAdd(&(bar)[XB_TMO], 1u); break; } } } } while (0)

struct XcdBarrier {
    unsigned* bar; unsigned x;
    volatile LAS unsigned* st;
};

__device__ __forceinline__ XcdBarrier xcd_barrier_post(unsigned* bar, volatile LAS unsigned* st) {
    XcdBarrier b; b.bar = bar; b.x = xb_xcc_id(); b.st = st;
    if (threadIdx.x == 0) (void)xb_add(&bar[XB_XCNT(b.x)], 1u);
    return b;
}
__device__ __forceinline__ void xcd_barrier_complete(unsigned* bar, unsigned x, unsigned& nloc, unsigned& nx) {
    const unsigned G = gridDim.x * gridDim.y * gridDim.z;
    unsigned sum, cnt, mine, sp = 0u;
    for (;;) {
        sum = 0u; cnt = 0u; mine = 0u;
#pragma unroll
        for (unsigned j = 0; j < 16; ++j) { const unsigned c = xb_ld(&bar[XB_XCNT(j)]); sum += c; cnt += (c > 0u) ? 1u : 0u; mine = (j == x) ? c : mine; }
        if (sum == G) break;
        __builtin_amdgcn_s_sleep(1);
        if ((++sp & 255u) == 0u) { if (xb_ld(&bar[XB_TMO])) break; if (sp > XB_SPIN_CAP) { atomicAdd(&bar[XB_TMO], 1u); break; } }
    }
    nloc = mine > 0u ? mine : 1u; nx = cnt > 0u ? cnt : 1u;
}

__device__ __forceinline__ void xcd_barrier(const XcdBarrier& b) {
    asm volatile("s_waitcnt vmcnt(0)" ::: "memory");
    __syncthreads();
    if (threadIdx.x == 0) {
        unsigned* bar = b.bar;
        __builtin_amdgcn_s_waitcnt(0);
        unsigned nloc = b.st[0], nx = b.st[1];
        if (nloc == 0u) { xcd_barrier_complete(bar, b.x, nloc, nx); b.st[0] = nloc; b.st[1] = nx; }
        const unsigned old = xb_add(&bar[XB_XSUB(b.x)], 1u);
        const unsigned gen = old / nloc;
        if (old + 1u == (gen + 1u) * nloc) {
            __builtin_amdgcn_fence(__ATOMIC_RELEASE, "agent");
            asm volatile("s_waitcnt vmcnt(0)" ::: "memory");
            const unsigned og = xb_add(&bar[XB_TOP], 1u);
            const unsigned tg = og / nx;
            if (og + 1u == (tg + 1u) * nx) xb_add(&bar[XB_TOPGEN], 1u);
            else XB_SPIN(xb_ld(&bar[XB_TOPGEN]) == tg, bar);
            __builtin_amdgcn_fence(__ATOMIC_ACQUIRE, "agent");
            xb_add(&bar[XB_XGEN(b.x)], 1u);
            asm volatile("s_waitcnt vmcnt(0)" ::: "memory");
        } else {
            XB_SPIN(xb_ld(&bar[XB_XGEN(b.x)]) == gen, bar);
            __builtin_amdgcn_fence(__ATOMIC_ACQUIRE, "agent");
            asm volatile("s_waitcnt vmcnt(0)" ::: "memory");
        }
    }
    __syncthreads();
}

#ifndef PHMASK
#define PHMASK 0xFFFFF
#endif
#define PH(k) if ((PHMASK >> (k)) & 1)
struct Args { const float* in[25]; float* out; unsigned char* ws; };
__device__ __forceinline__ const float* karg(int i) {
    unsigned off = (unsigned)i * 8u; asm volatile("" : "+s"(off));
    return *(const float* const __attribute__((address_space(4)))*)((const char __attribute__((address_space(4)))*)__builtin_amdgcn_kernarg_segment_ptr() + off);
}

__global__ void __launch_bounds__(NTHR, 2) hymba_fwd(Args a) {
    extern __shared__ __attribute__((aligned(16))) unsigned char lds[];
    cg::grid_group grid = cg::this_grid();
    const int tid = threadIdx.x, lane = tid & 63, wave = __builtin_amdgcn_readfirstlane(tid >> 6);
    const int G = gridDim.x, bx = blockIdx.x;
    const int vcu = (G % 8 == 0) ? (bx % 8) * (G / 8) + bx / 8 : bx;
    const int gw = vcu * NWAVES + wave, NGW = G * NWAVES;
    LAS unsigned char* ldsl = (LAS unsigned char*)lds;
#define KIN(i) karg(i)
#define ws_p ((unsigned char*)karg(26))
#define out_p ((float*)karg(25))
#define x_in KIN(0)
#define cvec KIN(1)
#define ctx KIN(2)
#define c_ctx KIN(3)
#define w_mod KIN(4)
#define b_mod KIN(5)
#define norm_g KIN(6)
#define ffn_w_in KIN(7)
#define ffn_w_out KIN(8)
#define w_in KIN(9)
#define w_out KIN(10)
#define ssm_a_re KIN(11)
#define ssm_a_im KIN(12)
#define ssm_log_dt KIN(13)
#define ssm_b_re KIN(14)
#define ssm_b_im KIN(15)
#define ssm_c_re KIN(16)
#define ssm_c_im KIN(17)
#define ssm_d KIN(18)
#define w_glu KIN(19)
#define b_glu KIN(20)
#define lam_q KIN(21)
#define lam_k KIN(22)
#define subln_g KIN(23)
#define final_g KIN(24)
#define MISC ((float*)(ws_p + WS_CTL))
#define MOD ((float*)(ws_p + WS_MOD))
#define ABAR ((float2*)(ws_p + WS_ABAR))
#define APOW ((float2*)(ws_p + WS_APOW))
#define BBT ((bf16*)(ws_p + WS_BBT))
#define CM ((bf16*)(ws_p + WS_CM))
#define ROPE ((float*)(ws_p + WS_ROPE))
#define W1A ((bf16*)(ws_p + WS_W1A))
#define W1B ((bf16*)(ws_p + WS_W1B))
#define W2A ((bf16*)(ws_p + WS_W2A))
#define W2B ((bf16*)(ws_p + WS_W2B))
#define WIN ((bf16*)(ws_p + WS_WIN))
#define WOUT ((bf16*)(ws_p + WS_WOUT))
#define WGLU ((bf16*)(ws_p + WS_WGLU))
#define EST ((float2*)(ws_p + WS_E))
#define HIN ((float2*)(ws_p + WS_HIN))
#define XC ((float*)(ws_p + WS_XC))
#define XN ((bf16*)(ws_p + WS_XN))
#define SA ((bf16*)(ws_p + WS_XN))
#define ACT ((bf16*)(ws_p + WS_ACT))
#define OATT ((float*)(ws_p + WS_OATT))
#define GB ((bf16*)(ws_p + WS_G))
#define YFB ((float*)(ws_p + WS_OATT + 132 * MiB))
#define BIAS1 ((float*)(ws_p + WS_BIAS1))
#define BIAS2 ((float*)(ws_p + WS_BIAS2))
#define RSS1 ((float*)(ws_p + WS_RSS1))
#define RSS2 ((float*)(ws_p + WS_RSS2))
#define XN2 ((bf16*)(ws_p + WS_U))
#define UB ((bf16*)(ws_p + WS_U))
#define QB ((bf16*)(ws_p + WS_Q))
#define KB ((bf16*)(ws_p + WS_K))
#define VB ((bf16*)(ws_p + WS_V))
    (void)a;
    { volatile LAS unsigned* st0 = (volatile LAS unsigned*)(ldsl + 138240); if (tid < 4) st0[tid] = 0u; }
    __syncthreads();
    XcdBarrier xbar = xcd_barrier_post((unsigned*)(ws_p + WS_BAR), (volatile LAS unsigned*)(ldsl + 138240));
#define GSYNC() xcd_barrier(xbar)

    PH(0) {
        if (bx < 288) {
            LAS float* sl = (LAS float*)ldsl; LAS float* part = (LAS float*)(ldsl + 36864);
            for (int i = tid; i < 9 * DM; i += NTHR) { const float v = i < 8 * DM ? cvec[i] : c_ctx[i - 8 * DM]; sl[i] = v / (1.0f + __expf(-v)); }
            __syncthreads();
            for (int unit = bx; unit < 288; unit += G) {
                const int cl = tid & 31, kg = tid >> 5, k0 = kg * 64; const float* wp = w_mod + (size_t)k0 * NMODV + unit * 32 + cl;
                float acc[9];
#pragma unroll
                for (int i = 0; i < 9; ++i) acc[i] = 0.f;
#pragma unroll 4
                for (int kk = 0; kk < 64; kk += 4) {
                    const float w0 = wp[(size_t)(kk + 0) * NMODV], w1 = wp[(size_t)(kk + 1) * NMODV], w2 = wp[(size_t)(kk + 2) * NMODV], w3 = wp[(size_t)(kk + 3) * NMODV];
#pragma unroll
                    for (int i = 0; i < 9; ++i) { const f32x4 sv = *(const LAS f32x4*)(sl + i * DM + k0 + kk); acc[i] = fmaf(sv.x, w0, fmaf(sv.y, w1, fmaf(sv.z, w2, fmaf(sv.w, w3, acc[i])))); }
                }
#pragma unroll
                for (int i = 0; i < 9; ++i) part[(kg * 9 + i) * 32 + cl] = acc[i];
                __syncthreads();
                if (tid < 288) { const int i = tid >> 5; float sum = 0.f;
#pragma unroll
                    for (int k = 0; k < 16; ++k) sum += part[(k * 9 + i) * 32 + cl];
                    MOD[i * NMODV + unit * 32 + cl] = sum + b_mod[unit * 32 + cl]; }
                __syncthreads();
            }
        }
        __syncthreads();
        {
            LAS float* scr = (LAS float*)(ldsl + wave * 16384);
            constexpr int I_1A = (DM / 64) * (2 * DFF / 32), I_1B = (DFF / 64) * (DM / 32), I_IN = (DM / 64) * (2048 / 32), I_OUT = (DM / 64) * (DM / 32), I_GLU = (512 / 64) * (512 / 32);
            constexpr int NITEMS = 2 * I_1A + 2 * I_1B + I_IN + I_OUT + I_GLU;
            for (int it = gw; it < NITEMS; it += NGW) {
                int r = it;
                if (r < I_1A) { transpose_item(ffn_w_in, DM, 2 * DFF, W1A, 1, scr, r, lane); continue; } r -= I_1A;
                if (r < I_1A) { transpose_item(ffn_w_in + (size_t)DM * 2 * DFF, DM, 2 * DFF, W2A, 1, scr, r, lane); continue; } r -= I_1A;
                if (r < I_1B) { transpose_item(ffn_w_out, DFF, DM, W1B, 0, scr, r, lane); continue; } r -= I_1B;
                if (r < I_1B) { transpose_item(ffn_w_out + (size_t)DFF * DM, DFF, DM, W2B, 0, scr, r, lane); continue; } r -= I_1B;
                if (r < I_IN) { transpose_item(w_in, DM, 2048, WIN, 2, scr, r, lane); continue; } r -= I_IN;
                if (r < I_OUT) { transpose_item(w_out, DM, DM, WOUT, 0, scr, r, lane); continue; } r -= I_OUT;
                transpose_item(w_glu, 512, 512, WGLU, 0, scr, r, lane);
            }
        }
        const int gt = bx * NTHR + tid, NT_ALL = G * NTHR;
        for (int i = gt; i < 2 * 32 * 64; i += NT_ALL) {
            const int p = i & 63, dg = i >> 6;
            const double dt = dexp((double)ssm_log_dt[dg]), are = (double)ssm_a_re[i], aim = (double)ssm_a_im[i];
            double s1, c1, s2, c2; dsincos(dt * aim, s1, c1); dsincos(256.0 * dt * aim, s2, c2);
            const double mag = dexp(dt * are), mag2 = dexp(256.0 * dt * are);
            const double abr = mag * c1, abi = mag * s1;
            ABAR[i] = make_float2((float)abr, (float)abi); APOW[i] = make_float2((float)(mag2 * c2), (float)(mag2 * s2));
            const double zr = abr - 1.0, zi = abi, den = are * are + aim * aim;
            const double cr = (zr * are + zi * aim) / den, ci = (zi * are - zr * aim) / den;
            const float* bre = ssm_b_re + (size_t)i * 16; const float* bim = ssm_b_im + (size_t)i * 16;
            bf16* dre = BBT + ((size_t)(dg * 4 + (p >> 5)) * 32 + (p & 31)) * 16; bf16* dim = BBT + ((size_t)(dg * 4 + 2 + (p >> 5)) * 32 + (p & 31)) * 16;
#pragma unroll
            for (int h = 0; h < 16; ++h) { const double br = (double)bre[h], bi = (double)bim[h]; dre[h] = (bf16)f2bf((float)(cr * br - ci * bi)); dim[h] = (bf16)f2bf((float)(cr * bi + ci * br)); }
        }
        for (int i = gt; i < 2 * 32 * 16 * 64; i += NT_ALL) {
            const int p = i & 63, dgh = i >> 6;
            ((unsigned*)CM)[(size_t)dgh * 64 + p] = pk2(ssm_c_re[i], -ssm_c_im[i]);
        }
        for (int i = gt; i < 128 * 16; i += NT_ALL) {
            const int f = i & 15, pos = i >> 4;
            const double inv = dexp(-(double)f * (9.210340371976182736 / 16.0)); double s, c; dsincos((double)pos * inv, s, c);
            ROPE[2 * i] = (float)c; ROPE[2 * i + 1] = (float)s;
        }
        for (int i = gt; i < NROWS; i += NT_ALL) { RSS1[i] = 0.f; RSS2[i] = 0.f; }
        if (gt == 0) { float s0 = 0.f, s1 = 0.f; for (int d = 0; d < 64; ++d) { s0 += lam_q[d] * lam_k[d]; s1 += lam_q[64 + d] * lam_k[64 + d]; } MISC[0] = expf(s0) - expf(s1) + 0.2f; }
    }
    grid.sync();

#define NORM_PASS(SRC_LAT, SRC_CTX, NIDX, LATONLY) do { int tid_l = threadIdx.x; asm volatile("" : "+v"(tid_l)); const int lane_l = tid_l & 63, gw_l = vcu * NWAVES + __builtin_amdgcn_readfirstlane(tid_l >> 6); \
        for (int it = gw_l; it < NROWS / 16; it += NGW) { const int r0 = it * 16, pm = r0 >> 8, b = pm / TILES_B, jt = pm - b * TILES_B, rl = r0 & 255; \
            if ((LATONLY) && jt == 32) continue; \
            const float* src = jt < 32 ? (SRC_LAT) + ((size_t)b * SEQ + jt * 256 + rl) * DM : (SRC_CTX) + ((size_t)b * CTXL + rl) * DM; \
            const float* mv = MOD + (jt < 32 ? b : 8) * NMODV + 3 * (NIDX) * DM; \
            norm_rows16<0>(src, XN + (size_t)r0 * DM, nullptr, norm_g + (NIDX) * DM, mv, mv + DM, lane_l); } } while (0)

    PH(1) {
        if (bx < 240) {
            const bool isin = bx < 64; const int unit = isin ? bx : bx - 64, N = isin ? 2048 : 2 * DFF, soff = isin ? 3 * DM : 6 * DM;
            const float* W = isin ? w_in : ffn_w_in + (size_t)DM * 2 * DFF; float* BO = isin ? BIAS1 : BIAS2;
            LAS float* sl = (LAS float*)ldsl; LAS float* part = (LAS float*)(ldsl + 36864);
            for (int i = tid; i < 9 * DM; i += NTHR) sl[i] = MOD[(i >> 10) * NMODV + soff + (i & 1023)];
            __syncthreads();
            const int cl = tid & 31, kg = tid >> 5, k0 = kg * 64; const float* wp = W + (size_t)k0 * N + unit * 32 + cl;
            float acc[9];
#pragma unroll
            for (int i = 0; i < 9; ++i) acc[i] = 0.f;
#pragma unroll 4
            for (int kk = 0; kk < 64; kk += 4) {
                const float w0 = wp[(size_t)(kk + 0) * N], w1 = wp[(size_t)(kk + 1) * N], w2 = wp[(size_t)(kk + 2) * N], w3 = wp[(size_t)(kk + 3) * N];
#pragma unroll
                for (int i = 0; i < 9; ++i) { const f32x4 sv = *(const LAS f32x4*)(sl + i * DM + k0 + kk); acc[i] = fmaf(sv.x, w0, fmaf(sv.y, w1, fmaf(sv.z, w2, fmaf(sv.w, w3, acc[i])))); }
            }
#pragma unroll
            for (int i = 0; i < 9; ++i) part[(kg * 9 + i) * 32 + cl] = acc[i];
            __syncthreads();
            if (tid < 288) { const int i = tid >> 5; float sum = 0.f;
#pragma unroll
                for (int k = 0; k < 16; ++k) sum += part[(k * 9 + i) * 32 + cl];
                const int src = unit * 32 + cl; int drow = src;
                if (isin) { if (src >= 512 && src < 1536) drow = unit * 32 + 2 * (cl & 15) + (cl >> 4); }
                else { const int up = src >= DFF ? 1 : 0, ff = src - up * DFF; drow = (ff >> 7) * 256 + up * 128 + (ff & 127); }
                BO[i * N + drow] = sum; }
            __syncthreads();
        }
        NORM_PASS(x_in, ctx, 0, false);
    }
    GSYNC();
    PH(2) { pg8::Gemm g{XN, W1A, NROWS, 2 * DFF, DM}; pg8::TileOrder S; S.init(264, 22, G, bx, 0); pg8::EpiSwiglu E{ACT, DFF, nullptr, nullptr};
      pg8::gemm_phase<pg8::EpiSwiglu, pg8::TileOrder, true, true>(ldsl, g, S, E); }
    GSYNC();
    PH(3) { pg8::Gemm g{ACT, W1B, NROWS, DM, DFF}; pg8::TileOrder S; S.init(264, 4, G, bx, 0); pg8::EpiResidNorm E{x_in, ctx, out_p, XC, MOD, 2 * DM, 1, norm_g + DM, 4 * DM, XN, RSS1};
      pg8::gemm_phase<pg8::EpiResidNorm, pg8::TileOrder, true, true>(ldsl, g, S, E); }
    GSYNC();
    PH(5) { pg8::Gemm g{XN, WIN, NROWS, 2048, DM}; pg8::TileOrder S; S.init(264, 8, G, bx, 0); pg8::EpiInproj E{UB, QB, KB, VB, ROPE, RSS1, BIAS1};
      pg8::gemm_phase<pg8::EpiInproj, pg8::TileOrder, true, true>(ldsl, g, S, E); }
    GSYNC();
    PH(6) for (int un = vcu; un < 8 * 33 * 4; un += G) { const int gq = un & 3, bc = un >> 2, b = bc / 33, c = bc - b * 33;
        s5_unit_a(b, c, gq, UB, ABAR, BBT, EST); }
    GSYNC();
    PH(7) if (bx < 64) {
        const int i = bx * NTHR + tid;
        const int p = i & 63, dir = (i >> 6) & 1, g = (i >> 7) & 31, b = i >> 12;
        const float2 ap = APOW[(dir * 32 + g) * 64 + p];
#define SIDX(cc) (((((size_t)b * 33 + (cc)) * 32 + g) * 2 + dir) * 64 + p)
        float2 h = EST[SIDX(32)];
        if (dir == 0) { HIN[SIDX(0)] = h; for (int c = 0; c < 31; ++c) { const float2 e = EST[SIDX(c)]; const float nr = fmaf(ap.x, h.x, fmaf(-ap.y, h.y, e.x)), ni = fmaf(ap.x, h.y, fmaf(ap.y, h.x, e.y)); h = make_float2(nr, ni); HIN[SIDX(c + 1)] = h; } }
        else { HIN[SIDX(31)] = h; for (int c = 31; c > 0; --c) { const float2 e = EST[SIDX(c)]; const float nr = fmaf(ap.x, h.x, fmaf(-ap.y, h.y, e.x)), ni = fmaf(ap.x, h.y, fmaf(ap.y, h.x, e.y)); h = make_float2(nr, ni); HIN[SIDX(c - 1)] = h; } }
#undef SIDX
    }
    PH(8) {
        const float lam = MISC[0];
        for (int un = vcu; un < 8 * 4 * 32; un += G) {
            const int qb = un & 31, bh = un >> 5, b = bh >> 2, h = bh & 3;
            const size_t rb = (size_t)b * ROWS_B, rq = rb + (size_t)qb * 256;
            attn::body<0>(QB + rq * 512 + h * 128, KB + rb * 512 + h * 128, VB + rb * 512 + h * 128, OATT + rq * 512 + h * 128, nullptr, lam, subln_g, ROWS_B, (char*)lds);
            attn::body<1>(QB + rq * 512 + h * 128 + 64, KB + rb * 512 + h * 128 + 64, VB + rb * 512 + h * 128, OATT + rq * 512 + h * 128, SA + rq * 1024 + 512 + h * 128, lam, subln_g, ROWS_B, (char*)lds);
        }
    }
    GSYNC();
    PH(9) for (int un = vcu; un < 8 * 32 * 4; un += G) { const int gq = un & 3, bc = un >> 2, b = bc >> 5, c = bc & 31;
        s5_unit<true>(ldsl, b, c, gq, UB, ABAR, BBT, CM, HIN, EST, ssm_d, GB, YFB); }
    GSYNC();
    PH(10) { pg8::Gemm g{GB, WGLU, NROWS, 512, 512}; pg8::TileOrder S; S.init(256, 2, G, bx, 1); pg8::EpiGlu E{GB, b_glu, SA};
      pg8::gemm_phase<pg8::EpiGlu, pg8::TileOrder, true, true>(ldsl, g, S, E); }
    GSYNC();
    PH(12) { pg8::Gemm g{SA, WOUT, NROWS, DM, DM}; pg8::TileOrder S; S.init(256, 4, G, bx, 1); pg8::EpiResidNorm E{out_p, XC, out_p, XC, MOD, 5 * DM, 0, norm_g + 2 * DM, 7 * DM, XN2, RSS2};
      pg8::gemm_phase<pg8::EpiResidNorm, pg8::TileOrder, true, true>(ldsl, g, S, E); }
    GSYNC();
    PH(14) { pg8::Gemm g{XN2, W2A, NROWS, 2 * DFF, DM}; pg8::TileOrder S; S.init(256, 22, G, bx, 1); pg8::EpiSwiglu E{ACT, DFF, RSS2, BIAS2};
      pg8::gemm_phase<pg8::EpiSwiglu, pg8::TileOrder, true, true>(ldsl, g, S, E); }
    GSYNC();
    PH(15) { pg8::Gemm g{ACT, W2B, NROWS, DM, DFF}; pg8::TileOrder S; S.init(256, 4, G, bx, 1); pg8::EpiResid E{out_p, XC, out_p, XC, MOD, 8 * DM, 0.5f};
      pg8::gemm_phase<pg8::EpiResid, pg8::TileOrder, true, true>(ldsl, g, S, E); }
    GSYNC();
    PH(16) { int tid_l = threadIdx.x; asm volatile("" : "+v"(tid_l)); const int lane_l = tid_l & 63, gw_l = vcu * NWAVES + __builtin_amdgcn_readfirstlane(tid_l >> 6);
        for (int it = gw_l; it < NB * SEQ / 16; it += NGW) norm_rows16<1>(out_p + (size_t)it * 16 * DM, nullptr, out_p + (size_t)it * 16 * DM, final_g, nullptr, nullptr, lane_l); }
#undef NORM_PASS
}

extern "C" void kernel_launch(void* const* d_in, const int* in_sizes, int n_in, void* d_out, int out_size, void* d_ws, size_t ws_size, hipStream_t stream) {
    static int grid = 0;
    if (grid == 0) {
        if (n_in != 25 || in_sizes[0] != NB * SEQ * DM || out_size != NB * SEQ * DM || ws_size < WS_END) {
            fprintf(stderr, "kernel_launch: shape mismatch (n_in %d, in0 %d, out %d, ws %zu, need %zu); nothing launched\n", n_in, n_in > 0 ? in_sizes[0] : -1, out_size, ws_size, (size_t)WS_END); grid = -1; return; }
        int dev = 0, cus = 0, per_cu = 0;
        if (hipGetDevice(&dev) != hipSuccess || hipDeviceGetAttribute(&cus, hipDeviceAttributeMultiprocessorCount, dev) != hipSuccess) { grid = -1; return; }
        if (hipFuncSetAttribute((const void*)hymba_fwd, hipFuncAttributeMaxDynamicSharedMemorySize, LDS_BYTES) != hipSuccess) { fprintf(stderr, "kernel_launch: hipFuncSetAttribute failed\n"); grid = -1; return; }
        if (hipOccupancyMaxActiveBlocksPerMultiprocessor(&per_cu, (const void*)hymba_fwd, NTHR, LDS_BYTES) != hipSuccess || per_cu < 1) { fprintf(stderr, "kernel_launch: occupancy query says %d\n", per_cu); per_cu = 1; }
        (void)hipGetLastError();
        grid = cus * (per_cu > 1 ? 1 : per_cu);
        if (grid != 256) fprintf(stderr, "kernel_launch: grid %d (expected 256)\n", grid);
    }
    if (grid < 0) return;
    (void)hipMemsetAsync((char*)d_ws + WS_BAR, 0, BAR_ZERO_BYTES, stream);
    Args a{};
    for (int i = 0; i < 25; ++i) a.in[i] = (const float*)d_in[i];
    a.out = (float*)d_out; a.ws = (unsigned char*)d_ws;
    void* args[] = {&a};
    const hipError_t e = hipLaunchCooperativeKernel((const void*)hymba_fwd, dim3(grid), dim3(NTHR), args, LDS_BYTES, stream);
    if (e != hipSuccess) fprintf(stderr, "kernel_launch: cooperative launch failed: %s (grid %d)\n", hipGetErrorString(e), grid);
}
```

```cpp
#include <hip/hip_runtime.h>
#include <hip/hip_cooperative_groups.h>
#include <cstdio>
#include <cstdint>
namespace cg = cooperative_groups;
namespace pg8 {
#define PG8_LAS __attribute__((address_space(3)))
typedef unsigned short bf16_t;
typedef short bf16x8 __attribute__((ext_vector_type(8)));
typedef float f32x4 __attribute__((ext_vector_type(4)));
typedef unsigned u32x4 __attribute__((ext_vector_type(4)));
constexpr int BM = 256, BK = 64, HALF = 128, HTB = HALF * BK * 2  , STAGE_BYTES = 8 * HTB, NXCD = 8, WGM = 8;

__host__ __device__ __forceinline__ int lds_byte(int r, int c) { const int st = (r >> 4) * 2 + (c >> 5), rr = r & 15, cc = c & 31, ob = rr * 64 + cc * 2; return st * 1024 + (ob ^ (((ob >> 9) & 1) << 5)); }
__host__ __device__ __forceinline__ void stage_rc(int b, int& R, int& C) { const int st = b / 1024, sb = b % 1024, swz = sb ^ (((sb >> 9) & 1) << 5); R = (st >> 1) * 16 + swz / 64; C = (st & 1) * 32 + (swz % 64) / 2; }
__host__ __device__ __forceinline__ int perm32(int rho) { const int n = rho >> 4, i = rho & 15; return 8 * (i >> 2) + 4 * n + (i & 3); }

struct Unit { int pm, pn; };
struct Gemm { const bf16_t* A; const bf16_t* Bt; int M, N, K; };

__device__ __forceinline__ unsigned cvt_pk_bf16(float lo, float hi) { unsigned r; asm volatile("v_cvt_pk_bf16_f32 %0, %1, %2" : "=v"(r) : "v"(lo), "v"(hi)); return r; }
typedef float f32x2 __attribute__((ext_vector_type(2)));
typedef unsigned u32x2 __attribute__((ext_vector_type(2)));
constexpr int ROWS_B = 8448, TILES_B = 33, NROWS = 8 * ROWS_B;

struct TileOrder {
    int nM, nN, nwg, G, c, lat;
    __device__ __forceinline__ void init(int nM_, int nN_, int G_, int c_, int lat_) { nM = nM_; nN = nN_; nwg = nM_ * nN_; G = G_; c = c_; lat = lat_; }
    __device__ __forceinline__ bool next(int i, Unit& u) const {
        const long L = (long)i * G + c; if (L >= nwg) return false;
        int wgid = (int)L; { const int q = nwg / NXCD, r = nwg % NXCD, xcd = wgid % NXCD, off = wgid / NXCD; wgid = (xcd < r ? xcd * (q + 1) : r * (q + 1) + (xcd - r) * q) + off; }
        const int nig = WGM * nN, gid = wgid / nig, fm = gid * WGM, gsz = (nM - fm) < WGM ? (nM - fm) : WGM;
        const int lm = fm + ((wgid % nig) % gsz); u.pn = (wgid % nig) / gsz; u.pm = lat ? (lm >> 5) * TILES_B + (lm & 31) : lm; return true;
    }
    __device__ __forceinline__ void a_ready(const Unit&) const {}
    __device__ __forceinline__ void done(const Unit&) const {}
};

__device__ __forceinline__ float fast_sigmoid(float z) { return __builtin_amdgcn_rcpf(1.0f + __builtin_amdgcn_exp2f(-1.4426950408889634f * z)); }
__device__ __forceinline__ float bf_lo(unsigned w) { return __uint_as_float(w << 16); }
__device__ __forceinline__ float bf_hi(unsigned w) { return __uint_as_float(w & 0xffff0000u); }

struct EpiSwiglu {
    static constexpr bool PERM = true, AFTER_DRAIN = false;
    bf16_t* O; int ldc; const float* rss; const float* bias;
    __device__ __forceinline__ void operator()(const f32x4 (&acc)[2][2][4][2], const Unit& u, int wr, int wc, int fr, int fq) const {
        const int row0 = u.pm * BM + wr * 64 + fr, col0 = u.pn * HALF + wc * 32 + 8 * fq;
        f32x4 bv[2][2];
#pragma unroll
        for (int bj = 0; bj < 2; ++bj)
#pragma unroll
            for (int n = 0; n < 2; ++n) bv[bj][n] = rss ? *(const f32x4*)(bias + (u.pm / TILES_B) * 5632 + u.pn * BM + bj * HALF + wc * 32 + 8 * fq + 4 * n) : (f32x4){0.f, 0.f, 0.f, 0.f};
#pragma unroll
        for (int ai = 0; ai < 2; ++ai)
#pragma unroll
            for (int m = 0; m < 4; ++m) {
                bf16_t* rowp = O + (size_t)(row0 + ai * HALF + m * 16) * ldc + col0;
                float v[8];
                const float rstd = rss ? 1.0f / sqrtf(rss[row0 + ai * HALF + m * 16] * (1.0f / 1024.0f) + 1e-6f) : 1.0f;
#pragma unroll
                for (int n = 0; n < 2; ++n)
#pragma unroll
                    for (int e = 0; e < 4; ++e) { const float gt = acc[ai][0][m][n][e] * rstd + bv[0][n][e], up = acc[ai][1][m][n][e] * rstd + bv[1][n][e]; v[4 * n + e] = gt * fast_sigmoid(gt) * up; }
                u32x4 w; w.x = cvt_pk_bf16(v[0], v[1]); w.y = cvt_pk_bf16(v[2], v[3]); w.z = cvt_pk_bf16(v[4], v[5]); w.w = cvt_pk_bf16(v[6], v[7]);
                *(u32x4*)rowp = w;
            }
    }
};

struct EpiResid {
    static constexpr bool PERM = true, AFTER_DRAIN = false;
    const float* res_lat; const float* res_ctx; float* out_lat; float* out_ctx; const float* mod; int modoff; float scale;
    __device__ __forceinline__ void operator()(const f32x4 (&acc)[2][2][4][2], const Unit& u, int wr, int wc, int fr, int fq) const {
        const int b = u.pm / TILES_B, jt = u.pm - b * TILES_B;
        const float* rb; float* ob; const float* gv;
        if (jt < 32) { const size_t o = ((size_t)b * 8192 + (size_t)jt * 256) * 1024; rb = res_lat + o; ob = out_lat + o; gv = mod + b * 9216 + modoff; }
        else { const size_t o = (size_t)b * 256 * 1024; rb = res_ctx + o; ob = out_ctx + o; gv = mod + 8 * 9216 + modoff; }
        const int rl = wr * 64 + fr, col0 = u.pn * BM + wc * 32 + 8 * fq;
        f32x4 g[2][2];
#pragma unroll
        for (int bj = 0; bj < 2; ++bj)
#pragma unroll
            for (int n = 0; n < 2; ++n) g[bj][n] = *(const f32x4*)(gv + col0 + bj * HALF + 4 * n) * scale;
#pragma unroll
        for (int ai = 0; ai < 2; ++ai)
#pragma unroll
            for (int m = 0; m < 4; ++m) { const size_t ro = (size_t)(rl + ai * HALF + m * 16) * 1024 + col0;
#pragma unroll
                for (int bj = 0; bj < 2; ++bj)
#pragma unroll
                    for (int n = 0; n < 2; ++n) { const size_t p = ro + bj * HALF + 4 * n; const f32x4 x = *(const f32x4*)(rb + p); *(f32x4*)(ob + p) = x + g[bj][n] * acc[ai][bj][m][n]; } }
    }
};

struct EpiResidNorm {
    static constexpr bool PERM = true, AFTER_DRAIN = false;
    const float* res_lat; const float* res_ctx; float* out_lat; float* out_ctx; const float* mod; int gateoff; int half_gate; const float* ng; int scaleoff; bf16_t* XNo; float* rss;
    __device__ __forceinline__ void operator()(const f32x4 (&acc)[2][2][4][2], const Unit& u, int wr, int wc, int fr, int fq) const {
        const int b = u.pm / TILES_B, jt = u.pm - b * TILES_B;
        const float* rb; float* ob; const float* mv;
        if (jt < 32) { const size_t o = ((size_t)b * 8192 + (size_t)jt * 256) * 1024; rb = res_lat + o; ob = out_lat + o; mv = mod + b * 9216; }
        else { const size_t o = (size_t)b * 256 * 1024; rb = res_ctx + o; ob = out_ctx + o; mv = mod + 8 * 9216; }
        const int rl = wr * 64 + fr, col0 = u.pn * BM + wc * 32 + 8 * fq;
        const float scale = half_gate ? 0.5f : 1.0f;
        float q[2][4];
#pragma unroll
        for (int ai = 0; ai < 2; ++ai)
#pragma unroll
            for (int m = 0; m < 4; ++m) q[ai][m] = 0.f;
#pragma unroll
        for (int bj = 0; bj < 2; ++bj) {
            const int c = col0 + bj * HALF;
            const f32x4 g0 = *(const f32x4*)(mv + gateoff + c) * scale, g1 = *(const f32x4*)(mv + gateoff + c + 4) * scale;
            const f32x4 gs0 = *(const f32x4*)(ng + c) * (*(const f32x4*)(mv + scaleoff + c) + 1.0f), gs1 = *(const f32x4*)(ng + c + 4) * (*(const f32x4*)(mv + scaleoff + c + 4) + 1.0f);
#pragma unroll
            for (int ai = 0; ai < 2; ++ai)
#pragma unroll
                for (int m = 0; m < 4; ++m) { const int rr = rl + ai * HALF + m * 16; const size_t p = (size_t)rr * 1024 + c; const size_t prow = (size_t)u.pm * BM + rr;
                    const f32x4 y0 = *(const f32x4*)(rb + p) + g0 * acc[ai][bj][m][0], y1 = *(const f32x4*)(rb + p + 4) + g1 * acc[ai][bj][m][1];
                    *(f32x4*)(ob + p) = y0; *(f32x4*)(ob + p + 4) = y1;
                    q[ai][m] += (y0[0] * y0[0] + y0[1] * y0[1]) + (y0[2] * y0[2] + y0[3] * y0[3]) + (y1[0] * y1[0] + y1[1] * y1[1]) + (y1[2] * y1[2] + y1[3] * y1[3]);
                    const f32x4 z0 = y0 * gs0, z1 = y1 * gs1;
                    u32x4 w; w.x = cvt_pk_bf16(z0[0], z0[1]); w.y = cvt_pk_bf16(z0[2], z0[3]); w.z = cvt_pk_bf16(z1[0], z1[1]); w.w = cvt_pk_bf16(z1[2], z1[3]);
                    *(u32x4*)(XNo + prow * 1024 + c) = w; }
        }
#pragma unroll
        for (int ai = 0; ai < 2; ++ai)
#pragma unroll
            for (int m = 0; m < 4; ++m) { float t = q[ai][m]; t += __shfl_xor(t, 16); t += __shfl_xor(t, 32);
                if (fq == 0) __hip_atomic_fetch_add((__attribute__((address_space(1))) float*)(rss + (size_t)u.pm * BM + rl + ai * HALF + m * 16), t, __ATOMIC_RELAXED, __HIP_MEMORY_SCOPE_AGENT); }
    }
};

struct EpiInproj {
    static constexpr bool PERM = true, AFTER_DRAIN = false;
    bf16_t* U; bf16_t* Q; bf16_t* K; bf16_t* V; const float* rope; const float* rss; const float* bias;
    __device__ __forceinline__ void operator()(const f32x4 (&acc)[2][2][4][2], const Unit& u, int wr, int wc, int fr, int fq) const {
        const int sec = u.pn >> 1, jt = u.pm % TILES_B;
        bf16_t* base = sec == 0 ? U : sec == 1 ? Q : sec == 2 ? K : V;
        const bool dorope = (sec == 1 || sec == 2) && jt < 32;
        const float qs = sec == 1 ? 0.125f * 1.4426950408889634f : 1.0f;
        const int col0 = (u.pn & 1) * BM + wc * 32 + 8 * fq, axis = wc & 1;
        const float* bp = bias + (jt < 32 ? u.pm / TILES_B : 8) * 2048 + u.pn * BM + wc * 32 + 8 * fq;
        f32x4 bv[2][2];
#pragma unroll
        for (int bj = 0; bj < 2; ++bj)
#pragma unroll
            for (int n = 0; n < 2; ++n) bv[bj][n] = *(const f32x4*)(bp + bj * HALF + 4 * n);
#pragma unroll
        for (int ai = 0; ai < 2; ++ai)
#pragma unroll
            for (int m = 0; m < 4; ++m) {
                const int rowl = wr * 64 + fr + ai * HALF + m * 16;
                bf16_t* rowp = base + (size_t)(u.pm * BM + rowl) * 512 + col0;
                const float rstd = 1.0f / sqrtf(rss[u.pm * BM + rowl] * (1.0f / 1024.0f) + 1e-6f);
                f32x4 cs0 = {1.f, 0.f, 1.f, 0.f}, cs1 = {1.f, 0.f, 1.f, 0.f};
                if (dorope) { const int t = jt * 256 + rowl, pos = axis ? (t & 63) : (t >> 6); const float* rp = rope + (pos * 16 + 4 * fq) * 2; cs0 = *(const f32x4*)rp; cs1 = *(const f32x4*)(rp + 4); }
#pragma unroll
                for (int bj = 0; bj < 2; ++bj) {
                    const f32x4 a0 = acc[ai][bj][m][0] * rstd + bv[bj][0], a1 = acc[ai][bj][m][1] * rstd + bv[bj][1];
                    float o[8];
                    o[0] = a0[0] * cs0[0] - a0[1] * cs0[1]; o[1] = a0[1] * cs0[0] + a0[0] * cs0[1];
                    o[2] = a0[2] * cs0[2] - a0[3] * cs0[3]; o[3] = a0[3] * cs0[2] + a0[2] * cs0[3];
                    o[4] = a1[0] * cs1[0] - a1[1] * cs1[1]; o[5] = a1[1] * cs1[0] + a1[0] * cs1[1];
                    o[6] = a1[2] * cs1[2] - a1[3] * cs1[3]; o[7] = a1[3] * cs1[2] + a1[2] * cs1[3];
                    u32x4 w; w.x = cvt_pk_bf16(o[0] * qs, o[1] * qs); w.y = cvt_pk_bf16(o[2] * qs, o[3] * qs); w.z = cvt_pk_bf16(o[4] * qs, o[5] * qs); w.w = cvt_pk_bf16(o[6] * qs, o[7] * qs);
                    *(u32x4*)(rowp + bj * HALF) = w;
                }
            }
    }
};

struct EpiGlu {
    static constexpr bool PERM = true, AFTER_DRAIN = false;
    const bf16_t* Gb; const float* bglu; bf16_t* SA;
    __device__ __forceinline__ void operator()(const f32x4 (&acc)[2][2][4][2], const Unit& u, int wr, int wc, int fr, int fq) const {
        const int row0 = u.pm * BM + wr * 64 + fr, col0 = u.pn * BM + wc * 32 + 8 * fq;
        f32x4 bv[2][2];
#pragma unroll
        for (int bj = 0; bj < 2; ++bj)
#pragma unroll
            for (int n = 0; n < 2; ++n) bv[bj][n] = *(const f32x4*)(bglu + col0 + bj * HALF + 4 * n);
#pragma unroll
        for (int ai = 0; ai < 2; ++ai)
#pragma unroll
            for (int m = 0; m < 4; ++m) { const size_t row = (size_t)(row0 + ai * HALF + m * 16);
#pragma unroll
                for (int bj = 0; bj < 2; ++bj) {
                    const u32x4 gw = *(const u32x4*)(Gb + row * 512 + col0 + bj * HALF);
                    const f32x4 z0 = acc[ai][bj][m][0] + bv[bj][0], z1 = acc[ai][bj][m][1] + bv[bj][1];
                    u32x4 w;
                    w.x = cvt_pk_bf16(bf_lo(gw.x) * fast_sigmoid(z0[0]), bf_hi(gw.x) * fast_sigmoid(z0[1]));
                    w.y = cvt_pk_bf16(bf_lo(gw.y) * fast_sigmoid(z0[2]), bf_hi(gw.y) * fast_sigmoid(z0[3]));
                    w.z = cvt_pk_bf16(bf_lo(gw.z) * fast_sigmoid(z1[0]), bf_hi(gw.z) * fast_sigmoid(z1[1]));
                    w.w = cvt_pk_bf16(bf_lo(gw.w) * fast_sigmoid(z1[2]), bf_hi(gw.w) * fast_sigmoid(z1[3]));
                    *(u32x4*)(SA + row * 1024 + col0 + bj * HALF) = w;
                } }
    }
};

template <class Epi, class Sched, bool ALIGN_EPI = false, bool SP2 = false>
__device__ __forceinline__ void gemm_phase(PG8_LAS unsigned char* lds, const Gemm g, const Sched& S, const Epi& E) {
    int tid_ = threadIdx.x; asm volatile("" : "+v"(tid_));
    const int tid = tid_, wid = __builtin_amdgcn_readfirstlane(tid >> 6), lane = tid & 63, wr = wid >> 2, wc = wid & 3, fr = lane & 15, fq = lane >> 4;
    const int K = g.K, nt = K / BK;
    unsigned voffA[2], voffB[2];
#pragma unroll
    for (int i = 0; i < 2; ++i) { int R, C; stage_rc(tid * 16 + i * 8192, R, C); const int Rb = Epi::PERM ? ((R & ~31) + perm32(R & 31)) : R;
        voffA[i] = (unsigned)(R * K + C) * 2u; voffB[i] = (unsigned)(Rb * K + C) * 2u; }
    const size_t kstep = (size_t)(BK * 2);
    const size_t hstep = (size_t)HALF * K * 2;
    const size_t tstep = 2 * hstep;
    const unsigned ldsw = (unsigned)wid * 1024u;
    const int aoff = lds_byte(wr * 64 + fr, fq * 8), boff = lds_byte(wc * 32 + fr, fq * 8);
#define PG8_SA(b, h) (((b) * 2 + (h)) * HTB)
#define PG8_SB(b, h) ((4 + (b) * 2 + (h)) * HTB)
#define PG8_STAGE(bufoff, gbase, voff) do { _Pragma("unroll") for (int _i = 0; _i < 2; ++_i) \
        __builtin_amdgcn_global_load_lds((const unsigned*)((const char*)(gbase) + (voff)[_i]), (PG8_LAS unsigned*)(lds + (bufoff) + ldsw + _i * 8192), 16, 0, 0); } while (0)
#define PG8_LDA(dst, b, h) do { _Pragma("unroll") for (int m = 0; m < 4; ++m) _Pragma("unroll") for (int k = 0; k < 2; ++k) dst[m][k] = *(const PG8_LAS bf16x8*)(lds + PG8_SA(b, h) + aoff + m * 2048 + k * 1024); } while (0)
#define PG8_LDB(dst, b, h) do { _Pragma("unroll") for (int n = 0; n < 2; ++n) _Pragma("unroll") for (int k = 0; k < 2; ++k) dst[n][k] = *(const PG8_LAS bf16x8*)(lds + PG8_SB(b, h) + boff + n * 2048 + k * 1024); } while (0)
#define PG8_MMA(ai, bj, At, Bt) do { __builtin_amdgcn_s_setprio(1); _Pragma("unroll") for (int m = 0; m < 4; ++m) _Pragma("unroll") for (int n = 0; n < 2; ++n) _Pragma("unroll") for (int k = 0; k < 2; ++k) \
        acc[ai][bj][m][n] = __builtin_amdgcn_mfma_f32_16x16x32_bf16(Bt[n][k], At[m][k], acc[ai][bj][m][n], 0, 0, 0); __builtin_amdgcn_s_setprio(0); } while (0)
#define PG8_WAIT_V(n) asm volatile("s_waitcnt vmcnt(" #n ")" ::: "memory")
#define PG8_WAIT_L(n) asm volatile("s_waitcnt lgkmcnt(" #n ")" ::: "memory")
#define PG8_BAR __builtin_amdgcn_s_barrier()
#define PG8_SCHED __builtin_amdgcn_sched_barrier(0)
    Unit cur, nxt; int ui = 0;
    if (!S.next(0, cur)) return;
    f32x4 acc[2][2][4][2];
#pragma unroll
    for (int a = 0; a < 2; ++a)
#pragma unroll
        for (int b = 0; b < 2; ++b)
#pragma unroll
            for (int m = 0; m < 4; ++m)
#pragma unroll
                for (int n = 0; n < 2; ++n) acc[a][b][m][n] = (f32x4){0.f, 0.f, 0.f, 0.f};
    bf16x8 At[4][2], B0[2][2], B1[2][2];
    const char* cA = (const char*)g.A + (size_t)cur.pm * tstep; const char* cB = (const char*)g.Bt + (size_t)cur.pn * tstep;
    S.a_ready(cur);
    if constexpr (SP2) {
        PG8_STAGE(PG8_SB(0, 0), cB, voffB); PG8_STAGE(PG8_SB(0, 1), cB + hstep, voffB); PG8_STAGE(PG8_SA(0, 0), cA, voffA); PG8_STAGE(PG8_SA(0, 1), cA + hstep, voffA);
        if (wr == 1) PG8_BAR;
        PG8_WAIT_V(2); PG8_BAR;
        PG8_STAGE(PG8_SB(1, 0), cB + kstep, voffB); PG8_STAGE(PG8_SA(1, 0), cA + kstep, voffA); PG8_STAGE(PG8_SB(1, 1), cB + hstep + kstep, voffB);
        PG8_WAIT_V(6); PG8_BAR;
    } else {
        PG8_STAGE(PG8_SB(0, 0), cB, voffB); PG8_STAGE(PG8_SA(0, 0), cA, voffA); PG8_STAGE(PG8_SB(0, 1), cB + hstep, voffB); PG8_STAGE(PG8_SA(0, 1), cA + hstep, voffA);
        if (wr == 1) PG8_BAR;
        PG8_WAIT_V(4); PG8_BAR;
        PG8_STAGE(PG8_SB(1, 0), cB + kstep, voffB); PG8_STAGE(PG8_SA(1, 0), cA + kstep, voffA); PG8_STAGE(PG8_SB(1, 1), cB + hstep + kstep, voffB);
        PG8_WAIT_V(6); PG8_BAR;
    }
    for (;;) {
        const bool has_next = S.next(ui + 1, nxt);
        const char* nA = has_next ? (const char*)g.A + (size_t)nxt.pm * tstep : cA; const char* nB = has_next ? (const char*)g.Bt + (size_t)nxt.pn * tstep : cB;
        for (int t = 0; t < nt; t += 2) {
            const bool last = (t == nt - 2);
            const char* a1 = cA + (size_t)(t + 1) * kstep;
            const char* a2 = last ? nA : cA + (size_t)(t + 2) * kstep; const char* b2 = last ? nB : cB + (size_t)(t + 2) * kstep;
            const char* a3 = a2 + kstep; const char* b3 = b2 + kstep;
            if (last && has_next) S.a_ready(nxt);
            if constexpr (SP2) {
            PG8_LDB(B0, 0, 0); PG8_LDB(B1, 0, 1); PG8_SCHED; PG8_LDA(At, 0, 0); PG8_STAGE(PG8_SA(1, 1), a1 + hstep, voffA);
            PG8_WAIT_V(8); PG8_WAIT_L(0); PG8_BAR; PG8_MMA(0, 0, At, B0); PG8_MMA(0, 1, At, B1); PG8_BAR; PG8_SCHED;
            PG8_LDA(At, 0, 1); PG8_STAGE(PG8_SB(0, 0), b2, voffB); PG8_STAGE(PG8_SB(0, 1), b2 + hstep, voffB); PG8_STAGE(PG8_SA(0, 0), a2, voffA);
            PG8_WAIT_V(8); PG8_WAIT_L(0); PG8_BAR; PG8_MMA(1, 0, At, B0); PG8_MMA(1, 1, At, B1); PG8_BAR; PG8_SCHED;
            PG8_LDB(B0, 1, 0); PG8_LDB(B1, 1, 1); PG8_SCHED; PG8_LDA(At, 1, 0); PG8_STAGE(PG8_SA(0, 1), a2 + hstep, voffA);
            PG8_WAIT_V(8); PG8_WAIT_L(0); PG8_BAR; PG8_MMA(0, 0, At, B0); PG8_MMA(0, 1, At, B1); PG8_BAR; PG8_SCHED;
            PG8_LDA(At, 1, 1); PG8_STAGE(PG8_SB(1, 0), b3, voffB); PG8_STAGE(PG8_SB(1, 1), b3 + hstep, voffB); PG8_STAGE(PG8_SA(1, 0), a3, voffA);
            PG8_WAIT_V(8); PG8_WAIT_L(0); PG8_BAR; PG8_MMA(1, 0, At, B0); PG8_MMA(1, 1, At, B1); PG8_BAR; PG8_SCHED;
            } else {
            PG8_LDB(B0, 0, 0); PG8_SCHED; PG8_LDA(At, 0, 0); PG8_STAGE(PG8_SA(1, 1), a1 + hstep, voffA);
            PG8_WAIT_L(8); PG8_BAR; PG8_WAIT_L(0); PG8_MMA(0, 0, At, B0); PG8_BAR; PG8_SCHED;
            PG8_LDB(B1, 0, 1); PG8_STAGE(PG8_SB(0, 0), b2, voffB);
            PG8_BAR; PG8_WAIT_L(0); PG8_MMA(0, 1, At, B1); PG8_BAR;
            PG8_LDA(At, 0, 1); PG8_STAGE(PG8_SA(0, 0), a2, voffA);
            PG8_BAR; PG8_WAIT_L(0); PG8_MMA(1, 0, At, B0); PG8_BAR; PG8_SCHED;
            PG8_STAGE(PG8_SB(0, 1), b2 + hstep, voffB);
            PG8_WAIT_V(6); PG8_BAR; PG8_MMA(1, 1, At, B1); PG8_BAR;
            PG8_LDB(B0, 1, 0); PG8_SCHED; PG8_LDA(At, 1, 0); PG8_STAGE(PG8_SA(0, 1), a2 + hstep, voffA);
            PG8_WAIT_L(8); PG8_BAR; PG8_WAIT_L(0); PG8_MMA(0, 0, At, B0); PG8_BAR; PG8_SCHED;
            PG8_LDB(B1, 1, 1); PG8_STAGE(PG8_SB(1, 0), b3, voffB);
            PG8_BAR; PG8_WAIT_L(0); PG8_MMA(0, 1, At, B1); PG8_BAR;
            PG8_LDA(At, 1, 1); PG8_STAGE(PG8_SA(1, 0), a3, voffA);
            PG8_BAR; PG8_WAIT_L(0); PG8_MMA(1, 0, At, B0); PG8_BAR; PG8_SCHED;
            PG8_STAGE(PG8_SB(1, 1), b3 + hstep, voffB);
            PG8_WAIT_V(6); PG8_BAR; PG8_MMA(1, 1, At, B1); PG8_BAR;
            }
        }
        if constexpr (ALIGN_EPI) { if (wr == 0) PG8_BAR; }
        if constexpr (!Epi::AFTER_DRAIN) { E(acc, cur, wr, wc, fr, fq); S.done(cur); }
        if (!has_next) break;
#pragma unroll
        for (int a = 0; a < 2; ++a)
#pragma unroll
            for (int b = 0; b < 2; ++b)
#pragma unroll
                for (int m = 0; m < 4; ++m)
#pragma unroll
                    for (int n = 0; n < 2; ++n) acc[a][b][m][n] = (f32x4){0.f, 0.f, 0.f, 0.f};
        cur = nxt; cA = nA; cB = nB; ++ui;
        if constexpr (ALIGN_EPI) { if (wr == 1) PG8_BAR; }
    }
    PG8_WAIT_V(0);
    if constexpr (!ALIGN_EPI) { if (wr == 0) PG8_BAR; }
    PG8_BAR;
    if constexpr (Epi::AFTER_DRAIN) { E.fused(acc, cur, wr, wc, fr, fq, lds, wid, lane); S.done(cur); }
#undef PG8_SA
#undef PG8_SB
#undef PG8_STAGE
#undef PG8_LDA
#undef PG8_LDB
#undef PG8_MMA
#undef PG8_WAIT_V
#undef PG8_WAIT_L
#undef PG8_BAR
#undef PG8_SCHED
}
}

namespace attn {
typedef unsigned short bf16_t;
using bf16x8 = __attribute__((ext_vector_type(8))) short;
using s16x4  = __attribute__((ext_vector_type(4))) short;
using f32x16 = __attribute__((ext_vector_type(16))) float;
using u32x4  = __attribute__((ext_vector_type(4))) unsigned;
constexpr int NW = 8, QBLK = 32, KVBLK = 64;
constexpr float QSCALE = 0.125f * 1.4426950408889634f;
constexpr int LDQ = 512, LDK = 512, LDV = 512, LDO = 512;
constexpr int SHM_V = KVBLK * 128 * 2, SHM_K = KVBLK * 64 * 2, SHM_ATTN = 2 * SHM_V + 2 * SHM_K + NW * 64 * 4;
#define KSWZ64(row, colB) ((row) * 128 + ((colB) ^ ((((row) >> 1) & 7) << 4)))
#define SBAR() __builtin_amdgcn_sched_barrier(0)
__device__ __forceinline__ int crow(int r, int hi) { return (r & 3) + 8 * (r >> 2) + 4 * hi; }
__device__ __forceinline__ unsigned cvtpk(float lo, float hi) { unsigned r; asm volatile("v_cvt_pk_bf16_f32 %0, %1, %2" : "=v"(r) : "v"(lo), "v"(hi)); return r; }
constexpr float THR2 = 11.5f;
template <bool FIRST>
__device__ __forceinline__ void partialSM(f32x16& p0, f32x16& p1, float& m_reg, float& alpha) {
  if (!FIRST) { if (__builtin_expect(__any(m_reg != 0.f), 0)) {
#pragma unroll
      for (int r = 0; r < 16; ++r) { p0[r] -= m_reg; p1[r] -= m_reg; } } }
  float a = fmaxf(fmaxf(p0[0], p0[1]), p1[0]), b = fmaxf(fmaxf(p0[2], p0[3]), p1[1]); a = fmaxf(fmaxf(a, p1[2]), p1[3]);
#pragma unroll
  for (int r = 4; r < 16; r += 4) { a = fmaxf(fmaxf(a, p0[r]), p0[r + 1]); b = fmaxf(fmaxf(b, p0[r + 2]), p0[r + 3]); a = fmaxf(fmaxf(a, p1[r]), p1[r + 1]); b = fmaxf(fmaxf(b, p1[r + 2]), p1[r + 3]); }
  float pmax = fmaxf(a, b);
  { auto rr = __builtin_amdgcn_permlane32_swap(__float_as_uint(pmax), __float_as_uint(pmax), false, false);
    pmax = fmaxf(__uint_as_float(rr[0]), __uint_as_float(rr[1])); }
  alpha = 1.f;
  if (FIRST) {
    if (__builtin_expect(__any(fabsf(pmax) > THR2), 0)) { const float dl = fabsf(pmax) > THR2 ? pmax : 0.f; m_reg = dl;
#pragma unroll
      for (int r = 0; r < 16; ++r) { p0[r] -= dl; p1[r] -= dl; } }
  } else {
    if (__builtin_expect(__any(pmax > THR2), 0)) { const float dl = fmaxf(pmax, 0.f); m_reg += dl;
#pragma unroll
      for (int r = 0; r < 16; ++r) { p0[r] -= dl; p1[r] -= dl; }
      alpha = __builtin_amdgcn_exp2f(-dl); }
  }
#pragma unroll
  for (int r = 0; r < 16; ++r) p0[r] = __builtin_amdgcn_exp2f(p0[r]);
}
__device__ __forceinline__ void finishSM(f32x16& p0, f32x16& p1, bf16x8& pa0, bf16x8& pa1, bf16x8& pa2, bf16x8& pa3) {
#pragma unroll
  for (int r = 0; r < 16; ++r) p1[r] = __builtin_amdgcn_exp2f(p1[r]);
#define PK4(P, BASE, OUT) do { unsigned a0 = cvtpk(P[BASE + 0], P[BASE + 1]), a1 = cvtpk(P[BASE + 2], P[BASE + 3]);   \
    unsigned b0 = cvtpk(P[BASE + 4], P[BASE + 5]), b1 = cvtpk(P[BASE + 6], P[BASE + 7]);                              \
    auto r0 = __builtin_amdgcn_permlane32_swap(a0, b0, false, false); auto r1 = __builtin_amdgcn_permlane32_swap(a1, b1, false, false); \
    u32x4 w = {r0[0], r1[0], r0[1], r1[1]}; OUT = *reinterpret_cast<bf16x8*>(&w); } while (0)
  PK4(p0, 0, pa0); PK4(p0, 8, pa1); PK4(p1, 0, pa2); PK4(p1, 8, pa3);
#undef PK4
}
__device__ __forceinline__ void qkt(f32x16& p0, f32x16& p1, const char* Ks, const bf16x8* qr, int r32, int hi) {
  p0 = f32x16{}; p1 = f32x16{};
#pragma unroll
  for (int d0 = 0; d0 < 4; ++d0) { const int cb = (d0 * 16 + hi * 8) * 2;
    bf16x8 b0 = *reinterpret_cast<const bf16x8*>(Ks + KSWZ64(r32, cb));
    bf16x8 b1 = *reinterpret_cast<const bf16x8*>(Ks + KSWZ64(32 + r32, cb));
    p0 = __builtin_amdgcn_mfma_f32_32x32x16_bf16(b0, qr[d0], p0, 0, 0, 0);
    p1 = __builtin_amdgcn_mfma_f32_32x32x16_bf16(b1, qr[d0], p1, 0, 0, 0); }
}
__device__ __forceinline__ int v_st(int k, int c) { const int kk = (k & ~0xC) | ((k & 4) << 1) | ((k & 8) >> 1); return ((kk >> 3) * 4 + (c >> 5)) * 512 + ((kk & 7) * 32 + (c & 31)) * 2; }
__device__ __forceinline__ int v_rd_base(int lane) { return ((lane & 3) << 3) | (((lane >> 2) & 3) << 6) | (((lane >> 4) & 1) << 5) | (((lane >> 5) & 1) << 8); }
constexpr int v_rd_off(int d0, int ks, int half) { return d0 * 512 + ks * 4096 + half * 2048; }
template <int OFF> __device__ __forceinline__ s16x4 tr_read(int vb) {
  s16x4 r; asm volatile("ds_read_b64_tr_b16 %0, %1 offset:%2" : "=&v"(r) : "v"(vb), "i"(OFF) : "memory"); return r;
}
template <int D0> __device__ __forceinline__ void pv_one(f32x16& od, int vb, bf16x8 pa0, bf16x8 pa1, bf16x8 pa2, bf16x8 pa3) {
  const s16x4 l0 = tr_read<v_rd_off(D0, 0, 0)>(vb), h0 = tr_read<v_rd_off(D0, 0, 1)>(vb), l1 = tr_read<v_rd_off(D0, 1, 0)>(vb), h1 = tr_read<v_rd_off(D0, 1, 1)>(vb);
  const s16x4 l2 = tr_read<v_rd_off(D0, 2, 0)>(vb), h2 = tr_read<v_rd_off(D0, 2, 1)>(vb), l3 = tr_read<v_rd_off(D0, 3, 0)>(vb), h3 = tr_read<v_rd_off(D0, 3, 1)>(vb);
  asm volatile("s_waitcnt lgkmcnt(0)" ::: "memory"); SBAR();
#define PK(L, H) (bf16x8){L[0], L[1], L[2], L[3], H[0], H[1], H[2], H[3]}
  od = __builtin_amdgcn_mfma_f32_32x32x16_bf16(pa0, PK(l0, h0), od, 0, 0, 0);
  od = __builtin_amdgcn_mfma_f32_32x32x16_bf16(pa1, PK(l1, h1), od, 0, 0, 0);
  od = __builtin_amdgcn_mfma_f32_32x32x16_bf16(pa2, PK(l2, h2), od, 0, 0, 0);
  od = __builtin_amdgcn_mfma_f32_32x32x16_bf16(pa3, PK(l3, h3), od, 0, 0, 0);
#undef PK
}
__device__ __forceinline__ void pv_d0(f32x16* o, f32x16& osum, int vb, bf16x8 pa0, bf16x8 pa1, bf16x8 pa2, bf16x8 pa3) {
  { const bf16x8 ones = {16256, 16256, 16256, 16256, 16256, 16256, 16256, 16256};
    osum = __builtin_amdgcn_mfma_f32_32x32x16_bf16(pa0, ones, osum, 0, 0, 0); osum = __builtin_amdgcn_mfma_f32_32x32x16_bf16(pa1, ones, osum, 0, 0, 0);
    osum = __builtin_amdgcn_mfma_f32_32x32x16_bf16(pa2, ones, osum, 0, 0, 0); osum = __builtin_amdgcn_mfma_f32_32x32x16_bf16(pa3, ones, osum, 0, 0, 0); }
  pv_one<0>(o[0], vb, pa0, pa1, pa2, pa3); pv_one<1>(o[1], vb, pa0, pa1, pa2, pa3); pv_one<2>(o[2], vb, pa0, pa1, pa2, pa3); pv_one<3>(o[3], vb, pa0, pa1, pa2, pa3);
}
template <int COMP>
__device__ __forceinline__ void body(const bf16_t* __restrict__ Qb, const bf16_t* __restrict__ Kh, const bf16_t* __restrict__ Vh, float* Ob, bf16_t* __restrict__ SAo, float lam, const float* __restrict__ sg, int seq, char* lds) {
  int tid_ = threadIdx.x; asm volatile("" : "+v"(tid_));
  const int tid = tid_, wid = tid >> 6, lane = tid & 63, r32 = lane & 31, hi = lane >> 5;
  char* V_lds = lds; char* K_lds = lds + 4 * SHM_V;
  float* ws = (float*)(lds + 4 * SHM_V + 4 * SHM_K) + wid * 64; float* al_l = ws + 32;
  float m_reg = 0.f; f32x16 o[4] = {}; f32x16 osum = {}; bf16x8 qr[4];
  const bf16_t* Qw = Qb + (long)(wid * QBLK + r32) * LDQ + hi * 8;
#pragma unroll
  for (int d0 = 0; d0 < 4; ++d0) qr[d0] = *reinterpret_cast<const bf16x8*>(Qw + d0 * 16);
  const int sr = tid >> 4, sc = (tid & 15) * 8, vst0 = v_st(sr, sc), vst1 = v_st(32 + sr, sc);
  const int ksr = tid >> 3, ksc = (tid & 7) * 8, kst = KSWZ64(ksr, ksc * 2);
  const int vb0 = (int)(uintptr_t)V_lds + v_rd_base(lane);
  bf16x8 rvs0, rvs1, rks0;
#define SLOAD(k0) do { rvs0 = *reinterpret_cast<const bf16x8*>(&Vh[(long)((k0) + sr) * LDV + sc]); rvs1 = *reinterpret_cast<const bf16x8*>(&Vh[(long)((k0) + 32 + sr) * LDV + sc]); \
    rks0 = *reinterpret_cast<const bf16x8*>(&Kh[(long)((k0) + ksr) * LDK + ksc]); } while (0)
#define SWRITE(slot) do { *(bf16x8*)(V_lds + (slot) * SHM_V + vst0) = rvs0; *(bf16x8*)(V_lds + (slot) * SHM_V + vst1) = rvs1; *(bf16x8*)(K_lds + (slot) * SHM_K + kst) = rks0; } while (0)
#define RESC(a) do { if (__any((a) < 1.f)) { if (hi == 0) al_l[r32] = (a); asm volatile("s_waitcnt lgkmcnt(0)" ::: "memory"); \
    _Pragma("unroll") for (int r = 0; r < 16; ++r) { const float f_ = al_l[crow(r, hi)]; osum[r] *= f_; _Pragma("unroll") for (int d = 0; d < 4; ++d) o[d][r] *= f_; } } } while (0)
  f32x16 pA0, pA1, pB0, pB1; float alA, alB; bf16x8 pa0, pa1, pa2, pa3; const int NT = seq / KVBLK;
  SLOAD(0); SWRITE(0); SLOAD(KVBLK); __syncthreads();
  qkt(pA0, pA1, K_lds, qr, r32, hi); partialSM<true>(pA0, pA1, m_reg, alA);
  SWRITE(1); SLOAD(2 * KVBLK); __syncthreads();
  const int grp = __builtin_amdgcn_readfirstlane(wid >> 2);
#define ITER(X0, X1, Y0, Y1, alX, i) do { const int scur = (i) & 3, sp = ((i) - 1) & 3, sn = ((i) + 1) & 3; \
    SBAR(); qkt(X0, X1, K_lds + scur * SHM_K, qr, r32, hi); \
    finishSM(Y0, Y1, pa0, pa1, pa2, pa3); SBAR(); \
    if (grp) { SWRITE(sn); if ((i) + 2 < NT) SLOAD(((i) + 2) * KVBLK); __syncthreads(); } \
    pv_d0(o, osum, vb0 + sp * SHM_V, pa0, pa1, pa2, pa3); partialSM<false>(X0, X1, m_reg, alX); \
    RESC(alX); \
    if (!grp) { SWRITE(sn); if ((i) + 2 < NT) SLOAD(((i) + 2) * KVBLK); __syncthreads(); } } while (0)
  int i = 1;
  for (; i + 1 < NT; i += 2) {
    ITER(pB0, pB1, pA0, pA1, alB, i);
    ITER(pA0, pA1, pB0, pB1, alA, i + 1);
  }
  { const int scur = i & 3, sp = (i - 1) & 3;
  SBAR(); qkt(pB0, pB1, K_lds + scur * SHM_K, qr, r32, hi);
  finishSM(pA0, pA1, pa0, pa1, pa2, pa3); SBAR();
  pv_d0(o, osum, vb0 + sp * SHM_V, pa0, pa1, pa2, pa3); partialSM<false>(pB0, pB1, m_reg, alB);
  RESC(alB);
  finishSM(pB0, pB1, pa0, pa1, pa2, pa3); SBAR();
  pv_d0(o, osum, vb0 + scur * SHM_V, pa0, pa1, pa2, pa3); }
#undef ITER
  float rli[16];
#pragma unroll
  for (int r = 0; r < 16; ++r) rli[r] = __builtin_amdgcn_rcpf(osum[r]);
  float* Ow = Ob + (long)(wid * QBLK) * LDO;
  if (COMP == 0) {
#pragma unroll
    for (int r = 0; r < 16; ++r) { const int orow = crow(r, hi);
#pragma unroll
      for (int d0 = 0; d0 < 4; ++d0) Ow[(long)orow * LDO + d0 * 32 + r32] = o[d0][r] * rli[r]; }
  } else {
    float ss[16];
#pragma unroll
    for (int r = 0; r < 16; ++r) { const int orow = crow(r, hi); float q = 0.f;
#pragma unroll
      for (int d0 = 0; d0 < 4; ++d0) { const float d = Ow[(long)orow * LDO + d0 * 32 + r32] - lam * (o[d0][r] * rli[r]); o[d0][r] = d; q = fmaf(d, d, q); }
      ss[r] = q; }
#pragma unroll
    for (int r = 0; r < 16; ++r) { float q = ss[r]; q += __shfl_xor(q, 1); q += __shfl_xor(q, 2); q += __shfl_xor(q, 4); q += __shfl_xor(q, 8); q += __shfl_xor(q, 16);
      ss[r] = 1.0f / sqrtf(q * (1.0f / 128.0f) + 1e-6f); }
    float gsub[4];
#pragma unroll
    for (int d0 = 0; d0 < 4; ++d0) gsub[d0] = sg[d0 * 32 + r32] * 0.8f;
    bf16_t* Sw = SAo + (long)(wid * QBLK) * 1024;
#pragma unroll
    for (int r = 0; r < 16; ++r) { const int orow = crow(r, hi);
#pragma unroll
      for (int d0 = 0; d0 < 4; ++d0) { const float y = o[d0][r] * ss[r] * gsub[d0]; unsigned u = __builtin_bit_cast(unsigned, y); u = (u + 0x7fffu + ((u >> 16) & 1u)) >> 16;
        Sw[(long)orow * 1024 + d0 * 32 + r32] = (bf16_t)u; } }
  }
  asm volatile("s_waitcnt vmcnt(0) lgkmcnt(0)" ::: "memory"); __syncthreads();
#undef SLOAD
#undef SWRITE
#undef RESC
}
#undef SBAR
}

#define GAS __attribute__((address_space(1)))
#define LAS __attribute__((address_space(3)))
typedef unsigned short bf16;
typedef unsigned v4u __attribute__((ext_vector_type(4)));
typedef float f32x4 __attribute__((ext_vector_type(4)));
typedef float f32x16 __attribute__((ext_vector_type(16)));
typedef short bf16x8 __attribute__((ext_vector_type(8)));

constexpr int NWAVES = 8, NTHR = 512;
constexpr int DM = 1024, DFF = 2816, NB = 8, SEQ = 8192, CTXL = 256, NMODV = 9 * DM;
constexpr int ROWS_B = 8448, TILES_B = 33, NROWS = NB * ROWS_B;

constexpr size_t MiB = 1u << 20;
constexpr size_t WS_CTL = 0, CTL_ZERO_BYTES = 1 * MiB;
constexpr size_t WS_MOD = 4096;
constexpr size_t WS_BIAS1 = 352 * 1024, WS_BIAS2 = 640 * 1024;
constexpr size_t WS_RSS1 = 69 * MiB, WS_RSS2 = 69 * MiB + 512 * 1024;
constexpr size_t WS_BAR = 512 * 1024, BAR_ZERO_BYTES = 16384;
constexpr size_t WS_ABAR = 1 * MiB, WS_APOW = WS_ABAR + 32768, WS_BBT = WS_APOW + 32768, WS_CM = WS_BBT + 262144, WS_ROPE = WS_CM + 262144;
constexpr size_t WS_W1A = 2 * MiB, WS_W1B = 13 * MiB, WS_W2A = 19 * MiB, WS_W2B = 30 * MiB, WS_WIN = 36 * MiB, WS_WOUT = 40 * MiB, WS_WGLU = 42 * MiB;
constexpr size_t WS_E = 43 * MiB, WS_HIN = 52 * MiB, WS_XC = 61 * MiB;
constexpr size_t WS_XN = 70 * MiB;
constexpr size_t WS_ACT = 202 * MiB;
constexpr size_t WS_OATT = WS_ACT, WS_G = WS_ACT + 264 * MiB;
constexpr size_t WS_U = 565 * MiB, WS_Q = 631 * MiB, WS_K = 697 * MiB, WS_V = 763 * MiB, WS_END = 829 * MiB;
static_assert(WS_ROPE + 16384 <= WS_W1A && WS_W1A + (size_t)5632 * 1024 * 2 <= WS_W1B && WS_W1B + (size_t)1024 * 2816 * 2 <= WS_W2A && WS_W2A + (size_t)5632 * 1024 * 2 <= WS_W2B, "ws map 1");
static_assert(WS_W2B + (size_t)1024 * 2816 * 2 <= WS_WIN && WS_WIN + (size_t)2048 * 1024 * 2 <= WS_WOUT && WS_WOUT + (size_t)1024 * 1024 * 2 <= WS_WGLU && WS_WGLU + 512 * 512 * 2 <= WS_E, "ws map 2");
static_assert(WS_E + (size_t)8 * 33 * 64 * 64 * 8 <= WS_HIN && WS_HIN + (size_t)8 * 33 * 64 * 64 * 8 <= WS_XC && WS_XC + (size_t)2048 * 1024 * 4 <= WS_XN, "ws map 3");
static_assert(WS_XN + (size_t)NROWS * 1024 * 2 <= WS_ACT && WS_ACT + (size_t)NROWS * 2816 * 2 <= WS_U && WS_G + (size_t)NROWS * 512 * 2 <= WS_U && WS_OATT + (size_t)NROWS * 1024 * 4 <= WS_G, "ws map 4");
static_assert(WS_U + (size_t)NROWS * 512 * 2 <= WS_Q && WS_V + (size_t)NROWS * 512 * 2 <= WS_END, "ws map 5");

constexpr int LDS_BYTES = 139264;

#define LDS_WAIT() asm volatile("s_waitcnt lgkmcnt(0)" ::: "memory")
__device__ __forceinline__ unsigned f2bf(float f) { unsigned u = __builtin_bit_cast(unsigned, f); return (u + 0x7fffu + ((u >> 16) & 1u)) >> 16; }
__device__ __forceinline__ unsigned pk2(float lo, float hi) { return f2bf(lo) | (f2bf(hi) << 16); }
__device__ __forceinline__ float wave_sum(float v) {
#pragma unroll
    for (int o = 1; o < 64; o <<= 1) v += __shfl_xor(v, o);
    return v;
}

__device__ __forceinline__ double dexp(double x) {
    const double n = __builtin_rint(x * 1.4426950408889634074);
    const double r = __builtin_fma(-n, 1.9082149292705877e-10, __builtin_fma(-n, 0.693147180369123816490, x));
    double p = 1.0 / 87178291200.0;
    p = p * r + 1.0 / 6227020800.0; p = p * r + 1.0 / 479001600.0; p = p * r + 1.0 / 39916800.0; p = p * r + 1.0 / 3628800.0; p = p * r + 1.0 / 362880.0; p = p * r + 1.0 / 40320.0;
    p = p * r + 1.0 / 5040.0; p = p * r + 1.0 / 720.0; p = p * r + 1.0 / 120.0; p = p * r + 1.0 / 24.0; p = p * r + 1.0 / 6.0; p = p * r + 0.5; p = p * r + 1.0; p = p * r + 1.0;
    const long long e = (long long)n + 1023; const double s = __builtin_bit_cast(double, (unsigned long long)e << 52);
    return p * s;
}
__device__ __forceinline__ void dsincos(double y, double& s, double& c) {
    const double k = __builtin_rint(y * 0.15915494309189533577);
    double r = __builtin_fma(-k, 6.283185307179586232, y); r = __builtin_fma(-k, 2.4492935982947064e-16, r);
    const double q = r * 0.125, q2 = q * q;
    double sp = -1.0 / 1307674368000.0; sp = sp * q2 + 1.0 / 6227020800.0; sp = sp * q2 - 1.0 / 39916800.0; sp = sp * q2 + 1.0 / 362880.0; sp = sp * q2 - 1.0 / 5040.0; sp = sp * q2 + 1.0 / 120.0; sp = sp * q2 - 1.0 / 6.0; sp = sp * q2 + 1.0;
    double cp = 1.0 / 20922789888000.0; cp = cp * q2 - 1.0 / 87178291200.0; cp = cp * q2 + 1.0 / 479001600.0; cp = cp * q2 - 1.0 / 3628800.0; cp = cp * q2 + 1.0 / 40320.0; cp = cp * q2 - 1.0 / 720.0; cp = cp * q2 + 1.0 / 24.0; cp = cp * q2 - 0.5; cp = cp * q2 + 1.0;
    double ss = sp * q, cc = cp;
#pragma unroll
    for (int i = 0; i < 3; ++i) { const double s2 = 2.0 * ss * cc, c2 = cc * cc - ss * ss; ss = s2; cc = c2; }
    s = ss; c = cc;
}

__device__ __forceinline__ void transpose_item(const float* W, int K, int N, bf16* WT, int mode, LAS float* scr, int item, int lane) {
    const int nblk = N / 32, kb = item / nblk, nb = item % nblk, k0 = 64 * kb, n0 = 32 * nb;
    { const float* wp = W + (size_t)(k0 + (lane >> 5)) * N + n0 + (lane & 31); float v[32];
#pragma unroll
      for (int i = 0; i < 32; ++i) v[i] = wp[(size_t)(2 * i) * N];
#pragma unroll
      for (int i = 0; i < 32; ++i) scr[(2 * i + (lane >> 5)) * 33 + (lane & 31)] = v[i]; }
    LDS_WAIT(); asm volatile("" ::: "memory");
    const int c = lane & 7;
#pragma unroll
    for (int j = 0; j < 4; ++j) { const int n = (lane >> 3) + 8 * j; const LAS float* s = scr + (8 * c) * 33 + n;
        const int src = n0 + n; int drow = src;
        if (mode == 1) { const int up = src >= DFF ? 1 : 0, ff = src - up * DFF; drow = (ff >> 7) * 256 + up * 128 + (ff & 127); }
        else if (mode == 2) { if (src >= 512 && src < 1536) drow = n0 + 2 * (n & 15) + (n >> 4); }
        v4u o; o.x = pk2(s[0 * 33], s[1 * 33]); o.y = pk2(s[2 * 33], s[3 * 33]); o.z = pk2(s[4 * 33], s[5 * 33]); o.w = pk2(s[6 * 33], s[7 * 33]);
        *(v4u*)(WT + (size_t)drow * K + k0 + 8 * c) = o; }
    LDS_WAIT(); asm volatile("" ::: "memory");
}

template <int MODE>
__device__ __forceinline__ void norm_rows16(const float* src, bf16* dstb, float* dstf, const float* g, const float* shift, const float* scale, int lane) {
    f32x4 gs[4], sh[4];
#pragma unroll
    for (int j = 0; j < 4; ++j) { const int cidx = 4 * lane + 256 * j; const f32x4 gv = *(const f32x4*)(g + cidx);
        if (MODE == 0) { const f32x4 sc = *(const f32x4*)(scale + cidx); gs[j] = gv * (sc + 1.0f); sh[j] = *(const f32x4*)(shift + cidx); } else { gs[j] = gv; sh[j] = (f32x4){0.f, 0.f, 0.f, 0.f}; } }
#pragma unroll 2
    for (int r = 0; r < 16; ++r) {
        const f32x4* xr = (const f32x4*)(src + (size_t)r * DM) + lane;
        f32x4 v[4]; float s = 0.f;
#pragma unroll
        for (int j = 0; j < 4; ++j) { v[j] = xr[64 * j]; s += (v[j].x * v[j].x + v[j].y * v[j].y) + (v[j].z * v[j].z + v[j].w * v[j].w); }
        const float rstd = 1.0f / sqrtf(wave_sum(s) * (1.0f / DM) + 1e-6f);
        if (MODE == 0) {
            unsigned long long* o8 = (unsigned long long*)(dstb + (size_t)r * DM) + lane;
#pragma unroll
            for (int j = 0; j < 4; ++j) { const f32x4 y = v[j] * rstd * gs[j] + sh[j]; o8[64 * j] = (unsigned long long)pk2(y.x, y.y) | ((unsigned long long)pk2(y.z, y.w) << 32); }
        } else {
            f32x4* of = (f32x4*)(dstf + (size_t)r * DM) + lane;
#pragma unroll
            for (int j = 0; j < 4; ++j) of[64 * j] = v[j] * rstd * gs[j];
        }
    }
}

__device__ __forceinline__ int crow16(int r, int hi) { return (r & 3) + 8 * (r >> 2) + 4 * hi; }
typedef float f32x2_t __attribute__((ext_vector_type(2))); typedef __bf16 bf16x2_t __attribute__((ext_vector_type(2)));
__device__ __forceinline__ unsigned cvtpk2(float lo, float hi) { f32x2_t v = {lo, hi}; bf16x2_t b = __builtin_convertvector(v, bf16x2_t); return __builtin_bit_cast(unsigned, b); }

template <bool FULL>
__device__ __forceinline__ void s5_unit(LAS unsigned char* lds, int b, int c, int gq, const bf16* U, const float2* ABAR, const bf16* BBT, const bf16* CM,
                                        const float2* HIN, float2* E, const float* dskip, bf16* G, float* YF) {
    int tid_ = threadIdx.x; asm volatile("" : "+v"(tid_));
    const int lane = tid_ & 63, wave = __builtin_amdgcn_readfirstlane(tid_ >> 6);
    const int g = gq * 8 + wave, hi = lane >> 5, r32 = lane & 31;
    LAS unsigned* scr = (LAS unsigned*)(lds + wave * 8704);
    const size_t r0 = (size_t)b * ROWS_B + (size_t)c * 256;
    const bf16* ubase = U + (r0 + r32) * 512 + g * 16 + hi * 8;
    const int ch = lane & 15; const float dv = dskip[g * 16 + ch];
    const size_t obase = (r0 + (lane >> 4) * 4) * 512 + g * 16 + ch;
    LAS unsigned short* yt_l = (LAS unsigned short*)(lds + 69632 + wave * 8192) + ((lane >> 4) * 4) * 16 + ch;
#pragma unroll
    for (int dir = 0; dir < 2; ++dir) {
        const int dg = dir * 32 + g;
        const float2 ab = ABAR[dg * 64 + lane];
        bf16x8 bb[4], cm[4];
#pragma unroll
        for (int blk = 0; blk < 4; ++blk) bb[blk] = *(const bf16x8*)(BBT + ((size_t)(dg * 4 + blk) * 32 + r32) * 16 + hi * 8);
        if (FULL) {
#pragma unroll
            for (int ks = 0; ks < 4; ++ks) cm[ks] = *(const bf16x8*)(CM + ((size_t)dg * 16 + (lane & 15)) * 128 + ks * 32 + (lane >> 4) * 8);
        }
        const size_t sidx = ((((size_t)b * 33 + c) * 32 + g) * 2 + dir) * 64 + lane;
        float hr = 0.f, hm = 0.f;
        if (FULL) { const float2 h0 = HIN[sidx]; hr = h0.x; hm = h0.y; }
        bf16x8 a_nx = *(const bf16x8*)(ubase + (size_t)(dir == 0 ? 0 : 224) * 512);
#pragma unroll 1
        for (int sb = 0; sb < 8; ++sb) {
            const int tb = dir == 0 ? sb * 32 : (7 - sb) * 32;
            const bf16x8 a = a_nx;
            { const int tn = dir == 0 ? (sb < 7 ? tb + 32 : tb) : (sb < 7 ? tb - 32 : tb); a_nx = *(const bf16x8*)(ubase + (size_t)tn * 512); }
            unsigned short uvv[2][4];
            if (FULL && dir == 1) {
#pragma unroll
                for (int mt = 0; mt < 2; ++mt)
#pragma unroll
                    for (int j = 0; j < 4; ++j) { const size_t idx = obase + (size_t)(tb + mt * 16 + j) * 512; uvv[mt][j] = U[idx]; }
            }
            const f32x16 z = {};
#pragma unroll
            for (int hf = 0; hf < 2; ++hf) {
                const f32x16 c0 = __builtin_amdgcn_mfma_f32_32x32x16_bf16(a, bb[hf], z, 0, 0, 0), c2 = __builtin_amdgcn_mfma_f32_32x32x16_bf16(a, bb[2 + hf], z, 0, 0, 0);
#pragma unroll
                for (int r = 0; r < 16; ++r) { const int row = crow16(r, hi); scr[row * 68 + hf * 32 + r32] = cvtpk2(c0[r], c2[r]); }
            }
            LDS_WAIT(); asm volatile("" ::: "memory");
#pragma unroll
            for (int half = 0; half < 2; ++half) {
                unsigned v[16];
#pragma unroll
                for (int q = 0; q < 16; ++q) { const int t = dir == 0 ? half * 16 + q : 31 - (half * 16 + q); v[q] = scr[t * 68 + lane]; }
#pragma unroll
                for (int q = 0; q < 16; ++q) { const int t = dir == 0 ? half * 16 + q : 31 - (half * 16 + q);
                    const float re = __uint_as_float(v[q] << 16), im = __uint_as_float(v[q] & 0xffff0000u);
                    const float nr = fmaf(ab.x, hr, fmaf(-ab.y, hm, re)), ni = fmaf(ab.x, hm, fmaf(ab.y, hr, im)); hr = nr; hm = ni;
                    if (FULL) scr[t * 68 + lane] = cvtpk2(hr, hm); }
                asm volatile("" ::: "memory");
            }
            if (FULL) {
                LDS_WAIT(); asm volatile("" ::: "memory");
                f32x4 yt[2];
#pragma unroll
                for (int mt = 0; mt < 2; ++mt) { yt[mt] = (f32x4){0.f, 0.f, 0.f, 0.f};
#pragma unroll
                    for (int ks = 0; ks < 4; ++ks) { const bf16x8 hf8 = *(const LAS bf16x8*)((const LAS unsigned char*)scr + (mt * 16 + (lane & 15)) * 272 + ks * 64 + (lane >> 4) * 16);
                        yt[mt] = __builtin_amdgcn_mfma_f32_16x16x32_bf16(hf8, cm[ks], yt[mt], 0, 0, 0); } }
#pragma unroll
                for (int mt = 0; mt < 2; ++mt)
#pragma unroll
                    for (int j = 0; j < 4; ++j) { LAS unsigned short* yp = yt_l + (tb + mt * 16 + j) * 16;
                        if (dir == 0) *yp = (unsigned short)f2bf(yt[mt][j]);
                        else { const float uv = __uint_as_float((unsigned)uvv[mt][j] << 16); const float yv = __uint_as_float((unsigned)*yp << 16) + yt[mt][j] + dv * uv;
                            const float zz = 1.5957691216057308f * (yv + 0.044715f * yv * yv * yv); *yp = (unsigned short)f2bf(yv * pg8::fast_sigmoid(zz)); } }
                LDS_WAIT(); asm volatile("" ::: "memory");
            }
        }
        if (!FULL) E[sidx] = make_float2(hr, hm);
    }
    if (FULL) {
        LDS_WAIT(); asm volatile("" ::: "memory");
        const LAS unsigned char* yb = (const LAS unsigned char*)(lds + 69632 + wave * 8192);
#pragma unroll
        for (int it = 0; it < 8; ++it) { const int row = it * 32 + (lane >> 1), hf = lane & 1;
            const v4u w = *(const LAS v4u*)(yb + row * 32 + hf * 16);
            *(v4u*)(G + (r0 + row) * 512 + g * 16 + hf * 8) = w; }
        LDS_WAIT(); asm volatile("" ::: "memory");
    }
}

__device__ __forceinline__ void cmulf(float ar, float ai, float br, float bi, float& cr, float& ci) { cr = ar * br - ai * bi; ci = ar * bi + ai * br; }
__device__ __forceinline__ void s5_unit_a(LAS unsigned char* lds, int b, int c, int gq, const bf16* U, const float2* ABAR, const bf16* BBT, float2* E) {
    int tid_ = threadIdx.x; asm volatile("" : "+v"(tid_));
    const int lane = tid_ & 63, wave = __builtin_amdgcn_readfirstlane(tid_ >> 6);
    const int g = gq * 8 + wave, hi = lane >> 5, r32 = lane & 31;
    const size_t r0 = (size_t)b * ROWS_B + (size_t)c * 256;
    LAS unsigned char* ut = lds + wave * 8192;
    { v4u t8[8];
#pragma unroll
      for (int it = 0; it < 8; ++it) t8[it] = *(const v4u*)(U + (r0 + it * 32 + (lane >> 1)) * 512 + g * 16 + (lane & 1) * 8);
#pragma unroll
      for (int it = 0; it < 8; ++it) *(LAS v4u*)(ut + (it * 32 + (lane >> 1)) * 32 + (lane & 1) * 16) = t8[it]; }
    LDS_WAIT(); asm volatile("" ::: "memory");
    const LAS unsigned char* ua = ut + r32 * 32 + hi * 16;
#pragma unroll
    for (int dir = 0; dir < 2; ++dir) {
        const int dg = dir * 32 + g;
        bf16x8 bb[4];
#pragma unroll
        for (int blk = 0; blk < 4; ++blk) bb[blk] = *(const bf16x8*)(BBT + ((size_t)(dg * 4 + blk) * 32 + r32) * 16 + hi * 8);
        float wr[2][16], wi[2][16], a32r[2], a32i[2];
#pragma unroll
        for (int hf = 0; hf < 2; ++hf) {
            const float2 ab = ABAR[dg * 64 + hf * 32 + r32];
            float qr[4], qi[4], orr[4], oi[4];
            qr[0] = 1.f; qi[0] = 0.f; qr[1] = ab.x; qi[1] = ab.y; cmulf(qr[1], qi[1], ab.x, ab.y, qr[2], qi[2]); cmulf(qr[2], qi[2], ab.x, ab.y, qr[3], qi[3]);
            float a4r, a4i; cmulf(qr[2], qi[2], qr[2], qi[2], a4r, a4i);
            orr[0] = 1.f; oi[0] = 0.f; cmulf(a4r, a4i, a4r, a4i, orr[1], oi[1]); cmulf(orr[1], oi[1], orr[1], oi[1], orr[2], oi[2]); cmulf(orr[2], oi[2], orr[1], oi[1], orr[3], oi[3]);
            cmulf(orr[2], oi[2], orr[2], oi[2], a32r[hf], a32i[hf]);
            const bool use4 = dir == 0 ? (hi == 0) : (hi != 0);
            const float br = use4 ? a4r : 1.f, bi = use4 ? a4i : 0.f;
#pragma unroll
            for (int r = 0; r < 16; ++r) { const int jq = dir == 0 ? 3 - (r & 3) : (r & 3), jo = dir == 0 ? 3 - (r >> 2) : (r >> 2);
                float tr, ti; cmulf(qr[jq], qi[jq], orr[jo], oi[jo], tr, ti); cmulf(tr, ti, br, bi, wr[hf][r], wi[hf][r]); }
        }
        float hr[2] = {0.f, 0.f}, hm[2] = {0.f, 0.f};
#pragma unroll 1
        for (int sb = 0; sb < 8; ++sb) {
            const bf16x8 a = *(const LAS bf16x8*)(ua + (dir == 0 ? sb * 32 : (7 - sb) * 32) * 32);
            const f32x16 z = {};
#pragma unroll
            for (int hf = 0; hf < 2; ++hf) {
                const f32x16 cre = __builtin_amdgcn_mfma_f32_32x32x16_bf16(a, bb[hf], z, 0, 0, 0), cim = __builtin_amdgcn_mfma_f32_32x32x16_bf16(a, bb[2 + hf], z, 0, 0, 0);
                float er = 0.f, ei = 0.f;
#pragma unroll
                for (int r = 0; r < 16; ++r) { er = fmaf(wr[hf][r], cre[r], fmaf(-wi[hf][r], cim[r], er)); ei = fmaf(wr[hf][r], cim[r], fmaf(wi[hf][r], cre[r], ei)); }
                er += __shfl_xor(er, 32); ei += __shfl_xor(ei, 32);
                const float nr = fmaf(a32r[hf], hr[hf], fmaf(-a32i[hf], hm[hf], er)), ni = fmaf(a32r[hf], hm[hf], fmaf(a32i[hf], hr[hf], ei));
                hr[hf] = nr; hm[hf] = ni;
            }
        }
        const size_t sidx = ((((size_t)b * 33 + c) * 32 + g) * 2 + dir) * 64 + lane;
        E[sidx] = hi ? make_float2(hr[1], hm[1]) : make_float2(hr[0], hm[0]);
    }
    LDS_WAIT(); asm volatile("" ::: "memory");
}

typedef GAS unsigned gu32;
#define RLX_AGENT __ATOMIC_RELAXED, __HIP_MEMORY_SCOPE_AGENT
#define XB_TMO      128
#define XB_XCNT(j)  (256  + 64 * (j))
#define XB_XSUB(j)  (1280 + 64 * (j))
#define XB_XGEN(j)  (2304 + 64 * (j))
#define XB_TOP      3328
#define XB_TOPGEN   3392
#define XCD_BAR_WORDS 3456
#define XB_SPIN_CAP (1u << 18)

__device__ __forceinline__ unsigned xb_ld(unsigned* p)              { return __hip_atomic_load(p, __ATOMIC_RELAXED, __HIP_MEMORY_SCOPE_AGENT); }
__device__ __forceinline__ unsigned xb_add(unsigned* p, unsigned v) { return __hip_atomic_fetch_add(p, v, __ATOMIC_RELAXED, __HIP_MEMORY_SCOPE_AGENT); }
__device__ __forceinline__ unsigned xb_xcc_id() { return (unsigned)__builtin_amdgcn_s_getreg((3 << 11) | 20) & 0xFu; }
#define XB_SPIN(cond, bar) do { unsigned _sp = 0; while (cond) { __builtin_amdgcn_s_sleep(1); \
    if ((++_sp & 255u) == 0u) { if (xb_ld(&(bar)[XB_TMO])) break; if (_sp > XB_SPIN_CAP) { atomicAdd(&(bar)[XB_TMO], 1u); break; } } } } while (0)

struct XcdBarrier {
    unsigned* bar; unsigned x;
    volatile LAS unsigned* st;
};

__device__ __forceinline__ XcdBarrier xcd_barrier_post(unsigned* bar, volatile LAS unsigned* st) {
    XcdBarrier b; b.bar = bar; b.x = xb_xcc_id(); b.st = st;
    if (threadIdx.x == 0) (void)xb_add(&bar[XB_XCNT(b.x)], 1u);
    return b;
}
__device__ __forceinline__ void xcd_barrier_complete(unsigned* bar, unsigned x, unsigned& nloc, unsigned& nx) {
    const unsigned G = gridDim.x * gridDim.y * gridDim.z;
    unsigned sum, cnt, mine, sp = 0u;
    for (;;) {
        sum = 0u; cnt = 0u; mine = 0u;
#pragma unroll
        for (unsigned j = 0; j < 16; ++j) { const unsigned c = xb_ld(&bar[XB_XCNT(j)]); sum += c; cnt += (c > 0u) ? 1u : 0u; mine = (j == x) ? c : mine; }
        if (sum == G) break;
        __builtin_amdgcn_s_sleep(1);
        if ((++sp & 255u) == 0u) { if (xb_ld(&bar[XB_TMO])) break; if (sp > XB_SPIN_CAP) { atomicAdd(&bar[XB_TMO], 1u); break; } }
    }
    nloc = mine > 0u ? mine : 1u; nx = cnt > 0u ? cnt : 1u;
}

__device__ __forceinline__ void xcd_barrier(const XcdBarrier& b) {
    asm volatile("s_waitcnt vmcnt(0)" ::: "memory");
    __syncthreads();
    if (threadIdx.x == 0) {
        unsigned* bar = b.bar;
        __builtin_amdgcn_s_waitcnt(0);
        unsigned nloc = b.st[0], nx = b.st[1];
        if (nloc == 0u) { xcd_barrier_complete(bar, b.x, nloc, nx); b.st[0] = nloc; b.st[1] = nx; }
        const unsigned old = xb_add(&bar[XB_XSUB(b.x)], 1u);
        const unsigned gen = old / nloc;
        if (old + 1u == (gen + 1u) * nloc) {
            __builtin_amdgcn_fence(__ATOMIC_RELEASE, "agent");
            asm volatile("s_waitcnt vmcnt(0)" ::: "memory");
            const unsigned og = xb_add(&bar[XB_TOP], 1u);
            const unsigned tg = og / nx;
            if (og + 1u == (tg + 1u) * nx) xb_add(&bar[XB_TOPGEN], 1u);
            else XB_SPIN(xb_ld(&bar[XB_TOPGEN]) == tg, bar);
            __builtin_amdgcn_fence(__ATOMIC_ACQUIRE, "agent");
            xb_add(&bar[XB_XGEN(b.x)], 1u);
            asm volatile("s_waitcnt vmcnt(0)" ::: "memory");
        } else {
            XB_SPIN(xb_ld(&bar[XB_XGEN(b.x)]) == gen, bar);
            __builtin_amdgcn_fence(__ATOMIC_ACQUIRE, "agent");
            asm volatile("s_waitcnt vmcnt(0)" ::: "memory");
        }
    }
    __syncthreads();
}

#ifndef PHMASK
#define PHMASK 0xFFFFF
#endif
#define PH(k) if ((PHMASK >> (k)) & 1)
struct Args { const float* in[25]; float* out; unsigned char* ws; };
__device__ __forceinline__ const float* karg(int i) {
    unsigned off = (unsigned)i * 8u; asm volatile("" : "+s"(off));
    return *(const float* const __attribute__((address_space(4)))*)((const char __attribute__((address_space(4)))*)__builtin_amdgcn_kernarg_segment_ptr() + off);
}

__global__ void __launch_bounds__(NTHR, 2) hymba_fwd(Args a) {
    extern __shared__ __attribute__((aligned(16))) unsigned char lds[];
    cg::grid_group grid = cg::this_grid();
    const int tid = threadIdx.x, lane = tid & 63, wave = __builtin_amdgcn_readfirstlane(tid >> 6);
    const int G = gridDim.x, bx = blockIdx.x;
    const int vcu = (G % 8 == 0) ? (bx % 8) * (G / 8) + bx / 8 : bx;
    const int gw = vcu * NWAVES + wave, NGW = G * NWAVES;
    LAS unsigned char* ldsl = (LAS unsigned char*)lds;
#define KIN(i) karg(i)
#define ws_p ((unsigned char*)karg(26))
#define out_p ((float*)karg(25))
#define x_in KIN(0)
#define cvec KIN(1)
#define ctx KIN(2)
#define c_ctx KIN(3)
#define w_mod KIN(4)
#define b_mod KIN(5)
#define norm_g KIN(6)
#define ffn_w_in KIN(7)
#define ffn_w_out KIN(8)
#define w_in KIN(9)
#define w_out KIN(10)
#define ssm_a_re KIN(11)
#define ssm_a_im KIN(12)
#define ssm_log_dt KIN(13)
#define ssm_b_re KIN(14)
#define ssm_b_im KIN(15)
#define ssm_c_re KIN(16)
#define ssm_c_im KIN(17)
#define ssm_d KIN(18)
#define w_glu KIN(19)
#define b_glu KIN(20)
#define lam_q KIN(21)
#define lam_k KIN(22)
#define subln_g KIN(23)
#define final_g KIN(24)
#define MISC ((float*)(ws_p + WS_CTL))
#define MOD ((float*)(ws_p + WS_MOD))
#define ABAR ((float2*)(ws_p + WS_ABAR))
#define APOW ((float2*)(ws_p + WS_APOW))
#define BBT ((bf16*)(ws_p + WS_BBT))
#define CM ((bf16*)(ws_p + WS_CM))
#define ROPE ((float*)(ws_p + WS_ROPE))
#define W1A ((bf16*)(ws_p + WS_W1A))
#define W1B ((bf16*)(ws_p + WS_W1B))
#define W2A ((bf16*)(ws_p + WS_W2A))
#define W2B ((bf16*)(ws_p + WS_W2B))
#define WIN ((bf16*)(ws_p + WS_WIN))
#define WOUT ((bf16*)(ws_p + WS_WOUT))
#define WGLU ((bf16*)(ws_p + WS_WGLU))
#define EST ((float2*)(ws_p + WS_E))
#define HIN ((float2*)(ws_p + WS_HIN))
#define XC ((float*)(ws_p + WS_XC))
#define XN ((bf16*)(ws_p + WS_XN))
#define SA ((bf16*)(ws_p + WS_XN))
#define ACT ((bf16*)(ws_p + WS_ACT))
#define OATT ((float*)(ws_p + WS_OATT))
#define GB ((bf16*)(ws_p + WS_G))
#define YFB ((float*)(ws_p + WS_OATT + 132 * MiB))
#define BIAS1 ((float*)(ws_p + WS_BIAS1))
#define BIAS2 ((float*)(ws_p + WS_BIAS2))
#define RSS1 ((float*)(ws_p + WS_RSS1))
#define RSS2 ((float*)(ws_p + WS_RSS2))
#define XN2 ((bf16*)(ws_p + WS_U))
#define UB ((bf16*)(ws_p + WS_U))
#define QB ((bf16*)(ws_p + WS_Q))
#define KB ((bf16*)(ws_p + WS_K))
#define VB ((bf16*)(ws_p + WS_V))
    (void)a;
    { volatile LAS unsigned* st0 = (volatile LAS unsigned*)(ldsl + 138240); if (tid < 4) st0[tid] = 0u; }
    __syncthreads();
    XcdBarrier xbar = xcd_barrier_post((unsigned*)(ws_p + WS_BAR), (volatile LAS unsigned*)(ldsl + 138240));
#define GSYNC() xcd_barrier(xbar)

    PH(0) {
        if (bx < 288) {
            LAS float* sl = (LAS float*)ldsl; LAS float* part = (LAS float*)(ldsl + 36864);
            for (int i = tid; i < 9 * DM; i += NTHR) { const float v = i < 8 * DM ? cvec[i] : c_ctx[i - 8 * DM]; sl[i] = v / (1.0f + __expf(-v)); }
            __syncthreads();
            for (int unit = bx; unit < 288; unit += G) {
                const int cl = tid & 31, kg = tid >> 5, k0 = kg * 64; const float* wp = w_mod + (size_t)k0 * NMODV + unit * 32 + cl;
                float acc[9];
#pragma unroll
                for (int i = 0; i < 9; ++i) acc[i] = 0.f;
                float wv[64];
#pragma unroll
                for (int kk = 0; kk < 64; ++kk) wv[kk] = wp[(size_t)kk * NMODV];
#pragma unroll
                for (int kk = 0; kk < 64; kk += 4) {
#pragma unroll
                    for (int i = 0; i < 9; ++i) { const f32x4 sv = *(const LAS f32x4*)(sl + i * DM + k0 + kk); acc[i] = fmaf(sv.x, wv[kk], fmaf(sv.y, wv[kk + 1], fmaf(sv.z, wv[kk + 2], fmaf(sv.w, wv[kk + 3], acc[i])))); }
                }
#pragma unroll
                for (int i = 0; i < 9; ++i) part[(kg * 9 + i) * 32 + cl] = acc[i];
                __syncthreads();
                if (tid < 288) { const int i = tid >> 5; float sum = 0.f;
#pragma unroll
                    for (int k = 0; k < 16; ++k) sum += part[(k * 9 + i) * 32 + cl];
                    MOD[i * NMODV + unit * 32 + cl] = sum + b_mod[unit * 32 + cl]; }
                __syncthreads();
            }
        }
        __syncthreads();
        {
            LAS float* scr = (LAS float*)(ldsl + wave * 16384);
            constexpr int I_1A = (DM / 64) * (2 * DFF / 32), I_1B = (DFF / 64) * (DM / 32), I_IN = (DM / 64) * (2048 / 32);
            constexpr int NITEMS = I_1A + I_1B + I_IN;
            for (int it = gw; it < NITEMS; it += NGW) {
                int r = it;
                if (r < I_1A) { transpose_item(ffn_w_in, DM, 2 * DFF, W1A, 1, scr, r, lane); continue; } r -= I_1A;
                if (r < I_1B) { transpose_item(ffn_w_out, DFF, DM, W1B, 0, scr, r, lane); continue; } r -= I_1B;
                transpose_item(w_in, DM, 2048, WIN, 2, scr, r, lane);
            }
        }
        const int gt = bx * NTHR + tid, NT_ALL = G * NTHR;
        for (int i = gt; i < 2 * 32 * 64; i += NT_ALL) {
            const int p = i & 63, dg = i >> 6;
            const double dt = dexp((double)ssm_log_dt[dg]), are = (double)ssm_a_re[i], aim = (double)ssm_a_im[i];
            double s1, c1, s2, c2; dsincos(dt * aim, s1, c1); dsincos(256.0 * dt * aim, s2, c2);
            const double mag = dexp(dt * are), mag2 = dexp(256.0 * dt * are);
            const double abr = mag * c1, abi = mag * s1;
            ABAR[i] = make_float2((float)abr, (float)abi); APOW[i] = make_float2((float)(mag2 * c2), (float)(mag2 * s2));
            const double zr = abr - 1.0, zi = abi, den = are * are + aim * aim;
            const double cr = (zr * are + zi * aim) / den, ci = (zi * are - zr * aim) / den;
            const float* bre = ssm_b_re + (size_t)i * 16; const float* bim = ssm_b_im + (size_t)i * 16;
            bf16* dre = BBT + ((size_t)(dg * 4 + (p >> 5)) * 32 + (p & 31)) * 16; bf16* dim = BBT + ((size_t)(dg * 4 + 2 + (p >> 5)) * 32 + (p & 31)) * 16;
#pragma unroll
            for (int h = 0; h < 16; ++h) { const double br = (double)bre[h], bi = (double)bim[h]; dre[h] = (bf16)f2bf((float)(cr * br - ci * bi)); dim[h] = (bf16)f2bf((float)(cr * bi + ci * br)); }
        }
        for (int i = gt; i < 2 * 32 * 16 * 64; i += NT_ALL) {
            const int p = i & 63, dgh = i >> 6;
            ((unsigned*)CM)[(size_t)dgh * 64 + p] = pk2(ssm_c_re[i], -ssm_c_im[i]);
        }
        for (int i = gt; i < 128 * 16; i += NT_ALL) {
            const int f = i & 15, pos = i >> 4;
            const double inv = dexp(-(double)f * (9.210340371976182736 / 16.0)); double s, c; dsincos((double)pos * inv, s, c);
            ROPE[2 * i] = (float)c; ROPE[2 * i + 1] = (float)s;
        }
        for (int i = gt; i < NROWS; i += NT_ALL) { RSS1[i] = 0.f; RSS2[i] = 0.f; }
        if (gt == 0) { float s0 = 0.f, s1 = 0.f; for (int d = 0; d < 64; ++d) { s0 += lam_q[d] * lam_k[d]; s1 += lam_q[64 + d] * lam_k[64 + d]; } MISC[0] = expf(s0) - expf(s1) + 0.2f; }
    }
    grid.sync();

#define NORM_PASS(SRC_LAT, SRC_CTX, NIDX, LATONLY) do { int tid_l = threadIdx.x; asm volatile("" : "+v"(tid_l)); const int lane_l = tid_l & 63, gw_l = vcu * NWAVES + __builtin_amdgcn_readfirstlane(tid_l >> 6); \
        for (int it = gw_l; it < NROWS / 16; it += NGW) { const int r0 = it * 16, pm = r0 >> 8, b = pm / TILES_B, jt = pm - b * TILES_B, rl = r0 & 255; \
            if ((LATONLY) && jt == 32) continue; \
            const float* src = jt < 32 ? (SRC_LAT) + ((size_t)b * SEQ + jt * 256 + rl) * DM : (SRC_CTX) + ((size_t)b * CTXL + rl) * DM; \
            const float* mv = MOD + (jt < 32 ? b : 8) * NMODV + 3 * (NIDX) * DM; \
            norm_rows16<0>(src, XN + (size_t)r0 * DM, nullptr, norm_g + (NIDX) * DM, mv, mv + DM, lane_l); } } while (0)

    PH(1) {
        if (bx < 240) {
            const bool isin = bx < 64; const int unit = isin ? bx : bx - 64, N = isin ? 2048 : 2 * DFF, soff = isin ? 3 * DM : 6 * DM;
            const float* W = isin ? w_in : ffn_w_in + (size_t)DM * 2 * DFF; float* BO = isin ? BIAS1 : BIAS2;
            LAS float* sl = (LAS float*)ldsl; LAS float* part = (LAS float*)(ldsl + 36864);
            for (int i = tid; i < 9 * DM; i += NTHR) sl[i] = MOD[(i >> 10) * NMODV + soff + (i & 1023)];
            __syncthreads();
            const int cl = tid & 31, kg = tid >> 5, k0 = kg * 64; const float* wp = W + (size_t)k0 * N + unit * 32 + cl;
            float acc[9];
#pragma unroll
            for (int i = 0; i < 9; ++i) acc[i] = 0.f;
            float wv[64];
#pragma unroll
            for (int kk = 0; kk < 64; ++kk) wv[kk] = wp[(size_t)kk * N];
#pragma unroll
            for (int kk = 0; kk < 64; kk += 4) {
#pragma unroll
                for (int i = 0; i < 9; ++i) { const f32x4 sv = *(const LAS f32x4*)(sl + i * DM + k0 + kk); acc[i] = fmaf(sv.x, wv[kk], fmaf(sv.y, wv[kk + 1], fmaf(sv.z, wv[kk + 2], fmaf(sv.w, wv[kk + 3], acc[i])))); }
            }
#pragma unroll
            for (int i = 0; i < 9; ++i) part[(kg * 9 + i) * 32 + cl] = acc[i];
            __syncthreads();
            if (tid < 288) { const int i = tid >> 5; float sum = 0.f;
#pragma unroll
                for (int k = 0; k < 16; ++k) sum += part[(k * 9 + i) * 32 + cl];
                const int src = unit * 32 + cl; int drow = src;
                if (isin) { if (src >= 512 && src < 1536) drow = unit * 32 + 2 * (cl & 15) + (cl >> 4); }
                else { const int up = src >= DFF ? 1 : 0, ff = src - up * DFF; drow = (ff >> 7) * 256 + up * 128 + (ff & 127); }
                BO[i * N + drow] = sum; }
            __syncthreads();
        }
        NORM_PASS(x_in, ctx, 0, false);
    }
    GSYNC();
    PH(2) { pg8::Gemm g{XN, W1A, NROWS, 2 * DFF, DM}; pg8::TileOrder S; S.init(264, 22, G, bx, 0); pg8::EpiSwiglu E{ACT, DFF, nullptr, nullptr};
      pg8::gemm_phase<pg8::EpiSwiglu, pg8::TileOrder, true, true>(ldsl, g, S, E); }
    GSYNC();
    PH(3) { pg8::Gemm g{ACT, W1B, NROWS, DM, DFF}; pg8::TileOrder S; S.init(264, 4, G, bx, 0); pg8::EpiResidNorm E{x_in, ctx, out_p, XC, MOD, 2 * DM, 1, norm_g + DM, 4 * DM, XN, RSS1};
      pg8::gemm_phase<pg8::EpiResidNorm, pg8::TileOrder, true, true>(ldsl, g, S, E);
      if (bx >= 32) {
          int tid_l = threadIdx.x; asm volatile("" : "+v"(tid_l)); const int lane_l = tid_l & 63, wave_l = __builtin_amdgcn_readfirstlane(tid_l >> 6);
          LAS float* scr = (LAS float*)(ldsl + wave_l * 16384);
          constexpr int I_1A = (DM / 64) * (2 * DFF / 32), I_1B = (DFF / 64) * (DM / 32), I_OUT = (DM / 64) * (DM / 32), I_GLU = (512 / 64) * (512 / 32);
          for (int it = (bx - 32) * NWAVES + wave_l; it < I_1A + I_1B + I_OUT + I_GLU; it += (G - 32) * NWAVES) {
              int r = it;
              if (r < I_1A) { transpose_item(ffn_w_in + (size_t)DM * 2 * DFF, DM, 2 * DFF, W2A, 1, scr, r, lane_l); continue; } r -= I_1A;
              if (r < I_1B) { transpose_item(ffn_w_out + (size_t)DFF * DM, DFF, DM, W2B, 0, scr, r, lane_l); continue; } r -= I_1B;
              if (r < I_OUT) { transpose_item(w_out, DM, DM, WOUT, 0, scr, r, lane_l); continue; } r -= I_OUT;
              transpose_item(w_glu, 512, 512, WGLU, 0, scr, r, lane_l);
          }
      } }
    GSYNC();
    PH(5) { pg8::Gemm g{XN, WIN, NROWS, 2048, DM}; pg8::TileOrder S; S.init(264, 8, G, bx, 0); pg8::EpiInproj E{UB, QB, KB, VB, ROPE, RSS1, BIAS1};
      pg8::gemm_phase<pg8::EpiInproj, pg8::TileOrder, true, true>(ldsl, g, S, E); }
    GSYNC();
    PH(6) for (int un = vcu; un < 8 * 33 * 4; un += G) { const int gq = un & 3, bc = un >> 2, b = bc / 33, c = bc - b * 33;
        s5_unit_a(ldsl, b, c, gq, UB, ABAR, BBT, EST); }
    GSYNC();
    PH(7) if (bx < 64) {
        const int i = bx * NTHR + tid;
        const int p = i & 63, dir = (i >> 6) & 1, g = (i >> 7) & 31, b = i >> 12;
        const float2 ap = APOW[(dir * 32 + g) * 64 + p];
#define SIDX(cc) (((((size_t)b * 33 + (cc)) * 32 + g) * 2 + dir) * 64 + p)
        float2 h = EST[SIDX(32)];
        if (dir == 0) { HIN[SIDX(0)] = h; for (int c = 0; c < 31; ++c) { const float2 e = EST[SIDX(c)]; const float nr = fmaf(ap.x, h.x, fmaf(-ap.y, h.y, e.x)), ni = fmaf(ap.x, h.y, fmaf(ap.y, h.x, e.y)); h = make_float2(nr, ni); HIN[SIDX(c + 1)] = h; } }
        else { HIN[SIDX(31)] = h; for (int c = 31; c > 0; --c) { const float2 e = EST[SIDX(c)]; const float nr = fmaf(ap.x, h.x, fmaf(-ap.y, h.y, e.x)), ni = fmaf(ap.x, h.y, fmaf(ap.y, h.x, e.y)); h = make_float2(nr, ni); HIN[SIDX(c - 1)] = h; } }
#undef SIDX
    }
    PH(8) {
        const float lam = MISC[0];
        for (int un = vcu; un < 8 * 4 * 32; un += G) {
            const int qb = un & 31, bh = un >> 5, b = bh >> 2, h = bh & 3;
            const size_t rb = (size_t)b * ROWS_B, rq = rb + (size_t)qb * 256;
            attn::body<0>(QB + rq * 512 + h * 128, KB + rb * 512 + h * 128, VB + rb * 512 + h * 128, OATT + rq * 512 + h * 128, nullptr, lam, subln_g, ROWS_B, (char*)lds);
            attn::body<1>(QB + rq * 512 + h * 128 + 64, KB + rb * 512 + h * 128 + 64, VB + rb * 512 + h * 128, OATT + rq * 512 + h * 128, SA + rq * 1024 + 512 + h * 128, lam, subln_g, ROWS_B, (char*)lds);
        }
    }
    GSYNC();
    PH(9) for (int un = vcu; un < 8 * 32 * 4; un += G) { const int gq = un & 3, bc = un >> 2, b = bc >> 5, c = bc & 31;
        s5_unit<true>(ldsl, b, c, gq, UB, ABAR, BBT, CM, HIN, EST, ssm_d, GB, YFB); }
    GSYNC();
    PH(10) { pg8::Gemm g{GB, WGLU, NROWS, 512, 512}; pg8::TileOrder S; S.init(256, 2, G, bx, 1); pg8::EpiGlu E{GB, b_glu, SA};
      pg8::gemm_phase<pg8::EpiGlu, pg8::TileOrder, true, true>(ldsl, g, S, E); }
    GSYNC();
    PH(12) { pg8::Gemm g{SA, WOUT, NROWS, DM, DM}; pg8::TileOrder S; S.init(256, 4, G, bx, 1); pg8::EpiResidNorm E{out_p, XC, out_p, XC, MOD, 5 * DM, 0, norm_g + 2 * DM, 7 * DM, XN2, RSS2};
      pg8::gemm_phase<pg8::EpiResidNorm, pg8::TileOrder, true, true>(ldsl, g, S, E); }
    GSYNC();
    PH(14) { pg8::Gemm g{XN2, W2A, NROWS, 2 * DFF, DM}; pg8::TileOrder S; S.init(256, 22, G, bx, 1); pg8::EpiSwiglu E{ACT, DFF, RSS2, BIAS2};
      pg8::gemm_phase<pg8::EpiSwiglu, pg8::TileOrder, true, true>(ldsl, g, S, E); }
    GSYNC();
    PH(15) { pg8::Gemm g{ACT, W2B, NROWS, DM, DFF}; pg8::TileOrder S; S.init(256, 4, G, bx, 1); pg8::EpiResid E{out_p, XC, out_p, XC, MOD, 8 * DM, 0.5f};
      pg8::gemm_phase<pg8::EpiResid, pg8::TileOrder, true, true>(ldsl, g, S, E); }
    GSYNC();
    PH(16) { int tid_l = threadIdx.x; asm volatile("" : "+v"(tid_l)); const int lane_l = tid_l & 63, gw_l = vcu * NWAVES + __builtin_amdgcn_readfirstlane(tid_l >> 6);
        for (int it = gw_l; it < NB * SEQ / 16; it += NGW) norm_rows16<1>(out_p + (size_t)it * 16 * DM, nullptr, out_p + (size_t)it * 16 * DM, final_g, nullptr, nullptr, lane_l); }
#undef NORM_PASS
}

extern "C" void kernel_launch(void* const* d_in, const int* in_sizes, int n_in, void* d_out, int out_size, void* d_ws, size_t ws_size, hipStream_t stream) {
    static int grid = 0;
    if (grid == 0) {
        if (n_in != 25 || in_sizes[0] != NB * SEQ * DM || out_size != NB * SEQ * DM || ws_size < WS_END) {
            fprintf(stderr, "kernel_launch: shape mismatch (n_in %d, in0 %d, out %d, ws %zu, need %zu); nothing launched\n", n_in, n_in > 0 ? in_sizes[0] : -1, out_size, ws_size, (size_t)WS_END); grid = -1; return; }
        int dev = 0, cus = 0, per_cu = 0;
        if (hipGetDevice(&dev) != hipSuccess || hipDeviceGetAttribute(&cus, hipDeviceAttributeMultiprocessorCount, dev) != hipSuccess) { grid = -1; return; }
        if (hipFuncSetAttribute((const void*)hymba_fwd, hipFuncAttributeMaxDynamicSharedMemorySize, LDS_BYTES) != hipSuccess) { fprintf(stderr, "kernel_launch: hipFuncSetAttribute failed\n"); grid = -1; return; }
        if (hipOccupancyMaxActiveBlocksPerMultiprocessor(&per_cu, (const void*)hymba_fwd, NTHR, LDS_BYTES) != hipSuccess || per_cu < 1) { fprintf(stderr, "kernel_launch: occupancy query says %d\n", per_cu); per_cu = 1; }
        (void)hipGetLastError();
        grid = cus * (per_cu > 1 ? 1 : per_cu);
        if (grid != 256) fprintf(stderr, "kernel_launch: grid %d (expected 256)\n", grid);
    }
    if (grid < 0) return;
    (void)hipMemsetAsync((char*)d_ws + WS_BAR, 0, BAR_ZERO_BYTES, stream);
    Args a{};
    for (int i = 0; i < 25; ++i) a.in[i] = (const float*)d_in[i];
    a.out = (float*)d_out; a.ws = (unsigned char*)d_ws;
    void* args[] = {&a};
    const hipError_t e = hipLaunchCooperativeKernel((const void*)hymba_fwd, dim3(grid), dim3(NTHR), args, LDS_BYTES, stream);
    if (e != hipSuccess) fprintf(stderr, "kernel_launch: cooperative launch failed: %s (grid %d)\n", hipGetErrorString(e), grid);
}
```

```cpp
#include <hip/hip_runtime.h>
#include <hip/hip_cooperative_groups.h>
#include <cstdio>
#include <cstdint>
namespace cg = cooperative_groups;
namespace pg8 {
#define PG8_LAS __attribute__((address_space(3)))
typedef unsigned short bf16_t;
typedef short bf16x8 __attribute__((ext_vector_type(8)));
typedef float f32x4 __attribute__((ext_vector_type(4)));
typedef unsigned u32x4 __attribute__((ext_vector_type(4)));
constexpr int BM = 256, BK = 64, HALF = 128, HTB = HALF * BK * 2  , STAGE_BYTES = 8 * HTB, NXCD = 8, WGM = 8;

__host__ __device__ __forceinline__ int lds_byte(int r, int c) { const int st = (r >> 4) * 2 + (c >> 5), rr = r & 15, cc = c & 31, ob = rr * 64 + cc * 2; return st * 1024 + (ob ^ (((ob >> 9) & 1) << 5)); }
__host__ __device__ __forceinline__ void stage_rc(int b, int& R, int& C) { const int st = b / 1024, sb = b % 1024, swz = sb ^ (((sb >> 9) & 1) << 5); R = (st >> 1) * 16 + swz / 64; C = (st & 1) * 32 + (swz % 64) / 2; }
__host__ __device__ __forceinline__ int perm32(int rho) { const int n = rho >> 4, i = rho & 15; return 8 * (i >> 2) + 4 * n + (i & 3); }

struct Unit { int pm, pn; };
struct Gemm { const bf16_t* A; const bf16_t* Bt; int M, N, K; };

__device__ __forceinline__ unsigned cvt_pk_bf16(float lo, float hi) { unsigned r; asm volatile("v_cvt_pk_bf16_f32 %0, %1, %2" : "=v"(r) : "v"(lo), "v"(hi)); return r; }
typedef float f32x2 __attribute__((ext_vector_type(2)));
typedef unsigned u32x2 __attribute__((ext_vector_type(2)));
constexpr int ROWS_B = 8448, TILES_B = 33, NROWS = 8 * ROWS_B;

struct TileOrder {
    int nM, nN, nwg, G, c, lat;
    __device__ __forceinline__ void init(int nM_, int nN_, int G_, int c_, int lat_) { nM = nM_; nN = nN_; nwg = nM_ * nN_; G = G_; c = c_; lat = lat_; }
    __device__ __forceinline__ bool next(int i, Unit& u) const {
        const long L = (long)i * G + c; if (L >= nwg) return false;
        int wgid = (int)L; { const int q = nwg / NXCD, r = nwg % NXCD, xcd = wgid % NXCD, off = wgid / NXCD; wgid = (xcd < r ? xcd * (q + 1) : r * (q + 1) + (xcd - r) * q) + off; }
        const int nig = WGM * nN, gid = wgid / nig, fm = gid * WGM, gsz = (nM - fm) < WGM ? (nM - fm) : WGM;
        const int lm = fm + ((wgid % nig) % gsz); u.pn = (wgid % nig) / gsz; u.pm = lat ? (lm >> 5) * TILES_B + (lm & 31) : lm; return true;
    }
    __device__ __forceinline__ void a_ready(const Unit&) const {}
    __device__ __forceinline__ void done(const Unit&) const {}
};

__device__ __forceinline__ float fast_sigmoid(float z) { return __builtin_amdgcn_rcpf(1.0f + __builtin_amdgcn_exp2f(-1.4426950408889634f * z)); }
__device__ __forceinline__ float bf_lo(unsigned w) { return __uint_as_float(w << 16); }
__device__ __forceinline__ float bf_hi(unsigned w) { return __uint_as_float(w & 0xffff0000u); }

struct EpiSwiglu {
    static constexpr bool PERM = true, AFTER_DRAIN = false;
    bf16_t* O; int ldc; const float* rss; const float* bias;
    __device__ __forceinline__ void operator()(const f32x4 (&acc)[2][2][4][2], const Unit& u, int wr, int wc, int fr, int fq) const {
        const int row0 = u.pm * BM + wr * 64 + fr, col0 = u.pn * HALF + wc * 32 + 8 * fq;
        f32x4 bv[2][2];
#pragma unroll
        for (int bj = 0; bj < 2; ++bj)
#pragma unroll
            for (int n = 0; n < 2; ++n) bv[bj][n] = rss ? *(const f32x4*)(bias + (u.pm / TILES_B) * 5632 + u.pn * BM + bj * HALF + wc * 32 + 8 * fq + 4 * n) : (f32x4){0.f, 0.f, 0.f, 0.f};
#pragma unroll
        for (int ai = 0; ai < 2; ++ai)
#pragma unroll
            for (int m = 0; m < 4; ++m) {
                bf16_t* rowp = O + (size_t)(row0 + ai * HALF + m * 16) * ldc + col0;
                float v[8];
                const float rstd = rss ? 1.0f / sqrtf(rss[row0 + ai * HALF + m * 16] * (1.0f / 1024.0f) + 1e-6f) : 1.0f;
#pragma unroll
                for (int n = 0; n < 2; ++n)
#pragma unroll
                    for (int e = 0; e < 4; ++e) { const float gt = acc[ai][0][m][n][e] * rstd + bv[0][n][e], up = acc[ai][1][m][n][e] * rstd + bv[1][n][e]; v[4 * n + e] = gt * fast_sigmoid(gt) * up; }
                u32x4 w; w.x = cvt_pk_bf16(v[0], v[1]); w.y = cvt_pk_bf16(v[2], v[3]); w.z = cvt_pk_bf16(v[4], v[5]); w.w = cvt_pk_bf16(v[6], v[7]);
                *(u32x4*)rowp = w;
            }
    }
};

struct EpiResid {
    static constexpr bool PERM = true, AFTER_DRAIN = false;
    const float* res_lat; const float* res_ctx; float* out_lat; float* out_ctx; const float* mod; int modoff; float scale;
    __device__ __forceinline__ void operator()(const f32x4 (&acc)[2][2][4][2], const Unit& u, int wr, int wc, int fr, int fq) const {
        const int b = u.pm / TILES_B, jt = u.pm - b * TILES_B;
        const float* rb; float* ob; const float* gv;
        if (jt < 32) { const size_t o = ((size_t)b * 8192 + (size_t)jt * 256) * 1024; rb = res_lat + o; ob = out_lat + o; gv = mod + b * 9216 + modoff; }
        else { const size_t o = (size_t)b * 256 * 1024; rb = res_ctx + o; ob = out_ctx + o; gv = mod + 8 * 9216 + modoff; }
        const int rl = wr * 64 + fr, col0 = u.pn * BM + wc * 32 + 8 * fq;
        f32x4 g[2][2];
#pragma unroll
        for (int bj = 0; bj < 2; ++bj)
#pragma unroll
            for (int n = 0; n < 2; ++n) g[bj][n] = *(const f32x4*)(gv + col0 + bj * HALF + 4 * n) * scale;
#pragma unroll
        for (int ai = 0; ai < 2; ++ai)
#pragma unroll
            for (int m = 0; m < 4; ++m) { const size_t ro = (size_t)(rl + ai * HALF + m * 16) * 1024 + col0;
#pragma unroll
                for (int bj = 0; bj < 2; ++bj)
#pragma unroll
                    for (int n = 0; n < 2; ++n) { const size_t p = ro + bj * HALF + 4 * n; const f32x4 x = *(const f32x4*)(rb + p); *(f32x4*)(ob + p) = x + g[bj][n] * acc[ai][bj][m][n]; } }
    }
};

struct EpiResidNorm {
    static constexpr bool PERM = true, AFTER_DRAIN = false;
    const float* res_lat; const float* res_ctx; float* out_lat; float* out_ctx; const float* mod; int gateoff; int half_gate; const float* ng; int scaleoff; bf16_t* XNo; float* rss;
    __device__ __forceinline__ void operator()(const f32x4 (&acc)[2][2][4][2], const Unit& u, int wr, int wc, int fr, int fq) const {
        const int b = u.pm / TILES_B, jt = u.pm - b * TILES_B;
        const float* rb; float* ob; const float* mv;
        if (jt < 32) { const size_t o = ((size_t)b * 8192 + (size_t)jt * 256) * 1024; rb = res_lat + o; ob = out_lat + o; mv = mod + b * 9216; }
        else { const size_t o = (size_t)b * 256 * 1024; rb = res_ctx + o; ob = out_ctx + o; mv = mod + 8 * 9216; }
        const int rl = wr * 64 + fr, col0 = u.pn * BM + wc * 32 + 8 * fq;
        const float scale = half_gate ? 0.5f : 1.0f;
        float q[2][4];
#pragma unroll
        for (int ai = 0; ai < 2; ++ai)
#pragma unroll
            for (int m = 0; m < 4; ++m) q[ai][m] = 0.f;
#pragma unroll
        for (int bj = 0; bj < 2; ++bj) {
            const int c = col0 + bj * HALF;
            const f32x4 g0 = *(const f32x4*)(mv + gateoff + c) * scale, g1 = *(const f32x4*)(mv + gateoff + c + 4) * scale;
            const f32x4 gs0 = *(const f32x4*)(ng + c) * (*(const f32x4*)(mv + scaleoff + c) + 1.0f), gs1 = *(const f32x4*)(ng + c + 4) * (*(const f32x4*)(mv + scaleoff + c + 4) + 1.0f);
#pragma unroll
            for (int ai = 0; ai < 2; ++ai)
#pragma unroll
                for (int m = 0; m < 4; ++m) { const int rr = rl + ai * HALF + m * 16; const size_t p = (size_t)rr * 1024 + c; const size_t prow = (size_t)u.pm * BM + rr;
                    const f32x4 y0 = *(const f32x4*)(rb + p) + g0 * acc[ai][bj][m][0], y1 = *(const f32x4*)(rb + p + 4) + g1 * acc[ai][bj][m][1];
                    *(f32x4*)(ob + p) = y0; *(f32x4*)(ob + p + 4) = y1;
                    q[ai][m] += (y0[0] * y0[0] + y0[1] * y0[1]) + (y0[2] * y0[2] + y0[3] * y0[3]) + (y1[0] * y1[0] + y1[1] * y1[1]) + (y1[2] * y1[2] + y1[3] * y1[3]);
                    const f32x4 z0 = y0 * gs0, z1 = y1 * gs1;
                    u32x4 w; w.x = cvt_pk_bf16(z0[0], z0[1]); w.y = cvt_pk_bf16(z0[2], z0[3]); w.z = cvt_pk_bf16(z1[0], z1[1]); w.w = cvt_pk_bf16(z1[2], z1[3]);
                    *(u32x4*)(XNo + prow * 1024 + c) = w;
                    if (m & 1) asm volatile("" ::: "memory"); }
        }
#pragma unroll
        for (int ai = 0; ai < 2; ++ai)
#pragma unroll
            for (int m = 0; m < 4; ++m) { float t = q[ai][m]; t += __shfl_xor(t, 16); t += __shfl_xor(t, 32);
                if (fq == 0) __hip_atomic_fetch_add((__attribute__((address_space(1))) float*)(rss + (size_t)u.pm * BM + rl + ai * HALF + m * 16), t, __ATOMIC_RELAXED, __HIP_MEMORY_SCOPE_AGENT); }
    }
};

struct EpiInproj {
    static constexpr bool PERM = true, AFTER_DRAIN = false;
    bf16_t* U; bf16_t* Q; bf16_t* K; bf16_t* V; const float* rope; const float* rss; const float* bias;
    __device__ __forceinline__ void operator()(const f32x4 (&acc)[2][2][4][2], const Unit& u, int wr, int wc, int fr, int fq) const {
        const int sec = u.pn >> 1, jt = u.pm % TILES_B;
        bf16_t* base = sec == 0 ? U : sec == 1 ? Q : sec == 2 ? K : V;
        const bool dorope = (sec == 1 || sec == 2) && jt < 32;
        const float qs = sec == 1 ? 0.125f * 1.4426950408889634f : 1.0f;
        const int col0 = (u.pn & 1) * BM + wc * 32 + 8 * fq, axis = wc & 1;
        const float* bp = bias + (jt < 32 ? u.pm / TILES_B : 8) * 2048 + u.pn * BM + wc * 32 + 8 * fq;
        f32x4 bv[2][2];
#pragma unroll
        for (int bj = 0; bj < 2; ++bj)
#pragma unroll
            for (int n = 0; n < 2; ++n) bv[bj][n] = *(const f32x4*)(bp + bj * HALF + 4 * n);
#pragma unroll
        for (int ai = 0; ai < 2; ++ai)
#pragma unroll
            for (int m = 0; m < 4; ++m) {
                const int rowl = wr * 64 + fr + ai * HALF + m * 16;
                bf16_t* rowp = base + (size_t)(u.pm * BM + rowl) * 512 + col0;
                const float rstd = 1.0f / sqrtf(rss[u.pm * BM + rowl] * (1.0f / 1024.0f) + 1e-6f);
                f32x4 cs0 = {1.f, 0.f, 1.f, 0.f}, cs1 = {1.f, 0.f, 1.f, 0.f};
                if (dorope) { const int t = jt * 256 + rowl, pos = axis ? (t & 63) : (t >> 6); const float* rp = rope + (pos * 16 + 4 * fq) * 2; cs0 = *(const f32x4*)rp; cs1 = *(const f32x4*)(rp + 4); }
#pragma unroll
                for (int bj = 0; bj < 2; ++bj) {
                    const f32x4 a0 = acc[ai][bj][m][0] * rstd + bv[bj][0], a1 = acc[ai][bj][m][1] * rstd + bv[bj][1];
                    float o[8];
                    o[0] = a0[0] * cs0[0] - a0[1] * cs0[1]; o[1] = a0[1] * cs0[0] + a0[0] * cs0[1];
                    o[2] = a0[2] * cs0[2] - a0[3] * cs0[3]; o[3] = a0[3] * cs0[2] + a0[2] * cs0[3];
                    o[4] = a1[0] * cs1[0] - a1[1] * cs1[1]; o[5] = a1[1] * cs1[0] + a1[0] * cs1[1];
                    o[6] = a1[2] * cs1[2] - a1[3] * cs1[3]; o[7] = a1[3] * cs1[2] + a1[2] * cs1[3];
                    u32x4 w; w.x = cvt_pk_bf16(o[0] * qs, o[1] * qs); w.y = cvt_pk_bf16(o[2] * qs, o[3] * qs); w.z = cvt_pk_bf16(o[4] * qs, o[5] * qs); w.w = cvt_pk_bf16(o[6] * qs, o[7] * qs);
                    *(u32x4*)(rowp + bj * HALF) = w;
                }
            }
    }
};

struct EpiGlu {
    static constexpr bool PERM = true, AFTER_DRAIN = false;
    const bf16_t* Gb; const float* bglu; bf16_t* SA;
    __device__ __forceinline__ void operator()(const f32x4 (&acc)[2][2][4][2], const Unit& u, int wr, int wc, int fr, int fq) const {
        const int row0 = u.pm * BM + wr * 64 + fr, col0 = u.pn * BM + wc * 32 + 8 * fq;
        f32x4 bv[2][2];
#pragma unroll
        for (int bj = 0; bj < 2; ++bj)
#pragma unroll
            for (int n = 0; n < 2; ++n) bv[bj][n] = *(const f32x4*)(bglu + col0 + bj * HALF + 4 * n);
#pragma unroll
        for (int ai = 0; ai < 2; ++ai)
#pragma unroll
            for (int m = 0; m < 4; ++m) { const size_t row = (size_t)(row0 + ai * HALF + m * 16);
#pragma unroll
                for (int bj = 0; bj < 2; ++bj) {
                    const u32x4 gw = *(const u32x4*)(Gb + row * 512 + col0 + bj * HALF);
                    const f32x4 z0 = acc[ai][bj][m][0] + bv[bj][0], z1 = acc[ai][bj][m][1] + bv[bj][1];
                    u32x4 w;
                    w.x = cvt_pk_bf16(bf_lo(gw.x) * fast_sigmoid(z0[0]), bf_hi(gw.x) * fast_sigmoid(z0[1]));
                    w.y = cvt_pk_bf16(bf_lo(gw.y) * fast_sigmoid(z0[2]), bf_hi(gw.y) * fast_sigmoid(z0[3]));
                    w.z = cvt_pk_bf16(bf_lo(gw.z) * fast_sigmoid(z1[0]), bf_hi(gw.z) * fast_sigmoid(z1[1]));
                    w.w = cvt_pk_bf16(bf_lo(gw.w) * fast_sigmoid(z1[2]), bf_hi(gw.w) * fast_sigmoid(z1[3]));
                    *(u32x4*)(SA + row * 1024 + col0 + bj * HALF) = w;
                } }
    }
};

template <class Epi, class Sched, bool ALIGN_EPI = false, bool SP2 = false>
__device__ __forceinline__ void gemm_phase(PG8_LAS unsigned char* lds, const Gemm g, const Sched& S, const Epi& E) {
    int tid_ = threadIdx.x; asm volatile("" : "+v"(tid_));
    const int tid = tid_, wid = __builtin_amdgcn_readfirstlane(tid >> 6), lane = tid & 63, wr = wid >> 2, wc = wid & 3, fr = lane & 15, fq = lane >> 4;
    const int K = g.K, nt = K / BK;
    unsigned voffA[2], voffB[2];
#pragma unroll
    for (int i = 0; i < 2; ++i) { int R, C; stage_rc(tid * 16 + i * 8192, R, C); const int Rb = Epi::PERM ? ((R & ~31) + perm32(R & 31)) : R;
        voffA[i] = (unsigned)(R * K + C) * 2u; voffB[i] = (unsigned)(Rb * K + C) * 2u; }
    const size_t kstep = (size_t)(BK * 2);
    const size_t hstep = (size_t)HALF * K * 2;
    const size_t tstep = 2 * hstep;
    const unsigned ldsw = (unsigned)wid * 1024u;
    const int aoff = lds_byte(wr * 64 + fr, fq * 8), boff = lds_byte(wc * 32 + fr, fq * 8);
#define PG8_SA(b, h) (((b) * 2 + (h)) * HTB)
#define PG8_SB(b, h) ((4 + (b) * 2 + (h)) * HTB)
#define PG8_STAGE(bufoff, gbase, voff) do { _Pragma("unroll") for (int _i = 0; _i < 2; ++_i) \
        __builtin_amdgcn_global_load_lds((const unsigned*)((const char*)(gbase) + (voff)[_i]), (PG8_LAS unsigned*)(lds + (bufoff) + ldsw + _i * 8192), 16, 0, 0); } while (0)
#define PG8_LDA(dst, b, h) do { _Pragma("unroll") for (int m = 0; m < 4; ++m) _Pragma("unroll") for (int k = 0; k < 2; ++k) dst[m][k] = *(const PG8_LAS bf16x8*)(lds + PG8_SA(b, h) + aoff + m * 2048 + k * 1024); } while (0)
#define PG8_LDB(dst, b, h) do { _Pragma("unroll") for (int n = 0; n < 2; ++n) _Pragma("unroll") for (int k = 0; k < 2; ++k) dst[n][k] = *(const PG8_LAS bf16x8*)(lds + PG8_SB(b, h) + boff + n * 2048 + k * 1024); } while (0)
#define PG8_MMA(ai, bj, At, Bt) do { __builtin_amdgcn_s_setprio(1); _Pragma("unroll") for (int m = 0; m < 4; ++m) _Pragma("unroll") for (int n = 0; n < 2; ++n) _Pragma("unroll") for (int k = 0; k < 2; ++k) \
        acc[ai][bj][m][n] = __builtin_amdgcn_mfma_f32_16x16x32_bf16(Bt[n][k], At[m][k], acc[ai][bj][m][n], 0, 0, 0); __builtin_amdgcn_s_setprio(0); } while (0)
#define PG8_WAIT_V(n) asm volatile("s_waitcnt vmcnt(" #n ")" ::: "memory")
#define PG8_WAIT_L(n) asm volatile("s_waitcnt lgkmcnt(" #n ")" ::: "memory")
#define PG8_BAR __builtin_amdgcn_s_barrier()
#define PG8_SCHED __builtin_amdgcn_sched_barrier(0)
    Unit cur, nxt; int ui = 0;
    if (!S.next(0, cur)) return;
    f32x4 acc[2][2][4][2];
#pragma unroll
    for (int a = 0; a < 2; ++a)
#pragma unroll
        for (int b = 0; b < 2; ++b)
#pragma unroll
            for (int m = 0; m < 4; ++m)
#pragma unroll
                for (int n = 0; n < 2; ++n) acc[a][b][m][n] = (f32x4){0.f, 0.f, 0.f, 0.f};
    bf16x8 At[4][2], B0[2][2], B1[2][2];
    const char* cA = (const char*)g.A + (size_t)cur.pm * tstep; const char* cB = (const char*)g.Bt + (size_t)cur.pn * tstep;
    S.a_ready(cur);
    if constexpr (SP2) {
        PG8_STAGE(PG8_SB(0, 0), cB, voffB); PG8_STAGE(PG8_SB(0, 1), cB + hstep, voffB); PG8_STAGE(PG8_SA(0, 0), cA, voffA); PG8_STAGE(PG8_SA(0, 1), cA + hstep, voffA);
        if (wr == 1) PG8_BAR;
        PG8_WAIT_V(2); PG8_BAR;
        PG8_STAGE(PG8_SB(1, 0), cB + kstep, voffB); PG8_STAGE(PG8_SA(1, 0), cA + kstep, voffA); PG8_STAGE(PG8_SB(1, 1), cB + hstep + kstep, voffB);
        PG8_WAIT_V(6); PG8_BAR;
    } else {
        PG8_STAGE(PG8_SB(0, 0), cB, voffB); PG8_STAGE(PG8_SA(0, 0), cA, voffA); PG8_STAGE(PG8_SB(0, 1), cB + hstep, voffB); PG8_STAGE(PG8_SA(0, 1), cA + hstep, voffA);
        if (wr == 1) PG8_BAR;
        PG8_WAIT_V(4); PG8_BAR;
        PG8_STAGE(PG8_SB(1, 0), cB + kstep, voffB); PG8_STAGE(PG8_SA(1, 0), cA + kstep, voffA); PG8_STAGE(PG8_SB(1, 1), cB + hstep + kstep, voffB);
        PG8_WAIT_V(6); PG8_BAR;
    }
    for (;;) {
        const bool has_next = S.next(ui + 1, nxt);
        const char* nA = has_next ? (const char*)g.A + (size_t)nxt.pm * tstep : cA; const char* nB = has_next ? (const char*)g.Bt + (size_t)nxt.pn * tstep : cB;
        for (int t = 0; t < nt; t += 2) {
            const bool last = (t == nt - 2);
            const char* a1 = cA + (size_t)(t + 1) * kstep;
            const char* a2 = last ? nA : cA + (size_t)(t + 2) * kstep; const char* b2 = last ? nB : cB + (size_t)(t + 2) * kstep;
            const char* a3 = a2 + kstep; const char* b3 = b2 + kstep;
            if (last && has_next) S.a_ready(nxt);
            if constexpr (SP2) {
            PG8_LDB(B0, 0, 0); PG8_LDB(B1, 0, 1); PG8_SCHED; PG8_LDA(At, 0, 0); PG8_STAGE(PG8_SA(1, 1), a1 + hstep, voffA);
            PG8_WAIT_V(8); PG8_WAIT_L(0); PG8_BAR; PG8_MMA(0, 0, At, B0); PG8_MMA(0, 1, At, B1); PG8_BAR; PG8_SCHED;
            PG8_LDA(At, 0, 1); PG8_STAGE(PG8_SB(0, 0), b2, voffB); PG8_STAGE(PG8_SB(0, 1), b2 + hstep, voffB); PG8_STAGE(PG8_SA(0, 0), a2, voffA);
            PG8_WAIT_V(8); PG8_WAIT_L(0); PG8_BAR; PG8_MMA(1, 0, At, B0); PG8_MMA(1, 1, At, B1); PG8_BAR; PG8_SCHED;
            PG8_LDB(B0, 1, 0); PG8_LDB(B1, 1, 1); PG8_SCHED; PG8_LDA(At, 1, 0); PG8_STAGE(PG8_SA(0, 1), a2 + hstep, voffA);
            PG8_WAIT_V(8); PG8_WAIT_L(0); PG8_BAR; PG8_MMA(0, 0, At, B0); PG8_MMA(0, 1, At, B1); PG8_BAR; PG8_SCHED;
            PG8_LDA(At, 1, 1); PG8_STAGE(PG8_SB(1, 0), b3, voffB); PG8_STAGE(PG8_SB(1, 1), b3 + hstep, voffB); PG8_STAGE(PG8_SA(1, 0), a3, voffA);
            PG8_WAIT_V(8); PG8_WAIT_L(0); PG8_BAR; PG8_MMA(1, 0, At, B0); PG8_MMA(1, 1, At, B1); PG8_BAR; PG8_SCHED;
            } else {
            PG8_LDB(B0, 0, 0); PG8_SCHED; PG8_LDA(At, 0, 0); PG8_STAGE(PG8_SA(1, 1), a1 + hstep, voffA);
            PG8_WAIT_L(8); PG8_BAR; PG8_WAIT_L(0); PG8_MMA(0, 0, At, B0); PG8_BAR; PG8_SCHED;
            PG8_LDB(B1, 0, 1); PG8_STAGE(PG8_SB(0, 0), b2, voffB);
            PG8_BAR; PG8_WAIT_L(0); PG8_MMA(0, 1, At, B1); PG8_BAR;
            PG8_LDA(At, 0, 1); PG8_STAGE(PG8_SA(0, 0), a2, voffA);
            PG8_BAR; PG8_WAIT_L(0); PG8_MMA(1, 0, At, B0); PG8_BAR; PG8_SCHED;
            PG8_STAGE(PG8_SB(0, 1), b2 + hstep, voffB);
            PG8_WAIT_V(6); PG8_BAR; PG8_MMA(1, 1, At, B1); PG8_BAR;
            PG8_LDB(B0, 1, 0); PG8_SCHED; PG8_LDA(At, 1, 0); PG8_STAGE(PG8_SA(0, 1), a2 + hstep, voffA);
            PG8_WAIT_L(8); PG8_BAR; PG8_WAIT_L(0); PG8_MMA(0, 0, At, B0); PG8_BAR; PG8_SCHED;
            PG8_LDB(B1, 1, 1); PG8_STAGE(PG8_SB(1, 0), b3, voffB);
            PG8_BAR; PG8_WAIT_L(0); PG8_MMA(0, 1, At, B1); PG8_BAR;
            PG8_LDA(At, 1, 1); PG8_STAGE(PG8_SA(1, 0), a3, voffA);
            PG8_BAR; PG8_WAIT_L(0); PG8_MMA(1, 0, At, B0); PG8_BAR; PG8_SCHED;
            PG8_STAGE(PG8_SB(1, 1), b3 + hstep, voffB);
            PG8_WAIT_V(6); PG8_BAR; PG8_MMA(1, 1, At, B1); PG8_BAR;
            }
        }
        if constexpr (ALIGN_EPI) { if (wr == 0) PG8_BAR; }
        if constexpr (!Epi::AFTER_DRAIN) { E(acc, cur, wr, wc, fr, fq); S.done(cur); }
        if (!has_next) break;
#pragma unroll
        for (int a = 0; a < 2; ++a)
#pragma unroll
            for (int b = 0; b < 2; ++b)
#pragma unroll
                for (int m = 0; m < 4; ++m)
#pragma unroll
                    for (int n = 0; n < 2; ++n) acc[a][b][m][n] = (f32x4){0.f, 0.f, 0.f, 0.f};
        cur = nxt; cA = nA; cB = nB; ++ui;
        if constexpr (ALIGN_EPI) { if (wr == 1) PG8_BAR; }
    }
    PG8_WAIT_V(0);
    if constexpr (!ALIGN_EPI) { if (wr == 0) PG8_BAR; }
    PG8_BAR;
    if constexpr (Epi::AFTER_DRAIN) { E.fused(acc, cur, wr, wc, fr, fq, lds, wid, lane); S.done(cur); }
#undef PG8_SA
#undef PG8_SB
#undef PG8_STAGE
#undef PG8_LDA
#undef PG8_LDB
#undef PG8_MMA
#undef PG8_WAIT_V
#undef PG8_WAIT_L
#undef PG8_BAR
#undef PG8_SCHED
}
}

namespace attn {
typedef unsigned short bf16_t;
using bf16x8 = __attribute__((ext_vector_type(8))) short;
using s16x4  = __attribute__((ext_vector_type(4))) short;
using f32x16 = __attribute__((ext_vector_type(16))) float;
using u32x4  = __attribute__((ext_vector_type(4))) unsigned;
constexpr int NW = 8, QBLK = 32, KVBLK = 64;
constexpr float QSCALE = 0.125f * 1.4426950408889634f;
constexpr int LDQ = 512, LDK = 512, LDV = 512, LDO = 512;
constexpr int SHM_V = KVBLK * 128 * 2, SHM_K = KVBLK * 64 * 2, SHM_ATTN = 2 * SHM_V + 2 * SHM_K + NW * 64 * 4;
#define KSWZ64(row, colB) ((row) * 128 + ((colB) ^ ((((row) >> 1) & 7) << 4)))
#define SBAR() __builtin_amdgcn_sched_barrier(0)
__device__ __forceinline__ int crow(int r, int hi) { return (r & 3) + 8 * (r >> 2) + 4 * hi; }
__device__ __forceinline__ unsigned cvtpk(float lo, float hi) { unsigned r; asm volatile("v_cvt_pk_bf16_f32 %0, %1, %2" : "=v"(r) : "v"(lo), "v"(hi)); return r; }
constexpr float THR2 = 11.5f;
template <bool FIRST, bool GUARD>
__device__ __forceinline__ void partialSM(f32x16& p0, f32x16& p1, float& m_reg, float& alpha) {
  if (!GUARD) {
    alpha = 1.f;
#pragma unroll
    for (int r = 0; r < 16; ++r) p0[r] = __builtin_amdgcn_exp2f(p0[r]);
    return;
  }
  if (!FIRST) { if (__builtin_expect(__any(m_reg != 0.f), 0)) {
#pragma unroll
      for (int r = 0; r < 16; ++r) { p0[r] -= m_reg; p1[r] -= m_reg; } } }
  float a = fmaxf(fmaxf(p0[0], p0[1]), p1[0]), b = fmaxf(fmaxf(p0[2], p0[3]), p1[1]); a = fmaxf(fmaxf(a, p1[2]), p1[3]);
#pragma unroll
  for (int r = 4; r < 16; r += 4) { a = fmaxf(fmaxf(a, p0[r]), p0[r + 1]); b = fmaxf(fmaxf(b, p0[r + 2]), p0[r + 3]); a = fmaxf(fmaxf(a, p1[r]), p1[r + 1]); b = fmaxf(fmaxf(b, p1[r + 2]), p1[r + 3]); }
  float pmax = fmaxf(a, b);
  { auto rr = __builtin_amdgcn_permlane32_swap(__float_as_uint(pmax), __float_as_uint(pmax), false, false);
    pmax = fmaxf(__uint_as_float(rr[0]), __uint_as_float(rr[1])); }
  alpha = 1.f;
  if (FIRST) {
    if (__builtin_expect(__any(fabsf(pmax) > THR2), 0)) { const float dl = fabsf(pmax) > THR2 ? pmax : 0.f; m_reg = dl;
#pragma unroll
      for (int r = 0; r < 16; ++r) { p0[r] -= dl; p1[r] -= dl; } }
  } else {
    if (__builtin_expect(__any(pmax > THR2), 0)) { const float dl = fmaxf(pmax, 0.f); m_reg += dl;
#pragma unroll
      for (int r = 0; r < 16; ++r) { p0[r] -= dl; p1[r] -= dl; }
      alpha = __builtin_amdgcn_exp2f(-dl); }
  }
#pragma unroll
  for (int r = 0; r < 16; ++r) p0[r] = __builtin_amdgcn_exp2f(p0[r]);
}
__device__ __forceinline__ void finishSM(f32x16& p0, f32x16& p1, bf16x8& pa0, bf16x8& pa1, bf16x8& pa2, bf16x8& pa3) {
#pragma unroll
  for (int r = 0; r < 16; ++r) p1[r] = __builtin_amdgcn_exp2f(p1[r]);
#define PK4(P, BASE, OUT) do { unsigned a0 = cvtpk(P[BASE + 0], P[BASE + 1]), a1 = cvtpk(P[BASE + 2], P[BASE + 3]);   \
    unsigned b0 = cvtpk(P[BASE + 4], P[BASE + 5]), b1 = cvtpk(P[BASE + 6], P[BASE + 7]);                              \
    auto r0 = __builtin_amdgcn_permlane32_swap(a0, b0, false, false); auto r1 = __builtin_amdgcn_permlane32_swap(a1, b1, false, false); \
    u32x4 w = {r0[0], r1[0], r0[1], r1[1]}; OUT = *reinterpret_cast<bf16x8*>(&w); } while (0)
  PK4(p0, 0, pa0); PK4(p0, 8, pa1); PK4(p1, 0, pa2); PK4(p1, 8, pa3);
#undef PK4
}
__device__ __forceinline__ void qkt(f32x16& p0, f32x16& p1, const char* Ks, const bf16x8* qr, int r32, int hi) {
  p0 = f32x16{}; p1 = f32x16{};
#pragma unroll
  for (int d0 = 0; d0 < 4; ++d0) { const int cb = (d0 * 16 + hi * 8) * 2;
    bf16x8 b0 = *reinterpret_cast<const bf16x8*>(Ks + KSWZ64(r32, cb));
    bf16x8 b1 = *reinterpret_cast<const bf16x8*>(Ks + KSWZ64(32 + r32, cb));
    p0 = __builtin_amdgcn_mfma_f32_32x32x16_bf16(b0, qr[d0], p0, 0, 0, 0);
    p1 = __builtin_amdgcn_mfma_f32_32x32x16_bf16(b1, qr[d0], p1, 0, 0, 0); }
}
__device__ __forceinline__ int v_st(int k, int c) { const int kk = (k & ~0xC) | ((k & 4) << 1) | ((k & 8) >> 1); return ((kk >> 3) * 4 + (c >> 5)) * 512 + ((kk & 7) * 32 + (c & 31)) * 2; }
__device__ __forceinline__ int v_rd_base(int lane) { return ((lane & 3) << 3) | (((lane >> 2) & 3) << 6) | (((lane >> 4) & 1) << 5) | (((lane >> 5) & 1) << 8); }
constexpr int v_rd_off(int d0, int ks, int half) { return d0 * 512 + ks * 4096 + half * 2048; }
template <int OFF> __device__ __forceinline__ s16x4 tr_read(int vb) {
  s16x4 r; asm volatile("ds_read_b64_tr_b16 %0, %1 offset:%2" : "=&v"(r) : "v"(vb), "i"(OFF) : "memory"); return r;
}
template <int D0> __device__ __forceinline__ void pv_one(f32x16& od, int vb, bf16x8 pa0, bf16x8 pa1, bf16x8 pa2, bf16x8 pa3) {
  const s16x4 l0 = tr_read<v_rd_off(D0, 0, 0)>(vb), h0 = tr_read<v_rd_off(D0, 0, 1)>(vb), l1 = tr_read<v_rd_off(D0, 1, 0)>(vb), h1 = tr_read<v_rd_off(D0, 1, 1)>(vb);
  const s16x4 l2 = tr_read<v_rd_off(D0, 2, 0)>(vb), h2 = tr_read<v_rd_off(D0, 2, 1)>(vb), l3 = tr_read<v_rd_off(D0, 3, 0)>(vb), h3 = tr_read<v_rd_off(D0, 3, 1)>(vb);
  asm volatile("s_waitcnt lgkmcnt(0)" ::: "memory"); SBAR();
#define PK(L, H) (bf16x8){L[0], L[1], L[2], L[3], H[0], H[1], H[2], H[3]}
  od = __builtin_amdgcn_mfma_f32_32x32x16_bf16(pa0, PK(l0, h0), od, 0, 0, 0);
  od = __builtin_amdgcn_mfma_f32_32x32x16_bf16(pa1, PK(l1, h1), od, 0, 0, 0);
  od = __builtin_amdgcn_mfma_f32_32x32x16_bf16(pa2, PK(l2, h2), od, 0, 0, 0);
  od = __builtin_amdgcn_mfma_f32_32x32x16_bf16(pa3, PK(l3, h3), od, 0, 0, 0);
#undef PK
}
__device__ __forceinline__ void pv_d0(f32x16* o, f32x16& osum, int vb, bf16x8 pa0, bf16x8 pa1, bf16x8 pa2, bf16x8 pa3) {
  { const bf16x8 ones = {16256, 16256, 16256, 16256, 16256, 16256, 16256, 16256};
    osum = __builtin_amdgcn_mfma_f32_32x32x16_bf16(pa0, ones, osum, 0, 0, 0); osum = __builtin_amdgcn_mfma_f32_32x32x16_bf16(pa1, ones, osum, 0, 0, 0);
    osum = __builtin_amdgcn_mfma_f32_32x32x16_bf16(pa2, ones, osum, 0, 0, 0); osum = __builtin_amdgcn_mfma_f32_32x32x16_bf16(pa3, ones, osum, 0, 0, 0); }
  pv_one<0>(o[0], vb, pa0, pa1, pa2, pa3); pv_one<1>(o[1], vb, pa0, pa1, pa2, pa3); pv_one<2>(o[2], vb, pa0, pa1, pa2, pa3); pv_one<3>(o[3], vb, pa0, pa1, pa2, pa3);
}
template <int COMP, bool GUARD>
__device__ __forceinline__ bool body(const bf16_t* __restrict__ Qb, const bf16_t* __restrict__ Kh, const bf16_t* __restrict__ Vh, float* Ob, bf16_t* __restrict__ SAo, float lam, const float* __restrict__ sg, int seq, char* lds) {
  int tid_ = threadIdx.x; asm volatile("" : "+v"(tid_));
  const int tid = tid_, wid = tid >> 6, lane = tid & 63, r32 = lane & 31, hi = lane >> 5;
  char* V_lds = lds; char* K_lds = lds + 4 * SHM_V;
  float* ws = (float*)(lds + 4 * SHM_V + 4 * SHM_K) + wid * 64; float* al_l = ws + 32;
  float m_reg = 0.f; f32x16 o[4] = {}; f32x16 osum = {}; bf16x8 qr[4];
  const bf16_t* Qw = Qb + (long)(wid * QBLK + r32) * LDQ + hi * 8;
#pragma unroll
  for (int d0 = 0; d0 < 4; ++d0) qr[d0] = *reinterpret_cast<const bf16x8*>(Qw + d0 * 16);
  const int sr = tid >> 4, sc = (tid & 15) * 8, vst0 = v_st(sr, sc), vst1 = v_st(32 + sr, sc);
  const int ksr = tid >> 3, ksc = (tid & 7) * 8, kst = KSWZ64(ksr, ksc * 2);
  const int vb0 = (int)(uintptr_t)V_lds + v_rd_base(lane);
  bf16x8 rvs0, rvs1, rks0;
#define SLOAD(k0) do { rvs0 = *reinterpret_cast<const bf16x8*>(&Vh[(long)((k0) + sr) * LDV + sc]); rvs1 = *reinterpret_cast<const bf16x8*>(&Vh[(long)((k0) + 32 + sr) * LDV + sc]); \
    rks0 = *reinterpret_cast<const bf16x8*>(&Kh[(long)((k0) + ksr) * LDK + ksc]); } while (0)
#define SWRITE(slot) do { *(bf16x8*)(V_lds + (slot) * SHM_V + vst0) = rvs0; *(bf16x8*)(V_lds + (slot) * SHM_V + vst1) = rvs1; *(bf16x8*)(K_lds + (slot) * SHM_K + kst) = rks0; } while (0)
#define RESC(a) do { if (__any((a) < 1.f)) { if (hi == 0) al_l[r32] = (a); asm volatile("s_waitcnt lgkmcnt(0)" ::: "memory"); \
    _Pragma("unroll") for (int r = 0; r < 16; ++r) { const float f_ = al_l[crow(r, hi)]; osum[r] *= f_; _Pragma("unroll") for (int d = 0; d < 4; ++d) o[d][r] *= f_; } } } while (0)
  f32x16 pA0, pA1, pB0, pB1; float alA, alB; bf16x8 pa0, pa1, pa2, pa3; const int NT = seq / KVBLK;
  SLOAD(0); SWRITE(0); SLOAD(KVBLK); __syncthreads();
  qkt(pA0, pA1, K_lds, qr, r32, hi); partialSM<true, GUARD>(pA0, pA1, m_reg, alA);
  SWRITE(1); SLOAD(2 * KVBLK); __syncthreads();
  const int grp = __builtin_amdgcn_readfirstlane(wid >> 2);
#define ITER(X0, X1, Y0, Y1, alX, i) do { const int scur = (i) & 3, sp = ((i) - 1) & 3, sn = ((i) + 1) & 3; \
    SBAR(); qkt(X0, X1, K_lds + scur * SHM_K, qr, r32, hi); \
    finishSM(Y0, Y1, pa0, pa1, pa2, pa3); SBAR(); \
    if (grp) { SWRITE(sn); if ((i) + 2 < NT) SLOAD(((i) + 2) * KVBLK); __syncthreads(); } \
    pv_d0(o, osum, vb0 + sp * SHM_V, pa0, pa1, pa2, pa3); partialSM<false, GUARD>(X0, X1, m_reg, alX); \
    if (GUARD) RESC(alX); \
    if (!grp) { SWRITE(sn); if ((i) + 2 < NT) SLOAD(((i) + 2) * KVBLK); __syncthreads(); } } while (0)
  int i = 1;
  for (; i + 1 < NT; i += 2) {
    ITER(pB0, pB1, pA0, pA1, alB, i);
    ITER(pA0, pA1, pB0, pB1, alA, i + 1);
  }
  { const int scur = i & 3, sp = (i - 1) & 3;
  SBAR(); qkt(pB0, pB1, K_lds + scur * SHM_K, qr, r32, hi);
  finishSM(pA0, pA1, pa0, pa1, pa2, pa3); SBAR();
  pv_d0(o, osum, vb0 + sp * SHM_V, pa0, pa1, pa2, pa3); partialSM<false, GUARD>(pB0, pB1, m_reg, alB);
  if (GUARD) RESC(alB);
  finishSM(pB0, pB1, pa0, pa1, pa2, pa3); SBAR();
  pv_d0(o, osum, vb0 + scur * SHM_V, pa0, pa1, pa2, pa3); }
#undef ITER
  if (!GUARD) {
    bool ok = true;
#pragma unroll
    for (int r = 0; r < 16; ++r) ok = ok && (osum[r] > 0.f) && (osum[r] < 3.0e38f);
    if (__syncthreads_or(ok ? 0 : 1)) return true;
  }
  float rli[16];
#pragma unroll
  for (int r = 0; r < 16; ++r) rli[r] = __builtin_amdgcn_rcpf(osum[r]);
  float* Ow = Ob + (long)(wid * QBLK) * LDO;
  if (COMP == 0) {
#pragma unroll
    for (int r = 0; r < 16; ++r) { const int orow = crow(r, hi);
#pragma unroll
      for (int d0 = 0; d0 < 4; ++d0) Ow[(long)orow * LDO + d0 * 32 + r32] = o[d0][r] * rli[r]; }
  } else {
    float ss[16];
#pragma unroll
    for (int r = 0; r < 16; ++r) { const int orow = crow(r, hi); float q = 0.f;
#pragma unroll
      for (int d0 = 0; d0 < 4; ++d0) { const float d = Ow[(long)orow * LDO + d0 * 32 + r32] - lam * (o[d0][r] * rli[r]); o[d0][r] = d; q = fmaf(d, d, q); }
      ss[r] = q; }
#pragma unroll
    for (int r = 0; r < 16; ++r) { float q = ss[r]; q += __shfl_xor(q, 1); q += __shfl_xor(q, 2); q += __shfl_xor(q, 4); q += __shfl_xor(q, 8); q += __shfl_xor(q, 16);
      ss[r] = 1.0f / sqrtf(q * (1.0f / 128.0f) + 1e-6f); }
    float gsub[4];
#pragma unroll
    for (int d0 = 0; d0 < 4; ++d0) gsub[d0] = sg[d0 * 32 + r32] * 0.8f;
    bf16_t* Sw = SAo + (long)(wid * QBLK) * 1024;
#pragma unroll
    for (int r = 0; r < 16; ++r) { const int orow = crow(r, hi);
#pragma unroll
      for (int d0 = 0; d0 < 4; ++d0) { const float y = o[d0][r] * ss[r] * gsub[d0]; unsigned u = __builtin_bit_cast(unsigned, y); u = (u + 0x7fffu + ((u >> 16) & 1u)) >> 16;
        Sw[(long)orow * 1024 + d0 * 32 + r32] = (bf16_t)u; } }
  }
  asm volatile("s_waitcnt vmcnt(0) lgkmcnt(0)" ::: "memory"); __syncthreads();
  return false;
#undef SLOAD
#undef SWRITE
#undef RESC
}
#undef SBAR
}

#define GAS __attribute__((address_space(1)))
#define LAS __attribute__((address_space(3)))
typedef unsigned short bf16;
typedef unsigned v4u __attribute__((ext_vector_type(4)));
typedef float f32x4 __attribute__((ext_vector_type(4)));
typedef float f32x16 __attribute__((ext_vector_type(16)));
typedef short bf16x8 __attribute__((ext_vector_type(8)));

constexpr int NWAVES = 8, NTHR = 512;
constexpr int DM = 1024, DFF = 2816, NB = 8, SEQ = 8192, CTXL = 256, NMODV = 9 * DM;
constexpr int ROWS_B = 8448, TILES_B = 33, NROWS = NB * ROWS_B;

constexpr size_t MiB = 1u << 20;
constexpr size_t WS_CTL = 0, CTL_ZERO_BYTES = 1 * MiB;
constexpr size_t WS_MOD = 4096;
constexpr size_t WS_BIAS1 = 352 * 1024, WS_BIAS2 = 640 * 1024;
constexpr size_t WS_RSS1 = 69 * MiB, WS_RSS2 = 69 * MiB + 512 * 1024;
constexpr size_t WS_BAR = 512 * 1024, BAR_ZERO_BYTES = 16384;
constexpr size_t WS_ABAR = 1 * MiB, WS_APOW = WS_ABAR + 32768, WS_BBT = WS_APOW + 32768, WS_CM = WS_BBT + 262144, WS_ROPE = WS_CM + 262144;
constexpr size_t WS_W1A = 2 * MiB, WS_W1B = 13 * MiB, WS_W2A = 19 * MiB, WS_W2B = 30 * MiB, WS_WIN = 36 * MiB, WS_WOUT = 40 * MiB, WS_WGLU = 42 * MiB;
constexpr size_t WS_E = 43 * MiB, WS_HIN = 52 * MiB, WS_XC = 61 * MiB;
constexpr size_t WS_XN = 70 * MiB;
constexpr size_t WS_ACT = 202 * MiB;
constexpr size_t WS_OATT = WS_ACT, WS_G = WS_ACT + 264 * MiB;
constexpr size_t WS_U = 565 * MiB, WS_Q = 631 * MiB, WS_K = 697 * MiB, WS_V = 763 * MiB, WS_END = 829 * MiB;
static_assert(WS_ROPE + 16384 <= WS_W1A && WS_W1A + (size_t)5632 * 1024 * 2 <= WS_W1B && WS_W1B + (size_t)1024 * 2816 * 2 <= WS_W2A && WS_W2A + (size_t)5632 * 1024 * 2 <= WS_W2B, "ws map 1");
static_assert(WS_W2B + (size_t)1024 * 2816 * 2 <= WS_WIN && WS_WIN + (size_t)2048 * 1024 * 2 <= WS_WOUT && WS_WOUT + (size_t)1024 * 1024 * 2 <= WS_WGLU && WS_WGLU + 512 * 512 * 2 <= WS_E, "ws map 2");
static_assert(WS_E + (size_t)8 * 33 * 64 * 64 * 8 <= WS_HIN && WS_HIN + (size_t)8 * 33 * 64 * 64 * 8 <= WS_XC && WS_XC + (size_t)2048 * 1024 * 4 <= WS_XN, "ws map 3");
static_assert(WS_XN + (size_t)NROWS * 1024 * 2 <= WS_ACT && WS_ACT + (size_t)NROWS * 2816 * 2 <= WS_U && WS_G + (size_t)NROWS * 512 * 2 <= WS_U && WS_OATT + (size_t)NROWS * 1024 * 4 <= WS_G, "ws map 4");
static_assert(WS_U + (size_t)NROWS * 512 * 2 <= WS_Q && WS_V + (size_t)NROWS * 512 * 2 <= WS_END, "ws map 5");

constexpr int LDS_BYTES = 139264;

#define LDS_WAIT() asm volatile("s_waitcnt lgkmcnt(0)" ::: "memory")
__device__ __forceinline__ unsigned f2bf(float f) { unsigned u = __builtin_bit_cast(unsigned, f); return (u + 0x7fffu + ((u >> 16) & 1u)) >> 16; }
__device__ __forceinline__ unsigned pk2(float lo, float hi) { return f2bf(lo) | (f2bf(hi) << 16); }
__device__ __forceinline__ float wave_sum(float v) {
#pragma unroll
    for (int o = 1; o < 64; o <<= 1) v += __shfl_xor(v, o);
    return v;
}

__device__ __forceinline__ double dexp(double x) {
    const double n = __builtin_rint(x * 1.4426950408889634074);
    const double r = __builtin_fma(-n, 1.9082149292705877e-10, __builtin_fma(-n, 0.693147180369123816490, x));
    double p = 1.0 / 87178291200.0;
    p = p * r + 1.0 / 6227020800.0; p = p * r + 1.0 / 479001600.0; p = p * r + 1.0 / 39916800.0; p = p * r + 1.0 / 3628800.0; p = p * r + 1.0 / 362880.0; p = p * r + 1.0 / 40320.0;
    p = p * r + 1.0 / 5040.0; p = p * r + 1.0 / 720.0; p = p * r + 1.0 / 120.0; p = p * r + 1.0 / 24.0; p = p * r + 1.0 / 6.0; p = p * r + 0.5; p = p * r + 1.0; p = p * r + 1.0;
    const long long e = (long long)n + 1023; const double s = __builtin_bit_cast(double, (unsigned long long)e << 52);
    return p * s;
}
__device__ __forceinline__ void dsincos(double y, double& s, double& c) {
    const double k = __builtin_rint(y * 0.15915494309189533577);
    double r = __builtin_fma(-k, 6.283185307179586232, y); r = __builtin_fma(-k, 2.4492935982947064e-16, r);
    const double q = r * 0.125, q2 = q * q;
    double sp = -1.0 / 1307674368000.0; sp = sp * q2 + 1.0 / 6227020800.0; sp = sp * q2 - 1.0 / 39916800.0; sp = sp * q2 + 1.0 / 362880.0; sp = sp * q2 - 1.0 / 5040.0; sp = sp * q2 + 1.0 / 120.0; sp = sp * q2 - 1.0 / 6.0; sp = sp * q2 + 1.0;
    double cp = 1.0 / 20922789888000.0; cp = cp * q2 - 1.0 / 87178291200.0; cp = cp * q2 + 1.0 / 479001600.0; cp = cp * q2 - 1.0 / 3628800.0; cp = cp * q2 + 1.0 / 40320.0; cp = cp * q2 - 1.0 / 720.0; cp = cp * q2 + 1.0 / 24.0; cp = cp * q2 - 0.5; cp = cp * q2 + 1.0;
    double ss = sp * q, cc = cp;
#pragma unroll
    for (int i = 0; i < 3; ++i) { const double s2 = 2.0 * ss * cc, c2 = cc * cc - ss * ss; ss = s2; cc = c2; }
    s = ss; c = cc;
}

__device__ __forceinline__ void transpose_item(const float* W, int K, int N, bf16* WT, int mode, LAS float* scr, int item, int lane) {
    const int nblk = N / 32, kb = item / nblk, nb = item % nblk, k0 = 64 * kb, n0 = 32 * nb;
    { const float* wp = W + (size_t)(k0 + (lane >> 5)) * N + n0 + (lane & 31); float v[32];
#pragma unroll
      for (int i = 0; i < 32; ++i) v[i] = wp[(size_t)(2 * i) * N];
#pragma unroll
      for (int i = 0; i < 32; ++i) scr[(2 * i + (lane >> 5)) * 33 + (lane & 31)] = v[i]; }
    LDS_WAIT(); asm volatile("" ::: "memory");
    const int c = lane & 7;
#pragma unroll
    for (int j = 0; j < 4; ++j) { const int n = (lane >> 3) + 8 * j; const LAS float* s = scr + (8 * c) * 33 + n;
        const int src = n0 + n; int drow = src;
        if (mode == 1) { const int up = src >= DFF ? 1 : 0, ff = src - up * DFF; drow = (ff >> 7) * 256 + up * 128 + (ff & 127); }
        else if (mode == 2) { if (src >= 512 && src < 1536) drow = n0 + 2 * (n & 15) + (n >> 4); }
        v4u o; o.x = pk2(s[0 * 33], s[1 * 33]); o.y = pk2(s[2 * 33], s[3 * 33]); o.z = pk2(s[4 * 33], s[5 * 33]); o.w = pk2(s[6 * 33], s[7 * 33]);
        *(v4u*)(WT + (size_t)drow * K + k0 + 8 * c) = o; }
    LDS_WAIT(); asm volatile("" ::: "memory");
}

template <int MODE>
__device__ __forceinline__ void norm_rows16(const float* src, bf16* dstb, float* dstf, const float* g, const float* shift, const float* scale, int lane) {
    f32x4 gs[4], sh[4];
#pragma unroll
    for (int j = 0; j < 4; ++j) { const int cidx = 4 * lane + 256 * j; const f32x4 gv = *(const f32x4*)(g + cidx);
        if (MODE == 0) { const f32x4 sc = *(const f32x4*)(scale + cidx); gs[j] = gv * (sc + 1.0f); sh[j] = *(const f32x4*)(shift + cidx); } else { gs[j] = gv; sh[j] = (f32x4){0.f, 0.f, 0.f, 0.f}; } }
#pragma unroll 2
    for (int r = 0; r < 16; ++r) {
        const f32x4* xr = (const f32x4*)(src + (size_t)r * DM) + lane;
        f32x4 v[4]; float s = 0.f;
#pragma unroll
        for (int j = 0; j < 4; ++j) { v[j] = xr[64 * j]; s += (v[j].x * v[j].x + v[j].y * v[j].y) + (v[j].z * v[j].z + v[j].w * v[j].w); }
        const float rstd = 1.0f / sqrtf(wave_sum(s) * (1.0f / DM) + 1e-6f);
        if (MODE == 0) {
            unsigned long long* o8 = (unsigned long long*)(dstb + (size_t)r * DM) + lane;
#pragma unroll
            for (int j = 0; j < 4; ++j) { const f32x4 y = v[j] * rstd * gs[j] + sh[j]; o8[64 * j] = (unsigned long long)pk2(y.x, y.y) | ((unsigned long long)pk2(y.z, y.w) << 32); }
        } else {
            f32x4* of = (f32x4*)(dstf + (size_t)r * DM) + lane;
#pragma unroll
            for (int j = 0; j < 4; ++j) of[64 * j] = v[j] * rstd * gs[j];
        }
    }
}

__device__ __forceinline__ int crow16(int r, int hi) { return (r & 3) + 8 * (r >> 2) + 4 * hi; }
typedef float f32x2_t __attribute__((ext_vector_type(2))); typedef __bf16 bf16x2_t __attribute__((ext_vector_type(2)));
__device__ __forceinline__ unsigned cvtpk2(float lo, float hi) { f32x2_t v = {lo, hi}; bf16x2_t b = __builtin_convertvector(v, bf16x2_t); return __builtin_bit_cast(unsigned, b); }

template <bool FULL>
__device__ __forceinline__ void s5_unit(LAS unsigned char* lds, int b, int c, int gq, const bf16* U, const float2* ABAR, const bf16* BBT, const bf16* CM,
                                        const float2* HIN, float2* E, const float* dskip, bf16* G, float* YF) {
    int tid_ = threadIdx.x; asm volatile("" : "+v"(tid_));
    const int lane = tid_ & 63, wave = __builtin_amdgcn_readfirstlane(tid_ >> 6);
    const int g = gq * 8 + wave, hi = lane >> 5, r32 = lane & 31;
    LAS unsigned* scr = (LAS unsigned*)(lds + wave * 8704);
    const size_t r0 = (size_t)b * ROWS_B + (size_t)c * 256;
    const bf16* ubase = U + (r0 + r32) * 512 + g * 16 + hi * 8;
    const int ch = lane & 15; const float dv = dskip[g * 16 + ch];
    const size_t obase = (r0 + (lane >> 4) * 4) * 512 + g * 16 + ch;
    LAS unsigned short* yt_l = (LAS unsigned short*)(lds + 69632 + wave * 8192) + ((lane >> 4) * 4) * 16 + ch;
#pragma unroll
    for (int dir = 0; dir < 2; ++dir) {
        const int dg = dir * 32 + g;
        const float2 ab = ABAR[dg * 64 + lane];
        bf16x8 bb[4], cm[4];
#pragma unroll
        for (int blk = 0; blk < 4; ++blk) bb[blk] = *(const bf16x8*)(BBT + ((size_t)(dg * 4 + blk) * 32 + r32) * 16 + hi * 8);
        if (FULL) {
#pragma unroll
            for (int ks = 0; ks < 4; ++ks) cm[ks] = *(const bf16x8*)(CM + ((size_t)dg * 16 + (lane & 15)) * 128 + ks * 32 + (lane >> 4) * 8);
        }
        const size_t sidx = ((((size_t)b * 33 + c) * 32 + g) * 2 + dir) * 64 + lane;
        float hr = 0.f, hm = 0.f;
        if (FULL) { const float2 h0 = HIN[sidx]; hr = h0.x; hm = h0.y; }
        bf16x8 a_nx = *(const bf16x8*)(ubase + (size_t)(dir == 0 ? 0 : 224) * 512);
#pragma unroll 1
        for (int sb = 0; sb < 8; ++sb) {
            const int tb = dir == 0 ? sb * 32 : (7 - sb) * 32;
            const bf16x8 a = a_nx;
            { const int tn = dir == 0 ? (sb < 7 ? tb + 32 : tb) : (sb < 7 ? tb - 32 : tb); a_nx = *(const bf16x8*)(ubase + (size_t)tn * 512); }
            unsigned short uvv[2][4];
            if (FULL && dir == 1) {
#pragma unroll
                for (int mt = 0; mt < 2; ++mt)
#pragma unroll
                    for (int j = 0; j < 4; ++j) { const size_t idx = obase + (size_t)(tb + mt * 16 + j) * 512; uvv[mt][j] = U[idx]; }
            }
            const f32x16 z = {};
#pragma unroll
            for (int hf = 0; hf < 2; ++hf) {
                const f32x16 c0 = __builtin_amdgcn_mfma_f32_32x32x16_bf16(a, bb[hf], z, 0, 0, 0), c2 = __builtin_amdgcn_mfma_f32_32x32x16_bf16(a, bb[2 + hf], z, 0, 0, 0);
#pragma unroll
                for (int r = 0; r < 16; ++r) { const int row = crow16(r, hi); scr[row * 68 + hf * 32 + r32] = cvtpk2(c0[r], c2[r]); }
            }
            LDS_WAIT(); asm volatile("" ::: "memory");
#pragma unroll
            for (int half = 0; half < 2; ++half) {
                unsigned v[16];
#pragma unroll
                for (int q = 0; q < 16; ++q) { const int t = dir == 0 ? half * 16 + q : 31 - (half * 16 + q); v[q] = scr[t * 68 + lane]; }
#pragma unroll
                for (int q = 0; q < 16; ++q) { const int t = dir == 0 ? half * 16 + q : 31 - (half * 16 + q);
                    const float re = __uint_as_float(v[q] << 16), im = __uint_as_float(v[q] & 0xffff0000u);
                    const float nr = fmaf(ab.x, hr, fmaf(-ab.y, hm, re)), ni = fmaf(ab.x, hm, fmaf(ab.y, hr, im)); hr = nr; hm = ni;
                    if (FULL) scr[t * 68 + lane] = cvtpk2(hr, hm); }
                asm volatile("" ::: "memory");
            }
            if (FULL) {
                LDS_WAIT(); asm volatile("" ::: "memory");
                f32x4 yt[2];
#pragma unroll
                for (int mt = 0; mt < 2; ++mt) { yt[mt] = (f32x4){0.f, 0.f, 0.f, 0.f};
#pragma unroll
                    for (int ks = 0; ks < 4; ++ks) { const bf16x8 hf8 = *(const LAS bf16x8*)((const LAS unsigned char*)scr + (mt * 16 + (lane & 15)) * 272 + ks * 64 + (lane >> 4) * 16);
                        yt[mt] = __builtin_amdgcn_mfma_f32_16x16x32_bf16(hf8, cm[ks], yt[mt], 0, 0, 0); } }
#pragma unroll
                for (int mt = 0; mt < 2; ++mt)
#pragma unroll
                    for (int j = 0; j < 4; ++j) { LAS unsigned short* yp = yt_l + (tb + mt * 16 + j) * 16;
                        if (dir == 0) *yp = (unsigned short)f2bf(yt[mt][j]);
                        else { const float uv = __uint_as_float((unsigned)uvv[mt][j] << 16); const float yv = __uint_as_float((unsigned)*yp << 16) + yt[mt][j] + dv * uv;
                            const float zz = 1.5957691216057308f * (yv + 0.044715f * yv * yv * yv); *yp = (unsigned short)f2bf(yv * pg8::fast_sigmoid(zz)); } }
                LDS_WAIT(); asm volatile("" ::: "memory");
            }
        }
        if (!FULL) E[sidx] = make_float2(hr, hm);
    }
    if (FULL) {
        LDS_WAIT(); asm volatile("" ::: "memory");
        const LAS unsigned char* yb = (const LAS unsigned char*)(lds + 69632 + wave * 8192);
#pragma unroll
        for (int it = 0; it < 8; ++it) { const int row = it * 32 + (lane >> 1), hf = lane & 1;
            const v4u w = *(const LAS v4u*)(yb + row * 32 + hf * 16);
            *(v4u*)(G + (r0 + row) * 512 + g * 16 + hf * 8) = w; }
        LDS_WAIT(); asm volatile("" ::: "memory");
    }
}

__device__ __forceinline__ void cmulf(float ar, float ai, float br, float bi, float& cr, float& ci) { cr = ar * br - ai * bi; ci = ar * bi + ai * br; }
__device__ __forceinline__ void s5_unit_a(LAS unsigned char* lds, int b, int c, int gq, const bf16* U, const float2* ABAR, const bf16* BBT, float2* E) {
    int tid_ = threadIdx.x; asm volatile("" : "+v"(tid_));
    const int lane = tid_ & 63, wave = __builtin_amdgcn_readfirstlane(tid_ >> 6);
    const int g = gq * 8 + wave, hi = lane >> 5, r32 = lane & 31;
    const size_t r0 = (size_t)b * ROWS_B + (size_t)c * 256;
    LAS unsigned char* ut = lds + wave * 8192;
    { v4u t8[8];
#pragma unroll
      for (int it = 0; it < 8; ++it) t8[it] = *(const v4u*)(U + (r0 + it * 32 + (lane >> 1)) * 512 + g * 16 + (lane & 1) * 8);
#pragma unroll
      for (int it = 0; it < 8; ++it) *(LAS v4u*)(ut + (it * 32 + (lane >> 1)) * 32 + (lane & 1) * 16) = t8[it]; }
    LDS_WAIT(); asm volatile("" ::: "memory");
    const LAS unsigned char* ua = ut + r32 * 32 + hi * 16;
#pragma unroll
    for (int dir = 0; dir < 2; ++dir) {
        const int dg = dir * 32 + g;
        bf16x8 bb[4];
#pragma unroll
        for (int blk = 0; blk < 4; ++blk) bb[blk] = *(const bf16x8*)(BBT + ((size_t)(dg * 4 + blk) * 32 + r32) * 16 + hi * 8);
        float wr[2][16], wi[2][16], a32r[2], a32i[2];
#pragma unroll
        for (int hf = 0; hf < 2; ++hf) {
            const float2 ab = ABAR[dg * 64 + hf * 32 + r32];
            float qr[4], qi[4], orr[4], oi[4];
            qr[0] = 1.f; qi[0] = 0.f; qr[1] = ab.x; qi[1] = ab.y; cmulf(qr[1], qi[1], ab.x, ab.y, qr[2], qi[2]); cmulf(qr[2], qi[2], ab.x, ab.y, qr[3], qi[3]);
            float a4r, a4i; cmulf(qr[2], qi[2], qr[2], qi[2], a4r, a4i);
            orr[0] = 1.f; oi[0] = 0.f; cmulf(a4r, a4i, a4r, a4i, orr[1], oi[1]); cmulf(orr[1], oi[1], orr[1], oi[1], orr[2], oi[2]); cmulf(orr[2], oi[2], orr[1], oi[1], orr[3], oi[3]);
            cmulf(orr[2], oi[2], orr[2], oi[2], a32r[hf], a32i[hf]);
            const bool use4 = dir == 0 ? (hi == 0) : (hi != 0);
            const float br = use4 ? a4r : 1.f, bi = use4 ? a4i : 0.f;
#pragma unroll
            for (int r = 0; r < 16; ++r) { const int jq = dir == 0 ? 3 - (r & 3) : (r & 3), jo = dir == 0 ? 3 - (r >> 2) : (r >> 2);
                float tr, ti; cmulf(qr[jq], qi[jq], orr[jo], oi[jo], tr, ti); cmulf(tr, ti, br, bi, wr[hf][r], wi[hf][r]); }
        }
        float hr[2] = {0.f, 0.f}, hm[2] = {0.f, 0.f};
#pragma unroll 1
        for (int sb = 0; sb < 8; ++sb) {
            const bf16x8 a = *(const LAS bf16x8*)(ua + (dir == 0 ? sb * 32 : (7 - sb) * 32) * 32);
            const f32x16 z = {};
#pragma unroll
            for (int hf = 0; hf < 2; ++hf) {
                const f32x16 cre = __builtin_amdgcn_mfma_f32_32x32x16_bf16(a, bb[hf], z, 0, 0, 0), cim = __builtin_amdgcn_mfma_f32_32x32x16_bf16(a, bb[2 + hf], z, 0, 0, 0);
                float er = 0.f, ei = 0.f;
#pragma unroll
                for (int r = 0; r < 16; ++r) { er = fmaf(wr[hf][r], cre[r], fmaf(-wi[hf][r], cim[r], er)); ei = fmaf(wr[hf][r], cim[r], fmaf(wi[hf][r], cre[r], ei)); }
                er += __shfl_xor(er, 32); ei += __shfl_xor(ei, 32);
                const float nr = fmaf(a32r[hf], hr[hf], fmaf(-a32i[hf], hm[hf], er)), ni = fmaf(a32r[hf], hm[hf], fmaf(a32i[hf], hr[hf], ei));
                hr[hf] = nr; hm[hf] = ni;
            }
        }
        const size_t sidx = ((((size_t)b * 33 + c) * 32 + g) * 2 + dir) * 64 + lane;
        E[sidx] = hi ? make_float2(hr[1], hm[1]) : make_float2(hr[0], hm[0]);
    }
    LDS_WAIT(); asm volatile("" ::: "memory");
}

typedef GAS unsigned gu32;
#define RLX_AGENT __ATOMIC_RELAXED, __HIP_MEMORY_SCOPE_AGENT
#define XB_TMO      128
#define XB_XCNT(j)  (256  + 64 * (j))
#define XB_XSUB(j)  (1280 + 64 * (j))
#define XB_XGEN(j)  (2304 + 64 * (j))
#define XB_TOP      3328
#define XB_TOPGEN   3392
#define XCD_BAR_WORDS 3456
#define XB_SPIN_CAP (1u << 18)

__device__ __forceinline__ unsigned xb_ld(unsigned* p)              { return __hip_atomic_load(p, __ATOMIC_RELAXED, __HIP_MEMORY_SCOPE_AGENT); }
__device__ __forceinline__ unsigned xb_add(unsigned* p, unsigned v) { return __hip_atomic_fetch_add(p, v, __ATOMIC_RELAXED, __HIP_MEMORY_SCOPE_AGENT); }
__device__ __forceinline__ unsigned xb_xcc_id() { return (unsigned)__builtin_amdgcn_s_getreg((3 << 11) | 20) & 0xFu; }
#define XB_SPIN(cond, bar) do { unsigned _sp = 0; while (cond) { __builtin_amdgcn_s_sleep(1); \
    if ((++_sp & 255u) == 0u) { if (xb_ld(&(bar)[XB_TMO])) break; if (_sp > XB_SPIN_CAP) { atomicAdd(&(bar)[XB_TMO], 1u); break; } } } } while (0)

struct XcdBarrier {
    unsigned* bar; unsigned x;
    volatile LAS unsigned* st;
};

__device__ __forceinline__ XcdBarrier xcd_barrier_post(unsigned* bar, volatile LAS unsigned* st) {
    XcdBarrier b; b.bar = bar; b.x = xb_xcc_id(); b.st = st;
    if (threadIdx.x == 0) (void)xb_add(&bar[XB_XCNT(b.x)], 1u);
    return b;
}
__device__ __forceinline__ void xcd_barrier_complete(unsigned* bar, unsigned x, unsigned& nloc, unsigned& nx) {
    const unsigned G = gridDim.x * gridDim.y * gridDim.z;
    unsigned sum, cnt, mine, sp = 0u;
    for (;;) {
        sum = 0u; cnt = 0u; mine = 0u;
#pragma unroll
        for (unsigned j = 0; j < 16; ++j) { const unsigned c = xb_ld(&bar[XB_XCNT(j)]); sum += c; cnt += (c > 0u) ? 1u : 0u; mine = (j == x) ? c : mine; }
        if (sum == G) break;
        __builtin_amdgcn_s_sleep(1);
        if ((++sp & 255u) == 0u) { if (xb_ld(&bar[XB_TMO])) break; if (sp > XB_SPIN_CAP) { atomicAdd(&bar[XB_TMO], 1u); break; } }
    }
    nloc = mine > 0u ? mine : 1u; nx = cnt > 0u ? cnt : 1u;
}

__device__ __forceinline__ void xcd_barrier(const XcdBarrier& b) {
    asm volatile("s_waitcnt vmcnt(0)" ::: "memory");
    __syncthreads();
    if (threadIdx.x == 0) {
        unsigned* bar = b.bar;
        __builtin_amdgcn_s_waitcnt(0);
        unsigned nloc = b.st[0], nx = b.st[1];
        if (nloc == 0u) { xcd_barrier_complete(bar, b.x, nloc, nx); b.st[0] = nloc; b.st[1] = nx; }
        const unsigned old = xb_add(&bar[XB_XSUB(b.x)], 1u);
        const unsigned gen = old / nloc;
        if (old + 1u == (gen + 1u) * nloc) {
            __builtin_amdgcn_fence(__ATOMIC_RELEASE, "agent");
            asm volatile("s_waitcnt vmcnt(0)" ::: "memory");
            const unsigned og = xb_add(&bar[XB_TOP], 1u);
            const unsigned tg = og / nx;
            if (og + 1u == (tg + 1u) * nx) xb_add(&bar[XB_TOPGEN], 1u);
            else XB_SPIN(xb_ld(&bar[XB_TOPGEN]) == tg, bar);
            __builtin_amdgcn_fence(__ATOMIC_ACQUIRE, "agent");
            xb_add(&bar[XB_XGEN(b.x)], 1u);
            asm volatile("s_waitcnt vmcnt(0)" ::: "memory");
        } else {
            XB_SPIN(xb_ld(&bar[XB_XGEN(b.x)]) == gen, bar);
            __builtin_amdgcn_fence(__ATOMIC_ACQUIRE, "agent");
            asm volatile("s_waitcnt vmcnt(0)" ::: "memory");
        }
    }
    __syncthreads();
}

#ifndef PHMASK
#define PHMASK 0xFFFFF
#endif
#define PH(k) if ((PHMASK >> (k)) & 1)
struct Args { const float* in[25]; float* out; unsigned char* ws; };
__device__ __forceinline__ const float* karg(int i) {
    unsigned off = (unsigned)i * 8u; asm volatile("" : "+s"(off));
    return *(const float* const __attribute__((address_space(4)))*)((const char __attribute__((address_space(4)))*)__builtin_amdgcn_kernarg_segment_ptr() + off);
}

__global__ void __launch_bounds__(NTHR, 2) hymba_fwd(Args a) {
    extern __shared__ __attribute__((aligned(16))) unsigned char lds[];
    cg::grid_group grid = cg::this_grid();
    const int tid = threadIdx.x, lane = tid & 63, wave = __builtin_amdgcn_readfirstlane(tid >> 6);
    const int G = gridDim.x, bx = blockIdx.x;
    const int vcu = (G % 8 == 0) ? (bx % 8) * (G / 8) + bx / 8 : bx;
    const int gw = vcu * NWAVES + wave, NGW = G * NWAVES;
    LAS unsigned char* ldsl = (LAS unsigned char*)lds;
#define KIN(i) karg(i)
#define ws_p ((unsigned char*)karg(26))
#define out_p ((float*)karg(25))
#define x_in KIN(0)
#define cvec KIN(1)
#define ctx KIN(2)
#define c_ctx KIN(3)
#define w_mod KIN(4)
#define b_mod KIN(5)
#define norm_g KIN(6)
#define ffn_w_in KIN(7)
#define ffn_w_out KIN(8)
#define w_in KIN(9)
#define w_out KIN(10)
#define ssm_a_re KIN(11)
#define ssm_a_im KIN(12)
#define ssm_log_dt KIN(13)
#define ssm_b_re KIN(14)
#define ssm_b_im KIN(15)
#define ssm_c_re KIN(16)
#define ssm_c_im KIN(17)
#define ssm_d KIN(18)
#define w_glu KIN(19)
#define b_glu KIN(20)
#define lam_q KIN(21)
#define lam_k KIN(22)
#define subln_g KIN(23)
#define final_g KIN(24)
#define MISC ((float*)(ws_p + WS_CTL))
#define MOD ((float*)(ws_p + WS_MOD))
#define ABAR ((float2*)(ws_p + WS_ABAR))
#define APOW ((float2*)(ws_p + WS_APOW))
#define BBT ((bf16*)(ws_p + WS_BBT))
#define CM ((bf16*)(ws_p + WS_CM))
#define ROPE ((float*)(ws_p + WS_ROPE))
#define W1A ((bf16*)(ws_p + WS_W1A))
#define W1B ((bf16*)(ws_p + WS_W1B))
#define W2A ((bf16*)(ws_p + WS_W2A))
#define W2B ((bf16*)(ws_p + WS_W2B))
#define WIN ((bf16*)(ws_p + WS_WIN))
#define WOUT ((bf16*)(ws_p + WS_WOUT))
#define WGLU ((bf16*)(ws_p + WS_WGLU))
#define EST ((float2*)(ws_p + WS_E))
#define HIN ((float2*)(ws_p + WS_HIN))
#define XC ((float*)(ws_p + WS_XC))
#define XN ((bf16*)(ws_p + WS_XN))
#define SA ((bf16*)(ws_p + WS_XN))
#define ACT ((bf16*)(ws_p + WS_ACT))
#define OATT ((float*)(ws_p + WS_OATT))
#define GB ((bf16*)(ws_p + WS_G))
#define YFB ((float*)(ws_p + WS_OATT + 132 * MiB))
#define BIAS1 ((float*)(ws_p + WS_BIAS1))
#define BIAS2 ((float*)(ws_p + WS_BIAS2))
#define RSS1 ((float*)(ws_p + WS_RSS1))
#define RSS2 ((float*)(ws_p + WS_RSS2))
#define XN2 ((bf16*)(ws_p + WS_U))
#define UB ((bf16*)(ws_p + WS_U))
#define QB ((bf16*)(ws_p + WS_Q))
#define KB ((bf16*)(ws_p + WS_K))
#define VB ((bf16*)(ws_p + WS_V))
    (void)a;
    { volatile LAS unsigned* st0 = (volatile LAS unsigned*)(ldsl + 138240); if (tid < 4) st0[tid] = 0u; }
    __syncthreads();
    XcdBarrier xbar = xcd_barrier_post((unsigned*)(ws_p + WS_BAR), (volatile LAS unsigned*)(ldsl + 138240));
#define GSYNC() xcd_barrier(xbar)

    PH(0) {
        if (bx < 288) {
            LAS float* sl = (LAS float*)ldsl; LAS float* part = (LAS float*)(ldsl + 36864);
            for (int i = tid; i < 9 * DM; i += NTHR) { const float v = i < 8 * DM ? cvec[i] : c_ctx[i - 8 * DM]; sl[i] = v / (1.0f + __expf(-v)); }
            __syncthreads();
            for (int unit = bx; unit < 288; unit += G) {
                const int cl = tid & 31, kg = tid >> 5, k0 = kg * 64; const float* wp = w_mod + (size_t)k0 * NMODV + unit * 32 + cl;
                float acc[9];
#pragma unroll
                for (int i = 0; i < 9; ++i) acc[i] = 0.f;
                float wv[64];
#pragma unroll
                for (int kk = 0; kk < 64; ++kk) wv[kk] = wp[(size_t)kk * NMODV];
#pragma unroll
                for (int kk = 0; kk < 64; kk += 4) {
#pragma unroll
                    for (int i = 0; i < 9; ++i) { const f32x4 sv = *(const LAS f32x4*)(sl + i * DM + k0 + kk); acc[i] = fmaf(sv.x, wv[kk], fmaf(sv.y, wv[kk + 1], fmaf(sv.z, wv[kk + 2], fmaf(sv.w, wv[kk + 3], acc[i])))); }
                }
#pragma unroll
                for (int i = 0; i < 9; ++i) part[(kg * 9 + i) * 32 + cl] = acc[i];
                __syncthreads();
                if (tid < 288) { const int i = tid >> 5; float sum = 0.f;
#pragma unroll
                    for (int k = 0; k < 16; ++k) sum += part[(k * 9 + i) * 32 + cl];
                    MOD[i * NMODV + unit * 32 + cl] = sum + b_mod[unit * 32 + cl]; }
                __syncthreads();
            }
        }
        __syncthreads();
        {
            LAS float* scr = (LAS float*)(ldsl + wave * 16384);
            constexpr int I_1A = (DM / 64) * (2 * DFF / 32), I_1B = (DFF / 64) * (DM / 32), I_IN = (DM / 64) * (2048 / 32);
            constexpr int NITEMS = I_1A + I_1B + I_IN;
            for (int it = gw; it < NITEMS; it += NGW) {
                int r = it;
                if (r < I_1A) { transpose_item(ffn_w_in, DM, 2 * DFF, W1A, 1, scr, r, lane); continue; } r -= I_1A;
                if (r < I_1B) { transpose_item(ffn_w_out, DFF, DM, W1B, 0, scr, r, lane); continue; } r -= I_1B;
                transpose_item(w_in, DM, 2048, WIN, 2, scr, r, lane);
            }
        }
        const int gt = bx * NTHR + tid, NT_ALL = G * NTHR;
        for (int i = gt; i < 2 * 32 * 64; i += NT_ALL) {
            const int p = i & 63, dg = i >> 6;
            const double dt = dexp((double)ssm_log_dt[dg]), are = (double)ssm_a_re[i], aim = (double)ssm_a_im[i];
            double s1, c1, s2, c2; dsincos(dt * aim, s1, c1); dsincos(256.0 * dt * aim, s2, c2);
            const double mag = dexp(dt * are), mag2 = dexp(256.0 * dt * are);
            const double abr = mag * c1, abi = mag * s1;
            ABAR[i] = make_float2((float)abr, (float)abi); APOW[i] = make_float2((float)(mag2 * c2), (float)(mag2 * s2));
            const double zr = abr - 1.0, zi = abi, den = are * are + aim * aim;
            const double cr = (zr * are + zi * aim) / den, ci = (zi * are - zr * aim) / den;
            const float* bre = ssm_b_re + (size_t)i * 16; const float* bim = ssm_b_im + (size_t)i * 16;
            bf16* dre = BBT + ((size_t)(dg * 4 + (p >> 5)) * 32 + (p & 31)) * 16; bf16* dim = BBT + ((size_t)(dg * 4 + 2 + (p >> 5)) * 32 + (p & 31)) * 16;
#pragma unroll
            for (int h = 0; h < 16; ++h) { const double br = (double)bre[h], bi = (double)bim[h]; dre[h] = (bf16)f2bf((float)(cr * br - ci * bi)); dim[h] = (bf16)f2bf((float)(cr * bi + ci * br)); }
        }
        for (int i = gt; i < 2 * 32 * 16 * 64; i += NT_ALL) {
            const int p = i & 63, dgh = i >> 6;
            ((unsigned*)CM)[(size_t)dgh * 64 + p] = pk2(ssm_c_re[i], -ssm_c_im[i]);
        }
        for (int i = gt; i < 128 * 16; i += NT_ALL) {
            const int f = i & 15, pos = i >> 4;
            const double inv = dexp(-(double)f * (9.210340371976182736 / 16.0)); double s, c; dsincos((double)pos * inv, s, c);
            ROPE[2 * i] = (float)c; ROPE[2 * i + 1] = (float)s;
        }
        for (int i = gt; i < NROWS; i += NT_ALL) { RSS1[i] = 0.f; RSS2[i] = 0.f; }
        if (gt == 0) { float s0 = 0.f, s1 = 0.f; for (int d = 0; d < 64; ++d) { s0 += lam_q[d] * lam_k[d]; s1 += lam_q[64 + d] * lam_k[64 + d]; } MISC[0] = expf(s0) - expf(s1) + 0.2f; }
    }
    grid.sync();

#define NORM_PASS(SRC_LAT, SRC_CTX, NIDX, LATONLY) do { int tid_l = threadIdx.x; asm volatile("" : "+v"(tid_l)); const int lane_l = tid_l & 63, gw_l = vcu * NWAVES + __builtin_amdgcn_readfirstlane(tid_l >> 6); \
        for (int it = gw_l; it < NROWS / 16; it += NGW) { const int r0 = it * 16, pm = r0 >> 8, b = pm / TILES_B, jt = pm - b * TILES_B, rl = r0 & 255; \
            if ((LATONLY) && jt == 32) continue; \
            const float* src = jt < 32 ? (SRC_LAT) + ((size_t)b * SEQ + jt * 256 + rl) * DM : (SRC_CTX) + ((size_t)b * CTXL + rl) * DM; \
            const float* mv = MOD + (jt < 32 ? b : 8) * NMODV + 3 * (NIDX) * DM; \
            norm_rows16<0>(src, XN + (size_t)r0 * DM, nullptr, norm_g + (NIDX) * DM, mv, mv + DM, lane_l); } } while (0)

    PH(1) {
        if (bx < 240) {
            const bool isin = bx < 64; const int unit = isin ? bx : bx - 64, N = isin ? 2048 : 2 * DFF, soff = isin ? 3 * DM : 6 * DM;
            const float* W = isin ? w_in : ffn_w_in + (size_t)DM * 2 * DFF; float* BO = isin ? BIAS1 : BIAS2;
            LAS float* sl = (LAS float*)ldsl; LAS float* part = (LAS float*)(ldsl + 36864);
            for (int i = tid; i < 9 * DM; i += NTHR) sl[i] = MOD[(i >> 10) * NMODV + soff + (i & 1023)];
            __syncthreads();
            const int cl = tid & 31, kg = tid >> 5, k0 = kg * 64; const float* wp = W + (size_t)k0 * N + unit * 32 + cl;
            float acc[9];
#pragma unroll
            for (int i = 0; i < 9; ++i) acc[i] = 0.f;
            float wv[64];
#pragma unroll
            for (int kk = 0; kk < 64; ++kk) wv[kk] = wp[(size_t)kk * N];
#pragma unroll
            for (int kk = 0; kk < 64; kk += 4) {
#pragma unroll
                for (int i = 0; i < 9; ++i) { const f32x4 sv = *(const LAS f32x4*)(sl + i * DM + k0 + kk); acc[i] = fmaf(sv.x, wv[kk], fmaf(sv.y, wv[kk + 1], fmaf(sv.z, wv[kk + 2], fmaf(sv.w, wv[kk + 3], acc[i])))); }
            }
#pragma unroll
            for (int i = 0; i < 9; ++i) part[(kg * 9 + i) * 32 + cl] = acc[i];
            __syncthreads();
            if (tid < 288) { const int i = tid >> 5; float sum = 0.f;
#pragma unroll
                for (int k = 0; k < 16; ++k) sum += part[(k * 9 + i) * 32 + cl];
                const int src = unit * 32 + cl; int drow = src;
                if (isin) { if (src >= 512 && src < 1536) drow = unit * 32 + 2 * (cl & 15) + (cl >> 4); }
                else { const int up = src >= DFF ? 1 : 0, ff = src - up * DFF; drow = (ff >> 7) * 256 + up * 128 + (ff & 127); }
                BO[i * N + drow] = sum; }
            __syncthreads();
        }
        NORM_PASS(x_in, ctx, 0, false);
    }
    GSYNC();
    PH(2) { pg8::Gemm g{XN, W1A, NROWS, 2 * DFF, DM}; pg8::TileOrder S; S.init(264, 22, G, bx, 0); pg8::EpiSwiglu E{ACT, DFF, nullptr, nullptr};
      pg8::gemm_phase<pg8::EpiSwiglu, pg8::TileOrder, true, true>(ldsl, g, S, E); }
    GSYNC();
    PH(3) { pg8::Gemm g{ACT, W1B, NROWS, DM, DFF}; pg8::TileOrder S; S.init(264, 4, G, bx, 0); pg8::EpiResidNorm E{x_in, ctx, out_p, XC, MOD, 2 * DM, 1, norm_g + DM, 4 * DM, XN, RSS1};
      pg8::gemm_phase<pg8::EpiResidNorm, pg8::TileOrder, true, true>(ldsl, g, S, E);
      if (bx >= 32) {
          int tid_l = threadIdx.x; asm volatile("" : "+v"(tid_l)); const int lane_l = tid_l & 63, wave_l = __builtin_amdgcn_readfirstlane(tid_l >> 6);
          LAS float* scr = (LAS float*)(ldsl + wave_l * 16384);
          constexpr int I_1A = (DM / 64) * (2 * DFF / 32), I_1B = (DFF / 64) * (DM / 32), I_OUT = (DM / 64) * (DM / 32), I_GLU = (512 / 64) * (512 / 32);
          for (int it = (bx - 32) * NWAVES + wave_l; it < I_1A + I_1B + I_OUT + I_GLU; it += (G - 32) * NWAVES) {
              int r = it;
              if (r < I_1A) { transpose_item(ffn_w_in + (size_t)DM * 2 * DFF, DM, 2 * DFF, W2A, 1, scr, r, lane_l); continue; } r -= I_1A;
              if (r < I_1B) { transpose_item(ffn_w_out + (size_t)DFF * DM, DFF, DM, W2B, 0, scr, r, lane_l); continue; } r -= I_1B;
              if (r < I_OUT) { transpose_item(w_out, DM, DM, WOUT, 0, scr, r, lane_l); continue; } r -= I_OUT;
              transpose_item(w_glu, 512, 512, WGLU, 0, scr, r, lane_l);
          }
      } }
    GSYNC();
    PH(5) { pg8::Gemm g{XN, WIN, NROWS, 2048, DM}; pg8::TileOrder S; S.init(264, 8, G, bx, 0); pg8::EpiInproj E{UB, QB, KB, VB, ROPE, RSS1, BIAS1};
      pg8::gemm_phase<pg8::EpiInproj, pg8::TileOrder, true, true>(ldsl, g, S, E); }
    GSYNC();
    PH(6) for (int un = vcu; un < 8 * 33 * 4; un += G) { const int gq = un & 3, bc = un >> 2, b = bc / 33, c = bc - b * 33;
        s5_unit_a(ldsl, b, c, gq, UB, ABAR, BBT, EST); }
    GSYNC();
    PH(7) if (bx < 64) {
        int tid_c = threadIdx.x; asm volatile("" : "+v"(tid_c));
        const int i = bx * NTHR + tid_c;
        const int p = i & 63, dir = (i >> 6) & 1, g = (i >> 7) & 31, b = i >> 12;
        const float2 ap = APOW[(dir * 32 + g) * 64 + p];
#define SIDX(cc) (((((size_t)b * 33 + (cc)) * 32 + g) * 2 + dir) * 64 + p)
        float2 h = EST[SIDX(32)];
        if (dir == 0) { HIN[SIDX(0)] = h; for (int c = 0; c < 31; ++c) { const float2 e = EST[SIDX(c)]; const float nr = fmaf(ap.x, h.x, fmaf(-ap.y, h.y, e.x)), ni = fmaf(ap.x, h.y, fmaf(ap.y, h.x, e.y)); h = make_float2(nr, ni); HIN[SIDX(c + 1)] = h; } }
        else { HIN[SIDX(31)] = h; for (int c = 31; c > 0; --c) { const float2 e = EST[SIDX(c)]; const float nr = fmaf(ap.x, h.x, fmaf(-ap.y, h.y, e.x)), ni = fmaf(ap.x, h.y, fmaf(ap.y, h.x, e.y)); h = make_float2(nr, ni); HIN[SIDX(c - 1)] = h; } }
#undef SIDX
    }
    PH(8) {
        const float lam = MISC[0];
        unsigned redo_mask = 0u;
        {
        int k_ = 0;
        for (int un = vcu; un < 8 * 4 * 32; un += G, ++k_) {
            const int qb = un & 31, bh = un >> 5, b = bh >> 2, h = bh & 3;
            const size_t rb = (size_t)b * ROWS_B, rq = rb + (size_t)qb * 256;
            const attn::bf16_t* q0 = QB + rq * 512 + h * 128; const attn::bf16_t* k0 = KB + rb * 512 + h * 128; const attn::bf16_t* v0 = VB + rb * 512 + h * 128;
            float* st = OATT + rq * 512 + h * 128; attn::bf16_t* so = SA + rq * 1024 + 512 + h * 128;
            bool redo = attn::body<0, false>(q0, k0, v0, st, nullptr, lam, subln_g, ROWS_B, (char*)lds);
            if (!redo) redo = attn::body<1, false>(q0 + 64, k0 + 64, v0, st, so, lam, subln_g, ROWS_B, (char*)lds);
            if (redo) redo_mask |= 1u << k_;
        }
        }
        if (redo_mask) {
            int k_ = 0;
            for (int un = vcu; un < 8 * 4 * 32; un += G, ++k_) {
                if (!((redo_mask >> k_) & 1u)) continue;
                const int qb = un & 31, bh = un >> 5, b = bh >> 2, h = bh & 3;
                const size_t rb = (size_t)b * ROWS_B, rq = rb + (size_t)qb * 256;
                const attn::bf16_t* q0 = QB + rq * 512 + h * 128; const attn::bf16_t* k0 = KB + rb * 512 + h * 128; const attn::bf16_t* v0 = VB + rb * 512 + h * 128;
                float* st = OATT + rq * 512 + h * 128; attn::bf16_t* so = SA + rq * 1024 + 512 + h * 128;
                (void)attn::body<0, true>(q0, k0, v0, st, nullptr, lam, subln_g, ROWS_B, (char*)lds);
                (void)attn::body<1, true>(q0 + 64, k0 + 64, v0, st, so, lam, subln_g, ROWS_B, (char*)lds);
            }
        }
    }
    GSYNC();
    PH(9) for (int un = vcu; un < 8 * 32 * 4; un += G) { const int gq = un & 3, bc = un >> 2, b = bc >> 5, c = bc & 31;
        s5_unit<true>(ldsl, b, c, gq, UB, ABAR, BBT, CM, HIN, EST, ssm_d, GB, YFB); }
    GSYNC();
    PH(10) { pg8::Gemm g{GB, WGLU, NROWS, 512, 512}; pg8::TileOrder S; S.init(256, 2, G, bx, 1); pg8::EpiGlu E{GB, b_glu, SA};
      pg8::gemm_phase<pg8::EpiGlu, pg8::TileOrder, true, true>(ldsl, g, S, E); }
    GSYNC();
    PH(12) { pg8::Gemm g{SA, WOUT, NROWS, DM, DM}; pg8::TileOrder S; S.init(256, 4, G, bx, 1); pg8::EpiResidNorm E{out_p, XC, out_p, XC, MOD, 5 * DM, 0, norm_g + 2 * DM, 7 * DM, XN2, RSS2};
      pg8::gemm_phase<pg8::EpiResidNorm, pg8::TileOrder, true, true>(ldsl, g, S, E); }
    GSYNC();
    PH(14) { pg8::Gemm g{XN2, W2A, NROWS, 2 * DFF, DM}; pg8::TileOrder S; S.init(256, 22, G, bx, 1); pg8::EpiSwiglu E{ACT, DFF, RSS2, BIAS2};
      pg8::gemm_phase<pg8::EpiSwiglu, pg8::TileOrder, true, true>(ldsl, g, S, E); }
    GSYNC();
    PH(15) { pg8::Gemm g{ACT, W2B, NROWS, DM, DFF}; pg8::TileOrder S; S.init(256, 4, G, bx, 1); pg8::EpiResid E{out_p, XC, out_p, XC, MOD, 8 * DM, 0.5f};
      pg8::gemm_phase<pg8::EpiResid, pg8::TileOrder, true, true>(ldsl, g, S, E); }
    GSYNC();
    PH(16) { int tid_l = threadIdx.x; asm volatile("" : "+v"(tid_l)); const int lane_l = tid_l & 63, gw_l = vcu * NWAVES + __builtin_amdgcn_readfirstlane(tid_l >> 6);
        for (int it = gw_l; it < NB * SEQ / 16; it += NGW) norm_rows16<1>(out_p + (size_t)it * 16 * DM, nullptr, out_p + (size_t)it * 16 * DM, final_g, nullptr, nullptr, lane_l); }
#undef NORM_PASS
}

extern "C" void kernel_launch(void* const* d_in, const int* in_sizes, int n_in, void* d_out, int out_size, void* d_ws, size_t ws_size, hipStream_t stream) {
    static int grid = 0;
    if (grid == 0) {
        if (n_in != 25 || in_sizes[0] != NB * SEQ * DM || out_size != NB * SEQ * DM || ws_size < WS_END) {
            fprintf(stderr, "kernel_launch: shape mismatch (n_in %d, in0 %d, out %d, ws %zu, need %zu); nothing launched\n", n_in, n_in > 0 ? in_sizes[0] : -1, out_size, ws_size, (size_t)WS_END); grid = -1; return; }
        int dev = 0, cus = 0, per_cu = 0;
        if (hipGetDevice(&dev) != hipSuccess || hipDeviceGetAttribute(&cus, hipDeviceAttributeMultiprocessorCount, dev) != hipSuccess) { grid = -1; return; }
        if (hipFuncSetAttribute((const void*)hymba_fwd, hipFuncAttributeMaxDynamicSharedMemorySize, LDS_BYTES) != hipSuccess) { fprintf(stderr, "kernel_launch: hipFuncSetAttribute failed\n"); grid = -1; return; }
        if (hipOccupancyMaxActiveBlocksPerMultiprocessor(&per_cu, (const void*)hymba_fwd, NTHR, LDS_BYTES) != hipSuccess || per_cu < 1) { fprintf(stderr, "kernel_launch: occupancy query says %d\n", per_cu); per_cu = 1; }
        (void)hipGetLastError();
        grid = cus * (per_cu > 1 ? 1 : per_cu);
        if (grid != 256) fprintf(stderr, "kernel_launch: grid %d (expected 256)\n", grid);
    }
    if (grid < 0) return;
    (void)hipMemsetAsync((char*)d_ws + WS_BAR, 0, BAR_ZERO_BYTES, stream);
    Args a{};
    for (int i = 0; i < 25; ++i) a.in[i] = (const float*)d_in[i];
    a.out = (float*)d_out; a.ws = (unsigned char*)d_ws;
    void* args[] = {&a};
    const hipError_t e = hipLaunchCooperativeKernel((const void*)hymba_fwd, dim3(grid), dim3(NTHR), args, LDS_BYTES, stream);
    if (e != hipSuccess) fprintf(stderr, "kernel_launch: cooperative launch failed: %s (grid %d)\n", hipGetErrorString(e), grid);
}
```

```cpp
#include <hip/hip_runtime.h>
#include <hip/hip_cooperative_groups.h>
#include <cstdio>
#include <cstdint>
namespace cg = cooperative_groups;
namespace pg8 {
#define PG8_LAS __attribute__((address_space(3)))
typedef unsigned short bf16_t;
typedef short bf16x8 __attribute__((ext_vector_type(8)));
typedef float f32x4 __attribute__((ext_vector_type(4)));
typedef unsigned u32x4 __attribute__((ext_vector_type(4)));
constexpr int BM = 256, BK = 64, HALF = 128, HTB = HALF * BK * 2  , STAGE_BYTES = 8 * HTB, NXCD = 8, WGM = 8;

__host__ __device__ __forceinline__ int lds_byte(int r, int c) { const int st = (r >> 4) * 2 + (c >> 5), rr = r & 15, cc = c & 31, ob = rr * 64 + cc * 2; return st * 1024 + (ob ^ (((ob >> 9) & 1) << 5)); }
__host__ __device__ __forceinline__ void stage_rc(int b, int& R, int& C) { const int st = b / 1024, sb = b % 1024, swz = sb ^ (((sb >> 9) & 1) << 5); R = (st >> 1) * 16 + swz / 64; C = (st & 1) * 32 + (swz % 64) / 2; }
__host__ __device__ __forceinline__ int perm32(int rho) { const int n = rho >> 4, i = rho & 15; return 8 * (i >> 2) + 4 * n + (i & 3); }

struct Unit { int pm, pn; };
struct Gemm { const bf16_t* A; const bf16_t* Bt; int M, N, K; };

__device__ __forceinline__ unsigned cvt_pk_bf16(float lo, float hi) { unsigned r; asm volatile("v_cvt_pk_bf16_f32 %0, %1, %2" : "=v"(r) : "v"(lo), "v"(hi)); return r; }
typedef float f32x2 __attribute__((ext_vector_type(2)));
typedef unsigned u32x2 __attribute__((ext_vector_type(2)));
constexpr int ROWS_B = 8448, TILES_B = 33, NROWS = 8 * ROWS_B;

struct TileOrder {
    int nM, nN, nwg, G, c, lat;
    __device__ __forceinline__ void init(int nM_, int nN_, int G_, int c_, int lat_) { nM = nM_; nN = nN_; nwg = nM_ * nN_; G = G_; c = c_; lat = lat_; }
    __device__ __forceinline__ bool next(int i, Unit& u) const {
        const long L = (long)i * G + c; if (L >= nwg) return false;
        int wgid = (int)L; { const int q = nwg / NXCD, r = nwg % NXCD, xcd = wgid % NXCD, off = wgid / NXCD; wgid = (xcd < r ? xcd * (q + 1) : r * (q + 1) + (xcd - r) * q) + off; }
        const int nig = WGM * nN, gid = wgid / nig, fm = gid * WGM, gsz = (nM - fm) < WGM ? (nM - fm) : WGM;
        const int lm = fm + ((wgid % nig) % gsz); u.pn = (wgid % nig) / gsz; u.pm = lat ? (lm >> 5) * TILES_B + (lm & 31) : lm; return true;
    }
    __device__ __forceinline__ void a_ready(const Unit&) const {}
    __device__ __forceinline__ void done(const Unit&) const {}
};

__device__ __forceinline__ float fast_sigmoid(float z) { return __builtin_amdgcn_rcpf(1.0f + __builtin_amdgcn_exp2f(-1.4426950408889634f * z)); }
__device__ __forceinline__ float bf_lo(unsigned w) { return __uint_as_float(w << 16); }
__device__ __forceinline__ float bf_hi(unsigned w) { return __uint_as_float(w & 0xffff0000u); }

struct EpiSwiglu {
    static constexpr bool PERM = true, AFTER_DRAIN = false;
    bf16_t* O; int ldc; const float* rss; const float* bias;
    __device__ __forceinline__ void operator()(const f32x4 (&acc)[2][2][4][2], const Unit& u, int wr, int wc, int fr, int fq) const {
        const int row0 = u.pm * BM + wr * 64 + fr, col0 = u.pn * HALF + wc * 32 + 8 * fq;
        f32x4 bv[2][2];
#pragma unroll
        for (int bj = 0; bj < 2; ++bj)
#pragma unroll
            for (int n = 0; n < 2; ++n) bv[bj][n] = rss ? *(const f32x4*)(bias + (u.pm / TILES_B) * 5632 + u.pn * BM + bj * HALF + wc * 32 + 8 * fq + 4 * n) : (f32x4){0.f, 0.f, 0.f, 0.f};
#pragma unroll
        for (int ai = 0; ai < 2; ++ai)
#pragma unroll
            for (int m = 0; m < 4; ++m) {
                bf16_t* rowp = O + (size_t)(row0 + ai * HALF + m * 16) * ldc + col0;
                float v[8];
                const float rstd = rss ? 1.0f / sqrtf(rss[row0 + ai * HALF + m * 16] * (1.0f / 1024.0f) + 1e-6f) : 1.0f;
#pragma unroll
                for (int n = 0; n < 2; ++n)
#pragma unroll
                    for (int e = 0; e < 4; ++e) { const float gt = acc[ai][0][m][n][e] * rstd + bv[0][n][e], up = acc[ai][1][m][n][e] * rstd + bv[1][n][e]; v[4 * n + e] = gt * fast_sigmoid(gt) * up; }
                u32x4 w; w.x = cvt_pk_bf16(v[0], v[1]); w.y = cvt_pk_bf16(v[2], v[3]); w.z = cvt_pk_bf16(v[4], v[5]); w.w = cvt_pk_bf16(v[6], v[7]);
                *(u32x4*)rowp = w;
            }
    }
};

struct EpiResid {
    static constexpr bool PERM = true, AFTER_DRAIN = false;
    const float* res_lat; const float* res_ctx; float* out_lat; float* out_ctx; const float* mod; int modoff; float scale;
    __device__ __forceinline__ void operator()(const f32x4 (&acc)[2][2][4][2], const Unit& u, int wr, int wc, int fr, int fq) const {
        const int b = u.pm / TILES_B, jt = u.pm - b * TILES_B;
        const float* rb; float* ob; const float* gv;
        if (jt < 32) { const size_t o = ((size_t)b * 8192 + (size_t)jt * 256) * 1024; rb = res_lat + o; ob = out_lat + o; gv = mod + b * 9216 + modoff; }
        else { const size_t o = (size_t)b * 256 * 1024; rb = res_ctx + o; ob = out_ctx + o; gv = mod + 8 * 9216 + modoff; }
        const int rl = wr * 64 + fr, col0 = u.pn * BM + wc * 32 + 8 * fq;
        f32x4 g[2][2];
#pragma unroll
        for (int bj = 0; bj < 2; ++bj)
#pragma unroll
            for (int n = 0; n < 2; ++n) g[bj][n] = *(const f32x4*)(gv + col0 + bj * HALF + 4 * n) * scale;
#pragma unroll
        for (int ai = 0; ai < 2; ++ai)
#pragma unroll
            for (int m = 0; m < 4; ++m) { const size_t ro = (size_t)(rl + ai * HALF + m * 16) * 1024 + col0;
#pragma unroll
                for (int bj = 0; bj < 2; ++bj)
#pragma unroll
                    for (int n = 0; n < 2; ++n) { const size_t p = ro + bj * HALF + 4 * n; const f32x4 x = *(const f32x4*)(rb + p); *(f32x4*)(ob + p) = x + g[bj][n] * acc[ai][bj][m][n]; } }
    }
};

struct EpiResidNorm {
    static constexpr bool PERM = true, AFTER_DRAIN = false;
    const float* res_lat; const float* res_ctx; float* out_lat; float* out_ctx; const float* mod; int gateoff; int half_gate; const float* ng; int scaleoff; bf16_t* XNo; float* rss;
    __device__ __forceinline__ void operator()(const f32x4 (&acc)[2][2][4][2], const Unit& u, int wr, int wc, int fr, int fq) const {
        const int b = u.pm / TILES_B, jt = u.pm - b * TILES_B;
        const float* rb; float* ob; const float* mv;
        if (jt < 32) { const size_t o = ((size_t)b * 8192 + (size_t)jt * 256) * 1024; rb = res_lat + o; ob = out_lat + o; mv = mod + b * 9216; }
        else { const size_t o = (size_t)b * 256 * 1024; rb = res_ctx + o; ob = out_ctx + o; mv = mod + 8 * 9216; }
        const int rl = wr * 64 + fr, col0 = u.pn * BM + wc * 32 + 8 * fq;
        const float scale = half_gate ? 0.5f : 1.0f;
        float q[2][4];
#pragma unroll
        for (int ai = 0; ai < 2; ++ai)
#pragma unroll
            for (int m = 0; m < 4; ++m) q[ai][m] = 0.f;
#pragma unroll
        for (int bj = 0; bj < 2; ++bj) {
            const int c = col0 + bj * HALF;
            const f32x4 g0 = *(const f32x4*)(mv + gateoff + c) * scale, g1 = *(const f32x4*)(mv + gateoff + c + 4) * scale;
            const f32x4 gs0 = *(const f32x4*)(ng + c) * (*(const f32x4*)(mv + scaleoff + c) + 1.0f), gs1 = *(const f32x4*)(ng + c + 4) * (*(const f32x4*)(mv + scaleoff + c + 4) + 1.0f);
#pragma unroll
            for (int ai = 0; ai < 2; ++ai)
#pragma unroll
                for (int m = 0; m < 4; ++m) { const int rr = rl + ai * HALF + m * 16; const size_t p = (size_t)rr * 1024 + c; const size_t prow = (size_t)u.pm * BM + rr;
                    const f32x4 y0 = *(const f32x4*)(rb + p) + g0 * acc[ai][bj][m][0], y1 = *(const f32x4*)(rb + p + 4) + g1 * acc[ai][bj][m][1];
                    *(f32x4*)(ob + p) = y0; *(f32x4*)(ob + p + 4) = y1;
                    q[ai][m] += (y0[0] * y0[0] + y0[1] * y0[1]) + (y0[2] * y0[2] + y0[3] * y0[3]) + (y1[0] * y1[0] + y1[1] * y1[1]) + (y1[2] * y1[2] + y1[3] * y1[3]);
                    const f32x4 z0 = y0 * gs0, z1 = y1 * gs1;
                    u32x4 w; w.x = cvt_pk_bf16(z0[0], z0[1]); w.y = cvt_pk_bf16(z0[2], z0[3]); w.z = cvt_pk_bf16(z1[0], z1[1]); w.w = cvt_pk_bf16(z1[2], z1[3]);
                    *(u32x4*)(XNo + prow * 1024 + c) = w;
                    if (m & 1) asm volatile("" ::: "memory"); }
        }
#pragma unroll
        for (int ai = 0; ai < 2; ++ai)
#pragma unroll
            for (int m = 0; m < 4; ++m) { float t = q[ai][m]; t += __shfl_xor(t, 16); t += __shfl_xor(t, 32);
                if (fq == 0) __hip_atomic_fetch_add((__attribute__((address_space(1))) float*)(rss + (size_t)u.pm * BM + rl + ai * HALF + m * 16), t, __ATOMIC_RELAXED, __HIP_MEMORY_SCOPE_AGENT); }
    }
};

struct EpiInproj {
    static constexpr bool PERM = true, AFTER_DRAIN = false;
    bf16_t* U; bf16_t* Q; bf16_t* K; bf16_t* V; const float* rope; const float* rss; const float* bias;
    __device__ __forceinline__ void operator()(const f32x4 (&acc)[2][2][4][2], const Unit& u, int wr, int wc, int fr, int fq) const {
        const int sec = u.pn >> 1, jt = u.pm % TILES_B;
        bf16_t* base = sec == 0 ? U : sec == 1 ? Q : sec == 2 ? K : V;
        const bool dorope = (sec == 1 || sec == 2) && jt < 32;
        const float qs = sec == 1 ? 0.125f * 1.4426950408889634f : 1.0f;
        const int col0 = (u.pn & 1) * BM + wc * 32 + 8 * fq, axis = wc & 1;
        const float* bp = bias + (jt < 32 ? u.pm / TILES_B : 8) * 2048 + u.pn * BM + wc * 32 + 8 * fq;
        f32x4 bv[2][2];
#pragma unroll
        for (int bj = 0; bj < 2; ++bj)
#pragma unroll
            for (int n = 0; n < 2; ++n) bv[bj][n] = *(const f32x4*)(bp + bj * HALF + 4 * n);
#pragma unroll
        for (int ai = 0; ai < 2; ++ai)
#pragma unroll
            for (int m = 0; m < 4; ++m) {
                const int rowl = wr * 64 + fr + ai * HALF + m * 16;
                bf16_t* rowp = base + (size_t)(u.pm * BM + rowl) * 512 + col0;
                const float rstd = 1.0f / sqrtf(rss[u.pm * BM + rowl] * (1.0f / 1024.0f) + 1e-6f);
                f32x4 cs0 = {1.f, 0.f, 1.f, 0.f}, cs1 = {1.f, 0.f, 1.f, 0.f};
                if (dorope) { const int t = jt * 256 + rowl, pos = axis ? (t & 63) : (t >> 6); const float* rp = rope + (pos * 16 + 4 * fq) * 2; cs0 = *(const f32x4*)rp; cs1 = *(const f32x4*)(rp + 4); }
#pragma unroll
                for (int bj = 0; bj < 2; ++bj) {
                    const f32x4 a0 = acc[ai][bj][m][0] * rstd + bv[bj][0], a1 = acc[ai][bj][m][1] * rstd + bv[bj][1];
                    float o[8];
                    o[0] = a0[0] * cs0[0] - a0[1] * cs0[1]; o[1] = a0[1] * cs0[0] + a0[0] * cs0[1];
                    o[2] = a0[2] * cs0[2] - a0[3] * cs0[3]; o[3] = a0[3] * cs0[2] + a0[2] * cs0[3];
                    o[4] = a1[0] * cs1[0] - a1[1] * cs1[1]; o[5] = a1[1] * cs1[0] + a1[0] * cs1[1];
                    o[6] = a1[2] * cs1[2] - a1[3] * cs1[3]; o[7] = a1[3] * cs1[2] + a1[2] * cs1[3];
                    u32x4 w; w.x = cvt_pk_bf16(o[0] * qs, o[1] * qs); w.y = cvt_pk_bf16(o[2] * qs, o[3] * qs); w.z = cvt_pk_bf16(o[4] * qs, o[5] * qs); w.w = cvt_pk_bf16(o[6] * qs, o[7] * qs);
                    *(u32x4*)(rowp + bj * HALF) = w;
                }
            }
    }
};

struct EpiGlu {
    static constexpr bool PERM = true, AFTER_DRAIN = false;
    const bf16_t* Gb; const float* bglu; bf16_t* SA;
    __device__ __forceinline__ void operator()(const f32x4 (&acc)[2][2][4][2], const Unit& u, int wr, int wc, int fr, int fq) const {
        const int row0 = u.pm * BM + wr * 64 + fr, col0 = u.pn * BM + wc * 32 + 8 * fq;
        f32x4 bv[2][2];
#pragma unroll
        for (int bj = 0; bj < 2; ++bj)
#pragma unroll
            for (int n = 0; n < 2; ++n) bv[bj][n] = *(const f32x4*)(bglu + col0 + bj * HALF + 4 * n);
#pragma unroll
        for (int ai = 0; ai < 2; ++ai)
#pragma unroll
            for (int m = 0; m < 4; ++m) { const size_t row = (size_t)(row0 + ai * HALF + m * 16);
#pragma unroll
                for (int bj = 0; bj < 2; ++bj) {
                    const u32x4 gw = *(const u32x4*)(Gb + row * 512 + col0 + bj * HALF);
                    const f32x4 z0 = acc[ai][bj][m][0] + bv[bj][0], z1 = acc[ai][bj][m][1] + bv[bj][1];
                    u32x4 w;
                    w.x = cvt_pk_bf16(bf_lo(gw.x) * fast_sigmoid(z0[0]), bf_hi(gw.x) * fast_sigmoid(z0[1]));
                    w.y = cvt_pk_bf16(bf_lo(gw.y) * fast_sigmoid(z0[2]), bf_hi(gw.y) * fast_sigmoid(z0[3]));
                    w.z = cvt_pk_bf16(bf_lo(gw.z) * fast_sigmoid(z1[0]), bf_hi(gw.z) * fast_sigmoid(z1[1]));
                    w.w = cvt_pk_bf16(bf_lo(gw.w) * fast_sigmoid(z1[2]), bf_hi(gw.w) * fast_sigmoid(z1[3]));
                    *(u32x4*)(SA + row * 1024 + col0 + bj * HALF) = w;
                } }
    }
};

template <class Epi, class Sched, bool ALIGN_EPI = false, bool SP2 = false>
__device__ __forceinline__ void gemm_phase(PG8_LAS unsigned char* lds, const Gemm g, const Sched& S, const Epi& E) {
    int tid_ = threadIdx.x; asm volatile("" : "+v"(tid_));
    const int tid = tid_, wid = __builtin_amdgcn_readfirstlane(tid >> 6), lane = tid & 63, wr = wid >> 2, wc = wid & 3, fr = lane & 15, fq = lane >> 4;
    const int K = g.K, nt = K / BK;
    unsigned voffA[2], voffB[2];
#pragma unroll
    for (int i = 0; i < 2; ++i) { int R, C; stage_rc(tid * 16 + i * 8192, R, C); const int Rb = Epi::PERM ? ((R & ~31) + perm32(R & 31)) : R;
        voffA[i] = (unsigned)(R * K + C) * 2u; voffB[i] = (unsigned)(Rb * K + C) * 2u; }
    const size_t kstep = (size_t)(BK * 2);
    const size_t hstep = (size_t)HALF * K * 2;
    const size_t tstep = 2 * hstep;
    const unsigned ldsw = (unsigned)wid * 1024u;
    const int aoff = lds_byte(wr * 64 + fr, fq * 8), boff = lds_byte(wc * 32 + fr, fq * 8);
#define PG8_SA(b, h) (((b) * 2 + (h)) * HTB)
#define PG8_SB(b, h) ((4 + (b) * 2 + (h)) * HTB)
#define PG8_STAGE(bufoff, gbase, voff) do { _Pragma("unroll") for (int _i = 0; _i < 2; ++_i) \
        __builtin_amdgcn_global_load_lds((const unsigned*)((const char*)(gbase) + (voff)[_i]), (PG8_LAS unsigned*)(lds + (bufoff) + ldsw + _i * 8192), 16, 0, 0); } while (0)
#define PG8_LDA(dst, b, h) do { _Pragma("unroll") for (int m = 0; m < 4; ++m) _Pragma("unroll") for (int k = 0; k < 2; ++k) dst[m][k] = *(const PG8_LAS bf16x8*)(lds + PG8_SA(b, h) + aoff + m * 2048 + k * 1024); } while (0)
#define PG8_LDB(dst, b, h) do { _Pragma("unroll") for (int n = 0; n < 2; ++n) _Pragma("unroll") for (int k = 0; k < 2; ++k) dst[n][k] = *(const PG8_LAS bf16x8*)(lds + PG8_SB(b, h) + boff + n * 2048 + k * 1024); } while (0)
#define PG8_MMA(ai, bj, At, Bt) do { __builtin_amdgcn_s_setprio(1); _Pragma("unroll") for (int m = 0; m < 4; ++m) _Pragma("unroll") for (int n = 0; n < 2; ++n) _Pragma("unroll") for (int k = 0; k < 2; ++k) \
        acc[ai][bj][m][n] = __builtin_amdgcn_mfma_f32_16x16x32_bf16(Bt[n][k], At[m][k], acc[ai][bj][m][n], 0, 0, 0); __builtin_amdgcn_s_setprio(0); } while (0)
#define PG8_WAIT_V(n) asm volatile("s_waitcnt vmcnt(" #n ")" ::: "memory")
#define PG8_WAIT_L(n) asm volatile("s_waitcnt lgkmcnt(" #n ")" ::: "memory")
#define PG8_BAR __builtin_amdgcn_s_barrier()
#define PG8_SCHED __builtin_amdgcn_sched_barrier(0)
    Unit cur, nxt; int ui = 0;
    if (!S.next(0, cur)) return;
    f32x4 acc[2][2][4][2];
#pragma unroll
    for (int a = 0; a < 2; ++a)
#pragma unroll
        for (int b = 0; b < 2; ++b)
#pragma unroll
            for (int m = 0; m < 4; ++m)
#pragma unroll
                for (int n = 0; n < 2; ++n) acc[a][b][m][n] = (f32x4){0.f, 0.f, 0.f, 0.f};
    bf16x8 At[4][2], B0[2][2], B1[2][2];
    const char* cA = (const char*)g.A + (size_t)cur.pm * tstep; const char* cB = (const char*)g.Bt + (size_t)cur.pn * tstep;
    S.a_ready(cur);
    if constexpr (SP2) {
        PG8_STAGE(PG8_SB(0, 0), cB, voffB); PG8_STAGE(PG8_SB(0, 1), cB + hstep, voffB); PG8_STAGE(PG8_SA(0, 0), cA, voffA); PG8_STAGE(PG8_SA(0, 1), cA + hstep, voffA);
        if (wr == 1) PG8_BAR;
        PG8_WAIT_V(2); PG8_BAR;
        PG8_STAGE(PG8_SB(1, 0), cB + kstep, voffB); PG8_STAGE(PG8_SA(1, 0), cA + kstep, voffA); PG8_STAGE(PG8_SB(1, 1), cB + hstep + kstep, voffB);
        PG8_WAIT_V(6); PG8_BAR;
    } else {
        PG8_STAGE(PG8_SB(0, 0), cB, voffB); PG8_STAGE(PG8_SA(0, 0), cA, voffA); PG8_STAGE(PG8_SB(0, 1), cB + hstep, voffB); PG8_STAGE(PG8_SA(0, 1), cA + hstep, voffA);
        if (wr == 1) PG8_BAR;
        PG8_WAIT_V(4); PG8_BAR;
        PG8_STAGE(PG8_SB(1, 0), cB + kstep, voffB); PG8_STAGE(PG8_SA(1, 0), cA + kstep, voffA); PG8_STAGE(PG8_SB(1, 1), cB + hstep + kstep, voffB);
        PG8_WAIT_V(6); PG8_BAR;
    }
    for (;;) {
        const bool has_next = S.next(ui + 1, nxt);
        const char* nA = has_next ? (const char*)g.A + (size_t)nxt.pm * tstep : cA; const char* nB = has_next ? (const char*)g.Bt + (size_t)nxt.pn * tstep : cB;
        for (int t = 0; t < nt; t += 2) {
            const bool last = (t == nt - 2);
            const char* a1 = cA + (size_t)(t + 1) * kstep;
            const char* a2 = last ? nA : cA + (size_t)(t + 2) * kstep; const char* b2 = last ? nB : cB + (size_t)(t + 2) * kstep;
            const char* a3 = a2 + kstep; const char* b3 = b2 + kstep;
            if (last && has_next) S.a_ready(nxt);
            if constexpr (SP2) {
            PG8_LDB(B0, 0, 0); PG8_LDB(B1, 0, 1); PG8_SCHED; PG8_LDA(At, 0, 0); PG8_STAGE(PG8_SA(1, 1), a1 + hstep, voffA);
            PG8_WAIT_V(8); PG8_WAIT_L(0); PG8_BAR; PG8_MMA(0, 0, At, B0); PG8_MMA(0, 1, At, B1); PG8_BAR; PG8_SCHED;
            PG8_LDA(At, 0, 1); PG8_STAGE(PG8_SB(0, 0), b2, voffB); PG8_STAGE(PG8_SB(0, 1), b2 + hstep, voffB); PG8_STAGE(PG8_SA(0, 0), a2, voffA);
            PG8_WAIT_V(8); PG8_WAIT_L(0); PG8_BAR; PG8_MMA(1, 0, At, B0); PG8_MMA(1, 1, At, B1); PG8_BAR; PG8_SCHED;
            PG8_LDB(B0, 1, 0); PG8_LDB(B1, 1, 1); PG8_SCHED; PG8_LDA(At, 1, 0); PG8_STAGE(PG8_SA(0, 1), a2 + hstep, voffA);
            PG8_WAIT_V(8); PG8_WAIT_L(0); PG8_BAR; PG8_MMA(0, 0, At, B0); PG8_MMA(0, 1, At, B1); PG8_BAR; PG8_SCHED;
            PG8_LDA(At, 1, 1); PG8_STAGE(PG8_SB(1, 0), b3, voffB); PG8_STAGE(PG8_SB(1, 1), b3 + hstep, voffB); PG8_STAGE(PG8_SA(1, 0), a3, voffA);
            PG8_WAIT_V(8); PG8_WAIT_L(0); PG8_BAR; PG8_MMA(1, 0, At, B0); PG8_MMA(1, 1, At, B1); PG8_BAR; PG8_SCHED;
            } else {
            PG8_LDB(B0, 0, 0); PG8_SCHED; PG8_LDA(At, 0, 0); PG8_STAGE(PG8_SA(1, 1), a1 + hstep, voffA);
            PG8_WAIT_L(8); PG8_BAR; PG8_WAIT_L(0); PG8_MMA(0, 0, At, B0); PG8_BAR; PG8_SCHED;
            PG8_LDB(B1, 0, 1); PG8_STAGE(PG8_SB(0, 0), b2, voffB);
            PG8_BAR; PG8_WAIT_L(0); PG8_MMA(0, 1, At, B1); PG8_BAR;
            PG8_LDA(At, 0, 1); PG8_STAGE(PG8_SA(0, 0), a2, voffA);
            PG8_BAR; PG8_WAIT_L(0); PG8_MMA(1, 0, At, B0); PG8_BAR; PG8_SCHED;
            PG8_STAGE(PG8_SB(0, 1), b2 + hstep, voffB);
            PG8_WAIT_V(6); PG8_BAR; PG8_MMA(1, 1, At, B1); PG8_BAR;
            PG8_LDB(B0, 1, 0); PG8_SCHED; PG8_LDA(At, 1, 0); PG8_STAGE(PG8_SA(0, 1), a2 + hstep, voffA);
            PG8_WAIT_L(8); PG8_BAR; PG8_WAIT_L(0); PG8_MMA(0, 0, At, B0); PG8_BAR; PG8_SCHED;
            PG8_LDB(B1, 1, 1); PG8_STAGE(PG8_SB(1, 0), b3, voffB);
            PG8_BAR; PG8_WAIT_L(0); PG8_MMA(0, 1, At, B1); PG8_BAR;
            PG8_LDA(At, 1, 1); PG8_STAGE(PG8_SA(1, 0), a3, voffA);
            PG8_BAR; PG8_WAIT_L(0); PG8_MMA(1, 0, At, B0); PG8_BAR; PG8_SCHED;
            PG8_STAGE(PG8_SB(1, 1), b3 + hstep, voffB);
            PG8_WAIT_V(6); PG8_BAR; PG8_MMA(1, 1, At, B1); PG8_BAR;
            }
        }
        if constexpr (ALIGN_EPI) { if (wr == 0) PG8_BAR; }
        if constexpr (!Epi::AFTER_DRAIN) { E(acc, cur, wr, wc, fr, fq); S.done(cur); }
        if (!has_next) break;
#pragma unroll
        for (int a = 0; a < 2; ++a)
#pragma unroll
            for (int b = 0; b < 2; ++b)
#pragma unroll
                for (int m = 0; m < 4; ++m)
#pragma unroll
                    for (int n = 0; n < 2; ++n) acc[a][b][m][n] = (f32x4){0.f, 0.f, 0.f, 0.f};
        cur = nxt; cA = nA; cB = nB; ++ui;
        if constexpr (ALIGN_EPI) { if (wr == 1) PG8_BAR; }
    }
    PG8_WAIT_V(0);
    if constexpr (!ALIGN_EPI) { if (wr == 0) PG8_BAR; }
    PG8_BAR;
    if constexpr (Epi::AFTER_DRAIN) { E.fused(acc, cur, wr, wc, fr, fq, lds, wid, lane); S.done(cur); }
#undef PG8_SA
#undef PG8_SB
#undef PG8_STAGE
#undef PG8_LDA
#undef PG8_LDB
#undef PG8_MMA
#undef PG8_WAIT_V
#undef PG8_WAIT_L
#undef PG8_BAR
#undef PG8_SCHED
}
}

namespace attn {
typedef unsigned short bf16_t;
using bf16x8 = __attribute__((ext_vector_type(8))) short;
using s16x4  = __attribute__((ext_vector_type(4))) short;
using f32x16 = __attribute__((ext_vector_type(16))) float;
using u32x4  = __attribute__((ext_vector_type(4))) unsigned;
constexpr int NW = 8, QBLK = 32, KVBLK = 64;
constexpr float QSCALE = 0.125f * 1.4426950408889634f;
constexpr int LDQ = 512, LDK = 512, LDV = 512, LDO = 512;
constexpr int SHM_V = KVBLK * 128 * 2, SHM_K = KVBLK * 64 * 2, SHM_ATTN = 2 * SHM_V + 2 * SHM_K + NW * 64 * 4;
#define KSWZ64(row, colB) ((row) * 128 + ((colB) ^ ((((row) >> 1) & 7) << 4)))
#define SBAR() __builtin_amdgcn_sched_barrier(0)
__device__ __forceinline__ int crow(int r, int hi) { return (r & 3) + 8 * (r >> 2) + 4 * hi; }
__device__ __forceinline__ unsigned cvtpk(float lo, float hi) { unsigned r; asm volatile("v_cvt_pk_bf16_f32 %0, %1, %2" : "=v"(r) : "v"(lo), "v"(hi)); return r; }
constexpr float THR2 = 11.5f;
template <bool FIRST, bool GUARD>
__device__ __forceinline__ void partialSM(f32x16& p0, f32x16& p1, float& m_reg, float& alpha) {
  if (!GUARD) {
    alpha = 1.f;
#pragma unroll
    for (int r = 0; r < 16; ++r) p0[r] = __builtin_amdgcn_exp2f(p0[r]);
    return;
  }
  if (!FIRST) { if (__builtin_expect(__any(m_reg != 0.f), 0)) {
#pragma unroll
      for (int r = 0; r < 16; ++r) { p0[r] -= m_reg; p1[r] -= m_reg; } } }
  float a = fmaxf(fmaxf(p0[0], p0[1]), p1[0]), b = fmaxf(fmaxf(p0[2], p0[3]), p1[1]); a = fmaxf(fmaxf(a, p1[2]), p1[3]);
#pragma unroll
  for (int r = 4; r < 16; r += 4) { a = fmaxf(fmaxf(a, p0[r]), p0[r + 1]); b = fmaxf(fmaxf(b, p0[r + 2]), p0[r + 3]); a = fmaxf(fmaxf(a, p1[r]), p1[r + 1]); b = fmaxf(fmaxf(b, p1[r + 2]), p1[r + 3]); }
  float pmax = fmaxf(a, b);
  { auto rr = __builtin_amdgcn_permlane32_swap(__float_as_uint(pmax), __float_as_uint(pmax), false, false);
    pmax = fmaxf(__uint_as_float(rr[0]), __uint_as_float(rr[1])); }
  alpha = 1.f;
  if (FIRST) {
    if (__builtin_expect(__any(fabsf(pmax) > THR2), 0)) { const float dl = fabsf(pmax) > THR2 ? pmax : 0.f; m_reg = dl;
#pragma unroll
      for (int r = 0; r < 16; ++r) { p0[r] -= dl; p1[r] -= dl; } }
  } else {
    if (__builtin_expect(__any(pmax > THR2), 0)) { const float dl = fmaxf(pmax, 0.f); m_reg += dl;
#pragma unroll
      for (int r = 0; r < 16; ++r) { p0[r] -= dl; p1[r] -= dl; }
      alpha = __builtin_amdgcn_exp2f(-dl); }
  }
#pragma unroll
  for (int r = 0; r < 16; ++r) p0[r] = __builtin_amdgcn_exp2f(p0[r]);
}
__device__ __forceinline__ void finishSM(f32x16& p0, f32x16& p1, bf16x8& pa0, bf16x8& pa1, bf16x8& pa2, bf16x8& pa3) {
#pragma unroll
  for (int r = 0; r < 16; ++r) p1[r] = __builtin_amdgcn_exp2f(p1[r]);
#define PK4(P, BASE, OUT) do { u32x4 w = {cvtpk(P[BASE + 0], P[BASE + 1]), cvtpk(P[BASE + 2], P[BASE + 3]), cvtpk(P[BASE + 4], P[BASE + 5]), cvtpk(P[BASE + 6], P[BASE + 7])}; \
    OUT = *reinterpret_cast<bf16x8*>(&w); } while (0)
  PK4(p0, 0, pa0); PK4(p0, 8, pa1); PK4(p1, 0, pa2); PK4(p1, 8, pa3);
#undef PK4
}
__device__ __forceinline__ void qkt(f32x16& p0, f32x16& p1, const char* Ks, const bf16x8* qr, int r32, int hi) {
  p0 = f32x16{}; p1 = f32x16{};
#pragma unroll
  for (int d0 = 0; d0 < 4; ++d0) { const int cb = (d0 * 16 + hi * 8) * 2;
    bf16x8 b0 = *reinterpret_cast<const bf16x8*>(Ks + KSWZ64(r32, cb));
    bf16x8 b1 = *reinterpret_cast<const bf16x8*>(Ks + KSWZ64(32 + r32, cb));
    p0 = __builtin_amdgcn_mfma_f32_32x32x16_bf16(b0, qr[d0], p0, 0, 0, 0);
    p1 = __builtin_amdgcn_mfma_f32_32x32x16_bf16(b1, qr[d0], p1, 0, 0, 0); }
}
__device__ __forceinline__ int v_st(int k, int c) { const int kk = k; return ((kk >> 3) * 4 + (c >> 5)) * 512 + ((kk & 7) * 32 + (c & 31)) * 2; }
__device__ __forceinline__ int v_rd_base(int lane) { return ((lane & 3) << 3) | (((lane >> 2) & 3) << 6) | (((lane >> 4) & 1) << 5) | (((lane >> 5) & 1) << 8); }
constexpr int v_rd_off(int d0, int ks, int half) { return d0 * 512 + ks * 4096 + half * 2048; }
template <int OFF> __device__ __forceinline__ s16x4 tr_read(int vb) {
  s16x4 r; asm volatile("ds_read_b64_tr_b16 %0, %1 offset:%2" : "=&v"(r) : "v"(vb), "i"(OFF) : "memory"); return r;
}
template <int D0> __device__ __forceinline__ void pv_one(f32x16& od, int vb, bf16x8 pa0, bf16x8 pa1, bf16x8 pa2, bf16x8 pa3) {
  const s16x4 l0 = tr_read<v_rd_off(D0, 0, 0)>(vb), h0 = tr_read<v_rd_off(D0, 0, 1)>(vb), l1 = tr_read<v_rd_off(D0, 1, 0)>(vb), h1 = tr_read<v_rd_off(D0, 1, 1)>(vb);
  const s16x4 l2 = tr_read<v_rd_off(D0, 2, 0)>(vb), h2 = tr_read<v_rd_off(D0, 2, 1)>(vb), l3 = tr_read<v_rd_off(D0, 3, 0)>(vb), h3 = tr_read<v_rd_off(D0, 3, 1)>(vb);
  asm volatile("s_waitcnt lgkmcnt(0)" ::: "memory"); SBAR();
#define PK(L, H) (bf16x8){L[0], L[1], L[2], L[3], H[0], H[1], H[2], H[3]}
  od = __builtin_amdgcn_mfma_f32_32x32x16_bf16(pa0, PK(l0, h0), od, 0, 0, 0);
  od = __builtin_amdgcn_mfma_f32_32x32x16_bf16(pa1, PK(l1, h1), od, 0, 0, 0);
  od = __builtin_amdgcn_mfma_f32_32x32x16_bf16(pa2, PK(l2, h2), od, 0, 0, 0);
  od = __builtin_amdgcn_mfma_f32_32x32x16_bf16(pa3, PK(l3, h3), od, 0, 0, 0);
#undef PK
}
__device__ __forceinline__ void pv_d0(f32x16* o, f32x16& osum, int vb, bf16x8 pa0, bf16x8 pa1, bf16x8 pa2, bf16x8 pa3) {
  { const bf16x8 ones = {16256, 16256, 16256, 16256, 16256, 16256, 16256, 16256};
    osum = __builtin_amdgcn_mfma_f32_32x32x16_bf16(pa0, ones, osum, 0, 0, 0); osum = __builtin_amdgcn_mfma_f32_32x32x16_bf16(pa1, ones, osum, 0, 0, 0);
    osum = __builtin_amdgcn_mfma_f32_32x32x16_bf16(pa2, ones, osum, 0, 0, 0); osum = __builtin_amdgcn_mfma_f32_32x32x16_bf16(pa3, ones, osum, 0, 0, 0); }
  pv_one<0>(o[0], vb, pa0, pa1, pa2, pa3); pv_one<1>(o[1], vb, pa0, pa1, pa2, pa3); pv_one<2>(o[2], vb, pa0, pa1, pa2, pa3); pv_one<3>(o[3], vb, pa0, pa1, pa2, pa3);
}
#define TRSET(L, D0) do { L[0] = tr_read<v_rd_off(D0, 0, 0)>(vb); L[1] = tr_read<v_rd_off(D0, 0, 1)>(vb); L[2] = tr_read<v_rd_off(D0, 1, 0)>(vb); L[3] = tr_read<v_rd_off(D0, 1, 1)>(vb); \
    L[4] = tr_read<v_rd_off(D0, 2, 0)>(vb); L[5] = tr_read<v_rd_off(D0, 2, 1)>(vb); L[6] = tr_read<v_rd_off(D0, 3, 0)>(vb); L[7] = tr_read<v_rd_off(D0, 3, 1)>(vb); } while (0)
#define PKV(L, k) (bf16x8){L[2 * (k)][0], L[2 * (k)][1], L[2 * (k)][2], L[2 * (k)][3], L[2 * (k) + 1][0], L[2 * (k) + 1][1], L[2 * (k) + 1][2], L[2 * (k) + 1][3]}
#define MM4(OD, L) do { OD = __builtin_amdgcn_mfma_f32_32x32x16_bf16(pa0, PKV(L, 0), OD, 0, 0, 0); OD = __builtin_amdgcn_mfma_f32_32x32x16_bf16(pa1, PKV(L, 1), OD, 0, 0, 0); \
    OD = __builtin_amdgcn_mfma_f32_32x32x16_bf16(pa2, PKV(L, 2), OD, 0, 0, 0); OD = __builtin_amdgcn_mfma_f32_32x32x16_bf16(pa3, PKV(L, 3), OD, 0, 0, 0); } while (0)
#define LWAIT() do { asm volatile("s_waitcnt lgkmcnt(0)" ::: "memory"); SBAR(); } while (0)
__device__ __forceinline__ void pv_d0_pipe(f32x16* o, f32x16& osum, int vb, bf16x8 pa0, bf16x8 pa1, bf16x8 pa2, bf16x8 pa3) {
  s16x4 LA[8], LB[8];
  TRSET(LA, 0); SBAR();
  { const bf16x8 ones = {16256, 16256, 16256, 16256, 16256, 16256, 16256, 16256};
    osum = __builtin_amdgcn_mfma_f32_32x32x16_bf16(pa0, ones, osum, 0, 0, 0); osum = __builtin_amdgcn_mfma_f32_32x32x16_bf16(pa1, ones, osum, 0, 0, 0);
    osum = __builtin_amdgcn_mfma_f32_32x32x16_bf16(pa2, ones, osum, 0, 0, 0); osum = __builtin_amdgcn_mfma_f32_32x32x16_bf16(pa3, ones, osum, 0, 0, 0); }
  LWAIT(); TRSET(LB, 1); SBAR(); MM4(o[0], LA); SBAR();
  LWAIT(); TRSET(LA, 2); SBAR(); MM4(o[1], LB); SBAR();
  LWAIT(); TRSET(LB, 3); SBAR(); MM4(o[2], LA); SBAR();
  LWAIT(); MM4(o[3], LB);
}
#undef TRSET
#undef PKV
#undef MM4
#undef LWAIT
template <int COMP, bool GUARD>
__device__ __forceinline__ bool body(const bf16_t* __restrict__ Qb, const bf16_t* __restrict__ Kh, const bf16_t* __restrict__ Vh, float* Ob, bf16_t* __restrict__ SAo, float lam, const float* __restrict__ sg, int seq, char* lds) {
  int tid_ = threadIdx.x; asm volatile("" : "+v"(tid_));
  const int tid = tid_, wid = tid >> 6, lane = tid & 63, r32 = lane & 31, hi = lane >> 5;
  char* V_lds = lds; char* K_lds = lds + 4 * SHM_V;
  float* ws = (float*)(lds + 4 * SHM_V + 4 * SHM_K) + wid * 64; float* al_l = ws + 32;
  float m_reg = 0.f; f32x16 o[4] = {}; f32x16 osum = {}; bf16x8 qr[4];
  const bf16_t* Qw = Qb + (long)(wid * QBLK + r32) * LDQ + hi * 8;
#pragma unroll
  for (int d0 = 0; d0 < 4; ++d0) qr[d0] = *reinterpret_cast<const bf16x8*>(Qw + d0 * 16);
  const int sr = tid >> 4, sc = (tid & 15) * 8, vst0 = v_st(sr, sc), vst1 = v_st(32 + sr, sc);
  const int ksr = tid >> 3, ksc = (tid & 7) * 8, kst = KSWZ64(ksr, ksc * 2);
  const int vb0 = (int)(uintptr_t)V_lds + v_rd_base(lane);
  bf16x8 rvs0, rvs1, rks0;
#define SLOAD(k0) do { rvs0 = *reinterpret_cast<const bf16x8*>(&Vh[(long)((k0) + sr) * LDV + sc]); rvs1 = *reinterpret_cast<const bf16x8*>(&Vh[(long)((k0) + 32 + sr) * LDV + sc]); \
    rks0 = *reinterpret_cast<const bf16x8*>(&Kh[(long)((k0) + ksr) * LDK + ksc]); } while (0)
#define SWRITE(slot) do { *(bf16x8*)(V_lds + (slot) * SHM_V + vst0) = rvs0; *(bf16x8*)(V_lds + (slot) * SHM_V + vst1) = rvs1; *(bf16x8*)(K_lds + (slot) * SHM_K + kst) = rks0; } while (0)
#define RESC(a) do { if (__any((a) < 1.f)) { if (hi == 0) al_l[r32] = (a); asm volatile("s_waitcnt lgkmcnt(0)" ::: "memory"); \
    _Pragma("unroll") for (int r = 0; r < 16; ++r) { const float f_ = al_l[crow(r, hi)]; osum[r] *= f_; _Pragma("unroll") for (int d = 0; d < 4; ++d) o[d][r] *= f_; } } } while (0)
  f32x16 pA0, pA1, pB0, pB1; float alA, alB; bf16x8 pa0, pa1, pa2, pa3; const int NT = seq / KVBLK;
  SLOAD(0); SWRITE(0); SLOAD(KVBLK); __syncthreads();
  qkt(pA0, pA1, K_lds, qr, r32, hi); partialSM<true, GUARD>(pA0, pA1, m_reg, alA);
  SWRITE(1); SLOAD(2 * KVBLK); __syncthreads();
  const int grp = __builtin_amdgcn_readfirstlane(wid >> 2);
#define ITER(X0, X1, Y0, Y1, alX, i) do { const int scur = (i) & 3, sp = ((i) - 1) & 3, sn = ((i) + 1) & 3; \
    SBAR(); qkt(X0, X1, K_lds + scur * SHM_K, qr, r32, hi); \
    finishSM(Y0, Y1, pa0, pa1, pa2, pa3); SBAR(); \
    if (grp) { SWRITE(sn); if ((i) + 2 < NT) SLOAD(((i) + 2) * KVBLK); __syncthreads(); } \
    if (GUARD) pv_d0(o, osum, vb0 + sp * SHM_V, pa0, pa1, pa2, pa3); else pv_d0_pipe(o, osum, vb0 + sp * SHM_V, pa0, pa1, pa2, pa3); partialSM<false, GUARD>(X0, X1, m_reg, alX); \
    if (GUARD) RESC(alX); \
    if (!grp) { SWRITE(sn); if ((i) + 2 < NT) SLOAD(((i) + 2) * KVBLK); __syncthreads(); } } while (0)
  int i = 1;
  for (; i + 1 < NT; i += 2) {
    ITER(pB0, pB1, pA0, pA1, alB, i);
    ITER(pA0, pA1, pB0, pB1, alA, i + 1);
  }
  { const int scur = i & 3, sp = (i - 1) & 3;
  SBAR(); qkt(pB0, pB1, K_lds + scur * SHM_K, qr, r32, hi);
  finishSM(pA0, pA1, pa0, pa1, pa2, pa3); SBAR();
  pv_d0(o, osum, vb0 + sp * SHM_V, pa0, pa1, pa2, pa3); partialSM<false, GUARD>(pB0, pB1, m_reg, alB);
  if (GUARD) RESC(alB);
  finishSM(pB0, pB1, pa0, pa1, pa2, pa3); SBAR();
  pv_d0(o, osum, vb0 + scur * SHM_V, pa0, pa1, pa2, pa3); }
#undef ITER
  if (!GUARD) {
    bool ok = true;
#pragma unroll
    for (int r = 0; r < 16; ++r) ok = ok && (osum[r] > 0.f) && (osum[r] < 3.0e38f);
    if (__syncthreads_or(ok ? 0 : 1)) return true;
  }
  float rli[16];
#pragma unroll
  for (int r = 0; r < 16; ++r) rli[r] = __builtin_amdgcn_rcpf(osum[r]);
  float* Ow = Ob + (long)(wid * QBLK) * LDO;
  if (COMP == 0) {
#pragma unroll
    for (int r = 0; r < 16; ++r) { const int orow = crow(r, hi);
#pragma unroll
      for (int d0 = 0; d0 < 4; ++d0) Ow[(long)orow * LDO + d0 * 32 + r32] = o[d0][r] * rli[r]; }
  } else {
    float ss[16];
#pragma unroll
    for (int r = 0; r < 16; ++r) { const int orow = crow(r, hi); float q = 0.f;
#pragma unroll
      for (int d0 = 0; d0 < 4; ++d0) { const float d = Ow[(long)orow * LDO + d0 * 32 + r32] - lam * (o[d0][r] * rli[r]); o[d0][r] = d; q = fmaf(d, d, q); }
      ss[r] = q; }
#pragma unroll
    for (int r = 0; r < 16; ++r) { float q = ss[r]; q += __shfl_xor(q, 1); q += __shfl_xor(q, 2); q += __shfl_xor(q, 4); q += __shfl_xor(q, 8); q += __shfl_xor(q, 16);
      ss[r] = 1.0f / sqrtf(q * (1.0f / 128.0f) + 1e-6f); }
    float gsub[4];
#pragma unroll
    for (int d0 = 0; d0 < 4; ++d0) gsub[d0] = sg[d0 * 32 + r32] * 0.8f;
    bf16_t* Sw = SAo + (long)(wid * QBLK) * 1024;
#pragma unroll
    for (int r = 0; r < 16; ++r) { const int orow = crow(r, hi);
#pragma unroll
      for (int d0 = 0; d0 < 4; ++d0) { const float y = o[d0][r] * ss[r] * gsub[d0]; unsigned u = __builtin_bit_cast(unsigned, y); u = (u + 0x7fffu + ((u >> 16) & 1u)) >> 16;
        Sw[(long)orow * 1024 + d0 * 32 + r32] = (bf16_t)u; } }
  }
  asm volatile("s_waitcnt vmcnt(0) lgkmcnt(0)" ::: "memory"); __syncthreads();
  return false;
#undef SLOAD
#undef SWRITE
#undef RESC
}
#undef SBAR
}

#define GAS __attribute__((address_space(1)))
#define LAS __attribute__((address_space(3)))
typedef unsigned short bf16;
typedef unsigned v4u __attribute__((ext_vector_type(4)));
typedef float f32x4 __attribute__((ext_vector_type(4)));
typedef float f32x16 __attribute__((ext_vector_type(16)));
typedef short bf16x8 __attribute__((ext_vector_type(8)));

constexpr int NWAVES = 8, NTHR = 512;
constexpr int DM = 1024, DFF = 2816, NB = 8, SEQ = 8192, CTXL = 256, NMODV = 9 * DM;
constexpr int ROWS_B = 8448, TILES_B = 33, NROWS = NB * ROWS_B;

constexpr size_t MiB = 1u << 20;
constexpr size_t WS_CTL = 0, CTL_ZERO_BYTES = 1 * MiB;
constexpr size_t WS_MOD = 4096;
constexpr size_t WS_BIAS1 = 352 * 1024, WS_BIAS2 = 640 * 1024;
constexpr size_t WS_RSS1 = 69 * MiB, WS_RSS2 = 69 * MiB + 512 * 1024;
constexpr size_t WS_BAR = 512 * 1024, BAR_ZERO_BYTES = 16384;
constexpr size_t WS_ABAR = 1 * MiB, WS_APOW = WS_ABAR + 32768, WS_BBT = WS_APOW + 32768, WS_CM = WS_BBT + 262144, WS_ROPE = WS_CM + 262144;
constexpr size_t WS_W1A = 2 * MiB, WS_W1B = 13 * MiB, WS_W2A = 19 * MiB, WS_W2B = 30 * MiB, WS_WIN = 36 * MiB, WS_WOUT = 40 * MiB, WS_WGLU = 42 * MiB;
constexpr size_t WS_E = 43 * MiB, WS_HIN = 52 * MiB, WS_XC = 61 * MiB;
constexpr size_t WS_XN = 70 * MiB;
constexpr size_t WS_ACT = 202 * MiB;
constexpr size_t WS_OATT = WS_ACT, WS_G = WS_ACT + 264 * MiB;
constexpr size_t WS_U = 565 * MiB, WS_Q = 631 * MiB, WS_K = 697 * MiB, WS_V = 763 * MiB, WS_END = 829 * MiB;
static_assert(WS_ROPE + 16384 <= WS_W1A && WS_W1A + (size_t)5632 * 1024 * 2 <= WS_W1B && WS_W1B + (size_t)1024 * 2816 * 2 <= WS_W2A && WS_W2A + (size_t)5632 * 1024 * 2 <= WS_W2B, "ws map 1");
static_assert(WS_W2B + (size_t)1024 * 2816 * 2 <= WS_WIN && WS_WIN + (size_t)2048 * 1024 * 2 <= WS_WOUT && WS_WOUT + (size_t)1024 * 1024 * 2 <= WS_WGLU && WS_WGLU + 512 * 512 * 2 <= WS_E, "ws map 2");
static_assert(WS_E + (size_t)8 * 33 * 64 * 64 * 8 <= WS_HIN && WS_HIN + (size_t)8 * 33 * 64 * 64 * 8 <= WS_XC && WS_XC + (size_t)2048 * 1024 * 4 <= WS_XN, "ws map 3");
static_assert(WS_XN + (size_t)NROWS * 1024 * 2 <= WS_ACT && WS_ACT + (size_t)NROWS * 2816 * 2 <= WS_U && WS_G + (size_t)NROWS * 512 * 2 <= WS_U && WS_OATT + (size_t)NROWS * 1024 * 4 <= WS_G, "ws map 4");
static_assert(WS_U + (size_t)NROWS * 512 * 2 <= WS_Q && WS_V + (size_t)NROWS * 512 * 2 <= WS_END, "ws map 5");

constexpr int LDS_BYTES = 139264;

#define LDS_WAIT() asm volatile("s_waitcnt lgkmcnt(0)" ::: "memory")
__device__ __forceinline__ unsigned f2bf(float f) { unsigned u = __builtin_bit_cast(unsigned, f); return (u + 0x7fffu + ((u >> 16) & 1u)) >> 16; }
__device__ __forceinline__ unsigned pk2(float lo, float hi) { return f2bf(lo) | (f2bf(hi) << 16); }
__device__ __forceinline__ float wave_sum(float v) {
#pragma unroll
    for (int o = 1; o < 64; o <<= 1) v += __shfl_xor(v, o);
    return v;
}

__device__ __forceinline__ double dexp(double x) {
    const double n = __builtin_rint(x * 1.4426950408889634074);
    const double r = __builtin_fma(-n, 1.9082149292705877e-10, __builtin_fma(-n, 0.693147180369123816490, x));
    double p = 1.0 / 87178291200.0;
    p = p * r + 1.0 / 6227020800.0; p = p * r + 1.0 / 479001600.0; p = p * r + 1.0 / 39916800.0; p = p * r + 1.0 / 3628800.0; p = p * r + 1.0 / 362880.0; p = p * r + 1.0 / 40320.0;
    p = p * r + 1.0 / 5040.0; p = p * r + 1.0 / 720.0; p = p * r + 1.0 / 120.0; p = p * r + 1.0 / 24.0; p = p * r + 1.0 / 6.0; p = p * r + 0.5; p = p * r + 1.0; p = p * r + 1.0;
    const long long e = (long long)n + 1023; const double s = __builtin_bit_cast(double, (unsigned long long)e << 52);
    return p * s;
}
__device__ __forceinline__ void dsincos(double y, double& s, double& c) {
    const double k = __builtin_rint(y * 0.15915494309189533577);
    double r = __builtin_fma(-k, 6.283185307179586232, y); r = __builtin_fma(-k, 2.4492935982947064e-16, r);
    const double q = r * 0.125, q2 = q * q;
    double sp = -1.0 / 1307674368000.0; sp = sp * q2 + 1.0 / 6227020800.0; sp = sp * q2 - 1.0 / 39916800.0; sp = sp * q2 + 1.0 / 362880.0; sp = sp * q2 - 1.0 / 5040.0; sp = sp * q2 + 1.0 / 120.0; sp = sp * q2 - 1.0 / 6.0; sp = sp * q2 + 1.0;
    double cp = 1.0 / 20922789888000.0; cp = cp * q2 - 1.0 / 87178291200.0; cp = cp * q2 + 1.0 / 479001600.0; cp = cp * q2 - 1.0 / 3628800.0; cp = cp * q2 + 1.0 / 40320.0; cp = cp * q2 - 1.0 / 720.0; cp = cp * q2 + 1.0 / 24.0; cp = cp * q2 - 0.5; cp = cp * q2 + 1.0;
    double ss = sp * q, cc = cp;
#pragma unroll
    for (int i = 0; i < 3; ++i) { const double s2 = 2.0 * ss * cc, c2 = cc * cc - ss * ss; ss = s2; cc = c2; }
    s = ss; c = cc;
}

__device__ __forceinline__ void transpose_item(const float* W, int K, int N, bf16* WT, int mode, LAS float* scr, int item, int lane) {
    const int nblk = N / 32, kb = item / nblk, nb = item % nblk, k0 = 64 * kb, n0 = 32 * nb;
    { const float* wp = W + (size_t)(k0 + (lane >> 5)) * N + n0 + (lane & 31); float v[32];
#pragma unroll
      for (int i = 0; i < 32; ++i) v[i] = wp[(size_t)(2 * i) * N];
#pragma unroll
      for (int i = 0; i < 32; ++i) scr[(2 * i + (lane >> 5)) * 33 + (lane & 31)] = v[i]; }
    LDS_WAIT(); asm volatile("" ::: "memory");
    const int c = lane & 7;
#pragma unroll
    for (int j = 0; j < 4; ++j) { const int n = (lane >> 3) + 8 * j; const LAS float* s = scr + (8 * c) * 33 + n;
        const int src = n0 + n; int drow = src;
        if (mode == 1) { const int up = src >= DFF ? 1 : 0, ff = src - up * DFF; drow = (ff >> 7) * 256 + up * 128 + (ff & 127); }
        else if (mode == 2) { if (src >= 512 && src < 1536) drow = n0 + 2 * (n & 15) + (n >> 4); }
        v4u o; o.x = pk2(s[0 * 33], s[1 * 33]); o.y = pk2(s[2 * 33], s[3 * 33]); o.z = pk2(s[4 * 33], s[5 * 33]); o.w = pk2(s[6 * 33], s[7 * 33]);
        *(v4u*)(WT + (size_t)drow * K + k0 + 8 * c) = o; }
    LDS_WAIT(); asm volatile("" ::: "memory");
}

template <int MODE>
__device__ __forceinline__ void norm_rows16(const float* src, bf16* dstb, float* dstf, const float* g, const float* shift, const float* scale, int lane) {
    f32x4 gs[4], sh[4];
#pragma unroll
    for (int j = 0; j < 4; ++j) { const int cidx = 4 * lane + 256 * j; const f32x4 gv = *(const f32x4*)(g + cidx);
        if (MODE == 0) { const f32x4 sc = *(const f32x4*)(scale + cidx); gs[j] = gv * (sc + 1.0f); sh[j] = *(const f32x4*)(shift + cidx); } else { gs[j] = gv; sh[j] = (f32x4){0.f, 0.f, 0.f, 0.f}; } }
#pragma unroll 2
    for (int r = 0; r < 16; ++r) {
        const f32x4* xr = (const f32x4*)(src + (size_t)r * DM) + lane;
        f32x4 v[4]; float s = 0.f;
#pragma unroll
        for (int j = 0; j < 4; ++j) { v[j] = xr[64 * j]; s += (v[j].x * v[j].x + v[j].y * v[j].y) + (v[j].z * v[j].z + v[j].w * v[j].w); }
        const float rstd = 1.0f / sqrtf(wave_sum(s) * (1.0f / DM) + 1e-6f);
        if (MODE == 0) {
            unsigned long long* o8 = (unsigned long long*)(dstb + (size_t)r * DM) + lane;
#pragma unroll
            for (int j = 0; j < 4; ++j) { const f32x4 y = v[j] * rstd * gs[j] + sh[j]; o8[64 * j] = (unsigned long long)pk2(y.x, y.y) | ((unsigned long long)pk2(y.z, y.w) << 32); }
        } else {
            f32x4* of = (f32x4*)(dstf + (size_t)r * DM) + lane;
#pragma unroll
            for (int j = 0; j < 4; ++j) of[64 * j] = v[j] * rstd * gs[j];
        }
    }
}

__device__ __forceinline__ int crow16(int r, int hi) { return (r & 3) + 8 * (r >> 2) + 4 * hi; }
typedef float f32x2_t __attribute__((ext_vector_type(2))); typedef __bf16 bf16x2_t __attribute__((ext_vector_type(2)));
__device__ __forceinline__ unsigned cvtpk2(float lo, float hi) { f32x2_t v = {lo, hi}; bf16x2_t b = __builtin_convertvector(v, bf16x2_t); return __builtin_bit_cast(unsigned, b); }

template <bool FULL>
__device__ __forceinline__ void s5_unit(LAS unsigned char* lds, int b, int c, int gq, const bf16* U, const float2* ABAR, const bf16* BBT, const bf16* CM,
                                        const float2* HIN, float2* E, const float* dskip, bf16* G, float* YF) {
    int tid_ = threadIdx.x; asm volatile("" : "+v"(tid_));
    const int lane = tid_ & 63, wave = __builtin_amdgcn_readfirstlane(tid_ >> 6);
    const int g = gq * 8 + wave, hi = lane >> 5, r32 = lane & 31;
    LAS unsigned* scr = (LAS unsigned*)(lds + wave * 8704);
    const size_t r0 = (size_t)b * ROWS_B + (size_t)c * 256;
    const bf16* ubase = U + (r0 + r32) * 512 + g * 16 + hi * 8;
    const int ch = lane & 15; const float dv = dskip[g * 16 + ch];
    const size_t obase = (r0 + (lane >> 4) * 4) * 512 + g * 16 + ch;
    LAS unsigned short* yt_l = (LAS unsigned short*)(lds + 69632 + wave * 8192) + ((lane >> 4) * 4) * 16 + ch;
#pragma unroll
    for (int dir = 0; dir < 2; ++dir) {
        const int dg = dir * 32 + g;
        const float2 ab = ABAR[dg * 64 + lane];
        bf16x8 bb[4], cm[4];
#pragma unroll
        for (int blk = 0; blk < 4; ++blk) bb[blk] = *(const bf16x8*)(BBT + ((size_t)(dg * 4 + blk) * 32 + r32) * 16 + hi * 8);
        if (FULL) {
#pragma unroll
            for (int ks = 0; ks < 4; ++ks) cm[ks] = *(const bf16x8*)(CM + ((size_t)dg * 16 + (lane & 15)) * 128 + ks * 32 + (lane >> 4) * 8);
        }
        const size_t sidx = ((((size_t)b * 33 + c) * 32 + g) * 2 + dir) * 64 + lane;
        float hr = 0.f, hm = 0.f;
        if (FULL) { const float2 h0 = HIN[sidx]; hr = h0.x; hm = h0.y; }
        bf16x8 a_nx = *(const bf16x8*)(ubase + (size_t)(dir == 0 ? 0 : 224) * 512);
#pragma unroll 1
        for (int sb = 0; sb < 8; ++sb) {
            const int tb = dir == 0 ? sb * 32 : (7 - sb) * 32;
            const bf16x8 a = a_nx;
            { const int tn = dir == 0 ? (sb < 7 ? tb + 32 : tb) : (sb < 7 ? tb - 32 : tb); a_nx = *(const bf16x8*)(ubase + (size_t)tn * 512); }
            unsigned short uvv[2][4];
            if (FULL && dir == 1) {
#pragma unroll
                for (int mt = 0; mt < 2; ++mt)
#pragma unroll
                    for (int j = 0; j < 4; ++j) { const size_t idx = obase + (size_t)(tb + mt * 16 + j) * 512; uvv[mt][j] = U[idx]; }
            }
            const f32x16 z = {};
#pragma unroll
            for (int hf = 0; hf < 2; ++hf) {
                const f32x16 c0 = __builtin_amdgcn_mfma_f32_32x32x16_bf16(a, bb[hf], z, 0, 0, 0), c2 = __builtin_amdgcn_mfma_f32_32x32x16_bf16(a, bb[2 + hf], z, 0, 0, 0);
#pragma unroll
                for (int r = 0; r < 16; ++r) { const int row = crow16(r, hi); scr[row * 68 + hf * 32 + r32] = cvtpk2(c0[r], c2[r]); }
            }
            LDS_WAIT(); asm volatile("" ::: "memory");
#pragma unroll
            for (int half = 0; half < 2; ++half) {
                unsigned v[16];
#pragma unroll
                for (int q = 0; q < 16; ++q) { const int t = dir == 0 ? half * 16 + q : 31 - (half * 16 + q); v[q] = scr[t * 68 + lane]; }
#pragma unroll
                for (int q = 0; q < 16; ++q) { const int t = dir == 0 ? half * 16 + q : 31 - (half * 16 + q);
                    const float re = __uint_as_float(v[q] << 16), im = __uint_as_float(v[q] & 0xffff0000u);
                    const float nr = fmaf(ab.x, hr, fmaf(-ab.y, hm, re)), ni = fmaf(ab.x, hm, fmaf(ab.y, hr, im)); hr = nr; hm = ni;
                    if (FULL) scr[t * 68 + lane] = cvtpk2(hr, hm); }
                asm volatile("" ::: "memory");
            }
            if (FULL) {
                LDS_WAIT(); asm volatile("" ::: "memory");
                f32x4 yt[2];
#pragma unroll
                for (int mt = 0; mt < 2; ++mt) { yt[mt] = (f32x4){0.f, 0.f, 0.f, 0.f};
#pragma unroll
                    for (int ks = 0; ks < 4; ++ks) { const bf16x8 hf8 = *(const LAS bf16x8*)((const LAS unsigned char*)scr + (mt * 16 + (lane & 15)) * 272 + ks * 64 + (lane >> 4) * 16);
                        yt[mt] = __builtin_amdgcn_mfma_f32_16x16x32_bf16(hf8, cm[ks], yt[mt], 0, 0, 0); } }
#pragma unroll
                for (int mt = 0; mt < 2; ++mt)
#pragma unroll
                    for (int j = 0; j < 4; ++j) { LAS unsigned short* yp = yt_l + (tb + mt * 16 + j) * 16;
                        if (dir == 0) *yp = (unsigned short)f2bf(yt[mt][j]);
                        else { const float uv = __uint_as_float((unsigned)uvv[mt][j] << 16); const float yv = __uint_as_float((unsigned)*yp << 16) + yt[mt][j] + dv * uv;
                            const float zz = 1.5957691216057308f * (yv + 0.044715f * yv * yv * yv); *yp = (unsigned short)f2bf(yv * pg8::fast_sigmoid(zz)); } }
                LDS_WAIT(); asm volatile("" ::: "memory");
            }
        }
        if (!FULL) E[sidx] = make_float2(hr, hm);
    }
    if (FULL) {
        LDS_WAIT(); asm volatile("" ::: "memory");
        const LAS unsigned char* yb = (const LAS unsigned char*)(lds + 69632 + wave * 8192);
#pragma unroll
        for (int it = 0; it < 8; ++it) { const int row = it * 32 + (lane >> 1), hf = lane & 1;
            const v4u w = *(const LAS v4u*)(yb + row * 32 + hf * 16);
            *(v4u*)(G + (r0 + row) * 512 + g * 16 + hf * 8) = w; }
        LDS_WAIT(); asm volatile("" ::: "memory");
    }
}

__device__ __forceinline__ void cmulf(float ar, float ai, float br, float bi, float& cr, float& ci) { cr = ar * br - ai * bi; ci = ar * bi + ai * br; }
__device__ __forceinline__ void s5_unit_a(LAS unsigned char* lds, int b, int c, int gq, const bf16* U, const float2* ABAR, const bf16* BBT, float2* E) {
    int tid_ = threadIdx.x; asm volatile("" : "+v"(tid_));
    const int lane = tid_ & 63, wave = __builtin_amdgcn_readfirstlane(tid_ >> 6);
    const int g = gq * 8 + wave, hi = lane >> 5, r32 = lane & 31;
    const size_t r0 = (size_t)b * ROWS_B + (size_t)c * 256;
    LAS unsigned char* ut = lds + wave * 8192;
    { v4u t8[8];
#pragma unroll
      for (int it = 0; it < 8; ++it) t8[it] = *(const v4u*)(U + (r0 + it * 32 + (lane >> 1)) * 512 + g * 16 + (lane & 1) * 8);
#pragma unroll
      for (int it = 0; it < 8; ++it) *(LAS v4u*)(ut + (it * 32 + (lane >> 1)) * 32 + (lane & 1) * 16) = t8[it]; }
    LDS_WAIT(); asm volatile("" ::: "memory");
    const LAS unsigned char* ua = ut + r32 * 32 + hi * 16;
#pragma unroll
    for (int dir = 0; dir < 2; ++dir) {
        const int dg = dir * 32 + g;
        bf16x8 bb[4];
#pragma unroll
        for (int blk = 0; blk < 4; ++blk) bb[blk] = *(const bf16x8*)(BBT + ((size_t)(dg * 4 + blk) * 32 + r32) * 16 + hi * 8);
        float wr[2][16], wi[2][16], a32r[2], a32i[2];
#pragma unroll
        for (int hf = 0; hf < 2; ++hf) {
            const float2 ab = ABAR[dg * 64 + hf * 32 + r32];
            float qr[4], qi[4], orr[4], oi[4];
            qr[0] = 1.f; qi[0] = 0.f; qr[1] = ab.x; qi[1] = ab.y; cmulf(qr[1], qi[1], ab.x, ab.y, qr[2], qi[2]); cmulf(qr[2], qi[2], ab.x, ab.y, qr[3], qi[3]);
            float a4r, a4i; cmulf(qr[2], qi[2], qr[2], qi[2], a4r, a4i);
            orr[0] = 1.f; oi[0] = 0.f; cmulf(a4r, a4i, a4r, a4i, orr[1], oi[1]); cmulf(orr[1], oi[1], orr[1], oi[1], orr[2], oi[2]); cmulf(orr[2], oi[2], orr[1], oi[1], orr[3], oi[3]);
            cmulf(orr[2], oi[2], orr[2], oi[2], a32r[hf], a32i[hf]);
            const bool use4 = dir == 0 ? (hi == 0) : (hi != 0);
            const float br = use4 ? a4r : 1.f, bi = use4 ? a4i : 0.f;
#pragma unroll
            for (int r = 0; r < 16; ++r) { const int jq = dir == 0 ? 3 - (r & 3) : (r & 3), jo = dir == 0 ? 3 - (r >> 2) : (r >> 2);
                float tr, ti; cmulf(qr[jq], qi[jq], orr[jo], oi[jo], tr, ti); cmulf(tr, ti, br, bi, wr[hf][r], wi[hf][r]); }
        }
        float hr[2] = {0.f, 0.f}, hm[2] = {0.f, 0.f};
#pragma unroll 1
        for (int sb = 0; sb < 8; ++sb) {
            const bf16x8 a = *(const LAS bf16x8*)(ua + (dir == 0 ? sb * 32 : (7 - sb) * 32) * 32);
            const f32x16 z = {};
#pragma unroll
            for (int hf = 0; hf < 2; ++hf) {
                const f32x16 cre = __builtin_amdgcn_mfma_f32_32x32x16_bf16(a, bb[hf], z, 0, 0, 0), cim = __builtin_amdgcn_mfma_f32_32x32x16_bf16(a, bb[2 + hf], z, 0, 0, 0);
                float er = 0.f, ei = 0.f;
#pragma unroll
                for (int r = 0; r < 16; ++r) { er = fmaf(wr[hf][r], cre[r], fmaf(-wi[hf][r], cim[r], er)); ei = fmaf(wr[hf][r], cim[r], fmaf(wi[hf][r], cre[r], ei)); }
                er += __shfl_xor(er, 32); ei += __shfl_xor(ei, 32);
                const float nr = fmaf(a32r[hf], hr[hf], fmaf(-a32i[hf], hm[hf], er)), ni = fmaf(a32r[hf], hm[hf], fmaf(a32i[hf], hr[hf], ei));
                hr[hf] = nr; hm[hf] = ni;
            }
        }
        const size_t sidx = ((((size_t)b * 33 + c) * 32 + g) * 2 + dir) * 64 + lane;
        E[sidx] = hi ? make_float2(hr[1], hm[1]) : make_float2(hr[0], hm[0]);
    }
    LDS_WAIT(); asm volatile("" ::: "memory");
}

typedef GAS unsigned gu32;
#define RLX_AGENT __ATOMIC_RELAXED, __HIP_MEMORY_SCOPE_AGENT
#define XB_TMO      128
#define XB_XCNT(j)  (256  + 64 * (j))
#define XB_XSUB(j)  (1280 + 64 * (j))
#define XB_XGEN(j)  (2304 + 64 * (j))
#define XB_TOP      3328
#define XB_TOPGEN   3392
#define XCD_BAR_WORDS 3456
#define XB_SPIN_CAP (1u << 18)

__device__ __forceinline__ unsigned xb_ld(unsigned* p)              { return __hip_atomic_load(p, __ATOMIC_RELAXED, __HIP_MEMORY_SCOPE_AGENT); }
__device__ __forceinline__ unsigned xb_add(unsigned* p, unsigned v) { return __hip_atomic_fetch_add(p, v, __ATOMIC_RELAXED, __HIP_MEMORY_SCOPE_AGENT); }
__device__ __forceinline__ unsigned xb_xcc_id() { return (unsigned)__builtin_amdgcn_s_getreg((3 << 11) | 20) & 0xFu; }
#define XB_SPIN(cond, bar) do { unsigned _sp = 0; while (cond) { __builtin_amdgcn_s_sleep(1); \
    if ((++_sp & 255u) == 0u) { if (xb_ld(&(bar)[XB_TMO])) break; if (_sp > XB_SPIN_CAP) { atomicAdd(&(bar)[XB_TMO], 1u); break; } } } } while (0)

struct XcdBarrier {
    unsigned* bar; unsigned x;
    volatile LAS unsigned* st;
};

__device__ __forceinline__ XcdBarrier xcd_barrier_post(unsigned* bar, volatile LAS unsigned* st) {
    XcdBarrier b; b.bar = bar; b.x = xb_xcc_id(); b.st = st;
    if (threadIdx.x == 0) (void)xb_add(&bar[XB_XCNT(b.x)], 1u);
    return b;
}
__device__ __forceinline__ void xcd_barrier_complete(unsigned* bar, unsigned x, unsigned& nloc, unsigned& nx) {
    const unsigned G = gridDim.x * gridDim.y * gridDim.z;
    unsigned sum, cnt, mine, sp = 0u;
    for (;;) {
        sum = 0u; cnt = 0u; mine = 0u;
#pragma unroll
        for (unsigned j = 0; j < 16; ++j) { const unsigned c = xb_ld(&bar[XB_XCNT(j)]); sum += c; cnt += (c > 0u) ? 1u : 0u; mine = (j == x) ? c : mine; }
        if (sum == G) break;
        __builtin_amdgcn_s_sleep(1);
        if ((++sp & 255u) == 0u) { if (xb_ld(&bar[XB_TMO])) break; if (sp > XB_SPIN_CAP) { atomicAdd(&bar[XB_TMO], 1u); break; } }
    }
    nloc = mine > 0u ? mine : 1u; nx = cnt > 0u ? cnt : 1u;
}

__device__ __forceinline__ void xcd_barrier(const XcdBarrier& b) {
    asm volatile("s_waitcnt vmcnt(0)" ::: "memory");
    __syncthreads();
    if (threadIdx.x == 0) {
        unsigned* bar = b.bar;
        __builtin_amdgcn_s_waitcnt(0);
        unsigned nloc = b.st[0], nx = b.st[1];
        if (nloc == 0u) { xcd_barrier_complete(bar, b.x, nloc, nx); b.st[0] = nloc; b.st[1] = nx; }
        const unsigned old = xb_add(&bar[XB_XSUB(b.x)], 1u);
        const unsigned gen = old / nloc;
        if (old + 1u == (gen + 1u) * nloc) {
            __builtin_amdgcn_fence(__ATOMIC_RELEASE, "agent");
            asm volatile("s_waitcnt vmcnt(0)" ::: "memory");
            const unsigned og = xb_add(&bar[XB_TOP], 1u);
            const unsigned tg = og / nx;
            if (og + 1u == (tg + 1u) * nx) xb_add(&bar[XB_TOPGEN], 1u);
            else XB_SPIN(xb_ld(&bar[XB_TOPGEN]) == tg, bar);
            __builtin_amdgcn_fence(__ATOMIC_ACQUIRE, "agent");
            xb_add(&bar[XB_XGEN(b.x)], 1u);
            asm volatile("s_waitcnt vmcnt(0)" ::: "memory");
        } else {
            XB_SPIN(xb_ld(&bar[XB_XGEN(b.x)]) == gen, bar);
            __builtin_amdgcn_fence(__ATOMIC_ACQUIRE, "agent");
            asm volatile("s_waitcnt vmcnt(0)" ::: "memory");
        }
    }
    __syncthreads();
}

#ifndef PHMASK
#define PHMASK 0xFFFFF
#endif
#define PH(k) if ((PHMASK >> (k)) & 1)
struct Args { const float* in[25]; float* out; unsigned char* ws; };
__device__ __forceinline__ const float* karg(int i) {
    unsigned off = (unsigned)i * 8u; asm volatile("" : "+s"(off));
    return *(const float* const __attribute__((address_space(4)))*)((const char __attribute__((address_space(4)))*)__builtin_amdgcn_kernarg_segment_ptr() + off);
}

__global__ void __launch_bounds__(NTHR, 2) hymba_fwd(Args a) {
    extern __shared__ __attribute__((aligned(16))) unsigned char lds[];
    cg::grid_group grid = cg::this_grid();
    const int tid = threadIdx.x, lane = tid & 63, wave = __builtin_amdgcn_readfirstlane(tid >> 6);
    const int G = gridDim.x, bx = blockIdx.x;
    const int vcu = (G % 8 == 0) ? (bx % 8) * (G / 8) + bx / 8 : bx;
    const int gw = vcu * NWAVES + wave, NGW = G * NWAVES;
    LAS unsigned char* ldsl = (LAS unsigned char*)lds;
#define KIN(i) karg(i)
#define ws_p ((unsigned char*)karg(26))
#define out_p ((float*)karg(25))
#define x_in KIN(0)
#define cvec KIN(1)
#define ctx KIN(2)
#define c_ctx KIN(3)
#define w_mod KIN(4)
#define b_mod KIN(5)
#define norm_g KIN(6)
#define ffn_w_in KIN(7)
#define ffn_w_out KIN(8)
#define w_in KIN(9)
#define w_out KIN(10)
#define ssm_a_re KIN(11)
#define ssm_a_im KIN(12)
#define ssm_log_dt KIN(13)
#define ssm_b_re KIN(14)
#define ssm_b_im KIN(15)
#define ssm_c_re KIN(16)
#define ssm_c_im KIN(17)
#define ssm_d KIN(18)
#define w_glu KIN(19)
#define b_glu KIN(20)
#define lam_q KIN(21)
#define lam_k KIN(22)
#define subln_g KIN(23)
#define final_g KIN(24)
#define MISC ((float*)(ws_p + WS_CTL))
#define MOD ((float*)(ws_p + WS_MOD))
#define ABAR ((float2*)(ws_p + WS_ABAR))
#define APOW ((float2*)(ws_p + WS_APOW))
#define BBT ((bf16*)(ws_p + WS_BBT))
#define CM ((bf16*)(ws_p + WS_CM))
#define ROPE ((float*)(ws_p + WS_ROPE))
#define W1A ((bf16*)(ws_p + WS_W1A))
#define W1B ((bf16*)(ws_p + WS_W1B))
#define W2A ((bf16*)(ws_p + WS_W2A))
#define W2B ((bf16*)(ws_p + WS_W2B))
#define WIN ((bf16*)(ws_p + WS_WIN))
#define WOUT ((bf16*)(ws_p + WS_WOUT))
#define WGLU ((bf16*)(ws_p + WS_WGLU))
#define EST ((float2*)(ws_p + WS_E))
#define HIN ((float2*)(ws_p + WS_HIN))
#define XC ((float*)(ws_p + WS_XC))
#define XN ((bf16*)(ws_p + WS_XN))
#define SA ((bf16*)(ws_p + WS_XN))
#define ACT ((bf16*)(ws_p + WS_ACT))
#define OATT ((float*)(ws_p + WS_OATT))
#define GB ((bf16*)(ws_p + WS_G))
#define YFB ((float*)(ws_p + WS_OATT + 132 * MiB))
#define BIAS1 ((float*)(ws_p + WS_BIAS1))
#define BIAS2 ((float*)(ws_p + WS_BIAS2))
#define RSS1 ((float*)(ws_p + WS_RSS1))
#define RSS2 ((float*)(ws_p + WS_RSS2))
#define XN2 ((bf16*)(ws_p + WS_U))
#define UB ((bf16*)(ws_p + WS_U))
#define QB ((bf16*)(ws_p + WS_Q))
#define KB ((bf16*)(ws_p + WS_K))
#define VB ((bf16*)(ws_p + WS_V))
    (void)a;
    { volatile LAS unsigned* st0 = (volatile LAS unsigned*)(ldsl + 138240); if (tid < 4) st0[tid] = 0u; }
    __syncthreads();
    XcdBarrier xbar = xcd_barrier_post((unsigned*)(ws_p + WS_BAR), (volatile LAS unsigned*)(ldsl + 138240));
#define GSYNC() xcd_barrier(xbar)

    PH(0) {
        if (bx < 288) {
            LAS float* sl = (LAS float*)ldsl; LAS float* part = (LAS float*)(ldsl + 36864);
            for (int i = tid; i < 9 * DM; i += NTHR) { const float v = i < 8 * DM ? cvec[i] : c_ctx[i - 8 * DM]; sl[i] = v / (1.0f + __expf(-v)); }
            __syncthreads();
            for (int unit = bx; unit < 288; unit += G) {
                const int cl = tid & 31, kg = tid >> 5, k0 = kg * 64; const float* wp = w_mod + (size_t)k0 * NMODV + unit * 32 + cl;
                float acc[9];
#pragma unroll
                for (int i = 0; i < 9; ++i) acc[i] = 0.f;
                float wv[64];
#pragma unroll
                for (int kk = 0; kk < 64; ++kk) wv[kk] = wp[(size_t)kk * NMODV];
#pragma unroll
                for (int kk = 0; kk < 64; kk += 4) {
#pragma unroll
                    for (int i = 0; i < 9; ++i) { const f32x4 sv = *(const LAS f32x4*)(sl + i * DM + k0 + kk); acc[i] = fmaf(sv.x, wv[kk], fmaf(sv.y, wv[kk + 1], fmaf(sv.z, wv[kk + 2], fmaf(sv.w, wv[kk + 3], acc[i])))); }
                }
#pragma unroll
                for (int i = 0; i < 9; ++i) part[(kg * 9 + i) * 32 + cl] = acc[i];
                __syncthreads();
                if (tid < 288) { const int i = tid >> 5; float sum = 0.f;
#pragma unroll
                    for (int k = 0; k < 16; ++k) sum += part[(k * 9 + i) * 32 + cl];
                    MOD[i * NMODV + unit * 32 + cl] = sum + b_mod[unit * 32 + cl]; }
                __syncthreads();
            }
        }
        __syncthreads();
        {
            LAS float* scr = (LAS float*)(ldsl + wave * 16384);
            constexpr int I_1A = (DM / 64) * (2 * DFF / 32);
            for (int it = gw; it < I_1A; it += NGW) transpose_item(ffn_w_in, DM, 2 * DFF, W1A, 1, scr, it, lane);
        }
        const int gt = bx * NTHR + tid, NT_ALL = G * NTHR;
        for (int i = gt; i < 2 * 32 * 64; i += NT_ALL) {
            const int p = i & 63, dg = i >> 6;
            const double dt = dexp((double)ssm_log_dt[dg]), are = (double)ssm_a_re[i], aim = (double)ssm_a_im[i];
            double s1, c1, s2, c2; dsincos(dt * aim, s1, c1); dsincos(256.0 * dt * aim, s2, c2);
            const double mag = dexp(dt * are), mag2 = dexp(256.0 * dt * are);
            const double abr = mag * c1, abi = mag * s1;
            ABAR[i] = make_float2((float)abr, (float)abi); APOW[i] = make_float2((float)(mag2 * c2), (float)(mag2 * s2));
            const double zr = abr - 1.0, zi = abi, den = are * are + aim * aim;
            const double cr = (zr * are + zi * aim) / den, ci = (zi * are - zr * aim) / den;
            const float* bre = ssm_b_re + (size_t)i * 16; const float* bim = ssm_b_im + (size_t)i * 16;
            bf16* dre = BBT + ((size_t)(dg * 4 + (p >> 5)) * 32 + (p & 31)) * 16; bf16* dim = BBT + ((size_t)(dg * 4 + 2 + (p >> 5)) * 32 + (p & 31)) * 16;
#pragma unroll
            for (int h = 0; h < 16; ++h) { const double br = (double)bre[h], bi = (double)bim[h]; dre[h] = (bf16)f2bf((float)(cr * br - ci * bi)); dim[h] = (bf16)f2bf((float)(cr * bi + ci * br)); }
        }
        for (int i = gt; i < 2 * 32 * 16 * 64; i += NT_ALL) {
            const int p = i & 63, dgh = i >> 6;
            ((unsigned*)CM)[(size_t)dgh * 64 + p] = pk2(ssm_c_re[i], -ssm_c_im[i]);
        }
        for (int i = gt; i < 128 * 16; i += NT_ALL) {
            const int f = i & 15, pos = i >> 4;
            const double inv = dexp(-(double)f * (9.210340371976182736 / 16.0)); double s, c; dsincos((double)pos * inv, s, c);
            ROPE[2 * i] = (float)c; ROPE[2 * i + 1] = (float)s;
        }
        for (int i = gt; i < NROWS; i += NT_ALL) { RSS1[i] = 0.f; RSS2[i] = 0.f; }
        if (gt == 0) { float s0 = 0.f, s1 = 0.f; for (int d = 0; d < 64; ++d) { s0 += lam_q[d] * lam_k[d]; s1 += lam_q[64 + d] * lam_k[64 + d]; } MISC[0] = expf(s0) - expf(s1) + 0.2f; }
    }
    grid.sync();

#define NORM_PASS(SRC_LAT, SRC_CTX, NIDX, LATONLY) do { int tid_l = threadIdx.x; asm volatile("" : "+v"(tid_l)); const int lane_l = tid_l & 63, gw_l = vcu * NWAVES + __builtin_amdgcn_readfirstlane(tid_l >> 6); \
        for (int it = gw_l; it < NROWS / 16; it += NGW) { const int r0 = it * 16, pm = r0 >> 8, b = pm / TILES_B, jt = pm - b * TILES_B, rl = r0 & 255; \
            if ((LATONLY) && jt == 32) continue; \
            const float* src = jt < 32 ? (SRC_LAT) + ((size_t)b * SEQ + jt * 256 + rl) * DM : (SRC_CTX) + ((size_t)b * CTXL + rl) * DM; \
            const float* mv = MOD + (jt < 32 ? b : 8) * NMODV + 3 * (NIDX) * DM; \
            norm_rows16<0>(src, XN + (size_t)r0 * DM, nullptr, norm_g + (NIDX) * DM, mv, mv + DM, lane_l); } } while (0)

    PH(1) {
        if (bx < 240) {
            const bool isin = bx < 64; const int unit = isin ? bx : bx - 64, N = isin ? 2048 : 2 * DFF, soff = isin ? 3 * DM : 6 * DM;
            const float* W = isin ? w_in : ffn_w_in + (size_t)DM * 2 * DFF; float* BO = isin ? BIAS1 : BIAS2;
            LAS float* sl = (LAS float*)ldsl; LAS float* part = (LAS float*)(ldsl + 36864);
            for (int i = tid; i < 9 * DM; i += NTHR) sl[i] = MOD[(i >> 10) * NMODV + soff + (i & 1023)];
            __syncthreads();
            const int cl = tid & 31, kg = tid >> 5, k0 = kg * 64; const float* wp = W + (size_t)k0 * N + unit * 32 + cl;
            float acc[9];
#pragma unroll
            for (int i = 0; i < 9; ++i) acc[i] = 0.f;
            float wv[64];
#pragma unroll
            for (int kk = 0; kk < 64; ++kk) wv[kk] = wp[(size_t)kk * N];
#pragma unroll
            for (int kk = 0; kk < 64; kk += 4) {
#pragma unroll
                for (int i = 0; i < 9; ++i) { const f32x4 sv = *(const LAS f32x4*)(sl + i * DM + k0 + kk); acc[i] = fmaf(sv.x, wv[kk], fmaf(sv.y, wv[kk + 1], fmaf(sv.z, wv[kk + 2], fmaf(sv.w, wv[kk + 3], acc[i])))); }
            }
#pragma unroll
            for (int i = 0; i < 9; ++i) part[(kg * 9 + i) * 32 + cl] = acc[i];
            __syncthreads();
            if (tid < 288) { const int i = tid >> 5; float sum = 0.f;
#pragma unroll
                for (int k = 0; k < 16; ++k) sum += part[(k * 9 + i) * 32 + cl];
                const int src = unit * 32 + cl; int drow = src;
                if (isin) { if (src >= 512 && src < 1536) drow = unit * 32 + 2 * (cl & 15) + (cl >> 4); }
                else { const int up = src >= DFF ? 1 : 0, ff = src - up * DFF; drow = (ff >> 7) * 256 + up * 128 + (ff & 127); }
                BO[i * N + drow] = sum; }
            __syncthreads();
        }
        NORM_PASS(x_in, ctx, 0, false);
    }
    GSYNC();
    PH(2) { pg8::Gemm g{XN, W1A, NROWS, 2 * DFF, DM}; pg8::TileOrder S; S.init(264, 22, G, bx, 0); pg8::EpiSwiglu E{ACT, DFF, nullptr, nullptr};
      pg8::gemm_phase<pg8::EpiSwiglu, pg8::TileOrder, true, true>(ldsl, g, S, E);
      if (bx >= 176) {
          int tid_l = threadIdx.x; asm volatile("" : "+v"(tid_l)); const int lane_l = tid_l & 63, wave_l = __builtin_amdgcn_readfirstlane(tid_l >> 6);
          LAS float* scr = (LAS float*)(ldsl + wave_l * 16384);
          constexpr int I_1B = (DFF / 64) * (DM / 32);
          for (int it = (bx - 176) * NWAVES + wave_l; it < I_1B; it += (G - 176) * NWAVES) transpose_item(ffn_w_out, DFF, DM, W1B, 0, scr, it, lane_l);
      } }
    GSYNC();
    PH(3) { pg8::Gemm g{ACT, W1B, NROWS, DM, DFF}; pg8::TileOrder S; S.init(264, 4, G, bx, 0); pg8::EpiResidNorm E{x_in, ctx, out_p, XC, MOD, 2 * DM, 1, norm_g + DM, 4 * DM, XN, RSS1};
      pg8::gemm_phase<pg8::EpiResidNorm, pg8::TileOrder, true, true>(ldsl, g, S, E);
      if (bx >= 32) {
          int tid_l = threadIdx.x; asm volatile("" : "+v"(tid_l)); const int lane_l = tid_l & 63, wave_l = __builtin_amdgcn_readfirstlane(tid_l >> 6);
          LAS float* scr = (LAS float*)(ldsl + wave_l * 16384);
          constexpr int I_1A = (DM / 64) * (2 * DFF / 32), I_1B = (DFF / 64) * (DM / 32), I_OUT = (DM / 64) * (DM / 32), I_GLU = (512 / 64) * (512 / 32), I_IN = (DM / 64) * (2048 / 32);
          for (int it = (bx - 32) * NWAVES + wave_l; it < I_IN + I_1A + I_1B + I_OUT + I_GLU; it += (G - 32) * NWAVES) {
              int r = it;
              if (r < I_IN) { transpose_item(w_in, DM, 2048, WIN, 2, scr, r, lane_l); continue; } r -= I_IN;
              if (r < I_1A) { transpose_item(ffn_w_in + (size_t)DM * 2 * DFF, DM, 2 * DFF, W2A, 1, scr, r, lane_l); continue; } r -= I_1A;
              if (r < I_1B) { transpose_item(ffn_w_out + (size_t)DFF * DM, DFF, DM, W2B, 0, scr, r, lane_l); continue; } r -= I_1B;
              if (r < I_OUT) { transpose_item(w_out, DM, DM, WOUT, 0, scr, r, lane_l); continue; } r -= I_OUT;
              transpose_item(w_glu, 512, 512, WGLU, 0, scr, r, lane_l);
          }
      } }
    GSYNC();
    PH(5) { pg8::Gemm g{XN, WIN, NROWS, 2048, DM}; pg8::TileOrder S; S.init(264, 8, G, bx, 0); pg8::EpiInproj E{UB, QB, KB, VB, ROPE, RSS1, BIAS1};
      pg8::gemm_phase<pg8::EpiInproj, pg8::TileOrder, true, true>(ldsl, g, S, E); }
    GSYNC();
    PH(6) for (int un = vcu; un < 8 * 33 * 4; un += G) { const int gq = un & 3, bc = un >> 2, b = bc / 33, c = bc - b * 33;
        s5_unit_a(ldsl, b, c, gq, UB, ABAR, BBT, EST); }
    GSYNC();
    PH(7) if (bx < 64) {
        int tid_c = threadIdx.x; asm volatile("" : "+v"(tid_c));
        const int i = bx * NTHR + tid_c;
        const int p = i & 63, dir = (i >> 6) & 1, g = (i >> 7) & 31, b = i >> 12;
        const float2 ap = APOW[(dir * 32 + g) * 64 + p];
#define SIDX(cc) (((((size_t)b * 33 + (cc)) * 32 + g) * 2 + dir) * 64 + p)
        float2 h = EST[SIDX(32)];
        if (dir == 0) { HIN[SIDX(0)] = h; for (int c = 0; c < 31; ++c) { const float2 e = EST[SIDX(c)]; const float nr = fmaf(ap.x, h.x, fmaf(-ap.y, h.y, e.x)), ni = fmaf(ap.x, h.y, fmaf(ap.y, h.x, e.y)); h = make_float2(nr, ni); HIN[SIDX(c + 1)] = h; } }
        else { HIN[SIDX(31)] = h; for (int c = 31; c > 0; --c) { const float2 e = EST[SIDX(c)]; const float nr = fmaf(ap.x, h.x, fmaf(-ap.y, h.y, e.x)), ni = fmaf(ap.x, h.y, fmaf(ap.y, h.x, e.y)); h = make_float2(nr, ni); HIN[SIDX(c - 1)] = h; } }
#undef SIDX
    }
    PH(8) {
        const float lam = MISC[0];
        unsigned redo_mask = 0u;
        {
        int k_ = 0;
        for (int un = vcu; un < 8 * 4 * 32; un += G, ++k_) {
            const int qb = un & 31, bh = un >> 5, b = bh >> 2, h = bh & 3;
            const size_t rb = (size_t)b * ROWS_B, rq = rb + (size_t)qb * 256;
            const attn::bf16_t* q0 = QB + rq * 512 + h * 128; const attn::bf16_t* k0 = KB + rb * 512 + h * 128; const attn::bf16_t* v0 = VB + rb * 512 + h * 128;
            float* st = OATT + rq * 512 + h * 128; attn::bf16_t* so = SA + rq * 1024 + 512 + h * 128;
            bool redo = attn::body<0, false>(q0, k0, v0, st, nullptr, lam, subln_g, ROWS_B, (char*)lds);
            if (!redo) redo = attn::body<1, false>(q0 + 64, k0 + 64, v0, st, so, lam, subln_g, ROWS_B, (char*)lds);
            if (redo) redo_mask |= 1u << k_;
        }
        }
        if (redo_mask) {
            int k_ = 0;
            for (int un = vcu; un < 8 * 4 * 32; un += G, ++k_) {
                if (!((redo_mask >> k_) & 1u)) continue;
                const int qb = un & 31, bh = un >> 5, b = bh >> 2, h = bh & 3;
                const size_t rb = (size_t)b * ROWS_B, rq = rb + (size_t)qb * 256;
                const attn::bf16_t* q0 = QB + rq * 512 + h * 128; const attn::bf16_t* k0 = KB + rb * 512 + h * 128; const attn::bf16_t* v0 = VB + rb * 512 + h * 128;
                float* st = OATT + rq * 512 + h * 128; attn::bf16_t* so = SA + rq * 1024 + 512 + h * 128;
                (void)attn::body<0, true>(q0, k0, v0, st, nullptr, lam, subln_g, ROWS_B, (char*)lds);
                (void)attn::body<1, true>(q0 + 64, k0 + 64, v0, st, so, lam, subln_g, ROWS_B, (char*)lds);
            }
        }
    }
    GSYNC();
    PH(9) for (int un = vcu; un < 8 * 32 * 4; un += G) { const int gq = un & 3, bc = un >> 2, b = bc >> 5, c = bc & 31;
        s5_unit<true>(ldsl, b, c, gq, UB, ABAR, BBT, CM, HIN, EST, ssm_d, GB, YFB); }
    GSYNC();
    PH(10) { pg8::Gemm g{GB, WGLU, NROWS, 512, 512}; pg8::TileOrder S; S.init(256, 2, G, bx, 1); pg8::EpiGlu E{GB, b_glu, SA};
      pg8::gemm_phase<pg8::EpiGlu, pg8::TileOrder, true, true>(ldsl, g, S, E); }
    GSYNC();
    PH(12) { pg8::Gemm g{SA, WOUT, NROWS, DM, DM}; pg8::TileOrder S; S.init(256, 4, G, bx, 1); pg8::EpiResidNorm E{out_p, XC, out_p, XC, MOD, 5 * DM, 0, norm_g + 2 * DM, 7 * DM, XN2, RSS2};
      pg8::gemm_phase<pg8::EpiResidNorm, pg8::TileOrder, true, true>(ldsl, g, S, E); }
    GSYNC();
    PH(14) { pg8::Gemm g{XN2, W2A, NROWS, 2 * DFF, DM}; pg8::TileOrder S; S.init(256, 22, G, bx, 1); pg8::EpiSwiglu E{ACT, DFF, RSS2, BIAS2};
      pg8::gemm_phase<pg8::EpiSwiglu, pg8::TileOrder, true, true>(ldsl, g, S, E); }
    GSYNC();
    PH(15) { pg8::Gemm g{ACT, W2B, NROWS, DM, DFF}; pg8::TileOrder S; S.init(256, 4, G, bx, 1); pg8::EpiResid E{out_p, XC, out_p, XC, MOD, 8 * DM, 0.5f};
      pg8::gemm_phase<pg8::EpiResid, pg8::TileOrder, true, true>(ldsl, g, S, E); }
    GSYNC();
    PH(16) { int tid_l = threadIdx.x; asm volatile("" : "+v"(tid_l)); const int lane_l = tid_l & 63, gw_l = vcu * NWAVES + __builtin_amdgcn_readfirstlane(tid_l >> 6);
        for (int it = gw_l; it < NB * SEQ / 16; it += NGW) norm_rows16<1>(out_p + (size_t)it * 16 * DM, nullptr, out_p + (size_t)it * 16 * DM, final_g, nullptr, nullptr, lane_l); }
#undef NORM_PASS
}

extern "C" void kernel_launch(void* const* d_in, const int* in_sizes, int n_in, void* d_out, int out_size, void* d_ws, size_t ws_size, hipStream_t stream) {
    static int grid = 0;
    if (grid == 0) {
        if (n_in != 25 || in_sizes[0] != NB * SEQ * DM || out_size != NB * SEQ * DM || ws_size < WS_END) {
            fprintf(stderr, "kernel_launch: shape mismatch (n_in %d, in0 %d, out %d, ws %zu, need %zu); nothing launched\n", n_in, n_in > 0 ? in_sizes[0] : -1, out_size, ws_size, (size_t)WS_END); grid = -1; return; }
        int dev = 0, cus = 0, per_cu = 0;
        if (hipGetDevice(&dev) != hipSuccess || hipDeviceGetAttribute(&cus, hipDeviceAttributeMultiprocessorCount, dev) != hipSuccess) { grid = -1; return; }
        if (hipFuncSetAttribute((const void*)hymba_fwd, hipFuncAttributeMaxDynamicSharedMemorySize, LDS_BYTES) != hipSuccess) { fprintf(stderr, "kernel_launch: hipFuncSetAttribute failed\n"); grid = -1; return; }
        if (hipOccupancyMaxActiveBlocksPerMultiprocessor(&per_cu, (const void*)hymba_fwd, NTHR, LDS_BYTES) != hipSuccess || per_cu < 1) { fprintf(stderr, "kernel_launch: occupancy query says %d\n", per_cu); per_cu = 1; }
        (void)hipGetLastError();
        grid = cus * (per_cu > 1 ? 1 : per_cu);
        if (grid != 256) fprintf(stderr, "kernel_launch: grid %d (expected 256)\n", grid);
    }
    if (grid < 0) return;
    (void)hipMemsetAsync((char*)d_ws + WS_BAR, 0, BAR_ZERO_BYTES, stream);
    Args a{};
    for (int i = 0; i < 25; ++i) a.in[i] = (const float*)d_in[i];
    a.out = (float*)d_out; a.ws = (unsigned char*)d_ws;
    void* args[] = {&a};
    const hipError_t e = hipLaunchCooperativeKernel((const void*)hymba_fwd, dim3(grid), dim3(NTHR), args, LDS_BYTES, stream);
    if (e != hipSuccess) fprintf(stderr, "kernel_launch: cooperative launch failed: %s (grid %d)\n", hipGetErrorString(e), grid);
}
```

```cpp
#include <hip/hip_runtime.h>
#include <hip/hip_cooperative_groups.h>
#include <cstdio>
#include <cstdint>
namespace cg = cooperative_groups;
namespace pg8 {
#define PG8_LAS __attribute__((address_space(3)))
typedef unsigned short bf16_t;
typedef short bf16x8 __attribute__((ext_vector_type(8)));
typedef float f32x4 __attribute__((ext_vector_type(4)));
typedef unsigned u32x4 __attribute__((ext_vector_type(4)));
constexpr int BM = 256, BK = 64, HALF = 128, HTB = HALF * BK * 2  , STAGE_BYTES = 8 * HTB, NXCD = 8, WGM = 8;

__host__ __device__ __forceinline__ int lds_byte(int r, int c) { const int st = (r >> 4) * 2 + (c >> 5), rr = r & 15, cc = c & 31, ob = rr * 64 + cc * 2; return st * 1024 + (ob ^ (((ob >> 9) & 1) << 5)); }
__host__ __device__ __forceinline__ void stage_rc(int b, int& R, int& C) { const int st = b / 1024, sb = b % 1024, swz = sb ^ (((sb >> 9) & 1) << 5); R = (st >> 1) * 16 + swz / 64; C = (st & 1) * 32 + (swz % 64) / 2; }
__host__ __device__ __forceinline__ int perm32(int rho) { const int n = rho >> 4, i = rho & 15; return 8 * (i >> 2) + 4 * n + (i & 3); }

struct Unit { int pm, pn; };
struct Gemm { const bf16_t* A; const bf16_t* Bt; int M, N, K; };

__device__ __forceinline__ unsigned cvt_pk_bf16(float lo, float hi) { unsigned r; asm volatile("v_cvt_pk_bf16_f32 %0, %1, %2" : "=v"(r) : "v"(lo), "v"(hi)); return r; }
typedef float f32x2 __attribute__((ext_vector_type(2)));
typedef unsigned u32x2 __attribute__((ext_vector_type(2)));
constexpr int ROWS_B = 8448, TILES_B = 33, NROWS = 8 * ROWS_B;

struct TileOrder {
    int nM, nN, nwg, G, c, lat;
    __device__ __forceinline__ void init(int nM_, int nN_, int G_, int c_, int lat_) { nM = nM_; nN = nN_; nwg = nM_ * nN_; G = G_; c = c_; lat = lat_; }
    __device__ __forceinline__ bool next(int i, Unit& u) const {
        const long L = (long)i * G + c; if (L >= nwg) return false;
        int wgid = (int)L; { const int q = nwg / NXCD, r = nwg % NXCD, xcd = wgid % NXCD, off = wgid / NXCD; wgid = (xcd < r ? xcd * (q + 1) : r * (q + 1) + (xcd - r) * q) + off; }
        const int nig = WGM * nN, gid = wgid / nig, fm = gid * WGM, gsz = (nM - fm) < WGM ? (nM - fm) : WGM;
        const int lm = fm + ((wgid % nig) % gsz); u.pn = (wgid % nig) / gsz; u.pm = lat ? (lm >> 5) * TILES_B + (lm & 31) : lm; return true;
    }
    __device__ __forceinline__ void a_ready(const Unit&) const {}
    __device__ __forceinline__ void done(const Unit&) const {}
};

__device__ __forceinline__ float fast_sigmoid(float z) { return __builtin_amdgcn_rcpf(1.0f + __builtin_amdgcn_exp2f(-1.4426950408889634f * z)); }
__device__ __forceinline__ float bf_lo(unsigned w) { return __uint_as_float(w << 16); }
__device__ __forceinline__ float bf_hi(unsigned w) { return __uint_as_float(w & 0xffff0000u); }

struct EpiSwiglu {
    static constexpr bool PERM = true, AFTER_DRAIN = false;
    bf16_t* O; int ldc; const float* rss; const float* bias;
    __device__ __forceinline__ void operator()(const f32x4 (&acc)[2][2][4][2], const Unit& u, int wr, int wc, int fr, int fq) const {
        const int row0 = u.pm * BM + wr * 64 + fr, col0 = u.pn * HALF + wc * 32 + 8 * fq;
        f32x4 bv[2][2];
#pragma unroll
        for (int bj = 0; bj < 2; ++bj)
#pragma unroll
            for (int n = 0; n < 2; ++n) bv[bj][n] = rss ? *(const f32x4*)(bias + (u.pm / TILES_B) * 5632 + u.pn * BM + bj * HALF + wc * 32 + 8 * fq + 4 * n) : (f32x4){0.f, 0.f, 0.f, 0.f};
#pragma unroll
        for (int ai = 0; ai < 2; ++ai)
#pragma unroll
            for (int m = 0; m < 4; ++m) {
                bf16_t* rowp = O + (size_t)(row0 + ai * HALF + m * 16) * ldc + col0;
                float v[8];
                const float rstd = rss ? 1.0f / sqrtf(rss[row0 + ai * HALF + m * 16] * (1.0f / 1024.0f) + 1e-6f) : 1.0f;
#pragma unroll
                for (int n = 0; n < 2; ++n)
#pragma unroll
                    for (int e = 0; e < 4; ++e) { const float gt = acc[ai][0][m][n][e] * rstd + bv[0][n][e], up = acc[ai][1][m][n][e] * rstd + bv[1][n][e]; v[4 * n + e] = gt * fast_sigmoid(gt) * up; }
                u32x4 w; w.x = cvt_pk_bf16(v[0], v[1]); w.y = cvt_pk_bf16(v[2], v[3]); w.z = cvt_pk_bf16(v[4], v[5]); w.w = cvt_pk_bf16(v[6], v[7]);
                *(u32x4*)rowp = w;
            }
    }
};

struct EpiResid {
    static constexpr bool PERM = true, AFTER_DRAIN = false;
    const float* res_lat; const float* res_ctx; float* out_lat; float* out_ctx; const float* mod; int modoff; float scale;
    __device__ __forceinline__ void operator()(const f32x4 (&acc)[2][2][4][2], const Unit& u, int wr, int wc, int fr, int fq) const {
        const int b = u.pm / TILES_B, jt = u.pm - b * TILES_B;
        const float* rb; float* ob; const float* gv;
        if (jt < 32) { const size_t o = ((size_t)b * 8192 + (size_t)jt * 256) * 1024; rb = res_lat + o; ob = out_lat + o; gv = mod + b * 9216 + modoff; }
        else { const size_t o = (size_t)b * 256 * 1024; rb = res_ctx + o; ob = out_ctx + o; gv = mod + 8 * 9216 + modoff; }
        const int rl = wr * 64 + fr, col0 = u.pn * BM + wc * 32 + 8 * fq;
        f32x4 g[2][2];
#pragma unroll
        for (int bj = 0; bj < 2; ++bj)
#pragma unroll
            for (int n = 0; n < 2; ++n) g[bj][n] = *(const f32x4*)(gv + col0 + bj * HALF + 4 * n) * scale;
#pragma unroll
        for (int ai = 0; ai < 2; ++ai)
#pragma unroll
            for (int m = 0; m < 4; ++m) { const size_t ro = (size_t)(rl + ai * HALF + m * 16) * 1024 + col0;
#pragma unroll
                for (int bj = 0; bj < 2; ++bj)
#pragma unroll
                    for (int n = 0; n < 2; ++n) { const size_t p = ro + bj * HALF + 4 * n; const f32x4 x = *(const f32x4*)(rb + p); *(f32x4*)(ob + p) = x + g[bj][n] * acc[ai][bj][m][n]; } }
    }
};

struct EpiResidNorm {
    static constexpr bool PERM = true, AFTER_DRAIN = false;
    const float* res_lat; const float* res_ctx; float* out_lat; float* out_ctx; const float* mod; int gateoff; int half_gate; const float* ng; int scaleoff; bf16_t* XNo; float* rss;
    __device__ __forceinline__ void operator()(const f32x4 (&acc)[2][2][4][2], const Unit& u, int wr, int wc, int fr, int fq) const {
        const int b = u.pm / TILES_B, jt = u.pm - b * TILES_B;
        const float* rb; float* ob; const float* mv;
        if (jt < 32) { const size_t o = ((size_t)b * 8192 + (size_t)jt * 256) * 1024; rb = res_lat + o; ob = out_lat + o; mv = mod + b * 9216; }
        else { const size_t o = (size_t)b * 256 * 1024; rb = res_ctx + o; ob = out_ctx + o; mv = mod + 8 * 9216; }
        const int rl = wr * 64 + fr, col0 = u.pn * BM + wc * 32 + 8 * fq;
        const float scale = half_gate ? 0.5f : 1.0f;
        float q[2][4];
#pragma unroll
        for (int ai = 0; ai < 2; ++ai)
#pragma unroll
            for (int m = 0; m < 4; ++m) q[ai][m] = 0.f;
#pragma unroll
        for (int bj = 0; bj < 2; ++bj) {
            const int c = col0 + bj * HALF;
            const f32x4 g0 = *(const f32x4*)(mv + gateoff + c) * scale, g1 = *(const f32x4*)(mv + gateoff + c + 4) * scale;
            const f32x4 gs0 = *(const f32x4*)(ng + c) * (*(const f32x4*)(mv + scaleoff + c) + 1.0f), gs1 = *(const f32x4*)(ng + c + 4) * (*(const f32x4*)(mv + scaleoff + c + 4) + 1.0f);
#pragma unroll
            for (int ai = 0; ai < 2; ++ai)
#pragma unroll
                for (int m = 0; m < 4; ++m) { const int rr = rl + ai * HALF + m * 16; const size_t p = (size_t)rr * 1024 + c; const size_t prow = (size_t)u.pm * BM + rr;
                    const f32x4 y0 = *(const f32x4*)(rb + p) + g0 * acc[ai][bj][m][0], y1 = *(const f32x4*)(rb + p + 4) + g1 * acc[ai][bj][m][1];
                    *(f32x4*)(ob + p) = y0; *(f32x4*)(ob + p + 4) = y1;
                    q[ai][m] += (y0[0] * y0[0] + y0[1] * y0[1]) + (y0[2] * y0[2] + y0[3] * y0[3]) + (y1[0] * y1[0] + y1[1] * y1[1]) + (y1[2] * y1[2] + y1[3] * y1[3]);
                    const f32x4 z0 = y0 * gs0, z1 = y1 * gs1;
                    u32x4 w; w.x = cvt_pk_bf16(z0[0], z0[1]); w.y = cvt_pk_bf16(z0[2], z0[3]); w.z = cvt_pk_bf16(z1[0], z1[1]); w.w = cvt_pk_bf16(z1[2], z1[3]);
                    *(u32x4*)(XNo + prow * 1024 + c) = w;
                    if (m & 1) asm volatile("" ::: "memory"); }
        }
#pragma unroll
        for (int ai = 0; ai < 2; ++ai)
#pragma unroll
            for (int m = 0; m < 4; ++m) { float t = q[ai][m]; t += __shfl_xor(t, 16); t += __shfl_xor(t, 32);
                if (fq == 0) __hip_atomic_fetch_add((__attribute__((address_space(1))) float*)(rss + (size_t)u.pm * BM + rl + ai * HALF + m * 16), t, __ATOMIC_RELAXED, __HIP_MEMORY_SCOPE_AGENT); }
    }
};

struct EpiInproj {
    static constexpr bool PERM = true, AFTER_DRAIN = false;
    bf16_t* U; bf16_t* Q; bf16_t* K; bf16_t* V; const float* rope; const float* rss; const float* bias;
    __device__ __forceinline__ void operator()(const f32x4 (&acc)[2][2][4][2], const Unit& u, int wr, int wc, int fr, int fq) const {
        const int sec = u.pn >> 1, jt = u.pm % TILES_B;
        bf16_t* base = sec == 0 ? U : sec == 1 ? Q : sec == 2 ? K : V;
        const bool dorope = (sec == 1 || sec == 2) && jt < 32;
        const float qs = sec == 1 ? 0.125f * 1.4426950408889634f : 1.0f;
        const int col0 = (u.pn & 1) * BM + wc * 32 + 8 * fq, axis = wc & 1;
        const float* bp = bias + (jt < 32 ? u.pm / TILES_B : 8) * 2048 + u.pn * BM + wc * 32 + 8 * fq;
        f32x4 bv[2][2];
#pragma unroll
        for (int bj = 0; bj < 2; ++bj)
#pragma unroll
            for (int n = 0; n < 2; ++n) bv[bj][n] = *(const f32x4*)(bp + bj * HALF + 4 * n);
#pragma unroll
        for (int ai = 0; ai < 2; ++ai)
#pragma unroll
            for (int m = 0; m < 4; ++m) {
                const int rowl = wr * 64 + fr + ai * HALF + m * 16;
                bf16_t* rowp = base + (size_t)(u.pm * BM + rowl) * 512 + col0;
                const float rstd = 1.0f / sqrtf(rss[u.pm * BM + rowl] * (1.0f / 1024.0f) + 1e-6f);
                f32x4 cs0 = {1.f, 0.f, 1.f, 0.f}, cs1 = {1.f, 0.f, 1.f, 0.f};
                if (dorope) { const int t = jt * 256 + rowl, pos = axis ? (t & 63) : (t >> 6); const float* rp = rope + (pos * 16 + 4 * fq) * 2; cs0 = *(const f32x4*)rp; cs1 = *(const f32x4*)(rp + 4); }
#pragma unroll
                for (int bj = 0; bj < 2; ++bj) {
                    const f32x4 a0 = acc[ai][bj][m][0] * rstd + bv[bj][0], a1 = acc[ai][bj][m][1] * rstd + bv[bj][1];
                    float o[8];
                    o[0] = a0[0] * cs0[0] - a0[1] * cs0[1]; o[1] = a0[1] * cs0[0] + a0[0] * cs0[1];
                    o[2] = a0[2] * cs0[2] - a0[3] * cs0[3]; o[3] = a0[3] * cs0[2] + a0[2] * cs0[3];
                    o[4] = a1[0] * cs1[0] - a1[1] * cs1[1]; o[5] = a1[1] * cs1[0] + a1[0] * cs1[1];
                    o[6] = a1[2] * cs1[2] - a1[3] * cs1[3]; o[7] = a1[3] * cs1[2] + a1[2] * cs1[3];
                    u32x4 w; w.x = cvt_pk_bf16(o[0] * qs, o[1] * qs); w.y = cvt_pk_bf16(o[2] * qs, o[3] * qs); w.z = cvt_pk_bf16(o[4] * qs, o[5] * qs); w.w = cvt_pk_bf16(o[6] * qs, o[7] * qs);
                    *(u32x4*)(rowp + bj * HALF) = w;
                }
            }
    }
};

struct EpiGlu {
    static constexpr bool PERM = true, AFTER_DRAIN = false;
    const bf16_t* Gb; const float* bglu; bf16_t* SA;
    __device__ __forceinline__ void operator()(const f32x4 (&acc)[2][2][4][2], const Unit& u, int wr, int wc, int fr, int fq) const {
        const int row0 = u.pm * BM + wr * 64 + fr, col0 = u.pn * BM + wc * 32 + 8 * fq;
        f32x4 bv[2][2];
#pragma unroll
        for (int bj = 0; bj < 2; ++bj)
#pragma unroll
            for (int n = 0; n < 2; ++n) bv[bj][n] = *(const f32x4*)(bglu + col0 + bj * HALF + 4 * n);
#pragma unroll
        for (int ai = 0; ai < 2; ++ai)
#pragma unroll
            for (int m = 0; m < 4; ++m) { const size_t row = (size_t)(row0 + ai * HALF + m * 16);
#pragma unroll
                for (int bj = 0; bj < 2; ++bj) {
                    const u32x4 gw = *(const u32x4*)(Gb + row * 512 + col0 + bj * HALF);
                    const f32x4 z0 = acc[ai][bj][m][0] + bv[bj][0], z1 = acc[ai][bj][m][1] + bv[bj][1];
                    u32x4 w;
                    w.x = cvt_pk_bf16(bf_lo(gw.x) * fast_sigmoid(z0[0]), bf_hi(gw.x) * fast_sigmoid(z0[1]));
                    w.y = cvt_pk_bf16(bf_lo(gw.y) * fast_sigmoid(z0[2]), bf_hi(gw.y) * fast_sigmoid(z0[3]));
                    w.z = cvt_pk_bf16(bf_lo(gw.z) * fast_sigmoid(z1[0]), bf_hi(gw.z) * fast_sigmoid(z1[1]));
                    w.w = cvt_pk_bf16(bf_lo(gw.w) * fast_sigmoid(z1[2]), bf_hi(gw.w) * fast_sigmoid(z1[3]));
                    *(u32x4*)(SA + row * 1024 + col0 + bj * HALF) = w;
                } }
    }
};

template <class Epi, class Sched, bool ALIGN_EPI = false, bool SP2 = false>
__device__ __forceinline__ void gemm_phase(PG8_LAS unsigned char* lds, const Gemm g, const Sched& S, const Epi& E) {
    int tid_ = threadIdx.x; asm volatile("" : "+v"(tid_));
    const int tid = tid_, wid = __builtin_amdgcn_readfirstlane(tid >> 6), lane = tid & 63, wr = wid >> 2, wc = wid & 3, fr = lane & 15, fq = lane >> 4;
    const int K = g.K, nt = K / BK;
    unsigned voffA[2], voffB[2];
#pragma unroll
    for (int i = 0; i < 2; ++i) { int R, C; stage_rc(tid * 16 + i * 8192, R, C); const int Rb = Epi::PERM ? ((R & ~31) + perm32(R & 31)) : R;
        voffA[i] = (unsigned)(R * K + C) * 2u; voffB[i] = (unsigned)(Rb * K + C) * 2u; }
    const size_t kstep = (size_t)(BK * 2);
    const size_t hstep = (size_t)HALF * K * 2;
    const size_t tstep = 2 * hstep;
    const unsigned ldsw = (unsigned)wid * 1024u;
    const int aoff = lds_byte(wr * 64 + fr, fq * 8), boff = lds_byte(wc * 32 + fr, fq * 8);
#define PG8_SA(b, h) (((b) * 2 + (h)) * HTB)
#define PG8_SB(b, h) ((4 + (b) * 2 + (h)) * HTB)
#define PG8_STAGE(bufoff, gbase, voff) do { _Pragma("unroll") for (int _i = 0; _i < 2; ++_i) \
        __builtin_amdgcn_global_load_lds((const unsigned*)((const char*)(gbase) + (voff)[_i]), (PG8_LAS unsigned*)(lds + (bufoff) + ldsw + _i * 8192), 16, 0, 0); } while (0)
#define PG8_LDA(dst, b, h) do { _Pragma("unroll") for (int m = 0; m < 4; ++m) _Pragma("unroll") for (int k = 0; k < 2; ++k) dst[m][k] = *(const PG8_LAS bf16x8*)(lds + PG8_SA(b, h) + aoff + m * 2048 + k * 1024); } while (0)
#define PG8_LDB(dst, b, h) do { _Pragma("unroll") for (int n = 0; n < 2; ++n) _Pragma("unroll") for (int k = 0; k < 2; ++k) dst[n][k] = *(const PG8_LAS bf16x8*)(lds + PG8_SB(b, h) + boff + n * 2048 + k * 1024); } while (0)
#define PG8_MMA(ai, bj, At, Bt) do { __builtin_amdgcn_s_setprio(1); _Pragma("unroll") for (int m = 0; m < 4; ++m) _Pragma("unroll") for (int n = 0; n < 2; ++n) _Pragma("unroll") for (int k = 0; k < 2; ++k) \
        acc[ai][bj][m][n] = __builtin_amdgcn_mfma_f32_16x16x32_bf16(Bt[n][k], At[m][k], acc[ai][bj][m][n], 0, 0, 0); __builtin_amdgcn_s_setprio(0); } while (0)
#define PG8_WAIT_V(n) asm volatile("s_waitcnt vmcnt(" #n ")" ::: "memory")
#define PG8_WAIT_L(n) asm volatile("s_waitcnt lgkmcnt(" #n ")" ::: "memory")
#define PG8_BAR __builtin_amdgcn_s_barrier()
#define PG8_SCHED __builtin_amdgcn_sched_barrier(0)
    Unit cur, nxt; int ui = 0;
    if (!S.next(0, cur)) return;
    f32x4 acc[2][2][4][2];
#pragma unroll
    for (int a = 0; a < 2; ++a)
#pragma unroll
        for (int b = 0; b < 2; ++b)
#pragma unroll
            for (int m = 0; m < 4; ++m)
#pragma unroll
                for (int n = 0; n < 2; ++n) acc[a][b][m][n] = (f32x4){0.f, 0.f, 0.f, 0.f};
    bf16x8 At[4][2], B0[2][2], B1[2][2];
    const char* cA = (const char*)g.A + (size_t)cur.pm * tstep; const char* cB = (const char*)g.Bt + (size_t)cur.pn * tstep;
    S.a_ready(cur);
    if constexpr (SP2) {
        PG8_STAGE(PG8_SB(0, 0), cB, voffB); PG8_STAGE(PG8_SB(0, 1), cB + hstep, voffB); PG8_STAGE(PG8_SA(0, 0), cA, voffA); PG8_STAGE(PG8_SA(0, 1), cA + hstep, voffA);
        if (wr == 1) PG8_BAR;
        PG8_WAIT_V(2); PG8_BAR;
        PG8_STAGE(PG8_SB(1, 0), cB + kstep, voffB); PG8_STAGE(PG8_SA(1, 0), cA + kstep, voffA); PG8_STAGE(PG8_SB(1, 1), cB + hstep + kstep, voffB);
        PG8_WAIT_V(6); PG8_BAR;
    } else {
        PG8_STAGE(PG8_SB(0, 0), cB, voffB); PG8_STAGE(PG8_SA(0, 0), cA, voffA); PG8_STAGE(PG8_SB(0, 1), cB + hstep, voffB); PG8_STAGE(PG8_SA(0, 1), cA + hstep, voffA);
        if (wr == 1) PG8_BAR;
        PG8_WAIT_V(4); PG8_BAR;
        PG8_STAGE(PG8_SB(1, 0), cB + kstep, voffB); PG8_STAGE(PG8_SA(1, 0), cA + kstep, voffA); PG8_STAGE(PG8_SB(1, 1), cB + hstep + kstep, voffB);
        PG8_WAIT_V(6); PG8_BAR;
    }
    for (;;) {
        const bool has_next = S.next(ui + 1, nxt);
        const char* nA = has_next ? (const char*)g.A + (size_t)nxt.pm * tstep : cA; const char* nB = has_next ? (const char*)g.Bt + (size_t)nxt.pn * tstep : cB;
        for (int t = 0; t < nt; t += 2) {
            const bool last = (t == nt - 2);
            const char* a1 = cA + (size_t)(t + 1) * kstep;
            const char* a2 = last ? nA : cA + (size_t)(t + 2) * kstep; const char* b2 = last ? nB : cB + (size_t)(t + 2) * kstep;
            const char* a3 = a2 + kstep; const char* b3 = b2 + kstep;
            if (last && has_next) S.a_ready(nxt);
            if constexpr (SP2) {
            PG8_LDB(B0, 0, 0); PG8_LDB(B1, 0, 1); PG8_SCHED; PG8_LDA(At, 0, 0); PG8_STAGE(PG8_SA(1, 1), a1 + hstep, voffA);
            PG8_WAIT_V(8); PG8_WAIT_L(0); PG8_BAR; PG8_MMA(0, 0, At, B0); PG8_MMA(0, 1, At, B1); PG8_BAR; PG8_SCHED;
            PG8_LDA(At, 0, 1); PG8_STAGE(PG8_SB(0, 0), b2, voffB); PG8_STAGE(PG8_SB(0, 1), b2 + hstep, voffB); PG8_STAGE(PG8_SA(0, 0), a2, voffA);
            PG8_WAIT_V(8); PG8_WAIT_L(0); PG8_BAR; PG8_MMA(1, 0, At, B0); PG8_MMA(1, 1, At, B1); PG8_BAR; PG8_SCHED;
            PG8_LDB(B0, 1, 0); PG8_LDB(B1, 1, 1); PG8_SCHED; PG8_LDA(At, 1, 0); PG8_STAGE(PG8_SA(0, 1), a2 + hstep, voffA);
            PG8_WAIT_V(8); PG8_WAIT_L(0); PG8_BAR; PG8_MMA(0, 0, At, B0); PG8_MMA(0, 1, At, B1); PG8_BAR; PG8_SCHED;
            PG8_LDA(At, 1, 1); PG8_STAGE(PG8_SB(1, 0), b3, voffB); PG8_STAGE(PG8_SB(1, 1), b3 + hstep, voffB); PG8_STAGE(PG8_SA(1, 0), a3, voffA);
            PG8_WAIT_V(8); PG8_WAIT_L(0); PG8_BAR; PG8_MMA(1, 0, At, B0); PG8_MMA(1, 1, At, B1); PG8_BAR; PG8_SCHED;
            } else {
            PG8_LDB(B0, 0, 0); PG8_SCHED; PG8_LDA(At, 0, 0); PG8_STAGE(PG8_SA(1, 1), a1 + hstep, voffA);
            PG8_WAIT_L(8); PG8_BAR; PG8_WAIT_L(0); PG8_MMA(0, 0, At, B0); PG8_BAR; PG8_SCHED;
            PG8_LDB(B1, 0, 1); PG8_STAGE(PG8_SB(0, 0), b2, voffB);
            PG8_BAR; PG8_WAIT_L(0); PG8_MMA(0, 1, At, B1); PG8_BAR;
            PG8_LDA(At, 0, 1); PG8_STAGE(PG8_SA(0, 0), a2, voffA);
            PG8_BAR; PG8_WAIT_L(0); PG8_MMA(1, 0, At, B0); PG8_BAR; PG8_SCHED;
            PG8_STAGE(PG8_SB(0, 1), b2 + hstep, voffB);
            PG8_WAIT_V(6); PG8_BAR; PG8_MMA(1, 1, At, B1); PG8_BAR;
            PG8_LDB(B0, 1, 0); PG8_SCHED; PG8_LDA(At, 1, 0); PG8_STAGE(PG8_SA(0, 1), a2 + hstep, voffA);
            PG8_WAIT_L(8); PG8_BAR; PG8_WAIT_L(0); PG8_MMA(0, 0, At, B0); PG8_BAR; PG8_SCHED;
            PG8_LDB(B1, 1, 1); PG8_STAGE(PG8_SB(1, 0), b3, voffB);
            PG8_BAR; PG8_WAIT_L(0); PG8_MMA(0, 1, At, B1); PG8_BAR;
            PG8_LDA(At, 1, 1); PG8_STAGE(PG8_SA(1, 0), a3, voffA);
            PG8_BAR; PG8_WAIT_L(0); PG8_MMA(1, 0, At, B0); PG8_BAR; PG8_SCHED;
            PG8_STAGE(PG8_SB(1, 1), b3 + hstep, voffB);
            PG8_WAIT_V(6); PG8_BAR; PG8_MMA(1, 1, At, B1); PG8_BAR;
            }
        }
        if constexpr (ALIGN_EPI) { if (wr == 0) PG8_BAR; }
        if constexpr (!Epi::AFTER_DRAIN) { E(acc, cur, wr, wc, fr, fq); S.done(cur); }
        if (!has_next) break;
#pragma unroll
        for (int a = 0; a < 2; ++a)
#pragma unroll
            for (int b = 0; b < 2; ++b)
#pragma unroll
                for (int m = 0; m < 4; ++m)
#pragma unroll
                    for (int n = 0; n < 2; ++n) acc[a][b][m][n] = (f32x4){0.f, 0.f, 0.f, 0.f};
        cur = nxt; cA = nA; cB = nB; ++ui;
        if constexpr (ALIGN_EPI) { if (wr == 1) PG8_BAR; }
    }
    PG8_WAIT_V(0);
    if constexpr (!ALIGN_EPI) { if (wr == 0) PG8_BAR; }
    PG8_BAR;
    if constexpr (Epi::AFTER_DRAIN) { E.fused(acc, cur, wr, wc, fr, fq, lds, wid, lane); S.done(cur); }
#undef PG8_SA
#undef PG8_SB
#undef PG8_STAGE
#undef PG8_LDA
#undef PG8_LDB
#undef PG8_MMA
#undef PG8_WAIT_V
#undef PG8_WAIT_L
#undef PG8_BAR
#undef PG8_SCHED
}
}

namespace attn {
typedef unsigned short bf16_t;
using bf16x8 = __attribute__((ext_vector_type(8))) short;
using s16x4  = __attribute__((ext_vector_type(4))) short;
using f32x16 = __attribute__((ext_vector_type(16))) float;
using u32x4  = __attribute__((ext_vector_type(4))) unsigned;
constexpr int NW = 8, QBLK = 32, KVBLK = 64;
constexpr float QSCALE = 0.125f * 1.4426950408889634f;
constexpr int LDQ = 512, LDK = 512, LDV = 512, LDO = 512;
constexpr int SHM_V = KVBLK * 128 * 2, SHM_K = KVBLK * 64 * 2, SHM_ATTN = 2 * SHM_V + 2 * SHM_K + NW * 64 * 4;
#define KSWZ64(row, colB) ((row) * 128 + ((colB) ^ ((((row) >> 1) & 7) << 4)))
#define SBAR() __builtin_amdgcn_sched_barrier(0)
__device__ __forceinline__ int crow(int r, int hi) { return (r & 3) + 8 * (r >> 2) + 4 * hi; }
__device__ __forceinline__ unsigned cvtpk(float lo, float hi) { unsigned r; asm volatile("v_cvt_pk_bf16_f32 %0, %1, %2" : "=v"(r) : "v"(lo), "v"(hi)); return r; }
constexpr float THR2 = 11.5f;
template <bool FIRST, bool GUARD>
__device__ __forceinline__ void partialSM(f32x16& p0, f32x16& p1, float& m_reg, float& alpha) {
  if (!GUARD) {
    alpha = 1.f;
#pragma unroll
    for (int r = 0; r < 16; ++r) p0[r] = __builtin_amdgcn_exp2f(p0[r]);
    return;
  }
  if (!FIRST) { if (__builtin_expect(__any(m_reg != 0.f), 0)) {
#pragma unroll
      for (int r = 0; r < 16; ++r) { p0[r] -= m_reg; p1[r] -= m_reg; } } }
  float a = fmaxf(fmaxf(p0[0], p0[1]), p1[0]), b = fmaxf(fmaxf(p0[2], p0[3]), p1[1]); a = fmaxf(fmaxf(a, p1[2]), p1[3]);
#pragma unroll
  for (int r = 4; r < 16; r += 4) { a = fmaxf(fmaxf(a, p0[r]), p0[r + 1]); b = fmaxf(fmaxf(b, p0[r + 2]), p0[r + 3]); a = fmaxf(fmaxf(a, p1[r]), p1[r + 1]); b = fmaxf(fmaxf(b, p1[r + 2]), p1[r + 3]); }
  float pmax = fmaxf(a, b);
  { auto rr = __builtin_amdgcn_permlane32_swap(__float_as_uint(pmax), __float_as_uint(pmax), false, false);
    pmax = fmaxf(__uint_as_float(rr[0]), __uint_as_float(rr[1])); }
  alpha = 1.f;
  if (FIRST) {
    if (__builtin_expect(__any(fabsf(pmax) > THR2), 0)) { const float dl = fabsf(pmax) > THR2 ? pmax : 0.f; m_reg = dl;
#pragma unroll
      for (int r = 0; r < 16; ++r) { p0[r] -= dl; p1[r] -= dl; } }
  } else {
    if (__builtin_expect(__any(pmax > THR2), 0)) { const float dl = fmaxf(pmax, 0.f); m_reg += dl;
#pragma unroll
      for (int r = 0; r < 16; ++r) { p0[r] -= dl; p1[r] -= dl; }
      alpha = __builtin_amdgcn_exp2f(-dl); }
  }
#pragma unroll
  for (int r = 0; r < 16; ++r) p0[r] = __builtin_amdgcn_exp2f(p0[r]);
}
__device__ __forceinline__ void finishSM(f32x16& p0, f32x16& p1, bf16x8& pa0, bf16x8& pa1, bf16x8& pa2, bf16x8& pa3) {
#pragma unroll
  for (int r = 0; r < 16; ++r) p1[r] = __builtin_amdgcn_exp2f(p1[r]);
#define PK4(P, BASE, OUT) do { u32x4 w = {cvtpk(P[BASE + 0], P[BASE + 1]), cvtpk(P[BASE + 2], P[BASE + 3]), cvtpk(P[BASE + 4], P[BASE + 5]), cvtpk(P[BASE + 6], P[BASE + 7])}; \
    OUT = *reinterpret_cast<bf16x8*>(&w); } while (0)
  PK4(p0, 0, pa0); PK4(p0, 8, pa1); PK4(p1, 0, pa2); PK4(p1, 8, pa3);
#undef PK4
}
__device__ __forceinline__ void qkt(f32x16& p0, f32x16& p1, const char* Ks, const bf16x8* qr, int r32, int hi) {
  p0 = f32x16{}; p1 = f32x16{};
#pragma unroll
  for (int d0 = 0; d0 < 4; ++d0) { const int cb = (d0 * 16 + hi * 8) * 2;
    bf16x8 b0 = *reinterpret_cast<const bf16x8*>(Ks + KSWZ64(r32, cb));
    bf16x8 b1 = *reinterpret_cast<const bf16x8*>(Ks + KSWZ64(32 + r32, cb));
    p0 = __builtin_amdgcn_mfma_f32_32x32x16_bf16(b0, qr[d0], p0, 0, 0, 0);
    p1 = __builtin_amdgcn_mfma_f32_32x32x16_bf16(b1, qr[d0], p1, 0, 0, 0); }
}
__device__ __forceinline__ int v_st(int k, int c) { const int kk = k; return ((kk >> 3) * 4 + (c >> 5)) * 512 + ((kk & 7) * 32 + (c & 31)) * 2; }
__device__ __forceinline__ int v_rd_base(int lane) { return ((lane & 3) << 3) | (((lane >> 2) & 3) << 6) | (((lane >> 4) & 1) << 5) | (((lane >> 5) & 1) << 8); }
constexpr int v_rd_off(int d0, int ks, int half) { return d0 * 512 + ks * 4096 + half * 2048; }
template <int OFF> __device__ __forceinline__ s16x4 tr_read(int vb) {
  s16x4 r; asm volatile("ds_read_b64_tr_b16 %0, %1 offset:%2" : "=&v"(r) : "v"(vb), "i"(OFF) : "memory"); return r;
}
template <int D0> __device__ __forceinline__ void pv_one(f32x16& od, int vb, bf16x8 pa0, bf16x8 pa1, bf16x8 pa2, bf16x8 pa3) {
  const s16x4 l0 = tr_read<v_rd_off(D0, 0, 0)>(vb), h0 = tr_read<v_rd_off(D0, 0, 1)>(vb), l1 = tr_read<v_rd_off(D0, 1, 0)>(vb), h1 = tr_read<v_rd_off(D0, 1, 1)>(vb);
  const s16x4 l2 = tr_read<v_rd_off(D0, 2, 0)>(vb), h2 = tr_read<v_rd_off(D0, 2, 1)>(vb), l3 = tr_read<v_rd_off(D0, 3, 0)>(vb), h3 = tr_read<v_rd_off(D0, 3, 1)>(vb);
  asm volatile("s_waitcnt lgkmcnt(0)" ::: "memory"); SBAR();
#define PK(L, H) (bf16x8){L[0], L[1], L[2], L[3], H[0], H[1], H[2], H[3]}
  od = __builtin_amdgcn_mfma_f32_32x32x16_bf16(pa0, PK(l0, h0), od, 0, 0, 0);
  od = __builtin_amdgcn_mfma_f32_32x32x16_bf16(pa1, PK(l1, h1), od, 0, 0, 0);
  od = __builtin_amdgcn_mfma_f32_32x32x16_bf16(pa2, PK(l2, h2), od, 0, 0, 0);
  od = __builtin_amdgcn_mfma_f32_32x32x16_bf16(pa3, PK(l3, h3), od, 0, 0, 0);
#undef PK
}
__device__ __forceinline__ void pv_d0(f32x16* o, f32x16& osum, int vb, bf16x8 pa0, bf16x8 pa1, bf16x8 pa2, bf16x8 pa3) {
  { const bf16x8 ones = {16256, 16256, 16256, 16256, 16256, 16256, 16256, 16256};
    osum = __builtin_amdgcn_mfma_f32_32x32x16_bf16(pa0, ones, osum, 0, 0, 0); osum = __builtin_amdgcn_mfma_f32_32x32x16_bf16(pa1, ones, osum, 0, 0, 0);
    osum = __builtin_amdgcn_mfma_f32_32x32x16_bf16(pa2, ones, osum, 0, 0, 0); osum = __builtin_amdgcn_mfma_f32_32x32x16_bf16(pa3, ones, osum, 0, 0, 0); }
  pv_one<0>(o[0], vb, pa0, pa1, pa2, pa3); pv_one<1>(o[1], vb, pa0, pa1, pa2, pa3); pv_one<2>(o[2], vb, pa0, pa1, pa2, pa3); pv_one<3>(o[3], vb, pa0, pa1, pa2, pa3);
}
#define TRSET(L, D0) do { L[0] = tr_read<v_rd_off(D0, 0, 0)>(vb); L[1] = tr_read<v_rd_off(D0, 0, 1)>(vb); L[2] = tr_read<v_rd_off(D0, 1, 0)>(vb); L[3] = tr_read<v_rd_off(D0, 1, 1)>(vb); \
    L[4] = tr_read<v_rd_off(D0, 2, 0)>(vb); L[5] = tr_read<v_rd_off(D0, 2, 1)>(vb); L[6] = tr_read<v_rd_off(D0, 3, 0)>(vb); L[7] = tr_read<v_rd_off(D0, 3, 1)>(vb); } while (0)
#define PKV(L, k) (bf16x8){L[2 * (k)][0], L[2 * (k)][1], L[2 * (k)][2], L[2 * (k)][3], L[2 * (k) + 1][0], L[2 * (k) + 1][1], L[2 * (k) + 1][2], L[2 * (k) + 1][3]}
#define MM4(OD, L) do { OD = __builtin_amdgcn_mfma_f32_32x32x16_bf16(pa0, PKV(L, 0), OD, 0, 0, 0); OD = __builtin_amdgcn_mfma_f32_32x32x16_bf16(pa1, PKV(L, 1), OD, 0, 0, 0); \
    OD = __builtin_amdgcn_mfma_f32_32x32x16_bf16(pa2, PKV(L, 2), OD, 0, 0, 0); OD = __builtin_amdgcn_mfma_f32_32x32x16_bf16(pa3, PKV(L, 3), OD, 0, 0, 0); } while (0)
#define LWAIT() do { asm volatile("s_waitcnt lgkmcnt(0)" ::: "memory"); SBAR(); } while (0)
__device__ __forceinline__ void pv_d0_pipe(f32x16* o, f32x16& osum, int vb, bf16x8 pa0, bf16x8 pa1, bf16x8 pa2, bf16x8 pa3) {
  s16x4 LA[8], LB[8];
  __builtin_amdgcn_s_setprio(1);
  TRSET(LA, 0); SBAR();
  { const bf16x8 ones = {16256, 16256, 16256, 16256, 16256, 16256, 16256, 16256};
    osum = __builtin_amdgcn_mfma_f32_32x32x16_bf16(pa0, ones, osum, 0, 0, 0); osum = __builtin_amdgcn_mfma_f32_32x32x16_bf16(pa1, ones, osum, 0, 0, 0);
    osum = __builtin_amdgcn_mfma_f32_32x32x16_bf16(pa2, ones, osum, 0, 0, 0); osum = __builtin_amdgcn_mfma_f32_32x32x16_bf16(pa3, ones, osum, 0, 0, 0); }
  LWAIT(); TRSET(LB, 1); SBAR(); MM4(o[0], LA); SBAR();
  LWAIT(); TRSET(LA, 2); SBAR(); MM4(o[1], LB); SBAR();
  LWAIT(); TRSET(LB, 3); SBAR(); MM4(o[2], LA); SBAR();
  LWAIT(); MM4(o[3], LB);
  __builtin_amdgcn_s_setprio(0);
}
#undef TRSET
#undef PKV
#undef MM4
#undef LWAIT
template <int COMP, bool GUARD>
__device__ __forceinline__ bool body(const bf16_t* __restrict__ Qb, const bf16_t* __restrict__ Kh, const bf16_t* __restrict__ Vh, float* Ob, bf16_t* __restrict__ SAo, float lam, const float* __restrict__ sg, int seq, char* lds) {
  int tid_ = threadIdx.x; asm volatile("" : "+v"(tid_));
  const int tid = tid_, wid = tid >> 6, lane = tid & 63, r32 = lane & 31, hi = lane >> 5;
  char* V_lds = lds; char* K_lds = lds + 4 * SHM_V;
  float* ws = (float*)(lds + 4 * SHM_V + 4 * SHM_K) + wid * 64; float* al_l = ws + 32;
  float m_reg = 0.f; f32x16 o[4] = {}; f32x16 osum = {}; bf16x8 qr[4];
  const bf16_t* Qw = Qb + (long)(wid * QBLK + r32) * LDQ + hi * 8;
#pragma unroll
  for (int d0 = 0; d0 < 4; ++d0) qr[d0] = *reinterpret_cast<const bf16x8*>(Qw + d0 * 16);
  const int sr = tid >> 4, sc = (tid & 15) * 8, vst0 = v_st(sr, sc), vst1 = v_st(32 + sr, sc);
  const int ksr = tid >> 3, ksc = (tid & 7) * 8, kst = KSWZ64(ksr, ksc * 2);
  const int vb0 = (int)(uintptr_t)V_lds + v_rd_base(lane);
  bf16x8 rvs0, rvs1, rks0;
#define SLOAD(k0) do { rvs0 = *reinterpret_cast<const bf16x8*>(&Vh[(long)((k0) + sr) * LDV + sc]); rvs1 = *reinterpret_cast<const bf16x8*>(&Vh[(long)((k0) + 32 + sr) * LDV + sc]); \
    rks0 = *reinterpret_cast<const bf16x8*>(&Kh[(long)((k0) + ksr) * LDK + ksc]); } while (0)
#define SWRITE(slot) do { *(bf16x8*)(V_lds + (slot) * SHM_V + vst0) = rvs0; *(bf16x8*)(V_lds + (slot) * SHM_V + vst1) = rvs1; *(bf16x8*)(K_lds + (slot) * SHM_K + kst) = rks0; } while (0)
#define RESC(a) do { if (__any((a) < 1.f)) { if (hi == 0) al_l[r32] = (a); asm volatile("s_waitcnt lgkmcnt(0)" ::: "memory"); \
    _Pragma("unroll") for (int r = 0; r < 16; ++r) { const float f_ = al_l[crow(r, hi)]; osum[r] *= f_; _Pragma("unroll") for (int d = 0; d < 4; ++d) o[d][r] *= f_; } } } while (0)
  f32x16 pA0, pA1, pB0, pB1; float alA, alB; bf16x8 pa0, pa1, pa2, pa3; const int NT = seq / KVBLK;
  SLOAD(0); SWRITE(0); SLOAD(KVBLK); __syncthreads();
  qkt(pA0, pA1, K_lds, qr, r32, hi); partialSM<true, GUARD>(pA0, pA1, m_reg, alA);
  SWRITE(1); SLOAD(2 * KVBLK); __syncthreads();
  const int grp = __builtin_amdgcn_readfirstlane(wid >> 2);
#define ITER(X0, X1, Y0, Y1, alX, i) do { const int scur = (i) & 3, sp = ((i) - 1) & 3, sn = ((i) + 1) & 3; \
    SBAR(); qkt(X0, X1, K_lds + scur * SHM_K, qr, r32, hi); \
    finishSM(Y0, Y1, pa0, pa1, pa2, pa3); SBAR(); \
    if (grp) { SWRITE(sn); if ((i) + 2 < NT) SLOAD(((i) + 2) * KVBLK); __syncthreads(); } \
    if (GUARD) pv_d0(o, osum, vb0 + sp * SHM_V, pa0, pa1, pa2, pa3); else pv_d0_pipe(o, osum, vb0 + sp * SHM_V, pa0, pa1, pa2, pa3); partialSM<false, GUARD>(X0, X1, m_reg, alX); \
    if (GUARD) RESC(alX); \
    if (!grp) { SWRITE(sn); if ((i) + 2 < NT) SLOAD(((i) + 2) * KVBLK); __syncthreads(); } } while (0)
  int i = 1;
  for (; i + 1 < NT; i += 2) {
    ITER(pB0, pB1, pA0, pA1, alB, i);
    ITER(pA0, pA1, pB0, pB1, alA, i + 1);
  }
  { const int scur = i & 3, sp = (i - 1) & 3;
  SBAR(); qkt(pB0, pB1, K_lds + scur * SHM_K, qr, r32, hi);
  finishSM(pA0, pA1, pa0, pa1, pa2, pa3); SBAR();
  pv_d0(o, osum, vb0 + sp * SHM_V, pa0, pa1, pa2, pa3); partialSM<false, GUARD>(pB0, pB1, m_reg, alB);
  if (GUARD) RESC(alB);
  finishSM(pB0, pB1, pa0, pa1, pa2, pa3); SBAR();
  pv_d0(o, osum, vb0 + scur * SHM_V, pa0, pa1, pa2, pa3); }
#undef ITER
  if (!GUARD) {
    bool ok = true;
#pragma unroll
    for (int r = 0; r < 16; ++r) ok = ok && (osum[r] > 0.f) && (osum[r] < 3.0e38f);
    if (__syncthreads_or(ok ? 0 : 1)) return true;
  }
  float rli[16];
#pragma unroll
  for (int r = 0; r < 16; ++r) rli[r] = __builtin_amdgcn_rcpf(osum[r]);
  float* Ow = Ob + (long)(wid * QBLK) * LDO;
  if (COMP == 0) {
#pragma unroll
    for (int r = 0; r < 16; ++r) { const int orow = crow(r, hi);
#pragma unroll
      for (int d0 = 0; d0 < 4; ++d0) Ow[(long)orow * LDO + d0 * 32 + r32] = o[d0][r] * rli[r]; }
  } else {
    float ss[16];
#pragma unroll
    for (int r = 0; r < 16; ++r) { const int orow = crow(r, hi); float q = 0.f;
#pragma unroll
      for (int d0 = 0; d0 < 4; ++d0) { const float d = Ow[(long)orow * LDO + d0 * 32 + r32] - lam * (o[d0][r] * rli[r]); o[d0][r] = d; q = fmaf(d, d, q); }
      ss[r] = q; }
#pragma unroll
    for (int r = 0; r < 16; ++r) { float q = ss[r]; q += __shfl_xor(q, 1); q += __shfl_xor(q, 2); q += __shfl_xor(q, 4); q += __shfl_xor(q, 8); q += __shfl_xor(q, 16);
      ss[r] = 1.0f / sqrtf(q * (1.0f / 128.0f) + 1e-6f); }
    float gsub[4];
#pragma unroll
    for (int d0 = 0; d0 < 4; ++d0) gsub[d0] = sg[d0 * 32 + r32] * 0.8f;
    bf16_t* Sw = SAo + (long)(wid * QBLK) * 1024;
#pragma unroll
    for (int r = 0; r < 16; ++r) { const int orow = crow(r, hi);
#pragma unroll
      for (int d0 = 0; d0 < 4; ++d0) { const float y = o[d0][r] * ss[r] * gsub[d0]; unsigned u = __builtin_bit_cast(unsigned, y); u = (u + 0x7fffu + ((u >> 16) & 1u)) >> 16;
        Sw[(long)orow * 1024 + d0 * 32 + r32] = (bf16_t)u; } }
  }
  asm volatile("s_waitcnt vmcnt(0) lgkmcnt(0)" ::: "memory"); __syncthreads();
  return false;
#undef SLOAD
#undef SWRITE
#undef RESC
}
#undef SBAR
}

#define GAS __attribute__((address_space(1)))
#define LAS __attribute__((address_space(3)))
typedef unsigned short bf16;
typedef unsigned v4u __attribute__((ext_vector_type(4)));
typedef float f32x4 __attribute__((ext_vector_type(4)));
typedef float f32x16 __attribute__((ext_vector_type(16)));
typedef short bf16x8 __attribute__((ext_vector_type(8)));

constexpr int NWAVES = 8, NTHR = 512;
constexpr int DM = 1024, DFF = 2816, NB = 8, SEQ = 8192, CTXL = 256, NMODV = 9 * DM;
constexpr int ROWS_B = 8448, TILES_B = 33, NROWS = NB * ROWS_B;

constexpr size_t MiB = 1u << 20;
constexpr size_t WS_CTL = 0, CTL_ZERO_BYTES = 1 * MiB;
constexpr size_t WS_MOD = 4096;
constexpr size_t WS_BIAS1 = 352 * 1024, WS_BIAS2 = 640 * 1024;
constexpr size_t WS_RSS1 = 69 * MiB, WS_RSS2 = 69 * MiB + 512 * 1024;
constexpr size_t WS_BAR = 512 * 1024, BAR_ZERO_BYTES = 16384;
constexpr size_t WS_ABAR = 1 * MiB, WS_APOW = WS_ABAR + 32768, WS_BBT = WS_APOW + 32768, WS_CM = WS_BBT + 262144, WS_ROPE = WS_CM + 262144;
constexpr size_t WS_W1A = 2 * MiB, WS_W1B = 13 * MiB, WS_W2A = 19 * MiB, WS_W2B = 30 * MiB, WS_WIN = 36 * MiB, WS_WOUT = 40 * MiB, WS_WGLU = 42 * MiB;
constexpr size_t WS_E = 43 * MiB, WS_HIN = 52 * MiB, WS_XC = 61 * MiB;
constexpr size_t WS_XN = 70 * MiB;
constexpr size_t WS_ACT = 202 * MiB;
constexpr size_t WS_OATT = WS_ACT, WS_G = WS_ACT + 264 * MiB;
constexpr size_t WS_U = 565 * MiB, WS_Q = 631 * MiB, WS_K = 697 * MiB, WS_V = 763 * MiB, WS_END = 829 * MiB;
static_assert(WS_ROPE + 16384 <= WS_W1A && WS_W1A + (size_t)5632 * 1024 * 2 <= WS_W1B && WS_W1B + (size_t)1024 * 2816 * 2 <= WS_W2A && WS_W2A + (size_t)5632 * 1024 * 2 <= WS_W2B, "ws map 1");
static_assert(WS_W2B + (size_t)1024 * 2816 * 2 <= WS_WIN && WS_WIN + (size_t)2048 * 1024 * 2 <= WS_WOUT && WS_WOUT + (size_t)1024 * 1024 * 2 <= WS_WGLU && WS_WGLU + 512 * 512 * 2 <= WS_E, "ws map 2");
static_assert(WS_E + (size_t)8 * 33 * 64 * 64 * 8 <= WS_HIN && WS_HIN + (size_t)8 * 33 * 64 * 64 * 8 <= WS_XC && WS_XC + (size_t)2048 * 1024 * 4 <= WS_XN, "ws map 3");
static_assert(WS_XN + (size_t)NROWS * 1024 * 2 <= WS_ACT && WS_ACT + (size_t)NROWS * 2816 * 2 <= WS_U && WS_G + (size_t)NROWS * 512 * 2 <= WS_U && WS_OATT + (size_t)NROWS * 1024 * 4 <= WS_G, "ws map 4");
static_assert(WS_U + (size_t)NROWS * 512 * 2 <= WS_Q && WS_V + (size_t)NROWS * 512 * 2 <= WS_END, "ws map 5");

constexpr int LDS_BYTES = 139264;

#define LDS_WAIT() asm volatile("s_waitcnt lgkmcnt(0)" ::: "memory")
__device__ __forceinline__ unsigned f2bf(float f) { unsigned u = __builtin_bit_cast(unsigned, f); return (u + 0x7fffu + ((u >> 16) & 1u)) >> 16; }
__device__ __forceinline__ unsigned pk2(float lo, float hi) { return f2bf(lo) | (f2bf(hi) << 16); }
__device__ __forceinline__ float wave_sum(float v) {
#pragma unroll
    for (int o = 1; o < 64; o <<= 1) v += __shfl_xor(v, o);
    return v;
}

__device__ __forceinline__ double dexp(double x) {
    const double n = __builtin_rint(x * 1.4426950408889634074);
    const double r = __builtin_fma(-n, 1.9082149292705877e-10, __builtin_fma(-n, 0.693147180369123816490, x));
    double p = 1.0 / 87178291200.0;
    p = p * r + 1.0 / 6227020800.0; p = p * r + 1.0 / 479001600.0; p = p * r + 1.0 / 39916800.0; p = p * r + 1.0 / 3628800.0; p = p * r + 1.0 / 362880.0; p = p * r + 1.0 / 40320.0;
    p = p * r + 1.0 / 5040.0; p = p * r + 1.0 / 720.0; p = p * r + 1.0 / 120.0; p = p * r + 1.0 / 24.0; p = p * r + 1.0 / 6.0; p = p * r + 0.5; p = p * r + 1.0; p = p * r + 1.0;
    const long long e = (long long)n + 1023; const double s = __builtin_bit_cast(double, (unsigned long long)e << 52);
    return p * s;
}
__device__ __forceinline__ void dsincos(double y, double& s, double& c) {
    const double k = __builtin_rint(y * 0.15915494309189533577);
    double r = __builtin_fma(-k, 6.283185307179586232, y); r = __builtin_fma(-k, 2.4492935982947064e-16, r);
    const double q = r * 0.125, q2 = q * q;
    double sp = -1.0 / 1307674368000.0; sp = sp * q2 + 1.0 / 6227020800.0; sp = sp * q2 - 1.0 / 39916800.0; sp = sp * q2 + 1.0 / 362880.0; sp = sp * q2 - 1.0 / 5040.0; sp = sp * q2 + 1.0 / 120.0; sp = sp * q2 - 1.0 / 6.0; sp = sp * q2 + 1.0;
    double cp = 1.0 / 20922789888000.0; cp = cp * q2 - 1.0 / 87178291200.0; cp = cp * q2 + 1.0 / 479001600.0; cp = cp * q2 - 1.0 / 3628800.0; cp = cp * q2 + 1.0 / 40320.0; cp = cp * q2 - 1.0 / 720.0; cp = cp * q2 + 1.0 / 24.0; cp = cp * q2 - 0.5; cp = cp * q2 + 1.0;
    double ss = sp * q, cc = cp;
#pragma unroll
    for (int i = 0; i < 3; ++i) { const double s2 = 2.0 * ss * cc, c2 = cc * cc - ss * ss; ss = s2; cc = c2; }
    s = ss; c = cc;
}

__device__ __forceinline__ void transpose_item(const float* W, int K, int N, bf16* WT, int mode, LAS float* scr, int item, int lane) {
    const int nblk = N / 32, kb = item / nblk, nb = item % nblk, k0 = 64 * kb, n0 = 32 * nb;
    { const float* wp = W + (size_t)(k0 + (lane >> 5)) * N + n0 + (lane & 31); float v[32];
#pragma unroll
      for (int i = 0; i < 32; ++i) v[i] = wp[(size_t)(2 * i) * N];
#pragma unroll
      for (int i = 0; i < 32; ++i) scr[(2 * i + (lane >> 5)) * 33 + (lane & 31)] = v[i]; }
    LDS_WAIT(); asm volatile("" ::: "memory");
    const int c = lane & 7;
#pragma unroll
    for (int j = 0; j < 4; ++j) { const int n = (lane >> 3) + 8 * j; const LAS float* s = scr + (8 * c) * 33 + n;
        const int src = n0 + n; int drow = src;
        if (mode == 1) { const int up = src >= DFF ? 1 : 0, ff = src - up * DFF; drow = (ff >> 7) * 256 + up * 128 + (ff & 127); }
        else if (mode == 2) { if (src >= 512 && src < 1536) drow = n0 + 2 * (n & 15) + (n >> 4); }
        v4u o; o.x = pk2(s[0 * 33], s[1 * 33]); o.y = pk2(s[2 * 33], s[3 * 33]); o.z = pk2(s[4 * 33], s[5 * 33]); o.w = pk2(s[6 * 33], s[7 * 33]);
        *(v4u*)(WT + (size_t)drow * K + k0 + 8 * c) = o; }
    LDS_WAIT(); asm volatile("" ::: "memory");
}

template <int MODE>
__device__ __forceinline__ void norm_rows16(const float* src, bf16* dstb, float* dstf, const float* g, const float* shift, const float* scale, int lane) {
    f32x4 gs[4], sh[4];
#pragma unroll
    for (int j = 0; j < 4; ++j) { const int cidx = 4 * lane + 256 * j; const f32x4 gv = *(const f32x4*)(g + cidx);
        if (MODE == 0) { const f32x4 sc = *(const f32x4*)(scale + cidx); gs[j] = gv * (sc + 1.0f); sh[j] = *(const f32x4*)(shift + cidx); } else { gs[j] = gv; sh[j] = (f32x4){0.f, 0.f, 0.f, 0.f}; } }
#pragma unroll 2
    for (int r = 0; r < 16; ++r) {
        const f32x4* xr = (const f32x4*)(src + (size_t)r * DM) + lane;
        f32x4 v[4]; float s = 0.f;
#pragma unroll
        for (int j = 0; j < 4; ++j) { v[j] = xr[64 * j]; s += (v[j].x * v[j].x + v[j].y * v[j].y) + (v[j].z * v[j].z + v[j].w * v[j].w); }
        const float rstd = 1.0f / sqrtf(wave_sum(s) * (1.0f / DM) + 1e-6f);
        if (MODE == 0) {
            unsigned long long* o8 = (unsigned long long*)(dstb + (size_t)r * DM) + lane;
#pragma unroll
            for (int j = 0; j < 4; ++j) { const f32x4 y = v[j] * rstd * gs[j] + sh[j]; o8[64 * j] = (unsigned long long)pk2(y.x, y.y) | ((unsigned long long)pk2(y.z, y.w) << 32); }
        } else {
            f32x4* of = (f32x4*)(dstf + (size_t)r * DM) + lane;
#pragma unroll
            for (int j = 0; j < 4; ++j) of[64 * j] = v[j] * rstd * gs[j];
        }
    }
}

__device__ __forceinline__ int crow16(int r, int hi) { return (r & 3) + 8 * (r >> 2) + 4 * hi; }
typedef float f32x2_t __attribute__((ext_vector_type(2))); typedef __bf16 bf16x2_t __attribute__((ext_vector_type(2)));
__device__ __forceinline__ unsigned cvtpk2(float lo, float hi) { f32x2_t v = {lo, hi}; bf16x2_t b = __builtin_convertvector(v, bf16x2_t); return __builtin_bit_cast(unsigned, b); }

template <bool FULL>
__device__ __forceinline__ void s5_unit(LAS unsigned char* lds, int b, int c, int gq, const bf16* U, const float2* ABAR, const bf16* BBT, const bf16* CM,
                                        const float2* HIN, float2* E, const float* dskip, bf16* G, float* YF) {
    int tid_ = threadIdx.x; asm volatile("" : "+v"(tid_));
    const int lane = tid_ & 63, wave = __builtin_amdgcn_readfirstlane(tid_ >> 6);
    const int g = gq * 8 + wave, hi = lane >> 5, r32 = lane & 31;
    LAS unsigned* scr = (LAS unsigned*)(lds + wave * 8704);
    const size_t r0 = (size_t)b * ROWS_B + (size_t)c * 256;
    const bf16* ubase = U + (r0 + r32) * 512 + g * 16 + hi * 8;
    const int ch = lane & 15; const float dv = dskip[g * 16 + ch];
    const size_t obase = (r0 + (lane >> 4) * 4) * 512 + g * 16 + ch;
    LAS unsigned short* yt_l = (LAS unsigned short*)(lds + 69632 + wave * 8192) + ((lane >> 4) * 4) * 16 + ch;
#pragma unroll
    for (int dir = 0; dir < 2; ++dir) {
        const int dg = dir * 32 + g;
        const float2 ab = ABAR[dg * 64 + lane];
        bf16x8 bb[4], cm[4];
#pragma unroll
        for (int blk = 0; blk < 4; ++blk) bb[blk] = *(const bf16x8*)(BBT + ((size_t)(dg * 4 + blk) * 32 + r32) * 16 + hi * 8);
        if (FULL) {
#pragma unroll
            for (int ks = 0; ks < 4; ++ks) cm[ks] = *(const bf16x8*)(CM + ((size_t)dg * 16 + (lane & 15)) * 128 + ks * 32 + (lane >> 4) * 8);
        }
        const size_t sidx = ((((size_t)b * 33 + c) * 32 + g) * 2 + dir) * 64 + lane;
        float hr = 0.f, hm = 0.f;
        if (FULL) { const float2 h0 = HIN[sidx]; hr = h0.x; hm = h0.y; }
        bf16x8 a_nx = *(const bf16x8*)(ubase + (size_t)(dir == 0 ? 0 : 224) * 512);
#pragma unroll 1
        for (int sb = 0; sb < 8; ++sb) {
            const int tb = dir == 0 ? sb * 32 : (7 - sb) * 32;
            const bf16x8 a = a_nx;
            { const int tn = dir == 0 ? (sb < 7 ? tb + 32 : tb) : (sb < 7 ? tb - 32 : tb); a_nx = *(const bf16x8*)(ubase + (size_t)tn * 512); }
            unsigned short uvv[2][4];
            if (FULL && dir == 1) {
#pragma unroll
                for (int mt = 0; mt < 2; ++mt)
#pragma unroll
                    for (int j = 0; j < 4; ++j) { const size_t idx = obase + (size_t)(tb + mt * 16 + j) * 512; uvv[mt][j] = U[idx]; }
            }
            const f32x16 z = {};
#pragma unroll
            for (int hf = 0; hf < 2; ++hf) {
                const f32x16 c0 = __builtin_amdgcn_mfma_f32_32x32x16_bf16(a, bb[hf], z, 0, 0, 0), c2 = __builtin_amdgcn_mfma_f32_32x32x16_bf16(a, bb[2 + hf], z, 0, 0, 0);
#pragma unroll
                for (int r = 0; r < 16; ++r) { const int row = crow16(r, hi); scr[row * 68 + hf * 32 + r32] = cvtpk2(c0[r], c2[r]); }
            }
            LDS_WAIT(); asm volatile("" ::: "memory");
#pragma unroll
            for (int half = 0; half < 2; ++half) {
                unsigned v[16];
#pragma unroll
                for (int q = 0; q < 16; ++q) { const int t = dir == 0 ? half * 16 + q : 31 - (half * 16 + q); v[q] = scr[t * 68 + lane]; }
#pragma unroll
                for (int q = 0; q < 16; ++q) { const int t = dir == 0 ? half * 16 + q : 31 - (half * 16 + q);
                    const float re = __uint_as_float(v[q] << 16), im = __uint_as_float(v[q] & 0xffff0000u);
                    const float nr = fmaf(ab.x, hr, fmaf(-ab.y, hm, re)), ni = fmaf(ab.x, hm, fmaf(ab.y, hr, im)); hr = nr; hm = ni;
                    if (FULL) scr[t * 68 + lane] = cvtpk2(hr, hm); }
                asm volatile("" ::: "memory");
            }
            if (FULL) {
                LDS_WAIT(); asm volatile("" ::: "memory");
                f32x4 yt[2];
#pragma unroll
                for (int mt = 0; mt < 2; ++mt) { yt[mt] = (f32x4){0.f, 0.f, 0.f, 0.f};
#pragma unroll
                    for (int ks = 0; ks < 4; ++ks) { const bf16x8 hf8 = *(const LAS bf16x8*)((const LAS unsigned char*)scr + (mt * 16 + (lane & 15)) * 272 + ks * 64 + (lane >> 4) * 16);
                        yt[mt] = __builtin_amdgcn_mfma_f32_16x16x32_bf16(hf8, cm[ks], yt[mt], 0, 0, 0); } }
#pragma unroll
                for (int mt = 0; mt < 2; ++mt)
#pragma unroll
                    for (int j = 0; j < 4; ++j) { LAS unsigned short* yp = yt_l + (tb + mt * 16 + j) * 16;
                        if (dir == 0) *yp = (unsigned short)f2bf(yt[mt][j]);
                        else { const float uv = __uint_as_float((unsigned)uvv[mt][j] << 16); const float yv = __uint_as_float((unsigned)*yp << 16) + yt[mt][j] + dv * uv;
                            const float zz = 1.5957691216057308f * (yv + 0.044715f * yv * yv * yv); *yp = (unsigned short)f2bf(yv * pg8::fast_sigmoid(zz)); } }
                LDS_WAIT(); asm volatile("" ::: "memory");
            }
        }
        if (!FULL) E[sidx] = make_float2(hr, hm);
    }
    if (FULL) {
        LDS_WAIT(); asm volatile("" ::: "memory");
        const LAS unsigned char* yb = (const LAS unsigned char*)(lds + 69632 + wave * 8192);
#pragma unroll
        for (int it = 0; it < 8; ++it) { const int row = it * 32 + (lane >> 1), hf = lane & 1;
            const v4u w = *(const LAS v4u*)(yb + row * 32 + hf * 16);
            *(v4u*)(G + (r0 + row) * 512 + g * 16 + hf * 8) = w; }
        LDS_WAIT(); asm volatile("" ::: "memory");
    }
}

__device__ __forceinline__ void cmulf(float ar, float ai, float br, float bi, float& cr, float& ci) { cr = ar * br - ai * bi; ci = ar * bi + ai * br; }
__device__ __forceinline__ void s5_unit_a(LAS unsigned char* lds, int b, int c, int gq, const bf16* U, const float2* ABAR, const bf16* BBT, float2* E) {
    int tid_ = threadIdx.x; asm volatile("" : "+v"(tid_));
    const int lane = tid_ & 63, wave = __builtin_amdgcn_readfirstlane(tid_ >> 6);
    const int g = gq * 8 + wave, hi = lane >> 5, r32 = lane & 31;
    const size_t r0 = (size_t)b * ROWS_B + (size_t)c * 256;
    LAS unsigned char* ut = lds + wave * 8192;
    { v4u t8[8];
#pragma unroll
      for (int it = 0; it < 8; ++it) t8[it] = *(const v4u*)(U + (r0 + it * 32 + (lane >> 1)) * 512 + g * 16 + (lane & 1) * 8);
#pragma unroll
      for (int it = 0; it < 8; ++it) *(LAS v4u*)(ut + (it * 32 + (lane >> 1)) * 32 + (lane & 1) * 16) = t8[it]; }
    LDS_WAIT(); asm volatile("" ::: "memory");
    const LAS unsigned char* ua = ut + r32 * 32 + hi * 16;
#pragma unroll
    for (int dir = 0; dir < 2; ++dir) {
        const int dg = dir * 32 + g;
        bf16x8 bb[4];
#pragma unroll
        for (int blk = 0; blk < 4; ++blk) bb[blk] = *(const bf16x8*)(BBT + ((size_t)(dg * 4 + blk) * 32 + r32) * 16 + hi * 8);
        float wr[2][16], wi[2][16], a32r[2], a32i[2];
#pragma unroll
        for (int hf = 0; hf < 2; ++hf) {
            const float2 ab = ABAR[dg * 64 + hf * 32 + r32];
            float qr[4], qi[4], orr[4], oi[4];
            qr[0] = 1.f; qi[0] = 0.f; qr[1] = ab.x; qi[1] = ab.y; cmulf(qr[1], qi[1], ab.x, ab.y, qr[2], qi[2]); cmulf(qr[2], qi[2], ab.x, ab.y, qr[3], qi[3]);
            float a4r, a4i; cmulf(qr[2], qi[2], qr[2], qi[2], a4r, a4i);
            orr[0] = 1.f; oi[0] = 0.f; cmulf(a4r, a4i, a4r, a4i, orr[1], oi[1]); cmulf(orr[1], oi[1], orr[1], oi[1], orr[2], oi[2]); cmulf(orr[2], oi[2], orr[1], oi[1], orr[3], oi[3]);
            cmulf(orr[2], oi[2], orr[2], oi[2], a32r[hf], a32i[hf]);
            const bool use4 = dir == 0 ? (hi == 0) : (hi != 0);
            const float br = use4 ? a4r : 1.f, bi = use4 ? a4i : 0.f;
#pragma unroll
            for (int r = 0; r < 16; ++r) { const int jq = dir == 0 ? 3 - (r & 3) : (r & 3), jo = dir == 0 ? 3 - (r >> 2) : (r >> 2);
                float tr, ti; cmulf(qr[jq], qi[jq], orr[jo], oi[jo], tr, ti); cmulf(tr, ti, br, bi, wr[hf][r], wi[hf][r]); }
        }
        float hr[2] = {0.f, 0.f}, hm[2] = {0.f, 0.f};
#pragma unroll 1
        for (int sb = 0; sb < 8; ++sb) {
            const bf16x8 a = *(const LAS bf16x8*)(ua + (dir == 0 ? sb * 32 : (7 - sb) * 32) * 32);
            const f32x16 z = {};
#pragma unroll
            for (int hf = 0; hf < 2; ++hf) {
                const f32x16 cre = __builtin_amdgcn_mfma_f32_32x32x16_bf16(a, bb[hf], z, 0, 0, 0), cim = __builtin_amdgcn_mfma_f32_32x32x16_bf16(a, bb[2 + hf], z, 0, 0, 0);
                float er = 0.f, ei = 0.f;
#pragma unroll
                for (int r = 0; r < 16; ++r) { er = fmaf(wr[hf][r], cre[r], fmaf(-wi[hf][r], cim[r], er)); ei = fmaf(wr[hf][r], cim[r], fmaf(wi[hf][r], cre[r], ei)); }
                er += __shfl_xor(er, 32); ei += __shfl_xor(ei, 32);
                const float nr = fmaf(a32r[hf], hr[hf], fmaf(-a32i[hf], hm[hf], er)), ni = fmaf(a32r[hf], hm[hf], fmaf(a32i[hf], hr[hf], ei));
                hr[hf] = nr; hm[hf] = ni;
            }
        }
        const size_t sidx = ((((size_t)b * 33 + c) * 32 + g) * 2 + dir) * 64 + lane;
        E[sidx] = hi ? make_float2(hr[1], hm[1]) : make_float2(hr[0], hm[0]);
    }
    LDS_WAIT(); asm volatile("" ::: "memory");
}

typedef GAS unsigned gu32;
#define RLX_AGENT __ATOMIC_RELAXED, __HIP_MEMORY_SCOPE_AGENT
#define XB_TMO      128
#define XB_XCNT(j)  (256  + 64 * (j))
#define XB_XSUB(j)  (1280 + 64 * (j))
#define XB_XGEN(j)  (2304 + 64 * (j))
#define XB_TOP      3328
#define XB_TOPGEN   3392
#define XCD_BAR_WORDS 3456
#define XB_SPIN_CAP (1u << 18)

__device__ __forceinline__ unsigned xb_ld(unsigned* p)              { return __hip_atomic_load(p, __ATOMIC_RELAXED, __HIP_MEMORY_SCOPE_AGENT); }
__device__ __forceinline__ unsigned xb_add(unsigned* p, unsigned v) { return __hip_atomic_fetch_add(p, v, __ATOMIC_RELAXED, __HIP_MEMORY_SCOPE_AGENT); }
__device__ __forceinline__ unsigned xb_xcc_id() { return (unsigned)__builtin_amdgcn_s_getreg((3 << 11) | 20) & 0xFu; }
#define XB_SPIN(cond, bar) do { unsigned _sp = 0; while (cond) { __builtin_amdgcn_s_sleep(1); \
    if ((++_sp & 255u) == 0u) { if (xb_ld(&(bar)[XB_TMO])) break; if (_sp > XB_SPIN_CAP) { atomicAdd(&(bar)[XB_TMO], 1u); break; } } } } while (0)

struct XcdBarrier {
    unsigned* bar; unsigned x;
    volatile LAS unsigned* st;
};

__device__ __forceinline__ XcdBarrier xcd_barrier_post(unsigned* bar, volatile LAS unsigned* st) {
    XcdBarrier b; b.bar = bar; b.x = xb_xcc_id(); b.st = st;
    if (threadIdx.x == 0) (void)xb_add(&bar[XB_XCNT(b.x)], 1u);
    return b;
}
__device__ __forceinline__ void xcd_barrier_complete(unsigned* bar, unsigned x, unsigned& nloc, unsigned& nx) {
    const unsigned G = gridDim.x * gridDim.y * gridDim.z;
    unsigned sum, cnt, mine, sp = 0u;
    for (;;) {
        sum = 0u; cnt = 0u; mine = 0u;
#pragma unroll
        for (unsigned j = 0; j < 16; ++j) { const unsigned c = xb_ld(&bar[XB_XCNT(j)]); sum += c; cnt += (c > 0u) ? 1u : 0u; mine = (j == x) ? c : mine; }
        if (sum == G) break;
        __builtin_amdgcn_s_sleep(1);
        if ((++sp & 255u) == 0u) { if (xb_ld(&bar[XB_TMO])) break; if (sp > XB_SPIN_CAP) { atomicAdd(&bar[XB_TMO], 1u); break; } }
    }
    nloc = mine > 0u ? mine : 1u; nx = cnt > 0u ? cnt : 1u;
}

__device__ __forceinline__ void xcd_barrier(const XcdBarrier& b) {
    asm volatile("s_waitcnt vmcnt(0)" ::: "memory");
    __syncthreads();
    if (threadIdx.x == 0) {
        unsigned* bar = b.bar;
        __builtin_amdgcn_s_waitcnt(0);
        unsigned nloc = b.st[0], nx = b.st[1];
        if (nloc == 0u) { xcd_barrier_complete(bar, b.x, nloc, nx); b.st[0] = nloc; b.st[1] = nx; }
        const unsigned old = xb_add(&bar[XB_XSUB(b.x)], 1u);
        const unsigned gen = old / nloc;
        if (old + 1u == (gen + 1u) * nloc) {
            __builtin_amdgcn_fence(__ATOMIC_RELEASE, "agent");
            asm volatile("s_waitcnt vmcnt(0)" ::: "memory");
            const unsigned og = xb_add(&bar[XB_TOP], 1u);
            const unsigned tg = og / nx;
            if (og + 1u == (tg + 1u) * nx) xb_add(&bar[XB_TOPGEN], 1u);
            else XB_SPIN(xb_ld(&bar[XB_TOPGEN]) == tg, bar);
            __builtin_amdgcn_fence(__ATOMIC_ACQUIRE, "agent");
            xb_add(&bar[XB_XGEN(b.x)], 1u);
            asm volatile("s_waitcnt vmcnt(0)" ::: "memory");
        } else {
            XB_SPIN(xb_ld(&bar[XB_XGEN(b.x)]) == gen, bar);
            __builtin_amdgcn_fence(__ATOMIC_ACQUIRE, "agent");
            asm volatile("s_waitcnt vmcnt(0)" ::: "memory");
        }
    }
    __syncthreads();
}

#ifndef PHMASK
#define PHMASK 0xFFFFF
#endif
#define PH(k) if ((PHMASK >> (k)) & 1)
struct Args { const float* in[25]; float* out; unsigned char* ws; };
__device__ __forceinline__ const float* karg(int i) {
    unsigned off = (unsigned)i * 8u; asm volatile("" : "+s"(off));
    return *(const float* const __attribute__((address_space(4)))*)((const char __attribute__((address_space(4)))*)__builtin_amdgcn_kernarg_segment_ptr() + off);
}

__global__ void __launch_bounds__(NTHR, 2) hymba_fwd(Args a) {
    extern __shared__ __attribute__((aligned(16))) unsigned char lds[];
    cg::grid_group grid = cg::this_grid();
    const int tid = threadIdx.x, lane = tid & 63, wave = __builtin_amdgcn_readfirstlane(tid >> 6);
    const int G = gridDim.x, bx = blockIdx.x;
    const int vcu = (G % 8 == 0) ? (bx % 8) * (G / 8) + bx / 8 : bx;
    const int gw = vcu * NWAVES + wave, NGW = G * NWAVES;
    LAS unsigned char* ldsl = (LAS unsigned char*)lds;
#define KIN(i) karg(i)
#define ws_p ((unsigned char*)karg(26))
#define out_p ((float*)karg(25))
#define x_in KIN(0)
#define cvec KIN(1)
#define ctx KIN(2)
#define c_ctx KIN(3)
#define w_mod KIN(4)
#define b_mod KIN(5)
#define norm_g KIN(6)
#define ffn_w_in KIN(7)
#define ffn_w_out KIN(8)
#define w_in KIN(9)
#define w_out KIN(10)
#define ssm_a_re KIN(11)
#define ssm_a_im KIN(12)
#define ssm_log_dt KIN(13)
#define ssm_b_re KIN(14)
#define ssm_b_im KIN(15)
#define ssm_c_re KIN(16)
#define ssm_c_im KIN(17)
#define ssm_d KIN(18)
#define w_glu KIN(19)
#define b_glu KIN(20)
#define lam_q KIN(21)
#define lam_k KIN(22)
#define subln_g KIN(23)
#define final_g KIN(24)
#define MISC ((float*)(ws_p + WS_CTL))
#define MOD ((float*)(ws_p + WS_MOD))
#define ABAR ((float2*)(ws_p + WS_ABAR))
#define APOW ((float2*)(ws_p + WS_APOW))
#define BBT ((bf16*)(ws_p + WS_BBT))
#define CM ((bf16*)(ws_p + WS_CM))
#define ROPE ((float*)(ws_p + WS_ROPE))
#define W1A ((bf16*)(ws_p + WS_W1A))
#define W1B ((bf16*)(ws_p + WS_W1B))
#define W2A ((bf16*)(ws_p + WS_W2A))
#define W2B ((bf16*)(ws_p + WS_W2B))
#define WIN ((bf16*)(ws_p + WS_WIN))
#define WOUT ((bf16*)(ws_p + WS_WOUT))
#define WGLU ((bf16*)(ws_p + WS_WGLU))
#define EST ((float2*)(ws_p + WS_E))
#define HIN ((float2*)(ws_p + WS_HIN))
#define XC ((float*)(ws_p + WS_XC))
#define XN ((bf16*)(ws_p + WS_XN))
#define SA ((bf16*)(ws_p + WS_XN))
#define ACT ((bf16*)(ws_p + WS_ACT))
#define OATT ((float*)(ws_p + WS_OATT))
#define GB ((bf16*)(ws_p + WS_G))
#define YFB ((float*)(ws_p + WS_OATT + 132 * MiB))
#define BIAS1 ((float*)(ws_p + WS_BIAS1))
#define BIAS2 ((float*)(ws_p + WS_BIAS2))
#define RSS1 ((float*)(ws_p + WS_RSS1))
#define RSS2 ((float*)(ws_p + WS_RSS2))
#define XN2 ((bf16*)(ws_p + WS_U))
#define UB ((bf16*)(ws_p + WS_U))
#define QB ((bf16*)(ws_p + WS_Q))
#define KB ((bf16*)(ws_p + WS_K))
#define VB ((bf16*)(ws_p + WS_V))
    (void)a;
    { volatile LAS unsigned* st0 = (volatile LAS unsigned*)(ldsl + 138240); if (tid < 4) st0[tid] = 0u; }
    __syncthreads();
    XcdBarrier xbar = xcd_barrier_post((unsigned*)(ws_p + WS_BAR), (volatile LAS unsigned*)(ldsl + 138240));
#define GSYNC() xcd_barrier(xbar)

    PH(0) {
        if (bx < 288) {
            LAS float* sl = (LAS float*)ldsl; LAS float* part = (LAS float*)(ldsl + 36864);
            for (int i = tid; i < 9 * DM; i += NTHR) { const float v = i < 8 * DM ? cvec[i] : c_ctx[i - 8 * DM]; sl[i] = v / (1.0f + __expf(-v)); }
            __syncthreads();
            for (int unit = bx; unit < 288; unit += G) {
                const int cl = tid & 31, kg = tid >> 5, k0 = kg * 64; const float* wp = w_mod + (size_t)k0 * NMODV + unit * 32 + cl;
                float acc[9];
#pragma unroll
                for (int i = 0; i < 9; ++i) acc[i] = 0.f;
                float wv[64];
#pragma unroll
                for (int kk = 0; kk < 64; ++kk) wv[kk] = wp[(size_t)kk * NMODV];
#pragma unroll
                for (int kk = 0; kk < 64; kk += 4) {
#pragma unroll
                    for (int i = 0; i < 9; ++i) { const f32x4 sv = *(const LAS f32x4*)(sl + i * DM + k0 + kk); acc[i] = fmaf(sv.x, wv[kk], fmaf(sv.y, wv[kk + 1], fmaf(sv.z, wv[kk + 2], fmaf(sv.w, wv[kk + 3], acc[i])))); }
                }
#pragma unroll
                for (int i = 0; i < 9; ++i) part[(kg * 9 + i) * 32 + cl] = acc[i];
                __syncthreads();
                if (tid < 288) { const int i = tid >> 5; float sum = 0.f;
#pragma unroll
                    for (int k = 0; k < 16; ++k) sum += part[(k * 9 + i) * 32 + cl];
                    MOD[i * NMODV + unit * 32 + cl] = sum + b_mod[unit * 32 + cl]; }
                __syncthreads();
            }
        }
        __syncthreads();
        {
            LAS float* scr = (LAS float*)(ldsl + wave * 16384);
            constexpr int I_1A = (DM / 64) * (2 * DFF / 32);
            for (int it = gw; it < I_1A; it += NGW) transpose_item(ffn_w_in, DM, 2 * DFF, W1A, 1, scr, it, lane);
        }
        const int gt = bx * NTHR + tid, NT_ALL = G * NTHR;
        for (int i = gt; i < 2 * 32 * 64; i += NT_ALL) {
            const int p = i & 63, dg = i >> 6;
            const double dt = dexp((double)ssm_log_dt[dg]), are = (double)ssm_a_re[i], aim = (double)ssm_a_im[i];
            double s1, c1, s2, c2; dsincos(dt * aim, s1, c1); dsincos(256.0 * dt * aim, s2, c2);
            const double mag = dexp(dt * are), mag2 = dexp(256.0 * dt * are);
            const double abr = mag * c1, abi = mag * s1;
            ABAR[i] = make_float2((float)abr, (float)abi); APOW[i] = make_float2((float)(mag2 * c2), (float)(mag2 * s2));
            const double zr = abr - 1.0, zi = abi, den = are * are + aim * aim;
            const double cr = (zr * are + zi * aim) / den, ci = (zi * are - zr * aim) / den;
            const float* bre = ssm_b_re + (size_t)i * 16; const float* bim = ssm_b_im + (size_t)i * 16;
            bf16* dre = BBT + ((size_t)(dg * 4 + (p >> 5)) * 32 + (p & 31)) * 16; bf16* dim = BBT + ((size_t)(dg * 4 + 2 + (p >> 5)) * 32 + (p & 31)) * 16;
#pragma unroll
            for (int h = 0; h < 16; ++h) { const double br = (double)bre[h], bi = (double)bim[h]; dre[h] = (bf16)f2bf((float)(cr * br - ci * bi)); dim[h] = (bf16)f2bf((float)(cr * bi + ci * br)); }
        }
        for (int i = gt; i < 2 * 32 * 16 * 64; i += NT_ALL) {
            const int p = i & 63, dgh = i >> 6;
            ((unsigned*)CM)[(size_t)dgh * 64 + p] = pk2(ssm_c_re[i], -ssm_c_im[i]);
        }
        for (int i = gt; i < 128 * 16; i += NT_ALL) {
            const int f = i & 15, pos = i >> 4;
            const double inv = dexp(-(double)f * (9.210340371976182736 / 16.0)); double s, c; dsincos((double)pos * inv, s, c);
            ROPE[2 * i] = (float)c; ROPE[2 * i + 1] = (float)s;
        }
        for (int i = gt; i < NROWS; i += NT_ALL) { RSS1[i] = 0.f; RSS2[i] = 0.f; }
        if (gt == 0) { float s0 = 0.f, s1 = 0.f; for (int d = 0; d < 64; ++d) { s0 += lam_q[d] * lam_k[d]; s1 += lam_q[64 + d] * lam_k[64 + d]; } MISC[0] = expf(s0) - expf(s1) + 0.2f; }
    }
    grid.sync();

#define NORM_PASS(SRC_LAT, SRC_CTX, NIDX, LATONLY) do { int tid_l = threadIdx.x; asm volatile("" : "+v"(tid_l)); const int lane_l = tid_l & 63, gw_l = vcu * NWAVES + __builtin_amdgcn_readfirstlane(tid_l >> 6); \
        for (int it = gw_l; it < NROWS / 16; it += NGW) { const int r0 = it * 16, pm = r0 >> 8, b = pm / TILES_B, jt = pm - b * TILES_B, rl = r0 & 255; \
            if ((LATONLY) && jt == 32) continue; \
            const float* src = jt < 32 ? (SRC_LAT) + ((size_t)b * SEQ + jt * 256 + rl) * DM : (SRC_CTX) + ((size_t)b * CTXL + rl) * DM; \
            const float* mv = MOD + (jt < 32 ? b : 8) * NMODV + 3 * (NIDX) * DM; \
            norm_rows16<0>(src, XN + (size_t)r0 * DM, nullptr, norm_g + (NIDX) * DM, mv, mv + DM, lane_l); } } while (0)

    PH(1) {
        if (bx < 240) {
            const bool isin = bx < 64; const int unit = isin ? bx : bx - 64, N = isin ? 2048 : 2 * DFF, soff = isin ? 3 * DM : 6 * DM;
            const float* W = isin ? w_in : ffn_w_in + (size_t)DM * 2 * DFF; float* BO = isin ? BIAS1 : BIAS2;
            LAS float* sl = (LAS float*)ldsl; LAS float* part = (LAS float*)(ldsl + 36864);
            for (int i = tid; i < 9 * DM; i += NTHR) sl[i] = MOD[(i >> 10) * NMODV + soff + (i & 1023)];
            __syncthreads();
            const int cl = tid & 31, kg = tid >> 5, k0 = kg * 64; const float* wp = W + (size_t)k0 * N + unit * 32 + cl;
            float acc[9];
#pragma unroll
            for (int i = 0; i < 9; ++i) acc[i] = 0.f;
            float wv[64];
#pragma unroll
            for (int kk = 0; kk < 64; ++kk) wv[kk] = wp[(size_t)kk * N];
#pragma unroll
            for (int kk = 0; kk < 64; kk += 4) {
#pragma unroll
                for (int i = 0; i < 9; ++i) { const f32x4 sv = *(const LAS f32x4*)(sl + i * DM + k0 + kk); acc[i] = fmaf(sv.x, wv[kk], fmaf(sv.y, wv[kk + 1], fmaf(sv.z, wv[kk + 2], fmaf(sv.w, wv[kk + 3], acc[i])))); }
            }
#pragma unroll
            for (int i = 0; i < 9; ++i) part[(kg * 9 + i) * 32 + cl] = acc[i];
            __syncthreads();
            if (tid < 288) { const int i = tid >> 5; float sum = 0.f;
#pragma unroll
                for (int k = 0; k < 16; ++k) sum += part[(k * 9 + i) * 32 + cl];
                const int src = unit * 32 + cl; int drow = src;
                if (isin) { if (src >= 512 && src < 1536) drow = unit * 32 + 2 * (cl & 15) + (cl >> 4); }
                else { const int up = src >= DFF ? 1 : 0, ff = src - up * DFF; drow = (ff >> 7) * 256 + up * 128 + (ff & 127); }
                BO[i * N + drow] = sum; }
            __syncthreads();
        }
        NORM_PASS(x_in, ctx, 0, false);
    }
    GSYNC();
    PH(2) { pg8::Gemm g{XN, W1A, NROWS, 2 * DFF, DM}; pg8::TileOrder S; S.init(264, 22, G, bx, 0); pg8::EpiSwiglu E{ACT, DFF, nullptr, nullptr};
      pg8::gemm_phase<pg8::EpiSwiglu, pg8::TileOrder, true, true>(ldsl, g, S, E);
      if (bx >= 176) {
          int tid_l = threadIdx.x; asm volatile("" : "+v"(tid_l)); const int lane_l = tid_l & 63, wave_l = __builtin_amdgcn_readfirstlane(tid_l >> 6);
          LAS float* scr = (LAS float*)(ldsl + wave_l * 16384);
          constexpr int I_1B = (DFF / 64) * (DM / 32);
          for (int it = (bx - 176) * NWAVES + wave_l; it < I_1B; it += (G - 176) * NWAVES) transpose_item(ffn_w_out, DFF, DM, W1B, 0, scr, it, lane_l);
      } }
    GSYNC();
    PH(3) { pg8::Gemm g{ACT, W1B, NROWS, DM, DFF}; pg8::TileOrder S; S.init(264, 4, G, bx, 0); pg8::EpiResidNorm E{x_in, ctx, out_p, XC, MOD, 2 * DM, 1, norm_g + DM, 4 * DM, XN, RSS1};
      pg8::gemm_phase<pg8::EpiResidNorm, pg8::TileOrder, true, true>(ldsl, g, S, E);
      if (bx >= 32) {
          int tid_l = threadIdx.x; asm volatile("" : "+v"(tid_l)); const int lane_l = tid_l & 63, wave_l = __builtin_amdgcn_readfirstlane(tid_l >> 6);
          LAS float* scr = (LAS float*)(ldsl + wave_l * 16384);
          constexpr int I_1A = (DM / 64) * (2 * DFF / 32), I_1B = (DFF / 64) * (DM / 32), I_OUT = (DM / 64) * (DM / 32), I_GLU = (512 / 64) * (512 / 32), I_IN = (DM / 64) * (2048 / 32);
          for (int it = (bx - 32) * NWAVES + wave_l; it < I_IN + I_1A + I_1B + I_OUT + I_GLU; it += (G - 32) * NWAVES) {
              int r = it;
              if (r < I_IN) { transpose_item(w_in, DM, 2048, WIN, 2, scr, r, lane_l); continue; } r -= I_IN;
              if (r < I_1A) { transpose_item(ffn_w_in + (size_t)DM * 2 * DFF, DM, 2 * DFF, W2A, 1, scr, r, lane_l); continue; } r -= I_1A;
              if (r < I_1B) { transpose_item(ffn_w_out + (size_t)DFF * DM, DFF, DM, W2B, 0, scr, r, lane_l); continue; } r -= I_1B;
              if (r < I_OUT) { transpose_item(w_out, DM, DM, WOUT, 0, scr, r, lane_l); continue; } r -= I_OUT;
              transpose_item(w_glu, 512, 512, WGLU, 0, scr, r, lane_l);
          }
      } }
    GSYNC();
    PH(5) { pg8::Gemm g{XN, WIN, NROWS, 2048, DM}; pg8::TileOrder S; S.init(264, 8, G, bx, 0); pg8::EpiInproj E{UB, QB, KB, VB, ROPE, RSS1, BIAS1};
      pg8::gemm_phase<pg8::EpiInproj, pg8::TileOrder, true, true>(ldsl, g, S, E); }
    GSYNC();
    PH(6) for (int un = vcu; un < 8 * 33 * 4; un += G) { const int gq = un & 3, bc = un >> 2, b = bc / 33, c = bc - b * 33;
        s5_unit_a(ldsl, b, c, gq, UB, ABAR, BBT, EST); }
    GSYNC();
    PH(7) if (bx < 64) {
        int tid_c = threadIdx.x; asm volatile("" : "+v"(tid_c));
        const int i = bx * NTHR + tid_c;
        const int p = i & 63, dir = (i >> 6) & 1, g = (i >> 7) & 31, b = i >> 12;
        const float2 ap = APOW[(dir * 32 + g) * 64 + p];
#define SIDX(cc) (((((size_t)b * 33 + (cc)) * 32 + g) * 2 + dir) * 64 + p)
        float2 h = EST[SIDX(32)];
        if (dir == 0) { HIN[SIDX(0)] = h; for (int c = 0; c < 31; ++c) { const float2 e = EST[SIDX(c)]; const float nr = fmaf(ap.x, h.x, fmaf(-ap.y, h.y, e.x)), ni = fmaf(ap.x, h.y, fmaf(ap.y, h.x, e.y)); h = make_float2(nr, ni); HIN[SIDX(c + 1)] = h; } }
        else { HIN[SIDX(31)] = h; for (int c = 31; c > 0; --c) { const float2 e = EST[SIDX(c)]; const float nr = fmaf(ap.x, h.x, fmaf(-ap.y, h.y, e.x)), ni = fmaf(ap.x, h.y, fmaf(ap.y, h.x, e.y)); h = make_float2(nr, ni); HIN[SIDX(c - 1)] = h; } }
#undef SIDX
    }
    PH(8) {
        const float lam = MISC[0];
        unsigned redo_mask = 0u;
        {
        int k_ = 0;
        for (int un = vcu; un < 8 * 4 * 32; un += G, ++k_) {
            const int qb = un & 31, bh = un >> 5, b = bh >> 2, h = bh & 3;
            const size_t rb = (size_t)b * ROWS_B, rq = rb + (size_t)qb * 256;
            const attn::bf16_t* q0 = QB + rq * 512 + h * 128; const attn::bf16_t* k0 = KB + rb * 512 + h * 128; const attn::bf16_t* v0 = VB + rb * 512 + h * 128;
            float* st = OATT + rq * 512 + h * 128; attn::bf16_t* so = SA + rq * 1024 + 512 + h * 128;
            bool redo = attn::body<0, false>(q0, k0, v0, st, nullptr, lam, subln_g, ROWS_B, (char*)lds);
            if (!redo) redo = attn::body<1, false>(q0 + 64, k0 + 64, v0, st, so, lam, subln_g, ROWS_B, (char*)lds);
            if (redo) redo_mask |= 1u << k_;
        }
        }
        if (redo_mask) {
            int k_ = 0;
            for (int un = vcu; un < 8 * 4 * 32; un += G, ++k_) {
                if (!((redo_mask >> k_) & 1u)) continue;
                const int qb = un & 31, bh = un >> 5, b = bh >> 2, h = bh & 3;
                const size_t rb = (size_t)b * ROWS_B, rq = rb + (size_t)qb * 256;
                const attn::bf16_t* q0 = QB + rq * 512 + h * 128; const attn::bf16_t* k0 = KB + rb * 512 + h * 128; const attn::bf16_t* v0 = VB + rb * 512 + h * 128;
                float* st = OATT + rq * 512 + h * 128; attn::bf16_t* so = SA + rq * 1024 + 512 + h * 128;
                (void)attn::body<0, true>(q0, k0, v0, st, nullptr, lam, subln_g, ROWS_B, (char*)lds);
                (void)attn::body<1, true>(q0 + 64, k0 + 64, v0, st, so, lam, subln_g, ROWS_B, (char*)lds);
            }
        }
    }
    GSYNC();
    PH(9) for (int un = vcu; un < 8 * 32 * 4; un += G) { const int gq = un & 3, bc = un >> 2, b = bc >> 5, c = bc & 31;
        s5_unit<true>(ldsl, b, c, gq, UB, ABAR, BBT, CM, HIN, EST, ssm_d, GB, YFB); }
    GSYNC();
    PH(10) { pg8::Gemm g{GB, WGLU, NROWS, 512, 512}; pg8::TileOrder S; S.init(256, 2, G, bx, 1); pg8::EpiGlu E{GB, b_glu, SA};
      pg8::gemm_phase<pg8::EpiGlu, pg8::TileOrder, true, true>(ldsl, g, S, E); }
    GSYNC();
    PH(12) { pg8::Gemm g{SA, WOUT, NROWS, DM, DM}; pg8::TileOrder S; S.init(256, 4, G, bx, 1); pg8::EpiResidNorm E{out_p, XC, out_p, XC, MOD, 5 * DM, 0, norm_g + 2 * DM, 7 * DM, XN2, RSS2};
      pg8::gemm_phase<pg8::EpiResidNorm, pg8::TileOrder, true, true>(ldsl, g, S, E); }
    GSYNC();
    PH(14) { pg8::Gemm g{XN2, W2A, NROWS, 2 * DFF, DM}; pg8::TileOrder S; S.init(256, 22, G, bx, 1); pg8::EpiSwiglu E{ACT, DFF, RSS2, BIAS2};
      pg8::gemm_phase<pg8::EpiSwiglu, pg8::TileOrder, true, true>(ldsl, g, S, E); }
    GSYNC();
    PH(15) { pg8::Gemm g{ACT, W2B, NROWS, DM, DFF}; pg8::TileOrder S; S.init(256, 4, G, bx, 1); pg8::EpiResid E{out_p, XC, out_p, XC, MOD, 8 * DM, 0.5f};
      pg8::gemm_phase<pg8::EpiResid, pg8::TileOrder, true, true>(ldsl, g, S, E); }
    GSYNC();
    PH(16) { int tid_l = threadIdx.x; asm volatile("" : "+v"(tid_l)); const int lane_l = tid_l & 63, gw_l = vcu * NWAVES + __builtin_amdgcn_readfirstlane(tid_l >> 6);
        for (int it = gw_l; it < NB * SEQ / 16; it += NGW) norm_rows16<1>(out_p + (size_t)it * 16 * DM, nullptr, out_p + (size_t)it * 16 * DM, final_g, nullptr, nullptr, lane_l); }
#undef NORM_PASS
}

extern "C" void kernel_launch(void* const* d_in, const int* in_sizes, int n_in, void* d_out, int out_size, void* d_ws, size_t ws_size, hipStream_t stream) {
    static int grid = 0;
    if (grid == 0) {
        if (n_in != 25 || in_sizes[0] != NB * SEQ * DM || out_size != NB * SEQ * DM || ws_size < WS_END) {
            fprintf(stderr, "kernel_launch: shape mismatch (n_in %d, in0 %d, out %d, ws %zu, need %zu); nothing launched\n", n_in, n_in > 0 ? in_sizes[0] : -1, out_size, ws_size, (size_t)WS_END); grid = -1; return; }
        int dev = 0, cus = 0, per_cu = 0;
        if (hipGetDevice(&dev) != hipSuccess || hipDeviceGetAttribute(&cus, hipDeviceAttributeMultiprocessorCount, dev) != hipSuccess) { grid = -1; return; }
        if (hipFuncSetAttribute((const void*)hymba_fwd, hipFuncAttributeMaxDynamicSharedMemorySize, LDS_BYTES) != hipSuccess) { fprintf(stderr, "kernel_launch: hipFuncSetAttribute failed\n"); grid = -1; return; }
        if (hipOccupancyMaxActiveBlocksPerMultiprocessor(&per_cu, (const void*)hymba_fwd, NTHR, LDS_BYTES) != hipSuccess || per_cu < 1) { fprintf(stderr, "kernel_launch: occupancy query says %d\n", per_cu); per_cu = 1; }
        (void)hipGetLastError();
        grid = cus * (per_cu > 1 ? 1 : per_cu);
        if (grid != 256) fprintf(stderr, "kernel_launch: grid %d (expected 256)\n", grid);
    }
    if (grid < 0) return;
    (void)hipMemsetAsync((char*)d_ws + WS_BAR, 0, BAR_ZERO_BYTES, stream);
    Args a{};
    for (int i = 0; i < 25; ++i) a.in[i] = (const float*)d_in[i];
    a.out = (float*)d_out; a.ws = (unsigned char*)d_ws;
    void* args[] = {&a};
    const hipError_t e = hipLaunchCooperativeKernel((const void*)hymba_fwd, dim3(grid), dim3(NTHR), args, LDS_BYTES, stream);
    if (e != hipSuccess) fprintf(stderr, "kernel_launch: cooperative launch failed: %s (grid %d)\n", hipGetErrorString(e), grid);
}
```

```cpp
#include <hip/hip_runtime.h>
#include <hip/hip_cooperative_groups.h>
#include <cstdio>
#include <cstdint>
namespace cg = cooperative_groups;
namespace pg8 {
#define PG8_LAS __attribute__((address_space(3)))
typedef unsigned short bf16_t;
typedef short bf16x8 __attribute__((ext_vector_type(8)));
typedef float f32x4 __attribute__((ext_vector_type(4)));
typedef unsigned u32x4 __attribute__((ext_vector_type(4)));
constexpr int BM = 256, BK = 64, HALF = 128, HTB = HALF * BK * 2  , STAGE_BYTES = 8 * HTB, NXCD = 8, WGM = 8;

__host__ __device__ __forceinline__ int lds_byte(int r, int c) { const int st = (r >> 4) * 2 + (c >> 5), rr = r & 15, cc = c & 31, ob = rr * 64 + cc * 2; return st * 1024 + (ob ^ (((ob >> 9) & 1) << 5)); }
__host__ __device__ __forceinline__ void stage_rc(int b, int& R, int& C) { const int st = b / 1024, sb = b % 1024, swz = sb ^ (((sb >> 9) & 1) << 5); R = (st >> 1) * 16 + swz / 64; C = (st & 1) * 32 + (swz % 64) / 2; }
__host__ __device__ __forceinline__ int perm32(int rho) { const int n = rho >> 4, i = rho & 15; return 8 * (i >> 2) + 4 * n + (i & 3); }

struct Unit { int pm, pn; };
struct Gemm { const bf16_t* A; const bf16_t* Bt; int M, N, K; };

__device__ __forceinline__ unsigned cvt_pk_bf16(float lo, float hi) { unsigned r; asm volatile("v_cvt_pk_bf16_f32 %0, %1, %2" : "=v"(r) : "v"(lo), "v"(hi)); return r; }
typedef float f32x2 __attribute__((ext_vector_type(2)));
typedef unsigned u32x2 __attribute__((ext_vector_type(2)));
constexpr int ROWS_B = 8448, TILES_B = 33, NROWS = 8 * ROWS_B;

struct TileOrder {
    int nM, nN, nwg, G, c, lat;
    __device__ __forceinline__ void init(int nM_, int nN_, int G_, int c_, int lat_) { nM = nM_; nN = nN_; nwg = nM_ * nN_; G = G_; c = c_; lat = lat_; }
    __device__ __forceinline__ bool next(int i, Unit& u) const {
        const long L = (long)i * G + c; if (L >= nwg) return false;
        int wgid = (int)L; { const int q = nwg / NXCD, r = nwg % NXCD, xcd = wgid % NXCD, off = wgid / NXCD; wgid = (xcd < r ? xcd * (q + 1) : r * (q + 1) + (xcd - r) * q) + off; }
        const int nig = WGM * nN, gid = wgid / nig, fm = gid * WGM, gsz = (nM - fm) < WGM ? (nM - fm) : WGM;
        const int lm = fm + ((wgid % nig) % gsz); u.pn = (wgid % nig) / gsz; u.pm = lat ? (lm >> 5) * TILES_B + (lm & 31) : lm; return true;
    }
    __device__ __forceinline__ void a_ready(const Unit&) const {}
    __device__ __forceinline__ void done(const Unit&) const {}
};

__device__ __forceinline__ float fast_sigmoid(float z) { return __builtin_amdgcn_rcpf(1.0f + __builtin_amdgcn_exp2f(-1.4426950408889634f * z)); }
__device__ __forceinline__ float bf_lo(unsigned w) { return __uint_as_float(w << 16); }
__device__ __forceinline__ float bf_hi(unsigned w) { return __uint_as_float(w & 0xffff0000u); }

struct EpiSwiglu {
    static constexpr bool PERM = true, AFTER_DRAIN = false;
    bf16_t* O; int ldc; const float* rss; const float* bias;
    __device__ __forceinline__ void operator()(const f32x4 (&acc)[2][2][4][2], const Unit& u, int wr, int wc, int fr, int fq) const {
        const int row0 = u.pm * BM + wr * 64 + fr, col0 = u.pn * HALF + wc * 32 + 8 * fq;
        f32x4 bv[2][2];
#pragma unroll
        for (int bj = 0; bj < 2; ++bj)
#pragma unroll
            for (int n = 0; n < 2; ++n) bv[bj][n] = rss ? *(const f32x4*)(bias + (u.pm / TILES_B) * 5632 + u.pn * BM + bj * HALF + wc * 32 + 8 * fq + 4 * n) : (f32x4){0.f, 0.f, 0.f, 0.f};
#pragma unroll
        for (int ai = 0; ai < 2; ++ai)
#pragma unroll
            for (int m = 0; m < 4; ++m) {
                bf16_t* rowp = O + (size_t)(row0 + ai * HALF + m * 16) * ldc + col0;
                float v[8];
                const float rstd = rss ? 1.0f / sqrtf(rss[row0 + ai * HALF + m * 16] * (1.0f / 1024.0f) + 1e-6f) : 1.0f;
#pragma unroll
                for (int n = 0; n < 2; ++n)
#pragma unroll
                    for (int e = 0; e < 4; ++e) { const float gt = acc[ai][0][m][n][e] * rstd + bv[0][n][e], up = acc[ai][1][m][n][e] * rstd + bv[1][n][e]; v[4 * n + e] = gt * fast_sigmoid(gt) * up; }
                u32x4 w; w.x = cvt_pk_bf16(v[0], v[1]); w.y = cvt_pk_bf16(v[2], v[3]); w.z = cvt_pk_bf16(v[4], v[5]); w.w = cvt_pk_bf16(v[6], v[7]);
                *(u32x4*)rowp = w;
            }
    }
};

struct EpiResid {
    static constexpr bool PERM = true, AFTER_DRAIN = false;
    const float* res_lat; const float* res_ctx; float* out_lat; float* out_ctx; const float* mod; int modoff; float scale;
    __device__ __forceinline__ void operator()(const f32x4 (&acc)[2][2][4][2], const Unit& u, int wr, int wc, int fr, int fq) const {
        const int b = u.pm / TILES_B, jt = u.pm - b * TILES_B;
        const float* rb; float* ob; const float* gv;
        if (jt < 32) { const size_t o = ((size_t)b * 8192 + (size_t)jt * 256) * 1024; rb = res_lat + o; ob = out_lat + o; gv = mod + b * 9216 + modoff; }
        else { const size_t o = (size_t)b * 256 * 1024; rb = res_ctx + o; ob = out_ctx + o; gv = mod + 8 * 9216 + modoff; }
        const int rl = wr * 64 + fr, col0 = u.pn * BM + wc * 32 + 8 * fq;
        f32x4 g[2][2];
#pragma unroll
        for (int bj = 0; bj < 2; ++bj)
#pragma unroll
            for (int n = 0; n < 2; ++n) g[bj][n] = *(const f32x4*)(gv + col0 + bj * HALF + 4 * n) * scale;
#pragma unroll
        for (int ai = 0; ai < 2; ++ai)
#pragma unroll
            for (int m = 0; m < 4; ++m) { const size_t ro = (size_t)(rl + ai * HALF + m * 16) * 1024 + col0;
#pragma unroll
                for (int bj = 0; bj < 2; ++bj)
#pragma unroll
                    for (int n = 0; n < 2; ++n) { const size_t p = ro + bj * HALF + 4 * n; const f32x4 x = *(const f32x4*)(rb + p); *(f32x4*)(ob + p) = x + g[bj][n] * acc[ai][bj][m][n]; } }
    }
};

struct EpiResidNorm {
    static constexpr bool PERM = true, AFTER_DRAIN = false;
    const float* res_lat; const float* res_ctx; float* out_lat; float* out_ctx; const float* mod; int gateoff; int half_gate; const float* ng; int scaleoff; bf16_t* XNo; float* rss;
    __device__ __forceinline__ void operator()(const f32x4 (&acc)[2][2][4][2], const Unit& u, int wr, int wc, int fr, int fq) const {
        const int b = u.pm / TILES_B, jt = u.pm - b * TILES_B;
        const float* rb; float* ob; const float* mv;
        if (jt < 32) { const size_t o = ((size_t)b * 8192 + (size_t)jt * 256) * 1024; rb = res_lat + o; ob = out_lat + o; mv = mod + b * 9216; }
        else { const size_t o = (size_t)b * 256 * 1024; rb = res_ctx + o; ob = out_ctx + o; mv = mod + 8 * 9216; }
        const int rl = wr * 64 + fr, col0 = u.pn * BM + wc * 32 + 8 * fq;
        const float scale = half_gate ? 0.5f : 1.0f;
        float q[2][4];
#pragma unroll
        for (int ai = 0; ai < 2; ++ai)
#pragma unroll
            for (int m = 0; m < 4; ++m) q[ai][m] = 0.f;
#pragma unroll
        for (int bj = 0; bj < 2; ++bj) {
            const int c = col0 + bj * HALF;
            const f32x4 g0 = *(const f32x4*)(mv + gateoff + c) * scale, g1 = *(const f32x4*)(mv + gateoff + c + 4) * scale;
            const f32x4 gs0 = *(const f32x4*)(ng + c) * (*(const f32x4*)(mv + scaleoff + c) + 1.0f), gs1 = *(const f32x4*)(ng + c + 4) * (*(const f32x4*)(mv + scaleoff + c + 4) + 1.0f);
#pragma unroll
            for (int ai = 0; ai < 2; ++ai)
#pragma unroll
                for (int m = 0; m < 4; ++m) { const int rr = rl + ai * HALF + m * 16; const size_t p = (size_t)rr * 1024 + c; const size_t prow = (size_t)u.pm * BM + rr;
                    const f32x4 y0 = *(const f32x4*)(rb + p) + g0 * acc[ai][bj][m][0], y1 = *(const f32x4*)(rb + p + 4) + g1 * acc[ai][bj][m][1];
                    *(f32x4*)(ob + p) = y0; *(f32x4*)(ob + p + 4) = y1;
                    q[ai][m] += (y0[0] * y0[0] + y0[1] * y0[1]) + (y0[2] * y0[2] + y0[3] * y0[3]) + (y1[0] * y1[0] + y1[1] * y1[1]) + (y1[2] * y1[2] + y1[3] * y1[3]);
                    const f32x4 z0 = y0 * gs0, z1 = y1 * gs1;
                    u32x4 w; w.x = cvt_pk_bf16(z0[0], z0[1]); w.y = cvt_pk_bf16(z0[2], z0[3]); w.z = cvt_pk_bf16(z1[0], z1[1]); w.w = cvt_pk_bf16(z1[2], z1[3]);
                    *(u32x4*)(XNo + prow * 1024 + c) = w;
                    if (m & 1) asm volatile("" ::: "memory"); }
        }
#pragma unroll
        for (int ai = 0; ai < 2; ++ai)
#pragma unroll
            for (int m = 0; m < 4; ++m) { float t = q[ai][m]; t += __shfl_xor(t, 16); t += __shfl_xor(t, 32);
                if (fq == 0) __hip_atomic_fetch_add((__attribute__((address_space(1))) float*)(rss + (size_t)u.pm * BM + rl + ai * HALF + m * 16), t, __ATOMIC_RELAXED, __HIP_MEMORY_SCOPE_AGENT); }
    }
};

struct EpiInproj {
    static constexpr bool PERM = true, AFTER_DRAIN = false;
    bf16_t* U; bf16_t* Q; bf16_t* K; bf16_t* V; const float* rope; const float* rss; const float* bias;
    __device__ __forceinline__ void operator()(const f32x4 (&acc)[2][2][4][2], const Unit& u, int wr, int wc, int fr, int fq) const {
        const int sec = u.pn >> 1, jt = u.pm % TILES_B;
        bf16_t* base = sec == 0 ? U : sec == 1 ? Q : sec == 2 ? K : V;
        const bool dorope = (sec == 1 || sec == 2) && jt < 32;
        const float qs = sec == 1 ? 0.125f * 1.4426950408889634f : 1.0f;
        const int col0 = (u.pn & 1) * BM + wc * 32 + 8 * fq, axis = wc & 1;
        const float* bp = bias + (jt < 32 ? u.pm / TILES_B : 8) * 2048 + u.pn * BM + wc * 32 + 8 * fq;
        f32x4 bv[2][2];
#pragma unroll
        for (int bj = 0; bj < 2; ++bj)
#pragma unroll
            for (int n = 0; n < 2; ++n) bv[bj][n] = *(const f32x4*)(bp + bj * HALF + 4 * n);
#pragma unroll
        for (int ai = 0; ai < 2; ++ai)
#pragma unroll
            for (int m = 0; m < 4; ++m) {
                const int rowl = wr * 64 + fr + ai * HALF + m * 16;
                bf16_t* rowp = base + (size_t)(u.pm * BM + rowl) * 512 + col0;
                const float rstd = 1.0f / sqrtf(rss[u.pm * BM + rowl] * (1.0f / 1024.0f) + 1e-6f);
                f32x4 cs0 = {1.f, 0.f, 1.f, 0.f}, cs1 = {1.f, 0.f, 1.f, 0.f};
                if (dorope) { const int t = jt * 256 + rowl, pos = axis ? (t & 63) : (t >> 6); const float* rp = rope + (pos * 16 + 4 * fq) * 2; cs0 = *(const f32x4*)rp; cs1 = *(const f32x4*)(rp + 4); }
#pragma unroll
                for (int bj = 0; bj < 2; ++bj) {
                    const f32x4 a0 = acc[ai][bj][m][0] * rstd + bv[bj][0], a1 = acc[ai][bj][m][1] * rstd + bv[bj][1];
                    float o[8];
                    o[0] = a0[0] * cs0[0] - a0[1] * cs0[1]; o[1] = a0[1] * cs0[0] + a0[0] * cs0[1];
                    o[2] = a0[2] * cs0[2] - a0[3] * cs0[3]; o[3] = a0[3] * cs0[2] + a0[2] * cs0[3];
                    o[4] = a1[0] * cs1[0] - a1[1] * cs1[1]; o[5] = a1[1] * cs1[0] + a1[0] * cs1[1];
                    o[6] = a1[2] * cs1[2] - a1[3] * cs1[3]; o[7] = a1[3] * cs1[2] + a1[2] * cs1[3];
                    u32x4 w; w.x = cvt_pk_bf16(o[0] * qs, o[1] * qs); w.y = cvt_pk_bf16(o[2] * qs, o[3] * qs); w.z = cvt_pk_bf16(o[4] * qs, o[5] * qs); w.w = cvt_pk_bf16(o[6] * qs, o[7] * qs);
                    *(u32x4*)(rowp + bj * HALF) = w;
                }
            }
    }
};

struct EpiGlu {
    static constexpr bool PERM = true, AFTER_DRAIN = false;
    const bf16_t* Gb; const float* bglu; bf16_t* SA;
    __device__ __forceinline__ void operator()(const f32x4 (&acc)[2][2][4][2], const Unit& u, int wr, int wc, int fr, int fq) const {
        const int row0 = u.pm * BM + wr * 64 + fr, col0 = u.pn * BM + wc * 32 + 8 * fq;
        f32x4 bv[2][2];
#pragma unroll
        for (int bj = 0; bj < 2; ++bj)
#pragma unroll
            for (int n = 0; n < 2; ++n) bv[bj][n] = *(const f32x4*)(bglu + col0 + bj * HALF + 4 * n);
#pragma unroll
        for (int ai = 0; ai < 2; ++ai)
#pragma unroll
            for (int m = 0; m < 4; ++m) { const size_t row = (size_t)(row0 + ai * HALF + m * 16);
#pragma unroll
                for (int bj = 0; bj < 2; ++bj) {
                    const u32x4 gw = *(const u32x4*)(Gb + row * 512 + col0 + bj * HALF);
                    const f32x4 z0 = acc[ai][bj][m][0] + bv[bj][0], z1 = acc[ai][bj][m][1] + bv[bj][1];
                    u32x4 w;
                    w.x = cvt_pk_bf16(bf_lo(gw.x) * fast_sigmoid(z0[0]), bf_hi(gw.x) * fast_sigmoid(z0[1]));
                    w.y = cvt_pk_bf16(bf_lo(gw.y) * fast_sigmoid(z0[2]), bf_hi(gw.y) * fast_sigmoid(z0[3]));
                    w.z = cvt_pk_bf16(bf_lo(gw.z) * fast_sigmoid(z1[0]), bf_hi(gw.z) * fast_sigmoid(z1[1]));
                    w.w = cvt_pk_bf16(bf_lo(gw.w) * fast_sigmoid(z1[2]), bf_hi(gw.w) * fast_sigmoid(z1[3]));
                    *(u32x4*)(SA + row * 1024 + col0 + bj * HALF) = w;
                } }
    }
};

template <class Epi, class Sched, bool ALIGN_EPI = false, bool SP2 = false>
__device__ __forceinline__ void gemm_phase(PG8_LAS unsigned char* lds, const Gemm g, const Sched& S, const Epi& E) {
    int tid_ = threadIdx.x; asm volatile("" : "+v"(tid_));
    const int tid = tid_, wid = __builtin_amdgcn_readfirstlane(tid >> 6), lane = tid & 63, wr = wid >> 2, wc = wid & 3, fr = lane & 15, fq = lane >> 4;
    const int K = g.K, nt = K / BK;
    unsigned voffA[2], voffB[2];
#pragma unroll
    for (int i = 0; i < 2; ++i) { int R, C; stage_rc(tid * 16 + i * 8192, R, C); const int Rb = Epi::PERM ? ((R & ~31) + perm32(R & 31)) : R;
        voffA[i] = (unsigned)(R * K + C) * 2u; voffB[i] = (unsigned)(Rb * K + C) * 2u; }
    const size_t kstep = (size_t)(BK * 2);
    const size_t hstep = (size_t)HALF * K * 2;
    const size_t tstep = 2 * hstep;
    const unsigned ldsw = (unsigned)wid * 1024u;
    const int aoff = lds_byte(wr * 64 + fr, fq * 8), boff = lds_byte(wc * 32 + fr, fq * 8);
#define PG8_SA(b, h) (((b) * 2 + (h)) * HTB)
#define PG8_SB(b, h) ((4 + (b) * 2 + (h)) * HTB)
#define PG8_STAGE(bufoff, gbase, voff) do { _Pragma("unroll") for (int _i = 0; _i < 2; ++_i) \
        __builtin_amdgcn_global_load_lds((const unsigned*)((const char*)(gbase) + (voff)[_i]), (PG8_LAS unsigned*)(lds + (bufoff) + ldsw + _i * 8192), 16, 0, 0); } while (0)
#define PG8_LDA(dst, b, h) do { _Pragma("unroll") for (int m = 0; m < 4; ++m) _Pragma("unroll") for (int k = 0; k < 2; ++k) dst[m][k] = *(const PG8_LAS bf16x8*)(lds + PG8_SA(b, h) + aoff + m * 2048 + k * 1024); } while (0)
#define PG8_LDB(dst, b, h) do { _Pragma("unroll") for (int n = 0; n < 2; ++n) _Pragma("unroll") for (int k = 0; k < 2; ++k) dst[n][k] = *(const PG8_LAS bf16x8*)(lds + PG8_SB(b, h) + boff + n * 2048 + k * 1024); } while (0)
#define PG8_MMA(ai, bj, At, Bt) do { __builtin_amdgcn_s_setprio(1); _Pragma("unroll") for (int m = 0; m < 4; ++m) _Pragma("unroll") for (int n = 0; n < 2; ++n) _Pragma("unroll") for (int k = 0; k < 2; ++k) \
        acc[ai][bj][m][n] = __builtin_amdgcn_mfma_f32_16x16x32_bf16(Bt[n][k], At[m][k], acc[ai][bj][m][n], 0, 0, 0); __builtin_amdgcn_s_setprio(0); } while (0)
#define PG8_WAIT_V(n) asm volatile("s_waitcnt vmcnt(" #n ")" ::: "memory")
#define PG8_WAIT_L(n) asm volatile("s_waitcnt lgkmcnt(" #n ")" ::: "memory")
#define PG8_BAR __builtin_amdgcn_s_barrier()
#define PG8_SCHED __builtin_amdgcn_sched_barrier(0)
    Unit cur, nxt; int ui = 0;
    if (!S.next(0, cur)) return;
    f32x4 acc[2][2][4][2];
#pragma unroll
    for (int a = 0; a < 2; ++a)
#pragma unroll
        for (int b = 0; b < 2; ++b)
#pragma unroll
            for (int m = 0; m < 4; ++m)
#pragma unroll
                for (int n = 0; n < 2; ++n) acc[a][b][m][n] = (f32x4){0.f, 0.f, 0.f, 0.f};
    bf16x8 At[4][2], B0[2][2], B1[2][2];
    const char* cA = (const char*)g.A + (size_t)cur.pm * tstep; const char* cB = (const char*)g.Bt + (size_t)cur.pn * tstep;
    S.a_ready(cur);
    if constexpr (SP2) {
        PG8_STAGE(PG8_SB(0, 0), cB, voffB); PG8_STAGE(PG8_SB(0, 1), cB + hstep, voffB); PG8_STAGE(PG8_SA(0, 0), cA, voffA); PG8_STAGE(PG8_SA(0, 1), cA + hstep, voffA);
        if (wr == 1) PG8_BAR;
        PG8_WAIT_V(2); PG8_BAR;
        PG8_STAGE(PG8_SB(1, 0), cB + kstep, voffB); PG8_STAGE(PG8_SA(1, 0), cA + kstep, voffA); PG8_STAGE(PG8_SB(1, 1), cB + hstep + kstep, voffB);
        PG8_WAIT_V(6); PG8_BAR;
    } else {
        PG8_STAGE(PG8_SB(0, 0), cB, voffB); PG8_STAGE(PG8_SA(0, 0), cA, voffA); PG8_STAGE(PG8_SB(0, 1), cB + hstep, voffB); PG8_STAGE(PG8_SA(0, 1), cA + hstep, voffA);
        if (wr == 1) PG8_BAR;
        PG8_WAIT_V(4); PG8_BAR;
        PG8_STAGE(PG8_SB(1, 0), cB + kstep, voffB); PG8_STAGE(PG8_SA(1, 0), cA + kstep, voffA); PG8_STAGE(PG8_SB(1, 1), cB + hstep + kstep, voffB);
        PG8_WAIT_V(6); PG8_BAR;
    }
    for (;;) {
        const bool has_next = S.next(ui + 1, nxt);
        const char* nA = has_next ? (const char*)g.A + (size_t)nxt.pm * tstep : cA; const char* nB = has_next ? (const char*)g.Bt + (size_t)nxt.pn * tstep : cB;
        for (int t = 0; t < nt; t += 2) {
            const bool last = (t == nt - 2);
            const char* a1 = cA + (size_t)(t + 1) * kstep;
            const char* a2 = last ? nA : cA + (size_t)(t + 2) * kstep; const char* b2 = last ? nB : cB + (size_t)(t + 2) * kstep;
            const char* a3 = a2 + kstep; const char* b3 = b2 + kstep;
            if (last && has_next) S.a_ready(nxt);
            if constexpr (SP2) {
            PG8_LDB(B0, 0, 0); PG8_LDB(B1, 0, 1); PG8_SCHED; PG8_LDA(At, 0, 0); PG8_STAGE(PG8_SA(1, 1), a1 + hstep, voffA);
            PG8_WAIT_V(8); PG8_WAIT_L(0); PG8_BAR; PG8_MMA(0, 0, At, B0); PG8_MMA(0, 1, At, B1); PG8_BAR; PG8_SCHED;
            PG8_LDA(At, 0, 1); PG8_STAGE(PG8_SB(0, 0), b2, voffB); PG8_STAGE(PG8_SB(0, 1), b2 + hstep, voffB); PG8_STAGE(PG8_SA(0, 0), a2, voffA);
            PG8_WAIT_V(8); PG8_WAIT_L(0); PG8_BAR; PG8_MMA(1, 0, At, B0); PG8_MMA(1, 1, At, B1); PG8_BAR; PG8_SCHED;
            PG8_LDB(B0, 1, 0); PG8_LDB(B1, 1, 1); PG8_SCHED; PG8_LDA(At, 1, 0); PG8_STAGE(PG8_SA(0, 1), a2 + hstep, voffA);
            PG8_WAIT_V(8); PG8_WAIT_L(0); PG8_BAR; PG8_MMA(0, 0, At, B0); PG8_MMA(0, 1, At, B1); PG8_BAR; PG8_SCHED;
            PG8_LDA(At, 1, 1); PG8_STAGE(PG8_SB(1, 0), b3, voffB); PG8_STAGE(PG8_SB(1, 1), b3 + hstep, voffB); PG8_STAGE(PG8_SA(1, 0), a3, voffA);
            PG8_WAIT_V(8); PG8_WAIT_L(0); PG8_BAR; PG8_MMA(1, 0, At, B0); PG8_MMA(1, 1, At, B1); PG8_BAR; PG8_SCHED;
            } else {
            PG8_LDB(B0, 0, 0); PG8_SCHED; PG8_LDA(At, 0, 0); PG8_STAGE(PG8_SA(1, 1), a1 + hstep, voffA);
            PG8_WAIT_L(8); PG8_BAR; PG8_WAIT_L(0); PG8_MMA(0, 0, At, B0); PG8_BAR; PG8_SCHED;
            PG8_LDB(B1, 0, 1); PG8_STAGE(PG8_SB(0, 0), b2, voffB);
            PG8_BAR; PG8_WAIT_L(0); PG8_MMA(0, 1, At, B1); PG8_BAR;
            PG8_LDA(At, 0, 1); PG8_STAGE(PG8_SA(0, 0), a2, voffA);
            PG8_BAR; PG8_WAIT_L(0); PG8_MMA(1, 0, At, B0); PG8_BAR; PG8_SCHED;
            PG8_STAGE(PG8_SB(0, 1), b2 + hstep, voffB);
            PG8_WAIT_V(6); PG8_BAR; PG8_MMA(1, 1, At, B1); PG8_BAR;
            PG8_LDB(B0, 1, 0); PG8_SCHED; PG8_LDA(At, 1, 0); PG8_STAGE(PG8_SA(0, 1), a2 + hstep, voffA);
            PG8_WAIT_L(8); PG8_BAR; PG8_WAIT_L(0); PG8_MMA(0, 0, At, B0); PG8_BAR; PG8_SCHED;
            PG8_LDB(B1, 1, 1); PG8_STAGE(PG8_SB(1, 0), b3, voffB);
            PG8_BAR; PG8_WAIT_L(0); PG8_MMA(0, 1, At, B1); PG8_BAR;
            PG8_LDA(At, 1, 1); PG8_STAGE(PG8_SA(1, 0), a3, voffA);
            PG8_BAR; PG8_WAIT_L(0); PG8_MMA(1, 0, At, B0); PG8_BAR; PG8_SCHED;
            PG8_STAGE(PG8_SB(1, 1), b3 + hstep, voffB);
            PG8_WAIT_V(6); PG8_BAR; PG8_MMA(1, 1, At, B1); PG8_BAR;
            }
        }
        if constexpr (ALIGN_EPI) { if (wr == 0) PG8_BAR; }
        if constexpr (!Epi::AFTER_DRAIN) { E(acc, cur, wr, wc, fr, fq); S.done(cur); }
        if (!has_next) break;
#pragma unroll
        for (int a = 0; a < 2; ++a)
#pragma unroll
            for (int b = 0; b < 2; ++b)
#pragma unroll
                for (int m = 0; m < 4; ++m)
#pragma unroll
                    for (int n = 0; n < 2; ++n) acc[a][b][m][n] = (f32x4){0.f, 0.f, 0.f, 0.f};
        cur = nxt; cA = nA; cB = nB; ++ui;
        if constexpr (ALIGN_EPI) { if (wr == 1) PG8_BAR; }
    }
    PG8_WAIT_V(0);
    if constexpr (!ALIGN_EPI) { if (wr == 0) PG8_BAR; }
    PG8_BAR;
    if constexpr (Epi::AFTER_DRAIN) { E.fused(acc, cur, wr, wc, fr, fq, lds, wid, lane); S.done(cur); }
#undef PG8_SA
#undef PG8_SB
#undef PG8_STAGE
#undef PG8_LDA
#undef PG8_LDB
#undef PG8_MMA
#undef PG8_WAIT_V
#undef PG8_WAIT_L
#undef PG8_BAR
#undef PG8_SCHED
}
}

namespace attn {
typedef unsigned short bf16_t;
using bf16x8 = __attribute__((ext_vector_type(8))) short;
using s16x4  = __attribute__((ext_vector_type(4))) short;
using f32x16 = __attribute__((ext_vector_type(16))) float;
using u32x4  = __attribute__((ext_vector_type(4))) unsigned;
constexpr int NW = 8, QBLK = 32, KVBLK = 64;
constexpr float QSCALE = 0.125f * 1.4426950408889634f;
constexpr int LDQ = 512, LDK = 512, LDV = 512, LDO = 512;
constexpr int SHM_V = KVBLK * 128 * 2, SHM_K = KVBLK * 64 * 2, SHM_ATTN = 2 * SHM_V + 2 * SHM_K + NW * 64 * 4;
#define KSWZ64(row, colB) ((row) * 128 + ((colB) ^ ((((row) >> 1) & 7) << 4)))
#define SBAR() __builtin_amdgcn_sched_barrier(0)
__device__ __forceinline__ int crow(int r, int hi) { return (r & 3) + 8 * (r >> 2) + 4 * hi; }
__device__ __forceinline__ unsigned cvtpk(float lo, float hi) { unsigned r; asm volatile("v_cvt_pk_bf16_f32 %0, %1, %2" : "=v"(r) : "v"(lo), "v"(hi)); return r; }
constexpr float THR2 = 11.5f;
template <bool FIRST, bool GUARD>
__device__ __forceinline__ void partialSM(f32x16& p0, f32x16& p1, float& m_reg, float& alpha) {
  if (!GUARD) {
    alpha = 1.f;
#pragma unroll
    for (int r = 0; r < 16; ++r) p0[r] = __builtin_amdgcn_exp2f(p0[r]);
    return;
  }
  if (!FIRST) { if (__builtin_expect(__any(m_reg != 0.f), 0)) {
#pragma unroll
      for (int r = 0; r < 16; ++r) { p0[r] -= m_reg; p1[r] -= m_reg; } } }
  float a = fmaxf(fmaxf(p0[0], p0[1]), p1[0]), b = fmaxf(fmaxf(p0[2], p0[3]), p1[1]); a = fmaxf(fmaxf(a, p1[2]), p1[3]);
#pragma unroll
  for (int r = 4; r < 16; r += 4) { a = fmaxf(fmaxf(a, p0[r]), p0[r + 1]); b = fmaxf(fmaxf(b, p0[r + 2]), p0[r + 3]); a = fmaxf(fmaxf(a, p1[r]), p1[r + 1]); b = fmaxf(fmaxf(b, p1[r + 2]), p1[r + 3]); }
  float pmax = fmaxf(a, b);
  { auto rr = __builtin_amdgcn_permlane32_swap(__float_as_uint(pmax), __float_as_uint(pmax), false, false);
    pmax = fmaxf(__uint_as_float(rr[0]), __uint_as_float(rr[1])); }
  alpha = 1.f;
  if (FIRST) {
    if (__builtin_expect(__any(fabsf(pmax) > THR2), 0)) { const float dl = fabsf(pmax) > THR2 ? pmax : 0.f; m_reg = dl;
#pragma unroll
      for (int r = 0; r < 16; ++r) { p0[r] -= dl; p1[r] -= dl; } }
  } else {
    if (__builtin_expect(__any(pmax > THR2), 0)) { const float dl = fmaxf(pmax, 0.f); m_reg += dl;
#pragma unroll
      for (int r = 0; r < 16; ++r) { p0[r] -= dl; p1[r] -= dl; }
      alpha = __builtin_amdgcn_exp2f(-dl); }
  }
#pragma unroll
  for (int r = 0; r < 16; ++r) p0[r] = __builtin_amdgcn_exp2f(p0[r]);
}
__device__ __forceinline__ void finishSM(f32x16& p0, f32x16& p1, bf16x8& pa0, bf16x8& pa1, bf16x8& pa2, bf16x8& pa3) {
#pragma unroll
  for (int r = 0; r < 16; ++r) p1[r] = __builtin_amdgcn_exp2f(p1[r]);
#define PK4(P, BASE, OUT) do { u32x4 w = {cvtpk(P[BASE + 0], P[BASE + 1]), cvtpk(P[BASE + 2], P[BASE + 3]), cvtpk(P[BASE + 4], P[BASE + 5]), cvtpk(P[BASE + 6], P[BASE + 7])}; \
    OUT = *reinterpret_cast<bf16x8*>(&w); } while (0)
  PK4(p0, 0, pa0); PK4(p0, 8, pa1); PK4(p1, 0, pa2); PK4(p1, 8, pa3);
#undef PK4
}
__device__ __forceinline__ void qkt(f32x16& p0, f32x16& p1, const char* Ks, const bf16x8* qr, int r32, int hi) {
  p0 = f32x16{}; p1 = f32x16{};
#pragma unroll
  for (int d0 = 0; d0 < 4; ++d0) { const int cb = (d0 * 16 + hi * 8) * 2;
    bf16x8 b0 = *reinterpret_cast<const bf16x8*>(Ks + KSWZ64(r32, cb));
    bf16x8 b1 = *reinterpret_cast<const bf16x8*>(Ks + KSWZ64(32 + r32, cb));
    p0 = __builtin_amdgcn_mfma_f32_32x32x16_bf16(b0, qr[d0], p0, 0, 0, 0);
    p1 = __builtin_amdgcn_mfma_f32_32x32x16_bf16(b1, qr[d0], p1, 0, 0, 0); }
}
__device__ __forceinline__ int v_st(int k, int c) { const int kk = k; return ((kk >> 3) * 4 + (c >> 5)) * 512 + ((kk & 7) * 32 + (c & 31)) * 2; }
__device__ __forceinline__ int v_rd_base(int lane) { return ((lane & 3) << 3) | (((lane >> 2) & 3) << 6) | (((lane >> 4) & 1) << 5) | (((lane >> 5) & 1) << 8); }
constexpr int v_rd_off(int d0, int ks, int half) { return d0 * 512 + ks * 4096 + half * 2048; }
template <int OFF> __device__ __forceinline__ s16x4 tr_read(int vb) {
  s16x4 r; asm volatile("ds_read_b64_tr_b16 %0, %1 offset:%2" : "=&v"(r) : "v"(vb), "i"(OFF) : "memory"); return r;
}
template <int D0> __device__ __forceinline__ void pv_one(f32x16& od, int vb, bf16x8 pa0, bf16x8 pa1, bf16x8 pa2, bf16x8 pa3) {
  const s16x4 l0 = tr_read<v_rd_off(D0, 0, 0)>(vb), h0 = tr_read<v_rd_off(D0, 0, 1)>(vb), l1 = tr_read<v_rd_off(D0, 1, 0)>(vb), h1 = tr_read<v_rd_off(D0, 1, 1)>(vb);
  const s16x4 l2 = tr_read<v_rd_off(D0, 2, 0)>(vb), h2 = tr_read<v_rd_off(D0, 2, 1)>(vb), l3 = tr_read<v_rd_off(D0, 3, 0)>(vb), h3 = tr_read<v_rd_off(D0, 3, 1)>(vb);
  asm volatile("s_waitcnt lgkmcnt(0)" ::: "memory"); SBAR();
#define PK(L, H) (bf16x8){L[0], L[1], L[2], L[3], H[0], H[1], H[2], H[3]}
  od = __builtin_amdgcn_mfma_f32_32x32x16_bf16(pa0, PK(l0, h0), od, 0, 0, 0);
  od = __builtin_amdgcn_mfma_f32_32x32x16_bf16(pa1, PK(l1, h1), od, 0, 0, 0);
  od = __builtin_amdgcn_mfma_f32_32x32x16_bf16(pa2, PK(l2, h2), od, 0, 0, 0);
  od = __builtin_amdgcn_mfma_f32_32x32x16_bf16(pa3, PK(l3, h3), od, 0, 0, 0);
#undef PK
}
__device__ __forceinline__ void pv_d0(f32x16* o, f32x16& osum, int vb, bf16x8 pa0, bf16x8 pa1, bf16x8 pa2, bf16x8 pa3) {
  { const bf16x8 ones = {16256, 16256, 16256, 16256, 16256, 16256, 16256, 16256};
    osum = __builtin_amdgcn_mfma_f32_32x32x16_bf16(pa0, ones, osum, 0, 0, 0); osum = __builtin_amdgcn_mfma_f32_32x32x16_bf16(pa1, ones, osum, 0, 0, 0);
    osum = __builtin_amdgcn_mfma_f32_32x32x16_bf16(pa2, ones, osum, 0, 0, 0); osum = __builtin_amdgcn_mfma_f32_32x32x16_bf16(pa3, ones, osum, 0, 0, 0); }
  pv_one<0>(o[0], vb, pa0, pa1, pa2, pa3); pv_one<1>(o[1], vb, pa0, pa1, pa2, pa3); pv_one<2>(o[2], vb, pa0, pa1, pa2, pa3); pv_one<3>(o[3], vb, pa0, pa1, pa2, pa3);
}
#define TRSET(L, D0) do { L[0] = tr_read<v_rd_off(D0, 0, 0)>(vb); L[1] = tr_read<v_rd_off(D0, 0, 1)>(vb); L[2] = tr_read<v_rd_off(D0, 1, 0)>(vb); L[3] = tr_read<v_rd_off(D0, 1, 1)>(vb); \
    L[4] = tr_read<v_rd_off(D0, 2, 0)>(vb); L[5] = tr_read<v_rd_off(D0, 2, 1)>(vb); L[6] = tr_read<v_rd_off(D0, 3, 0)>(vb); L[7] = tr_read<v_rd_off(D0, 3, 1)>(vb); } while (0)
#define PKV(L, k) (bf16x8){L[2 * (k)][0], L[2 * (k)][1], L[2 * (k)][2], L[2 * (k)][3], L[2 * (k) + 1][0], L[2 * (k) + 1][1], L[2 * (k) + 1][2], L[2 * (k) + 1][3]}
#define MM4(OD, L) do { OD = __builtin_amdgcn_mfma_f32_32x32x16_bf16(pa0, PKV(L, 0), OD, 0, 0, 0); OD = __builtin_amdgcn_mfma_f32_32x32x16_bf16(pa1, PKV(L, 1), OD, 0, 0, 0); \
    OD = __builtin_amdgcn_mfma_f32_32x32x16_bf16(pa2, PKV(L, 2), OD, 0, 0, 0); OD = __builtin_amdgcn_mfma_f32_32x32x16_bf16(pa3, PKV(L, 3), OD, 0, 0, 0); } while (0)
#define LWAIT() do { asm volatile("s_waitcnt lgkmcnt(0)" ::: "memory"); SBAR(); } while (0)
__device__ __forceinline__ void pv_d0_pipe(f32x16* o, f32x16& osum, int vb, bf16x8 pa0, bf16x8 pa1, bf16x8 pa2, bf16x8 pa3) {
  s16x4 LA[8], LB[8];
  __builtin_amdgcn_s_setprio(1);
  TRSET(LA, 0); SBAR();
  { const bf16x8 ones = {16256, 16256, 16256, 16256, 16256, 16256, 16256, 16256};
    osum = __builtin_amdgcn_mfma_f32_32x32x16_bf16(pa0, ones, osum, 0, 0, 0); osum = __builtin_amdgcn_mfma_f32_32x32x16_bf16(pa1, ones, osum, 0, 0, 0);
    osum = __builtin_amdgcn_mfma_f32_32x32x16_bf16(pa2, ones, osum, 0, 0, 0); osum = __builtin_amdgcn_mfma_f32_32x32x16_bf16(pa3, ones, osum, 0, 0, 0); }
  LWAIT(); TRSET(LB, 1); SBAR(); MM4(o[0], LA); SBAR();
  LWAIT(); TRSET(LA, 2); SBAR(); MM4(o[1], LB); SBAR();
  LWAIT(); TRSET(LB, 3); SBAR(); MM4(o[2], LA); SBAR();
  LWAIT(); MM4(o[3], LB);
}
#undef TRSET
#undef PKV
#undef MM4
#undef LWAIT
template <int COMP, bool GUARD>
__device__ __forceinline__ bool body(const bf16_t* __restrict__ Qb, const bf16_t* __restrict__ Kh, const bf16_t* __restrict__ Vh, float* Ob, bf16_t* __restrict__ SAo, float lam, const float* __restrict__ sg, int seq, char* lds) {
  int tid_ = threadIdx.x; asm volatile("" : "+v"(tid_));
  const int tid = tid_, wid = tid >> 6, lane = tid & 63, r32 = lane & 31, hi = lane >> 5;
  char* V_lds = lds; char* K_lds = lds + 4 * SHM_V;
  float* ws = (float*)(lds + 4 * SHM_V + 4 * SHM_K) + wid * 64; float* al_l = ws + 32;
  float m_reg = 0.f; f32x16 o[4] = {}; f32x16 osum = {}; bf16x8 qr[4];
  const bf16_t* Qw = Qb + (long)(wid * QBLK + r32) * LDQ + hi * 8;
#pragma unroll
  for (int d0 = 0; d0 < 4; ++d0) qr[d0] = *reinterpret_cast<const bf16x8*>(Qw + d0 * 16);
  const int sr = tid >> 4, sc = (tid & 15) * 8, vst0 = v_st(sr, sc), vst1 = v_st(32 + sr, sc);
  const int ksr = tid >> 3, ksc = (tid & 7) * 8, kst = KSWZ64(ksr, ksc * 2);
  const int vb0 = (int)(uintptr_t)V_lds + v_rd_base(lane);
  bf16x8 rvs0, rvs1, rks0;
#define SLOAD(k0) do { rvs0 = *reinterpret_cast<const bf16x8*>(&Vh[(long)((k0) + sr) * LDV + sc]); rvs1 = *reinterpret_cast<const bf16x8*>(&Vh[(long)((k0) + 32 + sr) * LDV + sc]); \
    rks0 = *reinterpret_cast<const bf16x8*>(&Kh[(long)((k0) + ksr) * LDK + ksc]); } while (0)
#define SWRITE(slot) do { *(bf16x8*)(V_lds + (slot) * SHM_V + vst0) = rvs0; *(bf16x8*)(V_lds + (slot) * SHM_V + vst1) = rvs1; *(bf16x8*)(K_lds + (slot) * SHM_K + kst) = rks0; } while (0)
#define RESC(a) do { if (__any((a) < 1.f)) { if (hi == 0) al_l[r32] = (a); asm volatile("s_waitcnt lgkmcnt(0)" ::: "memory"); \
    _Pragma("unroll") for (int r = 0; r < 16; ++r) { const float f_ = al_l[crow(r, hi)]; osum[r] *= f_; _Pragma("unroll") for (int d = 0; d < 4; ++d) o[d][r] *= f_; } } } while (0)
  f32x16 pA0, pA1, pB0, pB1; float alA, alB; bf16x8 pa0, pa1, pa2, pa3; const int NT = seq / KVBLK;
  SLOAD(0); SWRITE(0); SLOAD(KVBLK); __syncthreads();
  qkt(pA0, pA1, K_lds, qr, r32, hi); partialSM<true, GUARD>(pA0, pA1, m_reg, alA);
  SWRITE(1); SLOAD(2 * KVBLK); __syncthreads();
  const int grp = __builtin_amdgcn_readfirstlane(wid >> 2);
#define ITER(X0, X1, Y0, Y1, alX, i) do { const int scur = (i) & 3, sp = ((i) - 1) & 3, sn = ((i) + 1) & 3; \
    SBAR(); qkt(X0, X1, K_lds + scur * SHM_K, qr, r32, hi); \
    finishSM(Y0, Y1, pa0, pa1, pa2, pa3); SBAR(); \
    if (grp) { SWRITE(sn); if ((i) + 2 < NT) SLOAD(((i) + 2) * KVBLK); __syncthreads(); } \
    if (GUARD) pv_d0(o, osum, vb0 + sp * SHM_V, pa0, pa1, pa2, pa3); else pv_d0_pipe(o, osum, vb0 + sp * SHM_V, pa0, pa1, pa2, pa3); partialSM<false, GUARD>(X0, X1, m_reg, alX); if (!GUARD) __builtin_amdgcn_s_setprio(0); \
    if (GUARD) RESC(alX); \
    if (!grp) { SWRITE(sn); if ((i) + 2 < NT) SLOAD(((i) + 2) * KVBLK); __syncthreads(); } } while (0)
  int i = 1;
  for (; i + 1 < NT; i += 2) {
    ITER(pB0, pB1, pA0, pA1, alB, i);
    ITER(pA0, pA1, pB0, pB1, alA, i + 1);
  }
  { const int scur = i & 3, sp = (i - 1) & 3;
  SBAR(); qkt(pB0, pB1, K_lds + scur * SHM_K, qr, r32, hi);
  finishSM(pA0, pA1, pa0, pa1, pa2, pa3); SBAR();
  pv_d0(o, osum, vb0 + sp * SHM_V, pa0, pa1, pa2, pa3); partialSM<false, GUARD>(pB0, pB1, m_reg, alB);
  if (GUARD) RESC(alB);
  finishSM(pB0, pB1, pa0, pa1, pa2, pa3); SBAR();
  pv_d0(o, osum, vb0 + scur * SHM_V, pa0, pa1, pa2, pa3); }
#undef ITER
  if (!GUARD) {
    bool ok = true;
#pragma unroll
    for (int r = 0; r < 16; ++r) ok = ok && (osum[r] > 0.f) && (osum[r] < 3.0e38f);
    if (__syncthreads_or(ok ? 0 : 1)) return true;
  }
  float rli[16];
#pragma unroll
  for (int r = 0; r < 16; ++r) rli[r] = __builtin_amdgcn_rcpf(osum[r]);
  float* Ow = Ob + (long)(wid * QBLK) * LDO;
  if (COMP == 0) {
#pragma unroll
    for (int r = 0; r < 16; ++r) { const int orow = crow(r, hi);
#pragma unroll
      for (int d0 = 0; d0 < 4; ++d0) Ow[(long)orow * LDO + d0 * 32 + r32] = o[d0][r] * rli[r]; }
  } else {
    float ss[16];
#pragma unroll
    for (int r = 0; r < 16; ++r) { const int orow = crow(r, hi); float q = 0.f;
#pragma unroll
      for (int d0 = 0; d0 < 4; ++d0) { const float d = Ow[(long)orow * LDO + d0 * 32 + r32] - lam * (o[d0][r] * rli[r]); o[d0][r] = d; q = fmaf(d, d, q); }
      ss[r] = q; }
#pragma unroll
    for (int r = 0; r < 16; ++r) { float q = ss[r]; q += __shfl_xor(q, 1); q += __shfl_xor(q, 2); q += __shfl_xor(q, 4); q += __shfl_xor(q, 8); q += __shfl_xor(q, 16);
      ss[r] = 1.0f / sqrtf(q * (1.0f / 128.0f) + 1e-6f); }
    float gsub[4];
#pragma unroll
    for (int d0 = 0; d0 < 4; ++d0) gsub[d0] = sg[d0 * 32 + r32] * 0.8f;
    bf16_t* Sw = SAo + (long)(wid * QBLK) * 1024;
#pragma unroll
    for (int r = 0; r < 16; ++r) { const int orow = crow(r, hi);
#pragma unroll
      for (int d0 = 0; d0 < 4; ++d0) { const float y = o[d0][r] * ss[r] * gsub[d0]; unsigned u = __builtin_bit_cast(unsigned, y); u = (u + 0x7fffu + ((u >> 16) & 1u)) >> 16;
        Sw[(long)orow * 1024 + d0 * 32 + r32] = (bf16_t)u; } }
  }
  asm volatile("s_waitcnt vmcnt(0) lgkmcnt(0)" ::: "memory"); __syncthreads();
  return false;
#undef SLOAD
#undef SWRITE
#undef RESC
}
#undef SBAR
}

#define GAS __attribute__((address_space(1)))
#define LAS __attribute__((address_space(3)))
typedef unsigned short bf16;
typedef unsigned v4u __attribute__((ext_vector_type(4)));
typedef float f32x4 __attribute__((ext_vector_type(4)));
typedef float f32x16 __attribute__((ext_vector_type(16)));
typedef short bf16x8 __attribute__((ext_vector_type(8)));

constexpr int NWAVES = 8, NTHR = 512;
constexpr int DM = 1024, DFF = 2816, NB = 8, SEQ = 8192, CTXL = 256, NMODV = 9 * DM;
constexpr int ROWS_B = 8448, TILES_B = 33, NROWS = NB * ROWS_B;

constexpr size_t MiB = 1u << 20;
constexpr size_t WS_CTL = 0, CTL_ZERO_BYTES = 1 * MiB;
constexpr size_t WS_MOD = 4096;
constexpr size_t WS_BIAS1 = 352 * 1024, WS_BIAS2 = 640 * 1024;
constexpr size_t WS_RSS1 = 69 * MiB, WS_RSS2 = 69 * MiB + 512 * 1024;
constexpr size_t WS_BAR = 512 * 1024, BAR_ZERO_BYTES = 16384;
constexpr size_t WS_ABAR = 1 * MiB, WS_APOW = WS_ABAR + 32768, WS_BBT = WS_APOW + 32768, WS_CM = WS_BBT + 262144, WS_ROPE = WS_CM + 262144;
constexpr size_t WS_W1A = 2 * MiB, WS_W1B = 13 * MiB, WS_W2A = 19 * MiB, WS_W2B = 30 * MiB, WS_WIN = 36 * MiB, WS_WOUT = 40 * MiB, WS_WGLU = 42 * MiB;
constexpr size_t WS_E = 43 * MiB, WS_HIN = 52 * MiB, WS_XC = 61 * MiB;
constexpr size_t WS_XN = 70 * MiB;
constexpr size_t WS_ACT = 202 * MiB;
constexpr size_t WS_OATT = WS_ACT, WS_G = WS_ACT + 264 * MiB;
constexpr size_t WS_U = 565 * MiB, WS_Q = 631 * MiB, WS_K = 697 * MiB, WS_V = 763 * MiB, WS_END = 829 * MiB;
static_assert(WS_ROPE + 16384 <= WS_W1A && WS_W1A + (size_t)5632 * 1024 * 2 <= WS_W1B && WS_W1B + (size_t)1024 * 2816 * 2 <= WS_W2A && WS_W2A + (size_t)5632 * 1024 * 2 <= WS_W2B, "ws map 1");
static_assert(WS_W2B + (size_t)1024 * 2816 * 2 <= WS_WIN && WS_WIN + (size_t)2048 * 1024 * 2 <= WS_WOUT && WS_WOUT + (size_t)1024 * 1024 * 2 <= WS_WGLU && WS_WGLU + 512 * 512 * 2 <= WS_E, "ws map 2");
static_assert(WS_E + (size_t)8 * 33 * 64 * 64 * 8 <= WS_HIN && WS_HIN + (size_t)8 * 33 * 64 * 64 * 8 <= WS_XC && WS_XC + (size_t)2048 * 1024 * 4 <= WS_XN, "ws map 3");
static_assert(WS_XN + (size_t)NROWS * 1024 * 2 <= WS_ACT && WS_ACT + (size_t)NROWS * 2816 * 2 <= WS_U && WS_G + (size_t)NROWS * 512 * 2 <= WS_U && WS_OATT + (size_t)NROWS * 1024 * 4 <= WS_G, "ws map 4");
static_assert(WS_U + (size_t)NROWS * 512 * 2 <= WS_Q && WS_V + (size_t)NROWS * 512 * 2 <= WS_END, "ws map 5");

constexpr int LDS_BYTES = 139264;

#define LDS_WAIT() asm volatile("s_waitcnt lgkmcnt(0)" ::: "memory")
__device__ __forceinline__ unsigned f2bf(float f) { unsigned u = __builtin_bit_cast(unsigned, f); return (u + 0x7fffu + ((u >> 16) & 1u)) >> 16; }
__device__ __forceinline__ unsigned pk2(float lo, float hi) { return f2bf(lo) | (f2bf(hi) << 16); }
__device__ __forceinline__ float wave_sum(float v) {
#pragma unroll
    for (int o = 1; o < 64; o <<= 1) v += __shfl_xor(v, o);
    return v;
}

__device__ __forceinline__ double dexp(double x) {
    const double n = __builtin_rint(x * 1.4426950408889634074);
    const double r = __builtin_fma(-n, 1.9082149292705877e-10, __builtin_fma(-n, 0.693147180369123816490, x));
    double p = 1.0 / 87178291200.0;
    p = p * r + 1.0 / 6227020800.0; p = p * r + 1.0 / 479001600.0; p = p * r + 1.0 / 39916800.0; p = p * r + 1.0 / 3628800.0; p = p * r + 1.0 / 362880.0; p = p * r + 1.0 / 40320.0;
    p = p * r + 1.0 / 5040.0; p = p * r + 1.0 / 720.0; p = p * r + 1.0 / 120.0; p = p * r + 1.0 / 24.0; p = p * r + 1.0 / 6.0; p = p * r + 0.5; p = p * r + 1.0; p = p * r + 1.0;
    const long long e = (long long)n + 1023; const double s = __builtin_bit_cast(double, (unsigned long long)e << 52);
    return p * s;
}
__device__ __forceinline__ void dsincos(double y, double& s, double& c) {
    const double k = __builtin_rint(y * 0.15915494309189533577);
    double r = __builtin_fma(-k, 6.283185307179586232, y); r = __builtin_fma(-k, 2.4492935982947064e-16, r);
    const double q = r * 0.125, q2 = q * q;
    double sp = -1.0 / 1307674368000.0; sp = sp * q2 + 1.0 / 6227020800.0; sp = sp * q2 - 1.0 / 39916800.0; sp = sp * q2 + 1.0 / 362880.0; sp = sp * q2 - 1.0 / 5040.0; sp = sp * q2 + 1.0 / 120.0; sp = sp * q2 - 1.0 / 6.0; sp = sp * q2 + 1.0;
    double cp = 1.0 / 20922789888000.0; cp = cp * q2 - 1.0 / 87178291200.0; cp = cp * q2 + 1.0 / 479001600.0; cp = cp * q2 - 1.0 / 3628800.0; cp = cp * q2 + 1.0 / 40320.0; cp = cp * q2 - 1.0 / 720.0; cp = cp * q2 + 1.0 / 24.0; cp = cp * q2 - 0.5; cp = cp * q2 + 1.0;
    double ss = sp * q, cc = cp;
#pragma unroll
    for (int i = 0; i < 3; ++i) { const double s2 = 2.0 * ss * cc, c2 = cc * cc - ss * ss; ss = s2; cc = c2; }
    s = ss; c = cc;
}

__device__ __forceinline__ void transpose_item(const float* W, int K, int N, bf16* WT, int mode, LAS float* scr, int item, int lane) {
    const int nblk = N / 32, kb = item / nblk, nb = item % nblk, k0 = 64 * kb, n0 = 32 * nb;
    { const float* wp = W + (size_t)(k0 + (lane >> 5)) * N + n0 + (lane & 31); float v[32];
#pragma unroll
      for (int i = 0; i < 32; ++i) v[i] = wp[(size_t)(2 * i) * N];
#pragma unroll
      for (int i = 0; i < 32; ++i) scr[(2 * i + (lane >> 5)) * 33 + (lane & 31)] = v[i]; }
    LDS_WAIT(); asm volatile("" ::: "memory");
    const int c = lane & 7;
#pragma unroll
    for (int j = 0; j < 4; ++j) { const int n = (lane >> 3) + 8 * j; const LAS float* s = scr + (8 * c) * 33 + n;
        const int src = n0 + n; int drow = src;
        if (mode == 1) { const int up = src >= DFF ? 1 : 0, ff = src - up * DFF; drow = (ff >> 7) * 256 + up * 128 + (ff & 127); }
        else if (mode == 2) { if (src >= 512 && src < 1536) drow = n0 + 2 * (n & 15) + (n >> 4); }
        v4u o; o.x = pk2(s[0 * 33], s[1 * 33]); o.y = pk2(s[2 * 33], s[3 * 33]); o.z = pk2(s[4 * 33], s[5 * 33]); o.w = pk2(s[6 * 33], s[7 * 33]);
        *(v4u*)(WT + (size_t)drow * K + k0 + 8 * c) = o; }
    LDS_WAIT(); asm volatile("" ::: "memory");
}

template <int MODE>
__device__ __forceinline__ void norm_rows16(const float* src, bf16* dstb, float* dstf, const float* g, const float* shift, const float* scale, int lane) {
    f32x4 gs[4], sh[4];
#pragma unroll
    for (int j = 0; j < 4; ++j) { const int cidx = 4 * lane + 256 * j; const f32x4 gv = *(const f32x4*)(g + cidx);
        if (MODE == 0) { const f32x4 sc = *(const f32x4*)(scale + cidx); gs[j] = gv * (sc + 1.0f); sh[j] = *(const f32x4*)(shift + cidx); } else { gs[j] = gv; sh[j] = (f32x4){0.f, 0.f, 0.f, 0.f}; } }
#pragma unroll 2
    for (int r = 0; r < 16; ++r) {
        const f32x4* xr = (const f32x4*)(src + (size_t)r * DM) + lane;
        f32x4 v[4]; float s = 0.f;
#pragma unroll
        for (int j = 0; j < 4; ++j) { v[j] = xr[64 * j]; s += (v[j].x * v[j].x + v[j].y * v[j].y) + (v[j].z * v[j].z + v[j].w * v[j].w); }
        const float rstd = 1.0f / sqrtf(wave_sum(s) * (1.0f / DM) + 1e-6f);
        if (MODE == 0) {
            unsigned long long* o8 = (unsigned long long*)(dstb + (size_t)r * DM) + lane;
#pragma unroll
            for (int j = 0; j < 4; ++j) { const f32x4 y = v[j] * rstd * gs[j] + sh[j]; o8[64 * j] = (unsigned long long)pk2(y.x, y.y) | ((unsigned long long)pk2(y.z, y.w) << 32); }
        } else {
            f32x4* of = (f32x4*)(dstf + (size_t)r * DM) + lane;
#pragma unroll
            for (int j = 0; j < 4; ++j) of[64 * j] = v[j] * rstd * gs[j];
        }
    }
}

__device__ __forceinline__ int crow16(int r, int hi) { return (r & 3) + 8 * (r >> 2) + 4 * hi; }
typedef float f32x2_t __attribute__((ext_vector_type(2))); typedef __bf16 bf16x2_t __attribute__((ext_vector_type(2)));
__device__ __forceinline__ unsigned cvtpk2(float lo, float hi) { f32x2_t v = {lo, hi}; bf16x2_t b = __builtin_convertvector(v, bf16x2_t); return __builtin_bit_cast(unsigned, b); }

template <bool FULL>
__device__ __forceinline__ void s5_unit(LAS unsigned char* lds, int b, int c, int gq, const bf16* U, const float2* ABAR, const bf16* BBT, const bf16* CM,
                                        const float2* HIN, float2* E, const float* dskip, bf16* G, float* YF) {
    int tid_ = threadIdx.x; asm volatile("" : "+v"(tid_));
    const int lane = tid_ & 63, wave = __builtin_amdgcn_readfirstlane(tid_ >> 6);
    const int g = gq * 8 + wave, hi = lane >> 5, r32 = lane & 31;
    LAS unsigned* scr = (LAS unsigned*)(lds + wave * 8704);
    const size_t r0 = (size_t)b * ROWS_B + (size_t)c * 256;
    const bf16* ubase = U + (r0 + r32) * 512 + g * 16 + hi * 8;
    const int ch = lane & 15; const float dv = dskip[g * 16 + ch];
    const size_t obase = (r0 + (lane >> 4) * 4) * 512 + g * 16 + ch;
    LAS unsigned short* yt_l = (LAS unsigned short*)(lds + 69632 + wave * 8192) + ((lane >> 4) * 4) * 16 + ch;
#pragma unroll
    for (int dir = 0; dir < 2; ++dir) {
        const int dg = dir * 32 + g;
        const float2 ab = ABAR[dg * 64 + lane];
        bf16x8 bb[4], cm[4];
#pragma unroll
        for (int blk = 0; blk < 4; ++blk) bb[blk] = *(const bf16x8*)(BBT + ((size_t)(dg * 4 + blk) * 32 + r32) * 16 + hi * 8);
        if (FULL) {
#pragma unroll
            for (int ks = 0; ks < 4; ++ks) cm[ks] = *(const bf16x8*)(CM + ((size_t)dg * 16 + (lane & 15)) * 128 + ks * 32 + (lane >> 4) * 8);
        }
        const size_t sidx = ((((size_t)b * 33 + c) * 32 + g) * 2 + dir) * 64 + lane;
        float hr = 0.f, hm = 0.f;
        if (FULL) { const float2 h0 = HIN[sidx]; hr = h0.x; hm = h0.y; }
        bf16x8 a_nx = *(const bf16x8*)(ubase + (size_t)(dir == 0 ? 0 : 224) * 512);
#pragma unroll 1
        for (int sb = 0; sb < 8; ++sb) {
            const int tb = dir == 0 ? sb * 32 : (7 - sb) * 32;
            const bf16x8 a = a_nx;
            { const int tn = dir == 0 ? (sb < 7 ? tb + 32 : tb) : (sb < 7 ? tb - 32 : tb); a_nx = *(const bf16x8*)(ubase + (size_t)tn * 512); }
            unsigned short uvv[2][4];
            if (FULL && dir == 1) {
#pragma unroll
                for (int mt = 0; mt < 2; ++mt)
#pragma unroll
                    for (int j = 0; j < 4; ++j) { const size_t idx = obase + (size_t)(tb + mt * 16 + j) * 512; uvv[mt][j] = U[idx]; }
            }
            const f32x16 z = {};
#pragma unroll
            for (int hf = 0; hf < 2; ++hf) {
                const f32x16 c0 = __builtin_amdgcn_mfma_f32_32x32x16_bf16(a, bb[hf], z, 0, 0, 0), c2 = __builtin_amdgcn_mfma_f32_32x32x16_bf16(a, bb[2 + hf], z, 0, 0, 0);
#pragma unroll
                for (int r = 0; r < 16; ++r) { const int row = crow16(r, hi); scr[row * 68 + hf * 32 + r32] = cvtpk2(c0[r], c2[r]); }
            }
            LDS_WAIT(); asm volatile("" ::: "memory");
#pragma unroll
            for (int half = 0; half < 2; ++half) {
                unsigned v[16];
#pragma unroll
                for (int q = 0; q < 16; ++q) { const int t = dir == 0 ? half * 16 + q : 31 - (half * 16 + q); v[q] = scr[t * 68 + lane]; }
#pragma unroll
                for (int q = 0; q < 16; ++q) { const int t = dir == 0 ? half * 16 + q : 31 - (half * 16 + q);
                    const float re = __uint_as_float(v[q] << 16), im = __uint_as_float(v[q] & 0xffff0000u);
                    const float nr = fmaf(ab.x, hr, fmaf(-ab.y, hm, re)), ni = fmaf(ab.x, hm, fmaf(ab.y, hr, im)); hr = nr; hm = ni;
                    if (FULL) scr[t * 68 + lane] = cvtpk2(hr, hm); }
                asm volatile("" ::: "memory");
            }
            if (FULL) {
                LDS_WAIT(); asm volatile("" ::: "memory");
                f32x4 yt[2];
#pragma unroll
                for (int mt = 0; mt < 2; ++mt) { yt[mt] = (f32x4){0.f, 0.f, 0.f, 0.f};
#pragma unroll
                    for (int ks = 0; ks < 4; ++ks) { const bf16x8 hf8 = *(const LAS bf16x8*)((const LAS unsigned char*)scr + (mt * 16 + (lane & 15)) * 272 + ks * 64 + (lane >> 4) * 16);
                        yt[mt] = __builtin_amdgcn_mfma_f32_16x16x32_bf16(hf8, cm[ks], yt[mt], 0, 0, 0); } }
#pragma unroll
                for (int mt = 0; mt < 2; ++mt)
#pragma unroll
                    for (int j = 0; j < 4; ++j) { LAS unsigned short* yp = yt_l + (tb + mt * 16 + j) * 16;
                        if (dir == 0) *yp = (unsigned short)f2bf(yt[mt][j]);
                        else { const float uv = __uint_as_float((unsigned)uvv[mt][j] << 16); const float yv = __uint_as_float((unsigned)*yp << 16) + yt[mt][j] + dv * uv;
                            const float zz = 1.5957691216057308f * (yv + 0.044715f * yv * yv * yv); *yp = (unsigned short)f2bf(yv * pg8::fast_sigmoid(zz)); } }
                LDS_WAIT(); asm volatile("" ::: "memory");
            }
        }
        if (!FULL) E[sidx] = make_float2(hr, hm);
    }
    if (FULL) {
        LDS_WAIT(); asm volatile("" ::: "memory");
        const LAS unsigned char* yb = (const LAS unsigned char*)(lds + 69632 + wave * 8192);
#pragma unroll
        for (int it = 0; it < 8; ++it) { const int row = it * 32 + (lane >> 1), hf = lane & 1;
            const v4u w = *(const LAS v4u*)(yb + row * 32 + hf * 16);
            *(v4u*)(G + (r0 + row) * 512 + g * 16 + hf * 8) = w; }
        LDS_WAIT(); asm volatile("" ::: "memory");
    }
}

__device__ __forceinline__ void cmulf(float ar, float ai, float br, float bi, float& cr, float& ci) { cr = ar * br - ai * bi; ci = ar * bi + ai * br; }
__device__ __forceinline__ void s5_unit_a(LAS unsigned char* lds, int b, int c, int gq, const bf16* U, const float2* ABAR, const bf16* BBT, float2* E) {
    int tid_ = threadIdx.x; asm volatile("" : "+v"(tid_));
    const int lane = tid_ & 63, wave = __builtin_amdgcn_readfirstlane(tid_ >> 6);
    const int g = gq * 8 + wave, hi = lane >> 5, r32 = lane & 31;
    const size_t r0 = (size_t)b * ROWS_B + (size_t)c * 256;
    LAS unsigned char* ut = lds + wave * 8192;
    { v4u t8[8];
#pragma unroll
      for (int it = 0; it < 8; ++it) t8[it] = *(const v4u*)(U + (r0 + it * 32 + (lane >> 1)) * 512 + g * 16 + (lane & 1) * 8);
#pragma unroll
      for (int it = 0; it < 8; ++it) *(LAS v4u*)(ut + (it * 32 + (lane >> 1)) * 32 + (lane & 1) * 16) = t8[it]; }
    LDS_WAIT(); asm volatile("" ::: "memory");
    const LAS unsigned char* ua = ut + r32 * 32 + hi * 16;
#pragma unroll
    for (int dir = 0; dir < 2; ++dir) {
        const int dg = dir * 32 + g;
        bf16x8 bb[4];
#pragma unroll
        for (int blk = 0; blk < 4; ++blk) bb[blk] = *(const bf16x8*)(BBT + ((size_t)(dg * 4 + blk) * 32 + r32) * 16 + hi * 8);
        float wr[2][16], wi[2][16], a32r[2], a32i[2];
#pragma unroll
        for (int hf = 0; hf < 2; ++hf) {
            const float2 ab = ABAR[dg * 64 + hf * 32 + r32];
            float qr[4], qi[4], orr[4], oi[4];
            qr[0] = 1.f; qi[0] = 0.f; qr[1] = ab.x; qi[1] = ab.y; cmulf(qr[1], qi[1], ab.x, ab.y, qr[2], qi[2]); cmulf(qr[2], qi[2], ab.x, ab.y, qr[3], qi[3]);
            float a4r, a4i; cmulf(qr[2], qi[2], qr[2], qi[2], a4r, a4i);
            orr[0] = 1.f; oi[0] = 0.f; cmulf(a4r, a4i, a4r, a4i, orr[1], oi[1]); cmulf(orr[1], oi[1], orr[1], oi[1], orr[2], oi[2]); cmulf(orr[2], oi[2], orr[1], oi[1], orr[3], oi[3]);
            cmulf(orr[2], oi[2], orr[2], oi[2], a32r[hf], a32i[hf]);
            const bool use4 = dir == 0 ? (hi == 0) : (hi != 0);
            const float br = use4 ? a4r : 1.f, bi = use4 ? a4i : 0.f;
#pragma unroll
            for (int r = 0; r < 16; ++r) { const int jq = dir == 0 ? 3 - (r & 3) : (r & 3), jo = dir == 0 ? 3 - (r >> 2) : (r >> 2);
                float tr, ti; cmulf(qr[jq], qi[jq], orr[jo], oi[jo], tr, ti); cmulf(tr, ti, br, bi, wr[hf][r], wi[hf][r]); }
        }
        float hr[2] = {0.f, 0.f}, hm[2] = {0.f, 0.f};
#pragma unroll 1
        for (int sb = 0; sb < 8; ++sb) {
            const bf16x8 a = *(const LAS bf16x8*)(ua + (dir == 0 ? sb * 32 : (7 - sb) * 32) * 32);
            const f32x16 z = {};
#pragma unroll
            for (int hf = 0; hf < 2; ++hf) {
                const f32x16 cre = __builtin_amdgcn_mfma_f32_32x32x16_bf16(a, bb[hf], z, 0, 0, 0), cim = __builtin_amdgcn_mfma_f32_32x32x16_bf16(a, bb[2 + hf], z, 0, 0, 0);
                float er = 0.f, ei = 0.f;
#pragma unroll
                for (int r = 0; r < 16; ++r) { er = fmaf(wr[hf][r], cre[r], fmaf(-wi[hf][r], cim[r], er)); ei = fmaf(wr[hf][r], cim[r], fmaf(wi[hf][r], cre[r], ei)); }
                er += __shfl_xor(er, 32); ei += __shfl_xor(ei, 32);
                const float nr = fmaf(a32r[hf], hr[hf], fmaf(-a32i[hf], hm[hf], er)), ni = fmaf(a32r[hf], hm[hf], fmaf(a32i[hf], hr[hf], ei));
                hr[hf] = nr; hm[hf] = ni;
            }
        }
        const size_t sidx = ((((size_t)b * 33 + c) * 32 + g) * 2 + dir) * 64 + lane;
        E[sidx] = hi ? make_float2(hr[1], hm[1]) : make_float2(hr[0], hm[0]);
    }
    LDS_WAIT(); asm volatile("" ::: "memory");
}

typedef GAS unsigned gu32;
#define RLX_AGENT __ATOMIC_RELAXED, __HIP_MEMORY_SCOPE_AGENT
#define XB_TMO      128
#define XB_XCNT(j)  (256  + 64 * (j))
#define XB_XSUB(j)  (1280 + 64 * (j))
#define XB_XGEN(j)  (2304 + 64 * (j))
#define XB_TOP      3328
#define XB_TOPGEN   3392
#define XCD_BAR_WORDS 3456
#define XB_SPIN_CAP (1u << 18)

__device__ __forceinline__ unsigned xb_ld(unsigned* p)              { return __hip_atomic_load(p, __ATOMIC_RELAXED, __HIP_MEMORY_SCOPE_AGENT); }
__device__ __forceinline__ unsigned xb_add(unsigned* p, unsigned v) { return __hip_atomic_fetch_add(p, v, __ATOMIC_RELAXED, __HIP_MEMORY_SCOPE_AGENT); }
__device__ __forceinline__ unsigned xb_xcc_id() { return (unsigned)__builtin_amdgcn_s_getreg((3 << 11) | 20) & 0xFu; }
#define XB_SPIN(cond, bar) do { unsigned _sp = 0; while (cond) { __builtin_amdgcn_s_sleep(1); \
    if ((++_sp & 255u) == 0u) { if (xb_ld(&(bar)[XB_TMO])) break; if (_sp > XB_SPIN_CAP) { atomicAdd(&(bar)[XB_TMO], 1u); break; } } } } while (0)

struct XcdBarrier {
    unsigned* bar; unsigned x;
    volatile LAS unsigned* st;
};

__device__ __forceinline__ XcdBarrier xcd_barrier_post(unsigned* bar, volatile LAS unsigned* st) {
    XcdBarrier b; b.bar = bar; b.x = xb_xcc_id(); b.st = st;
    if (threadIdx.x == 0) (void)xb_add(&bar[XB_XCNT(b.x)], 1u);
    return b;
}
__device__ __forceinline__ void xcd_barrier_complete(unsigned* bar, unsigned x, unsigned& nloc, unsigned& nx) {
    const unsigned G = gridDim.x * gridDim.y * gridDim.z;
    unsigned sum, cnt, mine, sp = 0u;
    for (;;) {
        sum = 0u; cnt = 0u; mine = 0u;
#pragma unroll
        for (unsigned j = 0; j < 16; ++j) { const unsigned c = xb_ld(&bar[XB_XCNT(j)]); sum += c; cnt += (c > 0u) ? 1u : 0u; mine = (j == x) ? c : mine; }
        if (sum == G) break;
        __builtin_amdgcn_s_sleep(1);
        if ((++sp & 255u) == 0u) { if (xb_ld(&bar[XB_TMO])) break; if (sp > XB_SPIN_CAP) { atomicAdd(&bar[XB_TMO], 1u); break; } }
    }
    nloc = mine > 0u ? mine : 1u; nx = cnt > 0u ? cnt : 1u;
}

__device__ __forceinline__ void xcd_barrier(const XcdBarrier& b) {
    asm volatile("s_waitcnt vmcnt(0)" ::: "memory");
    __syncthreads();
    if (threadIdx.x == 0) {
        unsigned* bar = b.bar;
        __builtin_amdgcn_s_waitcnt(0);
        unsigned nloc = b.st[0], nx = b.st[1];
        if (nloc == 0u) { xcd_barrier_complete(bar, b.x, nloc, nx); b.st[0] = nloc; b.st[1] = nx; }
        const unsigned old = xb_add(&bar[XB_XSUB(b.x)], 1u);
        const unsigned gen = old / nloc;
        if (old + 1u == (gen + 1u) * nloc) {
            __builtin_amdgcn_fence(__ATOMIC_RELEASE, "agent");
            asm volatile("s_waitcnt vmcnt(0)" ::: "memory");
            const unsigned og = xb_add(&bar[XB_TOP], 1u);
            const unsigned tg = og / nx;
            if (og + 1u == (tg + 1u) * nx) xb_add(&bar[XB_TOPGEN], 1u);
            else XB_SPIN(xb_ld(&bar[XB_TOPGEN]) == tg, bar);
            __builtin_amdgcn_fence(__ATOMIC_ACQUIRE, "agent");
            xb_add(&bar[XB_XGEN(b.x)], 1u);
            asm volatile("s_waitcnt vmcnt(0)" ::: "memory");
        } else {
            XB_SPIN(xb_ld(&bar[XB_XGEN(b.x)]) == gen, bar);
            __builtin_amdgcn_fence(__ATOMIC_ACQUIRE, "agent");
            asm volatile("s_waitcnt vmcnt(0)" ::: "memory");
        }
    }
    __syncthreads();
}

#ifndef PHMASK
#define PHMASK 0xFFFFF
#endif
#define PH(k) if ((PHMASK >> (k)) & 1)
struct Args { const float* in[25]; float* out; unsigned char* ws; };
__device__ __forceinline__ const float* karg(int i) {
    unsigned off = (unsigned)i * 8u; asm volatile("" : "+s"(off));
    return *(const float* const __attribute__((address_space(4)))*)((const char __attribute__((address_space(4)))*)__builtin_amdgcn_kernarg_segment_ptr() + off);
}

__global__ void __launch_bounds__(NTHR, 2) hymba_fwd(Args a) {
    extern __shared__ __attribute__((aligned(16))) unsigned char lds[];
    cg::grid_group grid = cg::this_grid();
    const int tid = threadIdx.x, lane = tid & 63, wave = __builtin_amdgcn_readfirstlane(tid >> 6);
    const int G = gridDim.x, bx = blockIdx.x;
    const int vcu = (G % 8 == 0) ? (bx % 8) * (G / 8) + bx / 8 : bx;
    const int gw = vcu * NWAVES + wave, NGW = G * NWAVES;
    LAS unsigned char* ldsl = (LAS unsigned char*)lds;
#define KIN(i) karg(i)
#define ws_p ((unsigned char*)karg(26))
#define out_p ((float*)karg(25))
#define x_in KIN(0)
#define cvec KIN(1)
#define ctx KIN(2)
#define c_ctx KIN(3)
#define w_mod KIN(4)
#define b_mod KIN(5)
#define norm_g KIN(6)
#define ffn_w_in KIN(7)
#define ffn_w_out KIN(8)
#define w_in KIN(9)
#define w_out KIN(10)
#define ssm_a_re KIN(11)
#define ssm_a_im KIN(12)
#define ssm_log_dt KIN(13)
#define ssm_b_re KIN(14)
#define ssm_b_im KIN(15)
#define ssm_c_re KIN(16)
#define ssm_c_im KIN(17)
#define ssm_d KIN(18)
#define w_glu KIN(19)
#define b_glu KIN(20)
#define lam_q KIN(21)
#define lam_k KIN(22)
#define subln_g KIN(23)
#define final_g KIN(24)
#define MISC ((float*)(ws_p + WS_CTL))
#define MOD ((float*)(ws_p + WS_MOD))
#define ABAR ((float2*)(ws_p + WS_ABAR))
#define APOW ((float2*)(ws_p + WS_APOW))
#define BBT ((bf16*)(ws_p + WS_BBT))
#define CM ((bf16*)(ws_p + WS_CM))
#define ROPE ((float*)(ws_p + WS_ROPE))
#define W1A ((bf16*)(ws_p + WS_W1A))
#define W1B ((bf16*)(ws_p + WS_W1B))
#define W2A ((bf16*)(ws_p + WS_W2A))
#define W2B ((bf16*)(ws_p + WS_W2B))
#define WIN ((bf16*)(ws_p + WS_WIN))
#define WOUT ((bf16*)(ws_p + WS_WOUT))
#define WGLU ((bf16*)(ws_p + WS_WGLU))
#define EST ((float2*)(ws_p + WS_E))
#define HIN ((float2*)(ws_p + WS_HIN))
#define XC ((float*)(ws_p + WS_XC))
#define XN ((bf16*)(ws_p + WS_XN))
#define SA ((bf16*)(ws_p + WS_XN))
#define ACT ((bf16*)(ws_p + WS_ACT))
#define OATT ((float*)(ws_p + WS_OATT))
#define GB ((bf16*)(ws_p + WS_G))
#define YFB ((float*)(ws_p + WS_OATT + 132 * MiB))
#define BIAS1 ((float*)(ws_p + WS_BIAS1))
#define BIAS2 ((float*)(ws_p + WS_BIAS2))
#define RSS1 ((float*)(ws_p + WS_RSS1))
#define RSS2 ((float*)(ws_p + WS_RSS2))
#define XN2 ((bf16*)(ws_p + WS_U))
#define UB ((bf16*)(ws_p + WS_U))
#define QB ((bf16*)(ws_p + WS_Q))
#define KB ((bf16*)(ws_p + WS_K))
#define VB ((bf16*)(ws_p + WS_V))
    (void)a;
    { volatile LAS unsigned* st0 = (volatile LAS unsigned*)(ldsl + 138240); if (tid < 4) st0[tid] = 0u; }
    __syncthreads();
    XcdBarrier xbar = xcd_barrier_post((unsigned*)(ws_p + WS_BAR), (volatile LAS unsigned*)(ldsl + 138240));
#define GSYNC() xcd_barrier(xbar)

    PH(0) {
        if (bx < 288) {
            LAS float* sl = (LAS float*)ldsl; LAS float* part = (LAS float*)(ldsl + 36864);
            for (int i = tid; i < 9 * DM; i += NTHR) { const float v = i < 8 * DM ? cvec[i] : c_ctx[i - 8 * DM]; sl[i] = v / (1.0f + __expf(-v)); }
            __syncthreads();
            for (int unit = bx; unit < 288; unit += G) {
                const int cl = tid & 31, kg = tid >> 5, k0 = kg * 64; const float* wp = w_mod + (size_t)k0 * NMODV + unit * 32 + cl;
                float acc[9];
#pragma unroll
                for (int i = 0; i < 9; ++i) acc[i] = 0.f;
                float wv[64];
#pragma unroll
                for (int kk = 0; kk < 64; ++kk) wv[kk] = wp[(size_t)kk * NMODV];
#pragma unroll
                for (int kk = 0; kk < 64; kk += 4) {
#pragma unroll
                    for (int i = 0; i < 9; ++i) { const f32x4 sv = *(const LAS f32x4*)(sl + i * DM + k0 + kk); acc[i] = fmaf(sv.x, wv[kk], fmaf(sv.y, wv[kk + 1], fmaf(sv.z, wv[kk + 2], fmaf(sv.w, wv[kk + 3], acc[i])))); }
                }
#pragma unroll
                for (int i = 0; i < 9; ++i) part[(kg * 9 + i) * 32 + cl] = acc[i];
                __syncthreads();
                if (tid < 288) { const int i = tid >> 5; float sum = 0.f;
#pragma unroll
                    for (int k = 0; k < 16; ++k) sum += part[(k * 9 + i) * 32 + cl];
                    MOD[i * NMODV + unit * 32 + cl] = sum + b_mod[unit * 32 + cl]; }
                __syncthreads();
            }
        }
        __syncthreads();
        {
            LAS float* scr = (LAS float*)(ldsl + wave * 16384);
            constexpr int I_1A = (DM / 64) * (2 * DFF / 32);
            for (int it = gw; it < I_1A; it += NGW) transpose_item(ffn_w_in, DM, 2 * DFF, W1A, 1, scr, it, lane);
        }
        const int gt = bx * NTHR + tid, NT_ALL = G * NTHR;
        for (int i = gt; i < 2 * 32 * 64; i += NT_ALL) {
            const int p = i & 63, dg = i >> 6;
            const double dt = dexp((double)ssm_log_dt[dg]), are = (double)ssm_a_re[i], aim = (double)ssm_a_im[i];
            double s1, c1, s2, c2; dsincos(dt * aim, s1, c1); dsincos(256.0 * dt * aim, s2, c2);
            const double mag = dexp(dt * are), mag2 = dexp(256.0 * dt * are);
            const double abr = mag * c1, abi = mag * s1;
            ABAR[i] = make_float2((float)abr, (float)abi); APOW[i] = make_float2((float)(mag2 * c2), (float)(mag2 * s2));
            const double zr = abr - 1.0, zi = abi, den = are * are + aim * aim;
            const double cr = (zr * are + zi * aim) / den, ci = (zi * are - zr * aim) / den;
            const float* bre = ssm_b_re + (size_t)i * 16; const float* bim = ssm_b_im + (size_t)i * 16;
            bf16* dre = BBT + ((size_t)(dg * 4 + (p >> 5)) * 32 + (p & 31)) * 16; bf16* dim = BBT + ((size_t)(dg * 4 + 2 + (p >> 5)) * 32 + (p & 31)) * 16;
#pragma unroll
            for (int h = 0; h < 16; ++h) { const double br = (double)bre[h], bi = (double)bim[h]; dre[h] = (bf16)f2bf((float)(cr * br - ci * bi)); dim[h] = (bf16)f2bf((float)(cr * bi + ci * br)); }
        }
        for (int i = gt; i < 2 * 32 * 16 * 64; i += NT_ALL) {
            const int p = i & 63, dgh = i >> 6;
            ((unsigned*)CM)[(size_t)dgh * 64 + p] = pk2(ssm_c_re[i], -ssm_c_im[i]);
        }
        for (int i = gt; i < 128 * 16; i += NT_ALL) {
            const int f = i & 15, pos = i >> 4;
            const double inv = dexp(-(double)f * (9.210340371976182736 / 16.0)); double s, c; dsincos((double)pos * inv, s, c);
            ROPE[2 * i] = (float)c; ROPE[2 * i + 1] = (float)s;
        }
        for (int i = gt; i < NROWS; i += NT_ALL) { RSS1[i] = 0.f; RSS2[i] = 0.f; }
        if (gt == 0) { float s0 = 0.f, s1 = 0.f; for (int d = 0; d < 64; ++d) { s0 += lam_q[d] * lam_k[d]; s1 += lam_q[64 + d] * lam_k[64 + d]; } MISC[0] = expf(s0) - expf(s1) + 0.2f; }
    }
    grid.sync();

#define NORM_PASS(SRC_LAT, SRC_CTX, NIDX, LATONLY) do { int tid_l = threadIdx.x; asm volatile("" : "+v"(tid_l)); const int lane_l = tid_l & 63, gw_l = vcu * NWAVES + __builtin_amdgcn_readfirstlane(tid_l >> 6); \
        for (int it = gw_l; it < NROWS / 16; it += NGW) { const int r0 = it * 16, pm = r0 >> 8, b = pm / TILES_B, jt = pm - b * TILES_B, rl = r0 & 255; \
            if ((LATONLY) && jt == 32) continue; \
            const float* src = jt < 32 ? (SRC_LAT) + ((size_t)b * SEQ + jt * 256 + rl) * DM : (SRC_CTX) + ((size_t)b * CTXL + rl) * DM; \
            const float* mv = MOD + (jt < 32 ? b : 8) * NMODV + 3 * (NIDX) * DM; \
            norm_rows16<0>(src, XN + (size_t)r0 * DM, nullptr, norm_g + (NIDX) * DM, mv, mv + DM, lane_l); } } while (0)

    PH(1) {
        if (bx < 240) {
            const bool isin = bx < 64; const int unit = isin ? bx : bx - 64, N = isin ? 2048 : 2 * DFF, soff = isin ? 3 * DM : 6 * DM;
            const float* W = isin ? w_in : ffn_w_in + (size_t)DM * 2 * DFF; float* BO = isin ? BIAS1 : BIAS2;
            LAS float* sl = (LAS float*)ldsl; LAS float* part = (LAS float*)(ldsl + 36864);
            for (int i = tid; i < 9 * DM; i += NTHR) sl[i] = MOD[(i >> 10) * NMODV + soff + (i & 1023)];
            __syncthreads();
            const int cl = tid & 31, kg = tid >> 5, k0 = kg * 64; const float* wp = W + (size_t)k0 * N + unit * 32 + cl;
            float acc[9];
#pragma unroll
            for (int i = 0; i < 9; ++i) acc[i] = 0.f;
            float wv[64];
#pragma unroll
            for (int kk = 0; kk < 64; ++kk) wv[kk] = wp[(size_t)kk * N];
#pragma unroll
            for (int kk = 0; kk < 64; kk += 4) {
#pragma unroll
                for (int i = 0; i < 9; ++i) { const f32x4 sv = *(const LAS f32x4*)(sl + i * DM + k0 + kk); acc[i] = fmaf(sv.x, wv[kk], fmaf(sv.y, wv[kk + 1], fmaf(sv.z, wv[kk + 2], fmaf(sv.w, wv[kk + 3], acc[i])))); }
            }
#pragma unroll
            for (int i = 0; i < 9; ++i) part[(kg * 9 + i) * 32 + cl] = acc[i];
            __syncthreads();
            if (tid < 288) { const int i = tid >> 5; float sum = 0.f;
#pragma unroll
                for (int k = 0; k < 16; ++k) sum += part[(k * 9 + i) * 32 + cl];
                const int src = unit * 32 + cl; int drow = src;
                if (isin) { if (src >= 512 && src < 1536) drow = unit * 32 + 2 * (cl & 15) + (cl >> 4); }
                else { const int up = src >= DFF ? 1 : 0, ff = src - up * DFF; drow = (ff >> 7) * 256 + up * 128 + (ff & 127); }
                BO[i * N + drow] = sum; }
            __syncthreads();
        }
        NORM_PASS(x_in, ctx, 0, false);
    }
    GSYNC();
    PH(2) { pg8::Gemm g{XN, W1A, NROWS, 2 * DFF, DM}; pg8::TileOrder S; S.init(264, 22, G, bx, 0); pg8::EpiSwiglu E{ACT, DFF, nullptr, nullptr};
      pg8::gemm_phase<pg8::EpiSwiglu, pg8::TileOrder, true, true>(ldsl, g, S, E);
      if (bx >= 176) {
          int tid_l = threadIdx.x; asm volatile("" : "+v"(tid_l)); const int lane_l = tid_l & 63, wave_l = __builtin_amdgcn_readfirstlane(tid_l >> 6);
          LAS float* scr = (LAS float*)(ldsl + wave_l * 16384);
          constexpr int I_1B = (DFF / 64) * (DM / 32);
          for (int it = (bx - 176) * NWAVES + wave_l; it < I_1B; it += (G - 176) * NWAVES) transpose_item(ffn_w_out, DFF, DM, W1B, 0, scr, it, lane_l);
      } }
    GSYNC();
    PH(3) { pg8::Gemm g{ACT, W1B, NROWS, DM, DFF}; pg8::TileOrder S; S.init(264, 4, G, bx, 0); pg8::EpiResidNorm E{x_in, ctx, out_p, XC, MOD, 2 * DM, 1, norm_g + DM, 4 * DM, XN, RSS1};
      pg8::gemm_phase<pg8::EpiResidNorm, pg8::TileOrder, true, true>(ldsl, g, S, E);
      if (bx >= 32) {
          int tid_l = threadIdx.x; asm volatile("" : "+v"(tid_l)); const int lane_l = tid_l & 63, wave_l = __builtin_amdgcn_readfirstlane(tid_l >> 6);
          LAS float* scr = (LAS float*)(ldsl + wave_l * 16384);
          constexpr int I_1A = (DM / 64) * (2 * DFF / 32), I_1B = (DFF / 64) * (DM / 32), I_OUT = (DM / 64) * (DM / 32), I_GLU = (512 / 64) * (512 / 32), I_IN = (DM / 64) * (2048 / 32);
          for (int it = (bx - 32) * NWAVES + wave_l; it < I_IN + I_1A + I_1B + I_OUT + I_GLU; it += (G - 32) * NWAVES) {
              int r = it;
              if (r < I_IN) { transpose_item(w_in, DM, 2048, WIN, 2, scr, r, lane_l); continue; } r -= I_IN;
              if (r < I_1A) { transpose_item(ffn_w_in + (size_t)DM * 2 * DFF, DM, 2 * DFF, W2A, 1, scr, r, lane_l); continue; } r -= I_1A;
              if (r < I_1B) { transpose_item(ffn_w_out + (size_t)DFF * DM, DFF, DM, W2B, 0, scr, r, lane_l); continue; } r -= I_1B;
              if (r < I_OUT) { transpose_item(w_out, DM, DM, WOUT, 0, scr, r, lane_l); continue; } r -= I_OUT;
              transpose_item(w_glu, 512, 512, WGLU, 0, scr, r, lane_l);
          }
      } }
    GSYNC();
    PH(5) { pg8::Gemm g{XN, WIN, NROWS, 2048, DM}; pg8::TileOrder S; S.init(264, 8, G, bx, 0); pg8::EpiInproj E{UB, QB, KB, VB, ROPE, RSS1, BIAS1};
      pg8::gemm_phase<pg8::EpiInproj, pg8::TileOrder, true, true>(ldsl, g, S, E); }
    GSYNC();
    PH(6) for (int un = vcu; un < 8 * 33 * 4; un += G) { const int gq = un & 3, bc = un >> 2, b = bc / 33, c = bc - b * 33;
        s5_unit_a(ldsl, b, c, gq, UB, ABAR, BBT, EST); }
    GSYNC();
    PH(7) if (bx < 64) {
        int tid_c = threadIdx.x; asm volatile("" : "+v"(tid_c));
        const int i = bx * NTHR + tid_c;
        const int p = i & 63, dir = (i >> 6) & 1, g = (i >> 7) & 31, b = i >> 12;
        const float2 ap = APOW[(dir * 32 + g) * 64 + p];
#define SIDX(cc) (((((size_t)b * 33 + (cc)) * 32 + g) * 2 + dir) * 64 + p)
        float2 h = EST[SIDX(32)];
        if (dir == 0) { HIN[SIDX(0)] = h; for (int c = 0; c < 31; ++c) { const float2 e = EST[SIDX(c)]; const float nr = fmaf(ap.x, h.x, fmaf(-ap.y, h.y, e.x)), ni = fmaf(ap.x, h.y, fmaf(ap.y, h.x, e.y)); h = make_float2(nr, ni); HIN[SIDX(c + 1)] = h; } }
        else { HIN[SIDX(31)] = h; for (int c = 31; c > 0; --c) { const float2 e = EST[SIDX(c)]; const float nr = fmaf(ap.x, h.x, fmaf(-ap.y, h.y, e.x)), ni = fmaf(ap.x, h.y, fmaf(ap.y, h.x, e.y)); h = make_float2(nr, ni); HIN[SIDX(c - 1)] = h; } }
#undef SIDX
    }
    PH(8) {
        const float lam = MISC[0];
        unsigned redo_mask = 0u;
        {
        int k_ = 0;
        for (int un = vcu; un < 8 * 4 * 32; un += G, ++k_) {
            const int qb = un & 31, bh = un >> 5, b = bh >> 2, h = bh & 3;
            const size_t rb = (size_t)b * ROWS_B, rq = rb + (size_t)qb * 256;
            const attn::bf16_t* q0 = QB + rq * 512 + h * 128; const attn::bf16_t* k0 = KB + rb * 512 + h * 128; const attn::bf16_t* v0 = VB + rb * 512 + h * 128;
            float* st = OATT + rq * 512 + h * 128; attn::bf16_t* so = SA + rq * 1024 + 512 + h * 128;
            bool redo = attn::body<0, false>(q0, k0, v0, st, nullptr, lam, subln_g, ROWS_B, (char*)lds);
            if (!redo) redo = attn::body<1, false>(q0 + 64, k0 + 64, v0, st, so, lam, subln_g, ROWS_B, (char*)lds);
            if (redo) redo_mask |= 1u << k_;
        }
        }
        if (redo_mask) {
            int k_ = 0;
            for (int un = vcu; un < 8 * 4 * 32; un += G, ++k_) {
                if (!((redo_mask >> k_) & 1u)) continue;
                const int qb = un & 31, bh = un >> 5, b = bh >> 2, h = bh & 3;
                const size_t rb = (size_t)b * ROWS_B, rq = rb + (size_t)qb * 256;
                const attn::bf16_t* q0 = QB + rq * 512 + h * 128; const attn::bf16_t* k0 = KB + rb * 512 + h * 128; const attn::bf16_t* v0 = VB + rb * 512 + h * 128;
                float* st = OATT + rq * 512 + h * 128; attn::bf16_t* so = SA + rq * 1024 + 512 + h * 128;
                (void)attn::body<0, true>(q0, k0, v0, st, nullptr, lam, subln_g, ROWS_B, (char*)lds);
                (void)attn::body<1, true>(q0 + 64, k0 + 64, v0, st, so, lam, subln_g, ROWS_B, (char*)lds);
            }
        }
    }
    GSYNC();
    PH(9) for (int un = vcu; un < 8 * 32 * 4; un += G) { const int gq = un & 3, bc = un >> 2, b = bc >> 5, c = bc & 31;
        s5_unit<true>(ldsl, b, c, gq, UB, ABAR, BBT, CM, HIN, EST, ssm_d, GB, YFB); }
    GSYNC();
    PH(10) { pg8::Gemm g{GB, WGLU, NROWS, 512, 512}; pg8::TileOrder S; S.init(256, 2, G, bx, 1); pg8::EpiGlu E{GB, b_glu, SA};
      pg8::gemm_phase<pg8::EpiGlu, pg8::TileOrder, true, true>(ldsl, g, S, E); }
    GSYNC();
    PH(12) { pg8::Gemm g{SA, WOUT, NROWS, DM, DM}; pg8::TileOrder S; S.init(256, 4, G, bx, 1); pg8::EpiResidNorm E{out_p, XC, out_p, XC, MOD, 5 * DM, 0, norm_g + 2 * DM, 7 * DM, XN2, RSS2};
      pg8::gemm_phase<pg8::EpiResidNorm, pg8::TileOrder, true, true>(ldsl, g, S, E); }
    GSYNC();
    PH(14) { pg8::Gemm g{XN2, W2A, NROWS, 2 * DFF, DM}; pg8::TileOrder S; S.init(256, 22, G, bx, 1); pg8::EpiSwiglu E{ACT, DFF, RSS2, BIAS2};
      pg8::gemm_phase<pg8::EpiSwiglu, pg8::TileOrder, true, true>(ldsl, g, S, E); }
    GSYNC();
    PH(15) { pg8::Gemm g{ACT, W2B, NROWS, DM, DFF}; pg8::TileOrder S; S.init(256, 4, G, bx, 1); pg8::EpiResid E{out_p, XC, out_p, XC, MOD, 8 * DM, 0.5f};
      pg8::gemm_phase<pg8::EpiResid, pg8::TileOrder, true, true>(ldsl, g, S, E); }
    GSYNC();
    PH(16) { int tid_l = threadIdx.x; asm volatile("" : "+v"(tid_l)); const int lane_l = tid_l & 63, gw_l = vcu * NWAVES + __builtin_amdgcn_readfirstlane(tid_l >> 6);
        for (int it = gw_l; it < NB * SEQ / 16; it += NGW) norm_rows16<1>(out_p + (size_t)it * 16 * DM, nullptr, out_p + (size_t)it * 16 * DM, final_g, nullptr, nullptr, lane_l); }
#undef NORM_PASS
}

extern "C" void kernel_launch(void* const* d_in, const int* in_sizes, int n_in, void* d_out, int out_size, void* d_ws, size_t ws_size, hipStream_t stream) {
    static int grid = 0;
    if (grid == 0) {
        if (n_in != 25 || in_sizes[0] != NB * SEQ * DM || out_size != NB * SEQ * DM || ws_size < WS_END) {
            fprintf(stderr, "kernel_launch: shape mismatch (n_in %d, in0 %d, out %d, ws %zu, need %zu); nothing launched\n", n_in, n_in > 0 ? in_sizes[0] : -1, out_size, ws_size, (size_t)WS_END); grid = -1; return; }
        int dev = 0, cus = 0, per_cu = 0;
        if (hipGetDevice(&dev) != hipSuccess || hipDeviceGetAttribute(&cus, hipDeviceAttributeMultiprocessorCount, dev) != hipSuccess) { grid = -1; return; }
        if (hipFuncSetAttribute((const void*)hymba_fwd, hipFuncAttributeMaxDynamicSharedMemorySize, LDS_BYTES) != hipSuccess) { fprintf(stderr, "kernel_launch: hipFuncSetAttribute failed\n"); grid = -1; return; }
        if (hipOccupancyMaxActiveBlocksPerMultiprocessor(&per_cu, (const void*)hymba_fwd, NTHR, LDS_BYTES) != hipSuccess || per_cu < 1) { fprintf(stderr, "kernel_launch: occupancy query says %d\n", per_cu); per_cu = 1; }
        (void)hipGetLastError();
        grid = cus * (per_cu > 1 ? 1 : per_cu);
        if (grid != 256) fprintf(stderr, "kernel_launch: grid %d (expected 256)\n", grid);
    }
    if (grid < 0) return;
    (void)hipMemsetAsync((char*)d_ws + WS_BAR, 0, BAR_ZERO_BYTES, stream);
    Args a{};
    for (int i = 0; i < 25; ++i) a.in[i] = (const float*)d_in[i];
    a.out = (float*)d_out; a.ws = (unsigned char*)d_ws;
    void* args[] = {&a};
    const hipError_t e = hipLaunchCooperativeKernel((const void*)hymba_fwd, dim3(grid), dim3(NTHR), args, LDS_BYTES, stream);
    if (e != hipSuccess) fprintf(stderr, "kernel_launch: cooperative launch failed: %s (grid %d)\n", hipGetErrorString(e), grid);
}
```

```cpp
#include <hip/hip_runtime.h>
#include <hip/hip_cooperative_groups.h>
#include <cstdio>
#include <cstdint>
namespace cg = cooperative_groups;
namespace pg8 {
#define PG8_LAS __attribute__((address_space(3)))
typedef unsigned short bf16_t;
typedef short bf16x8 __attribute__((ext_vector_type(8)));
typedef float f32x4 __attribute__((ext_vector_type(4)));
typedef unsigned u32x4 __attribute__((ext_vector_type(4)));
constexpr int BM = 256, BK = 64, HALF = 128, HTB = HALF * BK * 2  , STAGE_BYTES = 8 * HTB, NXCD = 8, WGM = 8;

__host__ __device__ __forceinline__ int lds_byte(int r, int c) { const int st = (r >> 4) * 2 + (c >> 5), rr = r & 15, cc = c & 31, ob = rr * 64 + cc * 2; return st * 1024 + (ob ^ (((ob >> 9) & 1) << 5)); }
__host__ __device__ __forceinline__ void stage_rc(int b, int& R, int& C) { const int st = b / 1024, sb = b % 1024, swz = sb ^ (((sb >> 9) & 1) << 5); R = (st >> 1) * 16 + swz / 64; C = (st & 1) * 32 + (swz % 64) / 2; }
__host__ __device__ __forceinline__ int perm32(int rho) { const int n = rho >> 4, i = rho & 15; return 8 * (i >> 2) + 4 * n + (i & 3); }

struct Unit { int pm, pn; };
struct Gemm { const bf16_t* A; const bf16_t* Bt; int M, N, K; };

__device__ __forceinline__ unsigned cvt_pk_bf16(float lo, float hi) { unsigned r; asm volatile("v_cvt_pk_bf16_f32 %0, %1, %2" : "=v"(r) : "v"(lo), "v"(hi)); return r; }
typedef float f32x2 __attribute__((ext_vector_type(2)));
typedef unsigned u32x2 __attribute__((ext_vector_type(2)));
constexpr int ROWS_B = 8448, TILES_B = 33, NROWS = 8 * ROWS_B;

struct TileOrder {
    int nM, nN, nwg, G, c, lat;
    __device__ __forceinline__ void init(int nM_, int nN_, int G_, int c_, int lat_) { nM = nM_; nN = nN_; nwg = nM_ * nN_; G = G_; c = c_; lat = lat_; }
    __device__ __forceinline__ bool next(int i, Unit& u) const {
        const long L = (long)i * G + c; if (L >= nwg) return false;
        int wgid = (int)L; { const int q = nwg / NXCD, r = nwg % NXCD, xcd = wgid % NXCD, off = wgid / NXCD; wgid = (xcd < r ? xcd * (q + 1) : r * (q + 1) + (xcd - r) * q) + off; }
        const int nig = WGM * nN, gid = wgid / nig, fm = gid * WGM, gsz = (nM - fm) < WGM ? (nM - fm) : WGM;
        const int lm = fm + ((wgid % nig) % gsz); u.pn = (wgid % nig) / gsz; u.pm = lat ? (lm >> 5) * TILES_B + (lm & 31) : lm; return true;
    }
    __device__ __forceinline__ void a_ready(const Unit&) const {}
    __device__ __forceinline__ void done(const Unit&) const {}
};

__device__ __forceinline__ float fast_sigmoid(float z) { return __builtin_amdgcn_rcpf(1.0f + __builtin_amdgcn_exp2f(-1.4426950408889634f * z)); }
__device__ __forceinline__ float bf_lo(unsigned w) { return __uint_as_float(w << 16); }
__device__ __forceinline__ float bf_hi(unsigned w) { return __uint_as_float(w & 0xffff0000u); }

struct EpiSwiglu {
    static constexpr bool PERM = true, AFTER_DRAIN = false;
    bf16_t* O; int ldc; const float* rss; const float* bias;
    __device__ __forceinline__ void operator()(const f32x4 (&acc)[2][2][4][2], const Unit& u, int wr, int wc, int fr, int fq) const {
        const int row0 = u.pm * BM + wr * 64 + fr, col0 = u.pn * HALF + wc * 32 + 8 * fq;
        f32x4 bv[2][2];
#pragma unroll
        for (int bj = 0; bj < 2; ++bj)
#pragma unroll
            for (int n = 0; n < 2; ++n) bv[bj][n] = rss ? *(const f32x4*)(bias + (u.pm / TILES_B) * 5632 + u.pn * BM + bj * HALF + wc * 32 + 8 * fq + 4 * n) : (f32x4){0.f, 0.f, 0.f, 0.f};
#pragma unroll
        for (int ai = 0; ai < 2; ++ai)
#pragma unroll
            for (int m = 0; m < 4; ++m) {
                bf16_t* rowp = O + (size_t)(row0 + ai * HALF + m * 16) * ldc + col0;
                float v[8];
                const float rstd = rss ? 1.0f / sqrtf(rss[row0 + ai * HALF + m * 16] * (1.0f / 1024.0f) + 1e-6f) : 1.0f;
#pragma unroll
                for (int n = 0; n < 2; ++n)
#pragma unroll
                    for (int e = 0; e < 4; ++e) { const float gt = acc[ai][0][m][n][e] * rstd + bv[0][n][e], up = acc[ai][1][m][n][e] * rstd + bv[1][n][e]; v[4 * n + e] = gt * fast_sigmoid(gt) * up; }
                u32x4 w; w.x = cvt_pk_bf16(v[0], v[1]); w.y = cvt_pk_bf16(v[2], v[3]); w.z = cvt_pk_bf16(v[4], v[5]); w.w = cvt_pk_bf16(v[6], v[7]);
                *(u32x4*)rowp = w;
            }
    }
};

struct EpiResid {
    static constexpr bool PERM = true, AFTER_DRAIN = false;
    const float* res_lat; const float* res_ctx; float* out_lat; float* out_ctx; const float* mod; int modoff; float scale;
    __device__ __forceinline__ void operator()(const f32x4 (&acc)[2][2][4][2], const Unit& u, int wr, int wc, int fr, int fq) const {
        const int b = u.pm / TILES_B, jt = u.pm - b * TILES_B;
        const float* rb; float* ob; const float* gv;
        if (jt < 32) { const size_t o = ((size_t)b * 8192 + (size_t)jt * 256) * 1024; rb = res_lat + o; ob = out_lat + o; gv = mod + b * 9216 + modoff; }
        else { const size_t o = (size_t)b * 256 * 1024; rb = res_ctx + o; ob = out_ctx + o; gv = mod + 8 * 9216 + modoff; }
        const int rl = wr * 64 + fr, col0 = u.pn * BM + wc * 32 + 8 * fq;
        const char* rbb = (const char*)rb; char* obb = (char*)ob;
#pragma unroll
        for (int bj = 0; bj < 2; ++bj) {
            const int c = col0 + bj * HALF;
            const f32x4 g0 = *(const f32x4*)(gv + c) * scale, g1 = *(const f32x4*)(gv + c + 4) * scale;
#pragma unroll
            for (int kb = 0; kb < 8; kb += 8) {
                f32x4 x0[8], x1[8];
#pragma unroll
                for (int k = 0; k < 8; ++k) { const int ai = (kb + k) >> 2, m = (kb + k) & 3; const unsigned pb = (unsigned)((rl + ai * HALF + m * 16) * 1024 + c) * 4u; x0[k] = *(const f32x4*)(rbb + pb); x1[k] = *(const f32x4*)(rbb + pb + 16); }
                asm volatile("" ::: "memory");
#pragma unroll
                for (int k = 0; k < 8; ++k) { const int ai = (kb + k) >> 2, m = (kb + k) & 3; const unsigned pb = (unsigned)((rl + ai * HALF + m * 16) * 1024 + c) * 4u;
                    *(f32x4*)(obb + pb) = x0[k] + g0 * acc[ai][bj][m][0]; *(f32x4*)(obb + pb + 16) = x1[k] + g1 * acc[ai][bj][m][1]; }
                asm volatile("" ::: "memory");
            }
        }
    }
};

struct EpiResidNorm {
    static constexpr bool PERM = true, AFTER_DRAIN = false;
    const float* res_lat; const float* res_ctx; float* out_lat; float* out_ctx; const float* mod; int gateoff; int half_gate; const float* ng; int scaleoff; bf16_t* XNo; float* rss;
    __device__ __forceinline__ void operator()(const f32x4 (&acc)[2][2][4][2], const Unit& u, int wr, int wc, int fr, int fq) const {
        const int b = u.pm / TILES_B, jt = u.pm - b * TILES_B;
        const float* rb; float* ob; const float* mv;
        if (jt < 32) { const size_t o = ((size_t)b * 8192 + (size_t)jt * 256) * 1024; rb = res_lat + o; ob = out_lat + o; mv = mod + b * 9216; }
        else { const size_t o = (size_t)b * 256 * 1024; rb = res_ctx + o; ob = out_ctx + o; mv = mod + 8 * 9216; }
        const int rl = wr * 64 + fr, col0 = u.pn * BM + wc * 32 + 8 * fq;
        const float scale = half_gate ? 0.5f : 1.0f;
#ifndef EPI_RB
#define EPI_RB 4
#endif
        const char* rbb = (const char*)rb; char* obb = (char*)ob;
        typedef __attribute__((address_space(1))) float gfloat_t;
#pragma unroll
        for (int bj = 0; bj < 2; ++bj) {
            const int c = col0 + bj * HALF;
            const f32x4 g0 = *(const f32x4*)(mv + gateoff + c) * scale, g1 = *(const f32x4*)(mv + gateoff + c + 4) * scale;
            const f32x4 gs0 = *(const f32x4*)(ng + c) * (*(const f32x4*)(mv + scaleoff + c) + 1.0f), gs1 = *(const f32x4*)(ng + c + 4) * (*(const f32x4*)(mv + scaleoff + c + 4) + 1.0f);
#pragma unroll
            for (int kb = 0; kb < 8; kb += EPI_RB) {
                f32x4 x0[EPI_RB], x1[EPI_RB];
#pragma unroll
                for (int k = 0; k < EPI_RB; ++k) { const int ai = (kb + k) >> 2, m = (kb + k) & 3; const unsigned pb = (unsigned)((rl + ai * HALF + m * 16) * 1024 + c) * 4u; x0[k] = *(const f32x4*)(rbb + pb); x1[k] = *(const f32x4*)(rbb + pb + 16); }
                asm volatile("" ::: "memory");
#pragma unroll
                for (int k = 0; k < EPI_RB; ++k) { const int ai = (kb + k) >> 2, m = (kb + k) & 3; const int rr = rl + ai * HALF + m * 16; const unsigned pb = (unsigned)(rr * 1024 + c) * 4u; const size_t prow = (size_t)u.pm * BM + rr;
                    const f32x4 y0 = x0[k] + g0 * acc[ai][bj][m][0], y1 = x1[k] + g1 * acc[ai][bj][m][1];
                    *(f32x4*)(obb + pb) = y0; *(f32x4*)(obb + pb + 16) = y1;
                    float t = (y0[0] * y0[0] + y0[1] * y0[1]) + (y0[2] * y0[2] + y0[3] * y0[3]) + (y1[0] * y1[0] + y1[1] * y1[1]) + (y1[2] * y1[2] + y1[3] * y1[3]);
                    const f32x4 z0 = y0 * gs0, z1 = y1 * gs1;
                    u32x4 w; w.x = cvt_pk_bf16(z0[0], z0[1]); w.y = cvt_pk_bf16(z0[2], z0[3]); w.z = cvt_pk_bf16(z1[0], z1[1]); w.w = cvt_pk_bf16(z1[2], z1[3]);
                    *(u32x4*)(XNo + prow * 1024 + c) = w;
                    t += __shfl_xor(t, 16); t += __shfl_xor(t, 32);
                    if (fq == 0) __hip_atomic_fetch_add((gfloat_t*)(rss + prow), t, __ATOMIC_RELAXED, __HIP_MEMORY_SCOPE_AGENT); }
                asm volatile("" ::: "memory");
            }
        }
    }
};

struct EpiInproj {
    static constexpr bool PERM = true, AFTER_DRAIN = false;
    bf16_t* U; bf16_t* Q; bf16_t* K; bf16_t* V; const float* rope; const float* rss; const float* bias;
    __device__ __forceinline__ void operator()(const f32x4 (&acc)[2][2][4][2], const Unit& u, int wr, int wc, int fr, int fq) const {
        const int sec = u.pn >> 1, jt = u.pm % TILES_B;
        bf16_t* base = sec == 0 ? U : sec == 1 ? Q : sec == 2 ? K : V;
        const bool dorope = (sec == 1 || sec == 2) && jt < 32;
        const float qs = sec == 1 ? 0.125f * 1.4426950408889634f : 1.0f;
        const int col0 = (u.pn & 1) * BM + wc * 32 + 8 * fq, axis = wc & 1;
        const float* bp = bias + (jt < 32 ? u.pm / TILES_B : 8) * 2048 + u.pn * BM + wc * 32 + 8 * fq;
        f32x4 bv[2][2];
#pragma unroll
        for (int bj = 0; bj < 2; ++bj)
#pragma unroll
            for (int n = 0; n < 2; ++n) bv[bj][n] = *(const f32x4*)(bp + bj * HALF + 4 * n);
#pragma unroll
        for (int ai = 0; ai < 2; ++ai)
#pragma unroll
            for (int m = 0; m < 4; ++m) {
                const int rowl = wr * 64 + fr + ai * HALF + m * 16;
                bf16_t* rowp = base + (size_t)(u.pm * BM + rowl) * 512 + col0;
                const float rstd = 1.0f / sqrtf(rss[u.pm * BM + rowl] * (1.0f / 1024.0f) + 1e-6f);
                f32x4 cs0 = {1.f, 0.f, 1.f, 0.f}, cs1 = {1.f, 0.f, 1.f, 0.f};
                if (dorope) { const int t = jt * 256 + rowl, pos = axis ? (t & 63) : (t >> 6); const float* rp = rope + (pos * 16 + 4 * fq) * 2; cs0 = *(const f32x4*)rp; cs1 = *(const f32x4*)(rp + 4); }
#pragma unroll
                for (int bj = 0; bj < 2; ++bj) {
                    const f32x4 a0 = acc[ai][bj][m][0] * rstd + bv[bj][0], a1 = acc[ai][bj][m][1] * rstd + bv[bj][1];
                    float o[8];
                    o[0] = a0[0] * cs0[0] - a0[1] * cs0[1]; o[1] = a0[1] * cs0[0] + a0[0] * cs0[1];
                    o[2] = a0[2] * cs0[2] - a0[3] * cs0[3]; o[3] = a0[3] * cs0[2] + a0[2] * cs0[3];
                    o[4] = a1[0] * cs1[0] - a1[1] * cs1[1]; o[5] = a1[1] * cs1[0] + a1[0] * cs1[1];
                    o[6] = a1[2] * cs1[2] - a1[3] * cs1[3]; o[7] = a1[3] * cs1[2] + a1[2] * cs1[3];
                    u32x4 w; w.x = cvt_pk_bf16(o[0] * qs, o[1] * qs); w.y = cvt_pk_bf16(o[2] * qs, o[3] * qs); w.z = cvt_pk_bf16(o[4] * qs, o[5] * qs); w.w = cvt_pk_bf16(o[6] * qs, o[7] * qs);
                    *(u32x4*)(rowp + bj * HALF) = w;
                }
            }
    }
};

struct EpiGlu {
    static constexpr bool PERM = true, AFTER_DRAIN = false;
    const bf16_t* Gb; const float* bglu; bf16_t* SA;
    __device__ __forceinline__ void operator()(const f32x4 (&acc)[2][2][4][2], const Unit& u, int wr, int wc, int fr, int fq) const {
        const int row0 = u.pm * BM + wr * 64 + fr, col0 = u.pn * BM + wc * 32 + 8 * fq;
        f32x4 bv[2][2];
#pragma unroll
        for (int bj = 0; bj < 2; ++bj)
#pragma unroll
            for (int n = 0; n < 2; ++n) bv[bj][n] = *(const f32x4*)(bglu + col0 + bj * HALF + 4 * n);
#pragma unroll
        for (int ai = 0; ai < 2; ++ai)
#pragma unroll
            for (int m = 0; m < 4; ++m) { const size_t row = (size_t)(row0 + ai * HALF + m * 16);
#pragma unroll
                for (int bj = 0; bj < 2; ++bj) {
                    const u32x4 gw = *(const u32x4*)(Gb + row * 512 + col0 + bj * HALF);
                    const f32x4 z0 = acc[ai][bj][m][0] + bv[bj][0], z1 = acc[ai][bj][m][1] + bv[bj][1];
                    u32x4 w;
                    w.x = cvt_pk_bf16(bf_lo(gw.x) * fast_sigmoid(z0[0]), bf_hi(gw.x) * fast_sigmoid(z0[1]));
                    w.y = cvt_pk_bf16(bf_lo(gw.y) * fast_sigmoid(z0[2]), bf_hi(gw.y) * fast_sigmoid(z0[3]));
                    w.z = cvt_pk_bf16(bf_lo(gw.z) * fast_sigmoid(z1[0]), bf_hi(gw.z) * fast_sigmoid(z1[1]));
                    w.w = cvt_pk_bf16(bf_lo(gw.w) * fast_sigmoid(z1[2]), bf_hi(gw.w) * fast_sigmoid(z1[3]));
                    *(u32x4*)(SA + row * 1024 + col0 + bj * HALF) = w;
                } }
    }
};

template <class Epi, class Sched, bool ALIGN_EPI = false, bool SP2 = false>
__device__ __forceinline__ void gemm_phase(PG8_LAS unsigned char* lds, const Gemm g, const Sched& S, const Epi& E) {
    int tid_ = threadIdx.x; asm volatile("" : "+v"(tid_));
    const int tid = tid_, wid = __builtin_amdgcn_readfirstlane(tid >> 6), lane = tid & 63, wr = wid >> 2, wc = wid & 3, fr = lane & 15, fq = lane >> 4;
    const int K = g.K, nt = K / BK;
    unsigned voffA[2], voffB[2];
#pragma unroll
    for (int i = 0; i < 2; ++i) { int R, C; stage_rc(tid * 16 + i * 8192, R, C); const int Rb = Epi::PERM ? ((R & ~31) + perm32(R & 31)) : R;
        voffA[i] = (unsigned)(R * K + C) * 2u; voffB[i] = (unsigned)(Rb * K + C) * 2u; }
    const size_t kstep = (size_t)(BK * 2);
    const size_t hstep = (size_t)HALF * K * 2;
    const size_t tstep = 2 * hstep;
    const unsigned ldsw = (unsigned)wid * 1024u;
    const int aoff = lds_byte(wr * 64 + fr, fq * 8), boff = lds_byte(wc * 32 + fr, fq * 8);
#define PG8_SA(b, h) (((b) * 2 + (h)) * HTB)
#define PG8_SB(b, h) ((4 + (b) * 2 + (h)) * HTB)
#define PG8_STAGE(bufoff, gbase, voff) do { _Pragma("unroll") for (int _i = 0; _i < 2; ++_i) \
        __builtin_amdgcn_global_load_lds((const unsigned*)((const char*)(gbase) + (voff)[_i]), (PG8_LAS unsigned*)(lds + (bufoff) + ldsw + _i * 8192), 16, 0, 0); } while (0)
#define PG8_LDA(dst, b, h) do { _Pragma("unroll") for (int m = 0; m < 4; ++m) _Pragma("unroll") for (int k = 0; k < 2; ++k) dst[m][k] = *(const PG8_LAS bf16x8*)(lds + PG8_SA(b, h) + aoff + m * 2048 + k * 1024); } while (0)
#define PG8_LDB(dst, b, h) do { _Pragma("unroll") for (int n = 0; n < 2; ++n) _Pragma("unroll") for (int k = 0; k < 2; ++k) dst[n][k] = *(const PG8_LAS bf16x8*)(lds + PG8_SB(b, h) + boff + n * 2048 + k * 1024); } while (0)
#define PG8_MMA(ai, bj, At, Bt) do { __builtin_amdgcn_s_setprio(1); _Pragma("unroll") for (int m = 0; m < 4; ++m) _Pragma("unroll") for (int n = 0; n < 2; ++n) _Pragma("unroll") for (int k = 0; k < 2; ++k) \
        acc[ai][bj][m][n] = __builtin_amdgcn_mfma_f32_16x16x32_bf16(Bt[n][k], At[m][k], acc[ai][bj][m][n], 0, 0, 0); __builtin_amdgcn_s_setprio(0); } while (0)
#define PG8_WAIT_V(n) asm volatile("s_waitcnt vmcnt(" #n ")" ::: "memory")
#define PG8_WAIT_L(n) asm volatile("s_waitcnt lgkmcnt(" #n ")" ::: "memory")
#define PG8_BAR __builtin_amdgcn_s_barrier()
#define PG8_SCHED __builtin_amdgcn_sched_barrier(0)
    Unit cur, nxt; int ui = 0;
    if (!S.next(0, cur)) return;
    f32x4 acc[2][2][4][2];
#pragma unroll
    for (int a = 0; a < 2; ++a)
#pragma unroll
        for (int b = 0; b < 2; ++b)
#pragma unroll
            for (int m = 0; m < 4; ++m)
#pragma unroll
                for (int n = 0; n < 2; ++n) acc[a][b][m][n] = (f32x4){0.f, 0.f, 0.f, 0.f};
    bf16x8 At[4][2], B0[2][2], B1[2][2];
    const char* cA = (const char*)g.A + (size_t)cur.pm * tstep; const char* cB = (const char*)g.Bt + (size_t)cur.pn * tstep;
    S.a_ready(cur);
    if constexpr (SP2) {
        PG8_STAGE(PG8_SB(0, 0), cB, voffB); PG8_STAGE(PG8_SB(0, 1), cB + hstep, voffB); PG8_STAGE(PG8_SA(0, 0), cA, voffA); PG8_STAGE(PG8_SA(0, 1), cA + hstep, voffA);
        if (wr == 1) PG8_BAR;
        PG8_WAIT_V(2); PG8_BAR;
        PG8_STAGE(PG8_SB(1, 0), cB + kstep, voffB); PG8_STAGE(PG8_SA(1, 0), cA + kstep, voffA); PG8_STAGE(PG8_SB(1, 1), cB + hstep + kstep, voffB);
        PG8_WAIT_V(6); PG8_BAR;
    } else {
        PG8_STAGE(PG8_SB(0, 0), cB, voffB); PG8_STAGE(PG8_SA(0, 0), cA, voffA); PG8_STAGE(PG8_SB(0, 1), cB + hstep, voffB); PG8_STAGE(PG8_SA(0, 1), cA + hstep, voffA);
        if (wr == 1) PG8_BAR;
        PG8_WAIT_V(4); PG8_BAR;
        PG8_STAGE(PG8_SB(1, 0), cB + kstep, voffB); PG8_STAGE(PG8_SA(1, 0), cA + kstep, voffA); PG8_STAGE(PG8_SB(1, 1), cB + hstep + kstep, voffB);
        PG8_WAIT_V(6); PG8_BAR;
    }
    for (;;) {
        const bool has_next = S.next(ui + 1, nxt);
        const char* nA = has_next ? (const char*)g.A + (size_t)nxt.pm * tstep : cA; const char* nB = has_next ? (const char*)g.Bt + (size_t)nxt.pn * tstep : cB;
        for (int t = 0; t < nt; t += 2) {
            const bool last = (t == nt - 2);
            const char* a1 = cA + (size_t)(t + 1) * kstep;
            const char* a2 = last ? nA : cA + (size_t)(t + 2) * kstep; const char* b2 = last ? nB : cB + (size_t)(t + 2) * kstep;
            const char* a3 = a2 + kstep; const char* b3 = b2 + kstep;
            if (last && has_next) S.a_ready(nxt);
            if constexpr (SP2) {
            PG8_LDB(B0, 0, 0); PG8_LDB(B1, 0, 1); PG8_SCHED; PG8_LDA(At, 0, 0); PG8_STAGE(PG8_SA(1, 1), a1 + hstep, voffA);
            PG8_WAIT_V(8); PG8_WAIT_L(0); PG8_BAR; PG8_MMA(0, 0, At, B0); PG8_MMA(0, 1, At, B1); PG8_BAR; PG8_SCHED;
            PG8_LDA(At, 0, 1); PG8_STAGE(PG8_SB(0, 0), b2, voffB); PG8_STAGE(PG8_SB(0, 1), b2 + hstep, voffB); PG8_STAGE(PG8_SA(0, 0), a2, voffA);
            PG8_WAIT_V(8); PG8_WAIT_L(0); PG8_BAR; PG8_MMA(1, 0, At, B0); PG8_MMA(1, 1, At, B1); PG8_BAR; PG8_SCHED;
            PG8_LDB(B0, 1, 0); PG8_LDB(B1, 1, 1); PG8_SCHED; PG8_LDA(At, 1, 0); PG8_STAGE(PG8_SA(0, 1), a2 + hstep, voffA);
            PG8_WAIT_V(8); PG8_WAIT_L(0); PG8_BAR; PG8_MMA(0, 0, At, B0); PG8_MMA(0, 1, At, B1); PG8_BAR; PG8_SCHED;
            PG8_LDA(At, 1, 1); PG8_STAGE(PG8_SB(1, 0), b3, voffB); PG8_STAGE(PG8_SB(1, 1), b3 + hstep, voffB); PG8_STAGE(PG8_SA(1, 0), a3, voffA);
            PG8_WAIT_V(8); PG8_WAIT_L(0); PG8_BAR; PG8_MMA(1, 0, At, B0); PG8_MMA(1, 1, At, B1); PG8_BAR; PG8_SCHED;
            } else {
            PG8_LDB(B0, 0, 0); PG8_SCHED; PG8_LDA(At, 0, 0); PG8_STAGE(PG8_SA(1, 1), a1 + hstep, voffA);
            PG8_WAIT_L(8); PG8_BAR; PG8_WAIT_L(0); PG8_MMA(0, 0, At, B0); PG8_BAR; PG8_SCHED;
            PG8_LDB(B1, 0, 1); PG8_STAGE(PG8_SB(0, 0), b2, voffB);
            PG8_BAR; PG8_WAIT_L(0); PG8_MMA(0, 1, At, B1); PG8_BAR;
            PG8_LDA(At, 0, 1); PG8_STAGE(PG8_SA(0, 0), a2, voffA);
            PG8_BAR; PG8_WAIT_L(0); PG8_MMA(1, 0, At, B0); PG8_BAR; PG8_SCHED;
            PG8_STAGE(PG8_SB(0, 1), b2 + hstep, voffB);
            PG8_WAIT_V(6); PG8_BAR; PG8_MMA(1, 1, At, B1); PG8_BAR;
            PG8_LDB(B0, 1, 0); PG8_SCHED; PG8_LDA(At, 1, 0); PG8_STAGE(PG8_SA(0, 1), a2 + hstep, voffA);
            PG8_WAIT_L(8); PG8_BAR; PG8_WAIT_L(0); PG8_MMA(0, 0, At, B0); PG8_BAR; PG8_SCHED;
            PG8_LDB(B1, 1, 1); PG8_STAGE(PG8_SB(1, 0), b3, voffB);
            PG8_BAR; PG8_WAIT_L(0); PG8_MMA(0, 1, At, B1); PG8_BAR;
            PG8_LDA(At, 1, 1); PG8_STAGE(PG8_SA(1, 0), a3, voffA);
            PG8_BAR; PG8_WAIT_L(0); PG8_MMA(1, 0, At, B0); PG8_BAR; PG8_SCHED;
            PG8_STAGE(PG8_SB(1, 1), b3 + hstep, voffB);
            PG8_WAIT_V(6); PG8_BAR; PG8_MMA(1, 1, At, B1); PG8_BAR;
            }
        }
        if constexpr (ALIGN_EPI) { if (wr == 0) PG8_BAR; }
        if constexpr (!Epi::AFTER_DRAIN) { E(acc, cur, wr, wc, fr, fq); S.done(cur); }
        if (!has_next) break;
#pragma unroll
        for (int a = 0; a < 2; ++a)
#pragma unroll
            for (int b = 0; b < 2; ++b)
#pragma unroll
                for (int m = 0; m < 4; ++m)
#pragma unroll
                    for (int n = 0; n < 2; ++n) acc[a][b][m][n] = (f32x4){0.f, 0.f, 0.f, 0.f};
        cur = nxt; cA = nA; cB = nB; ++ui;
        if constexpr (ALIGN_EPI) { if (wr == 1) PG8_BAR; }
    }
    PG8_WAIT_V(0);
    if constexpr (!ALIGN_EPI) { if (wr == 0) PG8_BAR; }
    PG8_BAR;
    if constexpr (Epi::AFTER_DRAIN) { E.fused(acc, cur, wr, wc, fr, fq, lds, wid, lane); S.done(cur); }
#undef PG8_SA
#undef PG8_SB
#undef PG8_STAGE
#undef PG8_LDA
#undef PG8_LDB
#undef PG8_MMA
#undef PG8_WAIT_V
#undef PG8_WAIT_L
#undef PG8_BAR
#undef PG8_SCHED
}
}

namespace attn {
typedef unsigned short bf16_t;
using bf16x8 = __attribute__((ext_vector_type(8))) short;
using s16x4  = __attribute__((ext_vector_type(4))) short;
using f32x16 = __attribute__((ext_vector_type(16))) float;
using u32x4  = __attribute__((ext_vector_type(4))) unsigned;
constexpr int NW = 8, QBLK = 32, KVBLK = 64;
constexpr float QSCALE = 0.125f * 1.4426950408889634f;
constexpr int LDQ = 512, LDK = 512, LDV = 512, LDO = 512;
constexpr int SHM_V = KVBLK * 128 * 2, SHM_K = KVBLK * 64 * 2, SHM_ATTN = 2 * SHM_V + 2 * SHM_K + NW * 64 * 4;
#define KSWZ64(row, colB) ((row) * 128 + ((colB) ^ ((((row) >> 1) & 7) << 4)))
#define SBAR() __builtin_amdgcn_sched_barrier(0)
__device__ __forceinline__ int crow(int r, int hi) { return (r & 3) + 8 * (r >> 2) + 4 * hi; }
__device__ __forceinline__ unsigned cvtpk(float lo, float hi) { unsigned r; asm volatile("v_cvt_pk_bf16_f32 %0, %1, %2" : "=v"(r) : "v"(lo), "v"(hi)); return r; }
constexpr float THR2 = 11.5f;
template <bool FIRST, bool GUARD>
__device__ __forceinline__ void partialSM(f32x16& p0, f32x16& p1, float& m_reg, float& alpha) {
  if (!GUARD) {
    alpha = 1.f;
#pragma unroll
    for (int r = 0; r < 16; ++r) p0[r] = __builtin_amdgcn_exp2f(p0[r]);
    return;
  }
  if (!FIRST) { if (__builtin_expect(__any(m_reg != 0.f), 0)) {
#pragma unroll
      for (int r = 0; r < 16; ++r) { p0[r] -= m_reg; p1[r] -= m_reg; } } }
  float a = fmaxf(fmaxf(p0[0], p0[1]), p1[0]), b = fmaxf(fmaxf(p0[2], p0[3]), p1[1]); a = fmaxf(fmaxf(a, p1[2]), p1[3]);
#pragma unroll
  for (int r = 4; r < 16; r += 4) { a = fmaxf(fmaxf(a, p0[r]), p0[r + 1]); b = fmaxf(fmaxf(b, p0[r + 2]), p0[r + 3]); a = fmaxf(fmaxf(a, p1[r]), p1[r + 1]); b = fmaxf(fmaxf(b, p1[r + 2]), p1[r + 3]); }
  float pmax = fmaxf(a, b);
  { auto rr = __builtin_amdgcn_permlane32_swap(__float_as_uint(pmax), __float_as_uint(pmax), false, false);
    pmax = fmaxf(__uint_as_float(rr[0]), __uint_as_float(rr[1])); }
  alpha = 1.f;
  if (FIRST) {
    if (__builtin_expect(__any(fabsf(pmax) > THR2), 0)) { const float dl = fabsf(pmax) > THR2 ? pmax : 0.f; m_reg = dl;
#pragma unroll
      for (int r = 0; r < 16; ++r) { p0[r] -= dl; p1[r] -= dl; } }
  } else {
    if (__builtin_expect(__any(pmax > THR2), 0)) { const float dl = fmaxf(pmax, 0.f); m_reg += dl;
#pragma unroll
      for (int r = 0; r < 16; ++r) { p0[r] -= dl; p1[r] -= dl; }
      alpha = __builtin_amdgcn_exp2f(-dl); }
  }
#pragma unroll
  for (int r = 0; r < 16; ++r) p0[r] = __builtin_amdgcn_exp2f(p0[r]);
}
__device__ __forceinline__ void finishSM(f32x16& p0, f32x16& p1, bf16x8& pa0, bf16x8& pa1, bf16x8& pa2, bf16x8& pa3) {
#pragma unroll
  for (int r = 0; r < 16; ++r) p1[r] = __builtin_amdgcn_exp2f(p1[r]);
#define PK4(P, BASE, OUT) do { u32x4 w = {cvtpk(P[BASE + 0], P[BASE + 1]), cvtpk(P[BASE + 2], P[BASE + 3]), cvtpk(P[BASE + 4], P[BASE + 5]), cvtpk(P[BASE + 6], P[BASE + 7])}; \
    OUT = *reinterpret_cast<bf16x8*>(&w); } while (0)
  PK4(p0, 0, pa0); PK4(p0, 8, pa1); PK4(p1, 0, pa2); PK4(p1, 8, pa3);
#undef PK4
}
__device__ __forceinline__ void qkt(f32x16& p0, f32x16& p1, const char* Ks, const bf16x8* qr, int r32, int hi) {
  p0 = f32x16{}; p1 = f32x16{};
#pragma unroll
  for (int d0 = 0; d0 < 4; ++d0) { const int cb = (d0 * 16 + hi * 8) * 2;
    bf16x8 b0 = *reinterpret_cast<const bf16x8*>(Ks + KSWZ64(r32, cb));
    bf16x8 b1 = *reinterpret_cast<const bf16x8*>(Ks + KSWZ64(32 + r32, cb));
    p0 = __builtin_amdgcn_mfma_f32_32x32x16_bf16(b0, qr[d0], p0, 0, 0, 0);
    p1 = __builtin_amdgcn_mfma_f32_32x32x16_bf16(b1, qr[d0], p1, 0, 0, 0); }
}
__device__ __forceinline__ int v_st(int k, int c) { const int kk = k; return ((kk >> 3) * 4 + (c >> 5)) * 512 + ((kk & 7) * 32 + (c & 31)) * 2; }
__device__ __forceinline__ int v_rd_base(int lane) { return ((lane & 3) << 3) | (((lane >> 2) & 3) << 6) | (((lane >> 4) & 1) << 5) | (((lane >> 5) & 1) << 8); }
constexpr int v_rd_off(int d0, int ks, int half) { return d0 * 512 + ks * 4096 + half * 2048; }
template <int OFF> __device__ __forceinline__ s16x4 tr_read(int vb) {
  s16x4 r; asm volatile("ds_read_b64_tr_b16 %0, %1 offset:%2" : "=&v"(r) : "v"(vb), "i"(OFF) : "memory"); return r;
}
template <int D0> __device__ __forceinline__ void pv_one(f32x16& od, int vb, bf16x8 pa0, bf16x8 pa1, bf16x8 pa2, bf16x8 pa3) {
  const s16x4 l0 = tr_read<v_rd_off(D0, 0, 0)>(vb), h0 = tr_read<v_rd_off(D0, 0, 1)>(vb), l1 = tr_read<v_rd_off(D0, 1, 0)>(vb), h1 = tr_read<v_rd_off(D0, 1, 1)>(vb);
  const s16x4 l2 = tr_read<v_rd_off(D0, 2, 0)>(vb), h2 = tr_read<v_rd_off(D0, 2, 1)>(vb), l3 = tr_read<v_rd_off(D0, 3, 0)>(vb), h3 = tr_read<v_rd_off(D0, 3, 1)>(vb);
  asm volatile("s_waitcnt lgkmcnt(0)" ::: "memory"); SBAR();
#define PK(L, H) (bf16x8){L[0], L[1], L[2], L[3], H[0], H[1], H[2], H[3]}
  od = __builtin_amdgcn_mfma_f32_32x32x16_bf16(pa0, PK(l0, h0), od, 0, 0, 0);
  od = __builtin_amdgcn_mfma_f32_32x32x16_bf16(pa1, PK(l1, h1), od, 0, 0, 0);
  od = __builtin_amdgcn_mfma_f32_32x32x16_bf16(pa2, PK(l2, h2), od, 0, 0, 0);
  od = __builtin_amdgcn_mfma_f32_32x32x16_bf16(pa3, PK(l3, h3), od, 0, 0, 0);
#undef PK
}
__device__ __forceinline__ void pv_d0(f32x16* o, f32x16& osum, int vb, bf16x8 pa0, bf16x8 pa1, bf16x8 pa2, bf16x8 pa3) {
  { const bf16x8 ones = {16256, 16256, 16256, 16256, 16256, 16256, 16256, 16256};
    osum = __builtin_amdgcn_mfma_f32_32x32x16_bf16(pa0, ones, osum, 0, 0, 0); osum = __builtin_amdgcn_mfma_f32_32x32x16_bf16(pa1, ones, osum, 0, 0, 0);
    osum = __builtin_amdgcn_mfma_f32_32x32x16_bf16(pa2, ones, osum, 0, 0, 0); osum = __builtin_amdgcn_mfma_f32_32x32x16_bf16(pa3, ones, osum, 0, 0, 0); }
  pv_one<0>(o[0], vb, pa0, pa1, pa2, pa3); pv_one<1>(o[1], vb, pa0, pa1, pa2, pa3); pv_one<2>(o[2], vb, pa0, pa1, pa2, pa3); pv_one<3>(o[3], vb, pa0, pa1, pa2, pa3);
}
#define TRSET(L, D0) do { L[0] = tr_read<v_rd_off(D0, 0, 0)>(vb); L[1] = tr_read<v_rd_off(D0, 0, 1)>(vb); L[2] = tr_read<v_rd_off(D0, 1, 0)>(vb); L[3] = tr_read<v_rd_off(D0, 1, 1)>(vb); \
    L[4] = tr_read<v_rd_off(D0, 2, 0)>(vb); L[5] = tr_read<v_rd_off(D0, 2, 1)>(vb); L[6] = tr_read<v_rd_off(D0, 3, 0)>(vb); L[7] = tr_read<v_rd_off(D0, 3, 1)>(vb); } while (0)
#define PKV(L, k) (bf16x8){L[2 * (k)][0], L[2 * (k)][1], L[2 * (k)][2], L[2 * (k)][3], L[2 * (k) + 1][0], L[2 * (k) + 1][1], L[2 * (k) + 1][2], L[2 * (k) + 1][3]}
#define MM4(OD, L) do { OD = __builtin_amdgcn_mfma_f32_32x32x16_bf16(pa0, PKV(L, 0), OD, 0, 0, 0); OD = __builtin_amdgcn_mfma_f32_32x32x16_bf16(pa1, PKV(L, 1), OD, 0, 0, 0); \
    OD = __builtin_amdgcn_mfma_f32_32x32x16_bf16(pa2, PKV(L, 2), OD, 0, 0, 0); OD = __builtin_amdgcn_mfma_f32_32x32x16_bf16(pa3, PKV(L, 3), OD, 0, 0, 0); } while (0)
#define LWAIT() do { asm volatile("s_waitcnt lgkmcnt(0)" ::: "memory"); SBAR(); } while (0)
__device__ __forceinline__ void pv_d0_pipe(f32x16* o, f32x16& osum, int vb, bf16x8 pa0, bf16x8 pa1, bf16x8 pa2, bf16x8 pa3, f32x16& px) {
  s16x4 LA[8], LB[8];
  __builtin_amdgcn_s_setprio(1);
  TRSET(LA, 0); SBAR();
  { const bf16x8 ones = {16256, 16256, 16256, 16256, 16256, 16256, 16256, 16256};
    osum = __builtin_amdgcn_mfma_f32_32x32x16_bf16(pa0, ones, osum, 0, 0, 0); osum = __builtin_amdgcn_mfma_f32_32x32x16_bf16(pa1, ones, osum, 0, 0, 0);
    osum = __builtin_amdgcn_mfma_f32_32x32x16_bf16(pa2, ones, osum, 0, 0, 0); osum = __builtin_amdgcn_mfma_f32_32x32x16_bf16(pa3, ones, osum, 0, 0, 0); }
#define EX4(B) do { px[B] = __builtin_amdgcn_exp2f(px[B]); px[B + 1] = __builtin_amdgcn_exp2f(px[B + 1]); px[B + 2] = __builtin_amdgcn_exp2f(px[B + 2]); px[B + 3] = __builtin_amdgcn_exp2f(px[B + 3]); } while (0)
  LWAIT(); TRSET(LB, 1); SBAR(); MM4(o[0], LA); EX4(0); SBAR();
  LWAIT(); TRSET(LA, 2); SBAR(); MM4(o[1], LB); EX4(4); SBAR();
  LWAIT(); TRSET(LB, 3); SBAR(); MM4(o[2], LA); EX4(8); SBAR();
  LWAIT(); MM4(o[3], LB); EX4(12);
#undef EX4
}
#undef TRSET
#undef PKV
#undef MM4
#undef LWAIT
template <int COMP, bool GUARD>
__device__ __forceinline__ bool body(const bf16_t* __restrict__ Qb, const bf16_t* __restrict__ Kh, const bf16_t* __restrict__ Vh, float* Ob, bf16_t* __restrict__ SAo, float lam, const float* __restrict__ sg, int seq, char* lds) {
  int tid_ = threadIdx.x; asm volatile("" : "+v"(tid_));
  const int tid = tid_, wid = tid >> 6, lane = tid & 63, r32 = lane & 31, hi = lane >> 5;
  char* V_lds = lds; char* K_lds = lds + 4 * SHM_V;
  float* ws = (float*)(lds + 4 * SHM_V + 4 * SHM_K) + wid * 64; float* al_l = ws + 32;
  float m_reg = 0.f; f32x16 o[4] = {}; f32x16 osum = {}; bf16x8 qr[4];
  const bf16_t* Qw = Qb + (long)(wid * QBLK + r32) * LDQ + hi * 8;
#pragma unroll
  for (int d0 = 0; d0 < 4; ++d0) qr[d0] = *reinterpret_cast<const bf16x8*>(Qw + d0 * 16);
  const int sr = tid >> 4, sc = (tid & 15) * 8, vst0 = v_st(sr, sc), vst1 = v_st(32 + sr, sc);
  const int ksr = tid >> 3, ksc = (tid & 7) * 8, kst = KSWZ64(ksr, ksc * 2);
  const int vb0 = (int)(uintptr_t)V_lds + v_rd_base(lane);
  bf16x8 rvs0, rvs1, rks0;
#define SLOAD(k0) do { rvs0 = *reinterpret_cast<const bf16x8*>(&Vh[(long)((k0) + sr) * LDV + sc]); rvs1 = *reinterpret_cast<const bf16x8*>(&Vh[(long)((k0) + 32 + sr) * LDV + sc]); \
    rks0 = *reinterpret_cast<const bf16x8*>(&Kh[(long)((k0) + ksr) * LDK + ksc]); } while (0)
#define SWRITE(slot) do { *(bf16x8*)(V_lds + (slot) * SHM_V + vst0) = rvs0; *(bf16x8*)(V_lds + (slot) * SHM_V + vst1) = rvs1; *(bf16x8*)(K_lds + (slot) * SHM_K + kst) = rks0; } while (0)
#define RESC(a) do { if (__any((a) < 1.f)) { if (hi == 0) al_l[r32] = (a); asm volatile("s_waitcnt lgkmcnt(0)" ::: "memory"); \
    _Pragma("unroll") for (int r = 0; r < 16; ++r) { const float f_ = al_l[crow(r, hi)]; osum[r] *= f_; _Pragma("unroll") for (int d = 0; d < 4; ++d) o[d][r] *= f_; } } } while (0)
  f32x16 pA0, pA1, pB0, pB1; float alA, alB; bf16x8 pa0, pa1, pa2, pa3; const int NT = seq / KVBLK;
  SLOAD(0); SWRITE(0); SLOAD(KVBLK); __syncthreads();
  qkt(pA0, pA1, K_lds, qr, r32, hi); partialSM<true, GUARD>(pA0, pA1, m_reg, alA);
  SWRITE(1); SLOAD(2 * KVBLK); __syncthreads();
  const int grp = __builtin_amdgcn_readfirstlane(wid >> 2);
#define ITER(X0, X1, Y0, Y1, alX, i) do { const int scur = (i) & 3, sp = ((i) - 1) & 3, sn = ((i) + 1) & 3; \
    SBAR(); qkt(X0, X1, K_lds + scur * SHM_K, qr, r32, hi); \
    finishSM(Y0, Y1, pa0, pa1, pa2, pa3); SBAR(); \
    if (grp) { SWRITE(sn); if ((i) + 2 < NT) SLOAD(((i) + 2) * KVBLK); __syncthreads(); } \
    if (GUARD) pv_d0(o, osum, vb0 + sp * SHM_V, pa0, pa1, pa2, pa3); else pv_d0_pipe(o, osum, vb0 + sp * SHM_V, pa0, pa1, pa2, pa3, X0); if (GUARD) partialSM<false, GUARD>(X0, X1, m_reg, alX); else { alX = 1.f; __builtin_amdgcn_s_setprio(0); } \
    if (GUARD) RESC(alX); \
    if (!grp) { SWRITE(sn); if ((i) + 2 < NT) SLOAD(((i) + 2) * KVBLK); __syncthreads(); } } while (0)
  int i = 1;
  for (; i + 1 < NT; i += 2) {
    ITER(pB0, pB1, pA0, pA1, alB, i);
    ITER(pA0, pA1, pB0, pB1, alA, i + 1);
  }
  { const int scur = i & 3, sp = (i - 1) & 3;
  SBAR(); qkt(pB0, pB1, K_lds + scur * SHM_K, qr, r32, hi);
  finishSM(pA0, pA1, pa0, pa1, pa2, pa3); SBAR();
  pv_d0(o, osum, vb0 + sp * SHM_V, pa0, pa1, pa2, pa3); partialSM<false, GUARD>(pB0, pB1, m_reg, alB);
  if (GUARD) RESC(alB);
  finishSM(pB0, pB1, pa0, pa1, pa2, pa3); SBAR();
  pv_d0(o, osum, vb0 + scur * SHM_V, pa0, pa1, pa2, pa3); }
#undef ITER
  if (!GUARD) {
    bool ok = true;
#pragma unroll
    for (int r = 0; r < 16; ++r) ok = ok && (osum[r] > 0.f) && (osum[r] < 3.0e38f);
    if (__syncthreads_or(ok ? 0 : 1)) return true;
  }
  float rli[16];
#pragma unroll
  for (int r = 0; r < 16; ++r) rli[r] = __builtin_amdgcn_rcpf(osum[r]);
  float* Ow = Ob + (long)(wid * QBLK) * LDO;
  if (COMP == 0) {
#pragma unroll
    for (int r = 0; r < 16; ++r) { const int orow = crow(r, hi);
#pragma unroll
      for (int d0 = 0; d0 < 4; ++d0) Ow[(long)orow * LDO + d0 * 32 + r32] = o[d0][r] * rli[r]; }
  } else {
    float ss[16];
#pragma unroll
    for (int r = 0; r < 16; ++r) { const int orow = crow(r, hi); float q = 0.f;
#pragma unroll
      for (int d0 = 0; d0 < 4; ++d0) { const float d = Ow[(long)orow * LDO + d0 * 32 + r32] - lam * (o[d0][r] * rli[r]); o[d0][r] = d; q = fmaf(d, d, q); }
      ss[r] = q; }
#pragma unroll
    for (int r = 0; r < 16; ++r) { float q = ss[r]; q += __shfl_xor(q, 1); q += __shfl_xor(q, 2); q += __shfl_xor(q, 4); q += __shfl_xor(q, 8); q += __shfl_xor(q, 16);
      ss[r] = 1.0f / sqrtf(q * (1.0f / 128.0f) + 1e-6f); }
    float gsub[4];
#pragma unroll
    for (int d0 = 0; d0 < 4; ++d0) gsub[d0] = sg[d0 * 32 + r32] * 0.8f;
    bf16_t* Sw = SAo + (long)(wid * QBLK) * 1024;
#pragma unroll
    for (int r = 0; r < 16; ++r) { const int orow = crow(r, hi);
#pragma unroll
      for (int d0 = 0; d0 < 4; ++d0) { const float y = o[d0][r] * ss[r] * gsub[d0]; unsigned u = __builtin_bit_cast(unsigned, y); u = (u + 0x7fffu + ((u >> 16) & 1u)) >> 16;
        Sw[(long)orow * 1024 + d0 * 32 + r32] = (bf16_t)u; } }
  }
  asm volatile("s_waitcnt vmcnt(0) lgkmcnt(0)" ::: "memory"); __syncthreads();
  return false;
#undef SLOAD
#undef SWRITE
#undef RESC
}
#undef SBAR
}

#define GAS __attribute__((address_space(1)))
#define LAS __attribute__((address_space(3)))
typedef unsigned short bf16;
typedef unsigned v4u __attribute__((ext_vector_type(4)));
typedef float f32x4 __attribute__((ext_vector_type(4)));
typedef float f32x16 __attribute__((ext_vector_type(16)));
typedef short bf16x8 __attribute__((ext_vector_type(8)));

constexpr int NWAVES = 8, NTHR = 512;
constexpr int DM = 1024, DFF = 2816, NB = 8, SEQ = 8192, CTXL = 256, NMODV = 9 * DM;
constexpr int ROWS_B = 8448, TILES_B = 33, NROWS = NB * ROWS_B;

constexpr size_t MiB = 1u << 20;
constexpr size_t WS_CTL = 0, CTL_ZERO_BYTES = 1 * MiB;
constexpr size_t WS_MOD = 4096;
constexpr size_t WS_BIAS1 = 352 * 1024, WS_BIAS2 = 640 * 1024;
constexpr size_t WS_RSS1 = 69 * MiB, WS_RSS2 = 69 * MiB + 512 * 1024;
constexpr size_t WS_BAR = 512 * 1024, BAR_ZERO_BYTES = 16384;
constexpr size_t WS_ABAR = 1 * MiB, WS_APOW = WS_ABAR + 32768, WS_BBT = WS_APOW + 32768, WS_CM = WS_BBT + 262144, WS_ROPE = WS_CM + 262144;
constexpr size_t WS_W1A = 2 * MiB, WS_W1B = 13 * MiB, WS_W2A = 19 * MiB, WS_W2B = 30 * MiB, WS_WIN = 36 * MiB, WS_WOUT = 40 * MiB, WS_WGLU = 42 * MiB;
constexpr size_t WS_E = 43 * MiB, WS_HIN = 52 * MiB, WS_XC = 61 * MiB;
constexpr size_t WS_XN = 70 * MiB;
constexpr size_t WS_ACT = 202 * MiB;
constexpr size_t WS_OATT = WS_ACT, WS_G = WS_ACT + 264 * MiB;
constexpr size_t WS_U = 565 * MiB, WS_Q = 631 * MiB, WS_K = 697 * MiB, WS_V = 763 * MiB, WS_END = 829 * MiB;
static_assert(WS_ROPE + 16384 <= WS_W1A && WS_W1A + (size_t)5632 * 1024 * 2 <= WS_W1B && WS_W1B + (size_t)1024 * 2816 * 2 <= WS_W2A && WS_W2A + (size_t)5632 * 1024 * 2 <= WS_W2B, "ws map 1");
static_assert(WS_W2B + (size_t)1024 * 2816 * 2 <= WS_WIN && WS_WIN + (size_t)2048 * 1024 * 2 <= WS_WOUT && WS_WOUT + (size_t)1024 * 1024 * 2 <= WS_WGLU && WS_WGLU + 512 * 512 * 2 <= WS_E, "ws map 2");
static_assert(WS_E + (size_t)8 * 33 * 64 * 64 * 8 <= WS_HIN && WS_HIN + (size_t)8 * 33 * 64 * 64 * 8 <= WS_XC && WS_XC + (size_t)2048 * 1024 * 4 <= WS_XN, "ws map 3");
static_assert(WS_XN + (size_t)NROWS * 1024 * 2 <= WS_ACT && WS_ACT + (size_t)NROWS * 2816 * 2 <= WS_U && WS_G + (size_t)NROWS * 512 * 2 <= WS_U && WS_OATT + (size_t)NROWS * 1024 * 4 <= WS_G, "ws map 4");
static_assert(WS_U + (size_t)NROWS * 512 * 2 <= WS_Q && WS_V + (size_t)NROWS * 512 * 2 <= WS_END, "ws map 5");

constexpr int LDS_BYTES = 139264;

#define LDS_WAIT() asm volatile("s_waitcnt lgkmcnt(0)" ::: "memory")
__device__ __forceinline__ unsigned f2bf(float f) { unsigned u = __builtin_bit_cast(unsigned, f); return (u + 0x7fffu + ((u >> 16) & 1u)) >> 16; }
__device__ __forceinline__ unsigned pk2(float lo, float hi) { return f2bf(lo) | (f2bf(hi) << 16); }
__device__ __forceinline__ float wave_sum(float v) {
#pragma unroll
    for (int o = 1; o < 64; o <<= 1) v += __shfl_xor(v, o);
    return v;
}

__device__ __forceinline__ double dexp(double x) {
    const double n = __builtin_rint(x * 1.4426950408889634074);
    const double r = __builtin_fma(-n, 1.9082149292705877e-10, __builtin_fma(-n, 0.693147180369123816490, x));
    double p = 1.0 / 87178291200.0;
    p = p * r + 1.0 / 6227020800.0; p = p * r + 1.0 / 479001600.0; p = p * r + 1.0 / 39916800.0; p = p * r + 1.0 / 3628800.0; p = p * r + 1.0 / 362880.0; p = p * r + 1.0 / 40320.0;
    p = p * r + 1.0 / 5040.0; p = p * r + 1.0 / 720.0; p = p * r + 1.0 / 120.0; p = p * r + 1.0 / 24.0; p = p * r + 1.0 / 6.0; p = p * r + 0.5; p = p * r + 1.0; p = p * r + 1.0;
    const long long e = (long long)n + 1023; const double s = __builtin_bit_cast(double, (unsigned long long)e << 52);
    return p * s;
}
__device__ __forceinline__ void dsincos(double y, double& s, double& c) {
    const double k = __builtin_rint(y * 0.15915494309189533577);
    double r = __builtin_fma(-k, 6.283185307179586232, y); r = __builtin_fma(-k, 2.4492935982947064e-16, r);
    const double q = r * 0.125, q2 = q * q;
    double sp = -1.0 / 1307674368000.0; sp = sp * q2 + 1.0 / 6227020800.0; sp = sp * q2 - 1.0 / 39916800.0; sp = sp * q2 + 1.0 / 362880.0; sp = sp * q2 - 1.0 / 5040.0; sp = sp * q2 + 1.0 / 120.0; sp = sp * q2 - 1.0 / 6.0; sp = sp * q2 + 1.0;
    double cp = 1.0 / 20922789888000.0; cp = cp * q2 - 1.0 / 87178291200.0; cp = cp * q2 + 1.0 / 479001600.0; cp = cp * q2 - 1.0 / 3628800.0; cp = cp * q2 + 1.0 / 40320.0; cp = cp * q2 - 1.0 / 720.0; cp = cp * q2 + 1.0 / 24.0; cp = cp * q2 - 0.5; cp = cp * q2 + 1.0;
    double ss = sp * q, cc = cp;
#pragma unroll
    for (int i = 0; i < 3; ++i) { const double s2 = 2.0 * ss * cc, c2 = cc * cc - ss * ss; ss = s2; cc = c2; }
    s = ss; c = cc;
}

__device__ __forceinline__ void transpose_item(const float* W, int K, int N, bf16* WT, int mode, LAS float* scr, int item, int lane) {
    const int nblk = N / 32, kb = item / nblk, nb = item % nblk, k0 = 64 * kb, n0 = 32 * nb;
    { const float* wp = W + (size_t)(k0 + (lane >> 5)) * N + n0 + (lane & 31); float v[32];
#pragma unroll
      for (int i = 0; i < 32; ++i) v[i] = wp[(size_t)(2 * i) * N];
#pragma unroll
      for (int i = 0; i < 32; ++i) scr[(2 * i + (lane >> 5)) * 33 + (lane & 31)] = v[i]; }
    LDS_WAIT(); asm volatile("" ::: "memory");
    const int c = lane & 7;
#pragma unroll
    for (int j = 0; j < 4; ++j) { const int n = (lane >> 3) + 8 * j; const LAS float* s = scr + (8 * c) * 33 + n;
        const int src = n0 + n; int drow = src;
        if (mode == 1) { const int up = src >= DFF ? 1 : 0, ff = src - up * DFF; drow = (ff >> 7) * 256 + up * 128 + (ff & 127); }
        else if (mode == 2) { if (src >= 512 && src < 1536) drow = n0 + 2 * (n & 15) + (n >> 4); }
        v4u o; o.x = pk2(s[0 * 33], s[1 * 33]); o.y = pk2(s[2 * 33], s[3 * 33]); o.z = pk2(s[4 * 33], s[5 * 33]); o.w = pk2(s[6 * 33], s[7 * 33]);
        *(v4u*)(WT + (size_t)drow * K + k0 + 8 * c) = o; }
    LDS_WAIT(); asm volatile("" ::: "memory");
}

template <int MODE>
__device__ __forceinline__ void norm_rows16(const float* src, bf16* dstb, float* dstf, const float* g, const float* shift, const float* scale, int lane) {
    f32x4 gs[4], sh[4];
#pragma unroll
    for (int j = 0; j < 4; ++j) { const int cidx = 4 * lane + 256 * j; const f32x4 gv = *(const f32x4*)(g + cidx);
        if (MODE == 0) { const f32x4 sc = *(const f32x4*)(scale + cidx); gs[j] = gv * (sc + 1.0f); sh[j] = *(const f32x4*)(shift + cidx); } else { gs[j] = gv; sh[j] = (f32x4){0.f, 0.f, 0.f, 0.f}; } }
#pragma unroll 2
    for (int r = 0; r < 16; ++r) {
        const f32x4* xr = (const f32x4*)(src + (size_t)r * DM) + lane;
        f32x4 v[4]; float s = 0.f;
#pragma unroll
        for (int j = 0; j < 4; ++j) { v[j] = xr[64 * j]; s += (v[j].x * v[j].x + v[j].y * v[j].y) + (v[j].z * v[j].z + v[j].w * v[j].w); }
        const float rstd = 1.0f / sqrtf(wave_sum(s) * (1.0f / DM) + 1e-6f);
        if (MODE == 0) {
            unsigned long long* o8 = (unsigned long long*)(dstb + (size_t)r * DM) + lane;
#pragma unroll
            for (int j = 0; j < 4; ++j) { const f32x4 y = v[j] * rstd * gs[j] + sh[j]; o8[64 * j] = (unsigned long long)pk2(y.x, y.y) | ((unsigned long long)pk2(y.z, y.w) << 32); }
        } else {
            f32x4* of = (f32x4*)(dstf + (size_t)r * DM) + lane;
#pragma unroll
            for (int j = 0; j < 4; ++j) of[64 * j] = v[j] * rstd * gs[j];
        }
    }
}

__device__ __forceinline__ int crow16(int r, int hi) { return (r & 3) + 8 * (r >> 2) + 4 * hi; }
typedef float f32x2_t __attribute__((ext_vector_type(2))); typedef __bf16 bf16x2_t __attribute__((ext_vector_type(2)));
__device__ __forceinline__ unsigned cvtpk2(float lo, float hi) { f32x2_t v = {lo, hi}; bf16x2_t b = __builtin_convertvector(v, bf16x2_t); return __builtin_bit_cast(unsigned, b); }

template <bool FULL>
__device__ __forceinline__ void s5_unit(LAS unsigned char* lds, int b, int c, int gq, const bf16* U, const float2* ABAR, const bf16* BBT, const bf16* CM,
                                        const float2* HIN, float2* E, const float* dskip, bf16* G, float* YF) {
    int tid_ = threadIdx.x; asm volatile("" : "+v"(tid_));
    const int lane = tid_ & 63, wave = __builtin_amdgcn_readfirstlane(tid_ >> 6);
    const int g = gq * 8 + wave, hi = lane >> 5, r32 = lane & 31;
    LAS unsigned* scr = (LAS unsigned*)(lds + wave * 8704);
    const size_t r0 = (size_t)b * ROWS_B + (size_t)c * 256;
    const bf16* ubase = U + (r0 + r32) * 512 + g * 16 + hi * 8;
    const int ch = lane & 15; const float dv = dskip[g * 16 + ch];
    const size_t obase = (r0 + (lane >> 4) * 4) * 512 + g * 16 + ch;
    LAS unsigned short* yt_l = (LAS unsigned short*)(lds + 69632 + wave * 8192) + ((lane >> 4) * 4) * 16 + ch;
#pragma unroll
    for (int dir = 0; dir < 2; ++dir) {
        const int dg = dir * 32 + g;
        const float2 ab = ABAR[dg * 64 + lane];
        bf16x8 bb[4], cm[4];
#pragma unroll
        for (int blk = 0; blk < 4; ++blk) bb[blk] = *(const bf16x8*)(BBT + ((size_t)(dg * 4 + blk) * 32 + r32) * 16 + hi * 8);
        if (FULL) {
#pragma unroll
            for (int ks = 0; ks < 4; ++ks) cm[ks] = *(const bf16x8*)(CM + ((size_t)dg * 16 + (lane & 15)) * 128 + ks * 32 + (lane >> 4) * 8);
        }
        const size_t sidx = ((((size_t)b * 33 + c) * 32 + g) * 2 + dir) * 64 + lane;
        float hr = 0.f, hm = 0.f;
        if (FULL) { const float2 h0 = HIN[sidx]; hr = h0.x; hm = h0.y; }
        bf16x8 a_nx = *(const bf16x8*)(ubase + (size_t)(dir == 0 ? 0 : 224) * 512);
#pragma unroll 1
        for (int sb = 0; sb < 8; ++sb) {
            const int tb = dir == 0 ? sb * 32 : (7 - sb) * 32;
            const bf16x8 a = a_nx;
            { const int tn = dir == 0 ? (sb < 7 ? tb + 32 : tb) : (sb < 7 ? tb - 32 : tb); a_nx = *(const bf16x8*)(ubase + (size_t)tn * 512); }
            unsigned short uvv[2][4];
            if (FULL && dir == 1) {
#pragma unroll
                for (int mt = 0; mt < 2; ++mt)
#pragma unroll
                    for (int j = 0; j < 4; ++j) { const size_t idx = obase + (size_t)(tb + mt * 16 + j) * 512; uvv[mt][j] = U[idx]; }
            }
            const f32x16 z = {};
#pragma unroll
            for (int hf = 0; hf < 2; ++hf) {
                const f32x16 c0 = __builtin_amdgcn_mfma_f32_32x32x16_bf16(a, bb[hf], z, 0, 0, 0), c2 = __builtin_amdgcn_mfma_f32_32x32x16_bf16(a, bb[2 + hf], z, 0, 0, 0);
#pragma unroll
                for (int r = 0; r < 16; ++r) { const int row = crow16(r, hi); scr[row * 68 + hf * 32 + r32] = cvtpk2(c0[r], c2[r]); }
            }
            LDS_WAIT(); asm volatile("" ::: "memory");
#pragma unroll
            for (int half = 0; half < 2; ++half) {
                unsigned v[16];
#pragma unroll
                for (int q = 0; q < 16; ++q) { const int t = dir == 0 ? half * 16 + q : 31 - (half * 16 + q); v[q] = scr[t * 68 + lane]; }
#pragma unroll
                for (int q = 0; q < 16; ++q) { const int t = dir == 0 ? half * 16 + q : 31 - (half * 16 + q);
                    const float re = __uint_as_float(v[q] << 16), im = __uint_as_float(v[q] & 0xffff0000u);
                    const float nr = fmaf(ab.x, hr, fmaf(-ab.y, hm, re)), ni = fmaf(ab.x, hm, fmaf(ab.y, hr, im)); hr = nr; hm = ni;
                    if (FULL) scr[t * 68 + lane] = cvtpk2(hr, hm); }
                asm volatile("" ::: "memory");
            }
            if (FULL) {
                LDS_WAIT(); asm volatile("" ::: "memory");
                f32x4 yt[2];
#pragma unroll
                for (int mt = 0; mt < 2; ++mt) { yt[mt] = (f32x4){0.f, 0.f, 0.f, 0.f};
#pragma unroll
                    for (int ks = 0; ks < 4; ++ks) { const bf16x8 hf8 = *(const LAS bf16x8*)((const LAS unsigned char*)scr + (mt * 16 + (lane & 15)) * 272 + ks * 64 + (lane >> 4) * 16);
                        yt[mt] = __builtin_amdgcn_mfma_f32_16x16x32_bf16(hf8, cm[ks], yt[mt], 0, 0, 0); } }
#pragma unroll
                for (int mt = 0; mt < 2; ++mt)
#pragma unroll
                    for (int j = 0; j < 4; ++j) { LAS unsigned short* yp = yt_l + (tb + mt * 16 + j) * 16;
                        if (dir == 0) *yp = (unsigned short)f2bf(yt[mt][j]);
                        else { const float uv = __uint_as_float((unsigned)uvv[mt][j] << 16); const float yv = __uint_as_float((unsigned)*yp << 16) + yt[mt][j] + dv * uv;
                            const float zz = 1.5957691216057308f * (yv + 0.044715f * yv * yv * yv); *yp = (unsigned short)f2bf(yv * pg8::fast_sigmoid(zz)); } }
                LDS_WAIT(); asm volatile("" ::: "memory");
            }
        }
        if (!FULL) E[sidx] = make_float2(hr, hm);
    }
    if (FULL) {
        LDS_WAIT(); asm volatile("" ::: "memory");
        const LAS unsigned char* yb = (const LAS unsigned char*)(lds + 69632 + wave * 8192);
#pragma unroll
        for (int it = 0; it < 8; ++it) { const int row = it * 32 + (lane >> 1), hf = lane & 1;
            const v4u w = *(const LAS v4u*)(yb + row * 32 + hf * 16);
            *(v4u*)(G + (r0 + row) * 512 + g * 16 + hf * 8) = w; }
        LDS_WAIT(); asm volatile("" ::: "memory");
    }
}

__device__ __forceinline__ void cmulf(float ar, float ai, float br, float bi, float& cr, float& ci) { cr = ar * br - ai * bi; ci = ar * bi + ai * br; }
__device__ __forceinline__ void s5_unit_a(LAS unsigned char* lds, int b, int c, int gq, const bf16* U, const float2* ABAR, const bf16* BBT, float2* E) {
    int tid_ = threadIdx.x; asm volatile("" : "+v"(tid_));
    const int lane = tid_ & 63, wave = __builtin_amdgcn_readfirstlane(tid_ >> 6);
    const int g = gq * 8 + wave, hi = lane >> 5, r32 = lane & 31;
    const size_t r0 = (size_t)b * ROWS_B + (size_t)c * 256;
    LAS unsigned char* ut = lds + wave * 8192;
    { v4u t8[8];
#pragma unroll
      for (int it = 0; it < 8; ++it) t8[it] = *(const v4u*)(U + (r0 + it * 32 + (lane >> 1)) * 512 + g * 16 + (lane & 1) * 8);
#pragma unroll
      for (int it = 0; it < 8; ++it) *(LAS v4u*)(ut + (it * 32 + (lane >> 1)) * 32 + (lane & 1) * 16) = t8[it]; }
    LDS_WAIT(); asm volatile("" ::: "memory");
    const LAS unsigned char* ua = ut + r32 * 32 + hi * 16;
#pragma unroll
    for (int dir = 0; dir < 2; ++dir) {
        const int dg = dir * 32 + g;
        bf16x8 bb[4];
#pragma unroll
        for (int blk = 0; blk < 4; ++blk) bb[blk] = *(const bf16x8*)(BBT + ((size_t)(dg * 4 + blk) * 32 + r32) * 16 + hi * 8);
        float wr[2][16], wi[2][16], a32r[2], a32i[2];
#pragma unroll
        for (int hf = 0; hf < 2; ++hf) {
            const float2 ab = ABAR[dg * 64 + hf * 32 + r32];
            float qr[4], qi[4], orr[4], oi[4];
            qr[0] = 1.f; qi[0] = 0.f; qr[1] = ab.x; qi[1] = ab.y; cmulf(qr[1], qi[1], ab.x, ab.y, qr[2], qi[2]); cmulf(qr[2], qi[2], ab.x, ab.y, qr[3], qi[3]);
            float a4r, a4i; cmulf(qr[2], qi[2], qr[2], qi[2], a4r, a4i);
            orr[0] = 1.f; oi[0] = 0.f; cmulf(a4r, a4i, a4r, a4i, orr[1], oi[1]); cmulf(orr[1], oi[1], orr[1], oi[1], orr[2], oi[2]); cmulf(orr[2], oi[2], orr[1], oi[1], orr[3], oi[3]);
            cmulf(orr[2], oi[2], orr[2], oi[2], a32r[hf], a32i[hf]);
            const bool use4 = dir == 0 ? (hi == 0) : (hi != 0);
            const float br = use4 ? a4r : 1.f, bi = use4 ? a4i : 0.f;
#pragma unroll
            for (int r = 0; r < 16; ++r) { const int jq = dir == 0 ? 3 - (r & 3) : (r & 3), jo = dir == 0 ? 3 - (r >> 2) : (r >> 2);
                float tr, ti; cmulf(qr[jq], qi[jq], orr[jo], oi[jo], tr, ti); cmulf(tr, ti, br, bi, wr[hf][r], wi[hf][r]); }
        }
        float hr[2] = {0.f, 0.f}, hm[2] = {0.f, 0.f};
#pragma unroll 1
        for (int sb = 0; sb < 8; ++sb) {
            const bf16x8 a = *(const LAS bf16x8*)(ua + (dir == 0 ? sb * 32 : (7 - sb) * 32) * 32);
            const f32x16 z = {};
#pragma unroll
            for (int hf = 0; hf < 2; ++hf) {
                const f32x16 cre = __builtin_amdgcn_mfma_f32_32x32x16_bf16(a, bb[hf], z, 0, 0, 0), cim = __builtin_amdgcn_mfma_f32_32x32x16_bf16(a, bb[2 + hf], z, 0, 0, 0);
                float er = 0.f, ei = 0.f;
#pragma unroll
                for (int r = 0; r < 16; ++r) { er = fmaf(wr[hf][r], cre[r], fmaf(-wi[hf][r], cim[r], er)); ei = fmaf(wr[hf][r], cim[r], fmaf(wi[hf][r], cre[r], ei)); }
                er += __shfl_xor(er, 32); ei += __shfl_xor(ei, 32);
                const float nr = fmaf(a32r[hf], hr[hf], fmaf(-a32i[hf], hm[hf], er)), ni = fmaf(a32r[hf], hm[hf], fmaf(a32i[hf], hr[hf], ei));
                hr[hf] = nr; hm[hf] = ni;
            }
        }
        const size_t sidx = ((((size_t)b * 33 + c) * 32 + g) * 2 + dir) * 64 + lane;
        E[sidx] = hi ? make_float2(hr[1], hm[1]) : make_float2(hr[0], hm[0]);
    }
    LDS_WAIT(); asm volatile("" ::: "memory");
}

typedef GAS unsigned gu32;
#define RLX_AGENT __ATOMIC_RELAXED, __HIP_MEMORY_SCOPE_AGENT
#define XB_TMO      128
#define XB_XCNT(j)  (256  + 64 * (j))
#define XB_XSUB(j)  (1280 + 64 * (j))
#define XB_XGEN(j)  (2304 + 64 * (j))
#define XB_TOP      3328
#define XB_TOPGEN   3392
#define XCD_BAR_WORDS 3456
#define XB_SPIN_CAP (1u << 18)

__device__ __forceinline__ unsigned xb_ld(unsigned* p)              { return __hip_atomic_load(p, __ATOMIC_RELAXED, __HIP_MEMORY_SCOPE_AGENT); }
__device__ __forceinline__ unsigned xb_add(unsigned* p, unsigned v) { return __hip_atomic_fetch_add(p, v, __ATOMIC_RELAXED, __HIP_MEMORY_SCOPE_AGENT); }
__device__ __forceinline__ unsigned xb_xcc_id() { return (unsigned)__builtin_amdgcn_s_getreg((3 << 11) | 20) & 0xFu; }
#define XB_SPIN(cond, bar) do { unsigned _sp = 0; while (cond) { __builtin_amdgcn_s_sleep(1); \
    if ((++_sp & 255u) == 0u) { if (xb_ld(&(bar)[XB_TMO])) break; if (_sp > XB_SPIN_CAP) { atomicAdd(&(bar)[XB_TMO], 1u); break; } } } } while (0)

struct XcdBarrier {
    unsigned* bar; unsigned x;
    volatile LAS unsigned* st;
};

__device__ __forceinline__ XcdBarrier xcd_barrier_post(unsigned* bar, volatile LAS unsigned* st) {
    XcdBarrier b; b.bar = bar; b.x = xb_xcc_id(); b.st = st;
    if (threadIdx.x == 0) (void)xb_add(&bar[XB_XCNT(b.x)], 1u);
    return b;
}
__device__ __forceinline__ void xcd_barrier_complete(unsigned* bar, unsigned x, unsigned& nloc, unsigned& nx) {
    const unsigned G = gridDim.x * gridDim.y * gridDim.z;
    unsigned sum, cnt, mine, sp = 0u;
    for (;;) {
        sum = 0u; cnt = 0u; mine = 0u;
#pragma unroll
        for (unsigned j = 0; j < 16; ++j) { const unsigned c = xb_ld(&bar[XB_XCNT(j)]); sum += c; cnt += (c > 0u) ? 1u : 0u; mine = (j == x) ? c : mine; }
        if (sum == G) break;
        __builtin_amdgcn_s_sleep(1);
        if ((++sp & 255u) == 0u) { if (xb_ld(&bar[XB_TMO])) break; if (sp > XB_SPIN_CAP) { atomicAdd(&bar[XB_TMO], 1u); break; } }
    }
    nloc = mine > 0u ? mine : 1u; nx = cnt > 0u ? cnt : 1u;
}

__device__ __forceinline__ void xcd_barrier(const XcdBarrier& b) {
    asm volatile("s_waitcnt vmcnt(0)" ::: "memory");
    __syncthreads();
    if (threadIdx.x == 0) {
        unsigned* bar = b.bar;
        __builtin_amdgcn_s_waitcnt(0);
        unsigned nloc = b.st[0], nx = b.st[1];
        if (nloc == 0u) { xcd_barrier_complete(bar, b.x, nloc, nx); b.st[0] = nloc; b.st[1] = nx; }
        const unsigned old = xb_add(&bar[XB_XSUB(b.x)], 1u);
        const unsigned gen = old / nloc;
        if (old + 1u == (gen + 1u) * nloc) {
            __builtin_amdgcn_fence(__ATOMIC_RELEASE, "agent");
            asm volatile("s_waitcnt vmcnt(0)" ::: "memory");
            const unsigned og = xb_add(&bar[XB_TOP], 1u);
            const unsigned tg = og / nx;
            if (og + 1u == (tg + 1u) * nx) xb_add(&bar[XB_TOPGEN], 1u);
            else XB_SPIN(xb_ld(&bar[XB_TOPGEN]) == tg, bar);
            __builtin_amdgcn_fence(__ATOMIC_ACQUIRE, "agent");
            xb_add(&bar[XB_XGEN(b.x)], 1u);
            asm volatile("s_waitcnt vmcnt(0)" ::: "memory");
        } else {
            XB_SPIN(xb_ld(&bar[XB_XGEN(b.x)]) == gen, bar);
            __builtin_amdgcn_fence(__ATOMIC_ACQUIRE, "agent");
            asm volatile("s_waitcnt vmcnt(0)" ::: "memory");
        }
    }
    __syncthreads();
}

#ifndef PHMASK
#define PHMASK 0xFFFFF
#endif
#define PH(k) if ((PHMASK >> (k)) & 1)
struct Args { const float* in[25]; float* out; unsigned char* ws; };
__device__ __forceinline__ const float* karg(int i) {
    unsigned off = (unsigned)i * 8u; asm volatile("" : "+s"(off));
    return *(const float* const __attribute__((address_space(4)))*)((const char __attribute__((address_space(4)))*)__builtin_amdgcn_kernarg_segment_ptr() + off);
}

__global__ void __launch_bounds__(NTHR, 2) hymba_fwd(Args a) {
    extern __shared__ __attribute__((aligned(16))) unsigned char lds[];
    cg::grid_group grid = cg::this_grid();
    const int tid = threadIdx.x, lane = tid & 63, wave = __builtin_amdgcn_readfirstlane(tid >> 6);
    const int G = gridDim.x, bx = blockIdx.x;
    const int vcu = (G % 8 == 0) ? (bx % 8) * (G / 8) + bx / 8 : bx;
    const int gw = vcu * NWAVES + wave, NGW = G * NWAVES;
    LAS unsigned char* ldsl = (LAS unsigned char*)lds;
#define KIN(i) karg(i)
#define ws_p ((unsigned char*)karg(26))
#define out_p ((float*)karg(25))
#define x_in KIN(0)
#define cvec KIN(1)
#define ctx KIN(2)
#define c_ctx KIN(3)
#define w_mod KIN(4)
#define b_mod KIN(5)
#define norm_g KIN(6)
#define ffn_w_in KIN(7)
#define ffn_w_out KIN(8)
#define w_in KIN(9)
#define w_out KIN(10)
#define ssm_a_re KIN(11)
#define ssm_a_im KIN(12)
#define ssm_log_dt KIN(13)
#define ssm_b_re KIN(14)
#define ssm_b_im KIN(15)
#define ssm_c_re KIN(16)
#define ssm_c_im KIN(17)
#define ssm_d KIN(18)
#define w_glu KIN(19)
#define b_glu KIN(20)
#define lam_q KIN(21)
#define lam_k KIN(22)
#define subln_g KIN(23)
#define final_g KIN(24)
#define MISC ((float*)(ws_p + WS_CTL))
#define MOD ((float*)(ws_p + WS_MOD))
#define ABAR ((float2*)(ws_p + WS_ABAR))
#define APOW ((float2*)(ws_p + WS_APOW))
#define BBT ((bf16*)(ws_p + WS_BBT))
#define CM ((bf16*)(ws_p + WS_CM))
#define ROPE ((float*)(ws_p + WS_ROPE))
#define W1A ((bf16*)(ws_p + WS_W1A))
#define W1B ((bf16*)(ws_p + WS_W1B))
#define W2A ((bf16*)(ws_p + WS_W2A))
#define W2B ((bf16*)(ws_p + WS_W2B))
#define WIN ((bf16*)(ws_p + WS_WIN))
#define WOUT ((bf16*)(ws_p + WS_WOUT))
#define WGLU ((bf16*)(ws_p + WS_WGLU))
#define EST ((float2*)(ws_p + WS_E))
#define HIN ((float2*)(ws_p + WS_HIN))
#define XC ((float*)(ws_p + WS_XC))
#define XN ((bf16*)(ws_p + WS_XN))
#define SA ((bf16*)(ws_p + WS_XN))
#define ACT ((bf16*)(ws_p + WS_ACT))
#define OATT ((float*)(ws_p + WS_OATT))
#define GB ((bf16*)(ws_p + WS_G))
#define YFB ((float*)(ws_p + WS_OATT + 132 * MiB))
#define BIAS1 ((float*)(ws_p + WS_BIAS1))
#define BIAS2 ((float*)(ws_p + WS_BIAS2))
#define RSS1 ((float*)(ws_p + WS_RSS1))
#define RSS2 ((float*)(ws_p + WS_RSS2))
#define XN2 ((bf16*)(ws_p + WS_U))
#define UB ((bf16*)(ws_p + WS_U))
#define QB ((bf16*)(ws_p + WS_Q))
#define KB ((bf16*)(ws_p + WS_K))
#define VB ((bf16*)(ws_p + WS_V))
    (void)a;
    { volatile LAS unsigned* st0 = (volatile LAS unsigned*)(ldsl + 138240); if (tid < 4) st0[tid] = 0u; }
    __syncthreads();
    XcdBarrier xbar = xcd_barrier_post((unsigned*)(ws_p + WS_BAR), (volatile LAS unsigned*)(ldsl + 138240));
#define GSYNC() xcd_barrier(xbar)

    PH(0) {
        if (bx < 288) {
            LAS float* sl = (LAS float*)ldsl; LAS float* part = (LAS float*)(ldsl + 36864);
            for (int i = tid; i < 9 * DM; i += NTHR) { const float v = i < 8 * DM ? cvec[i] : c_ctx[i - 8 * DM]; sl[i] = v / (1.0f + __expf(-v)); }
            __syncthreads();
            for (int unit = bx; unit < 288; unit += G) {
                const int cl = tid & 31, kg = tid >> 5, k0 = kg * 64; const float* wp = w_mod + (size_t)k0 * NMODV + unit * 32 + cl;
                float acc[9];
#pragma unroll
                for (int i = 0; i < 9; ++i) acc[i] = 0.f;
                float wv[64];
#pragma unroll
                for (int kk = 0; kk < 64; ++kk) wv[kk] = wp[(size_t)kk * NMODV];
#pragma unroll
                for (int kk = 0; kk < 64; kk += 4) {
#pragma unroll
                    for (int i = 0; i < 9; ++i) { const f32x4 sv = *(const LAS f32x4*)(sl + i * DM + k0 + kk); acc[i] = fmaf(sv.x, wv[kk], fmaf(sv.y, wv[kk + 1], fmaf(sv.z, wv[kk + 2], fmaf(sv.w, wv[kk + 3], acc[i])))); }
                }
#pragma unroll
                for (int i = 0; i < 9; ++i) part[(kg * 9 + i) * 32 + cl] = acc[i];
                __syncthreads();
                if (tid < 288) { const int i = tid >> 5; float sum = 0.f;
#pragma unroll
                    for (int k = 0; k < 16; ++k) sum += part[(k * 9 + i) * 32 + cl];
                    MOD[i * NMODV + unit * 32 + cl] = sum + b_mod[unit * 32 + cl]; }
                __syncthreads();
            }
        }
        __syncthreads();
        {
            LAS float* scr = (LAS float*)(ldsl + wave * 16384);
            constexpr int I_1A = (DM / 64) * (2 * DFF / 32);
            for (int it = gw; it < I_1A; it += NGW) transpose_item(ffn_w_in, DM, 2 * DFF, W1A, 1, scr, it, lane);
        }
        const int gt = bx * NTHR + tid, NT_ALL = G * NTHR;
        for (int i = gt; i < 2 * 32 * 64; i += NT_ALL) {
            const int p = i & 63, dg = i >> 6;
            const double dt = dexp((double)ssm_log_dt[dg]), are = (double)ssm_a_re[i], aim = (double)ssm_a_im[i];
            double s1, c1, s2, c2; dsincos(dt * aim, s1, c1); dsincos(256.0 * dt * aim, s2, c2);
            const double mag = dexp(dt * are), mag2 = dexp(256.0 * dt * are);
            const double abr = mag * c1, abi = mag * s1;
            ABAR[i] = make_float2((float)abr, (float)abi); APOW[i] = make_float2((float)(mag2 * c2), (float)(mag2 * s2));
            const double zr = abr - 1.0, zi = abi, den = are * are + aim * aim;
            const double cr = (zr * are + zi * aim) / den, ci = (zi * are - zr * aim) / den;
            const float* bre = ssm_b_re + (size_t)i * 16; const float* bim = ssm_b_im + (size_t)i * 16;
            bf16* dre = BBT + ((size_t)(dg * 4 + (p >> 5)) * 32 + (p & 31)) * 16; bf16* dim = BBT + ((size_t)(dg * 4 + 2 + (p >> 5)) * 32 + (p & 31)) * 16;
#pragma unroll
            for (int h = 0; h < 16; ++h) { const double br = (double)bre[h], bi = (double)bim[h]; dre[h] = (bf16)f2bf((float)(cr * br - ci * bi)); dim[h] = (bf16)f2bf((float)(cr * bi + ci * br)); }
        }
        for (int i = gt; i < 2 * 32 * 16 * 64; i += NT_ALL) {
            const int p = i & 63, dgh = i >> 6;
            ((unsigned*)CM)[(size_t)dgh * 64 + p] = pk2(ssm_c_re[i], -ssm_c_im[i]);
        }
        for (int i = gt; i < 128 * 16; i += NT_ALL) {
            const int f = i & 15, pos = i >> 4;
            const double inv = dexp(-(double)f * (9.210340371976182736 / 16.0)); double s, c; dsincos((double)pos * inv, s, c);
            ROPE[2 * i] = (float)c; ROPE[2 * i + 1] = (float)s;
        }
        for (int i = gt; i < NROWS; i += NT_ALL) { RSS1[i] = 0.f; RSS2[i] = 0.f; }
        if (gt == 0) { float s0 = 0.f, s1 = 0.f; for (int d = 0; d < 64; ++d) { s0 += lam_q[d] * lam_k[d]; s1 += lam_q[64 + d] * lam_k[64 + d]; } MISC[0] = expf(s0) - expf(s1) + 0.2f; }
    }
    grid.sync();

#define NORM_PASS(SRC_LAT, SRC_CTX, NIDX, LATONLY) do { int tid_l = threadIdx.x; asm volatile("" : "+v"(tid_l)); const int lane_l = tid_l & 63, gw_l = vcu * NWAVES + __builtin_amdgcn_readfirstlane(tid_l >> 6); \
        for (int it = gw_l; it < NROWS / 16; it += NGW) { const int r0 = it * 16, pm = r0 >> 8, b = pm / TILES_B, jt = pm - b * TILES_B, rl = r0 & 255; \
            if ((LATONLY) && jt == 32) continue; \
            const float* src = jt < 32 ? (SRC_LAT) + ((size_t)b * SEQ + jt * 256 + rl) * DM : (SRC_CTX) + ((size_t)b * CTXL + rl) * DM; \
            const float* mv = MOD + (jt < 32 ? b : 8) * NMODV + 3 * (NIDX) * DM; \
            norm_rows16<0>(src, XN + (size_t)r0 * DM, nullptr, norm_g + (NIDX) * DM, mv, mv + DM, lane_l); } } while (0)

    PH(1) {
        if (bx < 240) {
            const bool isin = bx < 64; const int unit = isin ? bx : bx - 64, N = isin ? 2048 : 2 * DFF, soff = isin ? 3 * DM : 6 * DM;
            const float* W = isin ? w_in : ffn_w_in + (size_t)DM * 2 * DFF; float* BO = isin ? BIAS1 : BIAS2;
            LAS float* sl = (LAS float*)ldsl; LAS float* part = (LAS float*)(ldsl + 36864);
            for (int i = tid; i < 9 * DM; i += NTHR) sl[i] = MOD[(i >> 10) * NMODV + soff + (i & 1023)];
            __syncthreads();
            const int cl = tid & 31, kg = tid >> 5, k0 = kg * 64; const float* wp = W + (size_t)k0 * N + unit * 32 + cl;
            float acc[9];
#pragma unroll
            for (int i = 0; i < 9; ++i) acc[i] = 0.f;
            float wv[64];
#pragma unroll
            for (int kk = 0; kk < 64; ++kk) wv[kk] = wp[(size_t)kk * N];
#pragma unroll
            for (int kk = 0; kk < 64; kk += 4) {
#pragma unroll
                for (int i = 0; i < 9; ++i) { const f32x4 sv = *(const LAS f32x4*)(sl + i * DM + k0 + kk); acc[i] = fmaf(sv.x, wv[kk], fmaf(sv.y, wv[kk + 1], fmaf(sv.z, wv[kk + 2], fmaf(sv.w, wv[kk + 3], acc[i])))); }
            }
#pragma unroll
            for (int i = 0; i < 9; ++i) part[(kg * 9 + i) * 32 + cl] = acc[i];
            __syncthreads();
            if (tid < 288) { const int i = tid >> 5; float sum = 0.f;
#pragma unroll
                for (int k = 0; k < 16; ++k) sum += part[(k * 9 + i) * 32 + cl];
                const int src = unit * 32 + cl; int drow = src;
                if (isin) { if (src >= 512 && src < 1536) drow = unit * 32 + 2 * (cl & 15) + (cl >> 4); }
                else { const int up = src >= DFF ? 1 : 0, ff = src - up * DFF; drow = (ff >> 7) * 256 + up * 128 + (ff & 127); }
                BO[i * N + drow] = sum; }
            __syncthreads();
        }
        NORM_PASS(x_in, ctx, 0, false);
    }
    GSYNC();
    PH(2) { pg8::Gemm g{XN, W1A, NROWS, 2 * DFF, DM}; pg8::TileOrder S; S.init(264, 22, G, bx, 0); pg8::EpiSwiglu E{ACT, DFF, nullptr, nullptr};
      pg8::gemm_phase<pg8::EpiSwiglu, pg8::TileOrder, true, true>(ldsl, g, S, E);
      if (bx >= 176) {
          int tid_l = threadIdx.x; asm volatile("" : "+v"(tid_l)); const int lane_l = tid_l & 63, wave_l = __builtin_amdgcn_readfirstlane(tid_l >> 6);
          LAS float* scr = (LAS float*)(ldsl + wave_l * 16384);
          constexpr int I_1B = (DFF / 64) * (DM / 32);
          for (int it = (bx - 176) * NWAVES + wave_l; it < I_1B; it += (G - 176) * NWAVES) transpose_item(ffn_w_out, DFF, DM, W1B, 0, scr, it, lane_l);
      } }
    GSYNC();
    PH(3) { pg8::Gemm g{ACT, W1B, NROWS, DM, DFF}; pg8::TileOrder S; S.init(264, 4, G, bx, 0); pg8::EpiResidNorm E{x_in, ctx, out_p, XC, MOD, 2 * DM, 1, norm_g + DM, 4 * DM, XN, RSS1};
      pg8::gemm_phase<pg8::EpiResidNorm, pg8::TileOrder, true, true>(ldsl, g, S, E);
      if (bx >= 32) {
          int tid_l = threadIdx.x; asm volatile("" : "+v"(tid_l)); const int lane_l = tid_l & 63, wave_l = __builtin_amdgcn_readfirstlane(tid_l >> 6);
          LAS float* scr = (LAS float*)(ldsl + wave_l * 16384);
          constexpr int I_1A = (DM / 64) * (2 * DFF / 32), I_1B = (DFF / 64) * (DM / 32), I_OUT = (DM / 64) * (DM / 32), I_GLU = (512 / 64) * (512 / 32), I_IN = (DM / 64) * (2048 / 32);
          for (int it = (bx - 32) * NWAVES + wave_l; it < I_IN + I_1A + I_1B + I_OUT + I_GLU; it += (G - 32) * NWAVES) {
              int r = it;
              if (r < I_IN) { transpose_item(w_in, DM, 2048, WIN, 2, scr, r, lane_l); continue; } r -= I_IN;
              if (r < I_1A) { transpose_item(ffn_w_in + (size_t)DM * 2 * DFF, DM, 2 * DFF, W2A, 1, scr, r, lane_l); continue; } r -= I_1A;
              if (r < I_1B) { transpose_item(ffn_w_out + (size_t)DFF * DM, DFF, DM, W2B, 0, scr, r, lane_l); continue; } r -= I_1B;
              if (r < I_OUT) { transpose_item(w_out, DM, DM, WOUT, 0, scr, r, lane_l); continue; } r -= I_OUT;
              transpose_item(w_glu, 512, 512, WGLU, 0, scr, r, lane_l);
          }
      } }
    GSYNC();
    PH(5) { pg8::Gemm g{XN, WIN, NROWS, 2048, DM}; pg8::TileOrder S; S.init(264, 8, G, bx, 0); pg8::EpiInproj E{UB, QB, KB, VB, ROPE, RSS1, BIAS1};
      pg8::gemm_phase<pg8::EpiInproj, pg8::TileOrder, true, true>(ldsl, g, S, E); }
    GSYNC();
    PH(6) for (int un = vcu; un < 8 * 33 * 4; un += G) { const int gq = un & 3, bc = un >> 2, b = bc / 33, c = bc - b * 33;
        s5_unit_a(ldsl, b, c, gq, UB, ABAR, BBT, EST); }
    GSYNC();
    PH(7) if (bx < 64) {
        int tid_c = threadIdx.x; asm volatile("" : "+v"(tid_c));
        const int i = bx * NTHR + tid_c;
        const int p = i & 63, dir = (i >> 6) & 1, g = (i >> 7) & 31, b = i >> 12;
        const float2 ap = APOW[(dir * 32 + g) * 64 + p];
#define SIDX(cc) (((((size_t)b * 33 + (cc)) * 32 + g) * 2 + dir) * 64 + p)
        float2 h = EST[SIDX(32)];
        if (dir == 0) { HIN[SIDX(0)] = h; for (int c = 0; c < 31; ++c) { const float2 e = EST[SIDX(c)]; const float nr = fmaf(ap.x, h.x, fmaf(-ap.y, h.y, e.x)), ni = fmaf(ap.x, h.y, fmaf(ap.y, h.x, e.y)); h = make_float2(nr, ni); HIN[SIDX(c + 1)] = h; } }
        else { HIN[SIDX(31)] = h; for (int c = 31; c > 0; --c) { const float2 e = EST[SIDX(c)]; const float nr = fmaf(ap.x, h.x, fmaf(-ap.y, h.y, e.x)), ni = fmaf(ap.x, h.y, fmaf(ap.y, h.x, e.y)); h = make_float2(nr, ni); HIN[SIDX(c - 1)] = h; } }
#undef SIDX
    }
    PH(8) {
        const float lam = MISC[0];
        unsigned redo_mask = 0u;
        {
        int k_ = 0;
        for (int un = vcu; un < 8 * 4 * 32; un += G, ++k_) {
            const int qb = un & 31, bh = un >> 5, b = bh >> 2, h = bh & 3;
            const size_t rb = (size_t)b * ROWS_B, rq = rb + (size_t)qb * 256;
            const attn::bf16_t* q0 = QB + rq * 512 + h * 128; const attn::bf16_t* k0 = KB + rb * 512 + h * 128; const attn::bf16_t* v0 = VB + rb * 512 + h * 128;
            float* st = OATT + rq * 512 + h * 128; attn::bf16_t* so = SA + rq * 1024 + 512 + h * 128;
            bool redo = attn::body<0, false>(q0, k0, v0, st, nullptr, lam, subln_g, ROWS_B, (char*)lds);
            if (!redo) redo = attn::body<1, false>(q0 + 64, k0 + 64, v0, st, so, lam, subln_g, ROWS_B, (char*)lds);
            if (redo) redo_mask |= 1u << k_;
        }
        }
        if (redo_mask) {
            int k_ = 0;
            for (int un = vcu; un < 8 * 4 * 32; un += G, ++k_) {
                if (!((redo_mask >> k_) & 1u)) continue;
                const int qb = un & 31, bh = un >> 5, b = bh >> 2, h = bh & 3;
                const size_t rb = (size_t)b * ROWS_B, rq = rb + (size_t)qb * 256;
                const attn::bf16_t* q0 = QB + rq * 512 + h * 128; const attn::bf16_t* k0 = KB + rb * 512 + h * 128; const attn::bf16_t* v0 = VB + rb * 512 + h * 128;
                float* st = OATT + rq * 512 + h * 128; attn::bf16_t* so = SA + rq * 1024 + 512 + h * 128;
                (void)attn::body<0, true>(q0, k0, v0, st, nullptr, lam, subln_g, ROWS_B, (char*)lds);
                (void)attn::body<1, true>(q0 + 64, k0 + 64, v0, st, so, lam, subln_g, ROWS_B, (char*)lds);
            }
        }
    }
    GSYNC();
    PH(9) for (int un = vcu; un < 8 * 32 * 4; un += G) { const int gq = un & 3, bc = un >> 2, b = bc >> 5, c = bc & 31;
        s5_unit<true>(ldsl, b, c, gq, UB, ABAR, BBT, CM, HIN, EST, ssm_d, GB, YFB); }
    GSYNC();
    PH(10) { pg8::Gemm g{GB, WGLU, NROWS, 512, 512}; pg8::TileOrder S; S.init(256, 2, G, bx, 1); pg8::EpiGlu E{GB, b_glu, SA};
      pg8::gemm_phase<pg8::EpiGlu, pg8::TileOrder, true, true>(ldsl, g, S, E); }
    GSYNC();
    PH(12) { pg8::Gemm g{SA, WOUT, NROWS, DM, DM}; pg8::TileOrder S; S.init(256, 4, G, bx, 1); pg8::EpiResidNorm E{out_p, XC, out_p, XC, MOD, 5 * DM, 0, norm_g + 2 * DM, 7 * DM, XN2, RSS2};
      pg8::gemm_phase<pg8::EpiResidNorm, pg8::TileOrder, true, true>(ldsl, g, S, E); }
    GSYNC();
    PH(14) { pg8::Gemm g{XN2, W2A, NROWS, 2 * DFF, DM}; pg8::TileOrder S; S.init(256, 22, G, bx, 1); pg8::EpiSwiglu E{ACT, DFF, RSS2, BIAS2};
      pg8::gemm_phase<pg8::EpiSwiglu, pg8::TileOrder, true, true>(ldsl, g, S, E); }
    GSYNC();
    PH(15) { pg8::Gemm g{ACT, W2B, NROWS, DM, DFF}; pg8::TileOrder S; S.init(256, 4, G, bx, 1); pg8::EpiResid E{out_p, XC, out_p, XC, MOD, 8 * DM, 0.5f};
      pg8::gemm_phase<pg8::EpiResid, pg8::TileOrder, true, true>(ldsl, g, S, E); }
    GSYNC();
    PH(16) { int tid_l = threadIdx.x; asm volatile("" : "+v"(tid_l)); const int lane_l = tid_l & 63, gw_l = vcu * NWAVES + __builtin_amdgcn_readfirstlane(tid_l >> 6);
        for (int it = gw_l; it < NB * SEQ / 16; it += NGW) norm_rows16<1>(out_p + (size_t)it * 16 * DM, nullptr, out_p + (size_t)it * 16 * DM, final_g, nullptr, nullptr, lane_l); }
#undef NORM_PASS
}

extern "C" void kernel_launch(void* const* d_in, const int* in_sizes, int n_in, void* d_out, int out_size, void* d_ws, size_t ws_size, hipStream_t stream) {
    static int grid = 0;
    if (grid == 0) {
        if (n_in != 25 || in_sizes[0] != NB * SEQ * DM || out_size != NB * SEQ * DM || ws_size < WS_END) {
            fprintf(stderr, "kernel_launch: shape mismatch (n_in %d, in0 %d, out %d, ws %zu, need %zu); nothing launched\n", n_in, n_in > 0 ? in_sizes[0] : -1, out_size, ws_size, (size_t)WS_END); grid = -1; return; }
        int dev = 0, cus = 0, per_cu = 0;
        if (hipGetDevice(&dev) != hipSuccess || hipDeviceGetAttribute(&cus, hipDeviceAttributeMultiprocessorCount, dev) != hipSuccess) { grid = -1; return; }
        if (hipFuncSetAttribute((const void*)hymba_fwd, hipFuncAttributeMaxDynamicSharedMemorySize, LDS_BYTES) != hipSuccess) { fprintf(stderr, "kernel_launch: hipFuncSetAttribute failed\n"); grid = -1; return; }
        if (hipOccupancyMaxActiveBlocksPerMultiprocessor(&per_cu, (const void*)hymba_fwd, NTHR, LDS_BYTES) != hipSuccess || per_cu < 1) { fprintf(stderr, "kernel_launch: occupancy query says %d\n", per_cu); per_cu = 1; }
        (void)hipGetLastError();
        grid = cus * (per_cu > 1 ? 1 : per_cu);
        if (grid != 256) fprintf(stderr, "kernel_launch: grid %d (expected 256)\n", grid);
    }
    if (grid < 0) return;
    (void)hipMemsetAsync((char*)d_ws + WS_BAR, 0, BAR_ZERO_BYTES, stream);
    Args a{};
    for (int i = 0; i < 25; ++i) a.in[i] = (const float*)d_in[i];
    a.out = (float*)d_out; a.ws = (unsigned char*)d_ws;
    void* args[] = {&a};
    const hipError_t e = hipLaunchCooperativeKernel((const void*)hymba_fwd, dim3(grid), dim3(NTHR), args, LDS_BYTES, stream);
    if (e != hipSuccess) fprintf(stderr, "kernel_launch: cooperative launch failed: %s (grid %d)\n", hipGetErrorString(e), grid);
}
```

```cpp
#include <hip/hip_runtime.h>
#include <hip/hip_cooperative_groups.h>
#include <cstdio>
#include <cstdint>
namespace cg = cooperative_groups;
namespace pg8 {
#define PG8_LAS __attribute__((address_space(3)))
typedef unsigned short bf16_t;
typedef short bf16x8 __attribute__((ext_vector_type(8)));
typedef float f32x4 __attribute__((ext_vector_type(4)));
typedef unsigned u32x4 __attribute__((ext_vector_type(4)));
constexpr int BM = 256, BK = 64, HALF = 128, HTB = HALF * BK * 2  , STAGE_BYTES = 8 * HTB, NXCD = 8, WGM = 8;

__host__ __device__ __forceinline__ int lds_byte(int r, int c) { const int st = (r >> 4) * 2 + (c >> 5), rr = r & 15, cc = c & 31, ob = rr * 64 + cc * 2; return st * 1024 + (ob ^ (((ob >> 9) & 1) << 5)); }
__host__ __device__ __forceinline__ void stage_rc(int b, int& R, int& C) { const int st = b / 1024, sb = b % 1024, swz = sb ^ (((sb >> 9) & 1) << 5); R = (st >> 1) * 16 + swz / 64; C = (st & 1) * 32 + (swz % 64) / 2; }
__host__ __device__ __forceinline__ int perm32(int rho) { const int n = rho >> 4, i = rho & 15; return 8 * (i >> 2) + 4 * n + (i & 3); }

struct Unit { int pm, pn; };
struct Gemm { const bf16_t* A; const bf16_t* Bt; int M, N, K; };

__device__ __forceinline__ unsigned cvt_pk_bf16(float lo, float hi) { unsigned r; asm volatile("v_cvt_pk_bf16_f32 %0, %1, %2" : "=v"(r) : "v"(lo), "v"(hi)); return r; }
typedef float f32x2 __attribute__((ext_vector_type(2)));
typedef unsigned u32x2 __attribute__((ext_vector_type(2)));
constexpr int ROWS_B = 8448, TILES_B = 33, NROWS = 8 * ROWS_B;

struct TileOrder {
    int nM, nN, nwg, G, c, lat;
    __device__ __forceinline__ void init(int nM_, int nN_, int G_, int c_, int lat_) { nM = nM_; nN = nN_; nwg = nM_ * nN_; G = G_; c = c_; lat = lat_; }
    __device__ __forceinline__ bool next(int i, Unit& u) const {
        const long L = (long)i * G + c; if (L >= nwg) return false;
        int wgid = (int)L; { const int q = nwg / NXCD, r = nwg % NXCD, xcd = wgid % NXCD, off = wgid / NXCD; wgid = (xcd < r ? xcd * (q + 1) : r * (q + 1) + (xcd - r) * q) + off; }
        const int nig = WGM * nN, gid = wgid / nig, fm = gid * WGM, gsz = (nM - fm) < WGM ? (nM - fm) : WGM;
        const int lm = fm + ((wgid % nig) % gsz); u.pn = (wgid % nig) / gsz; u.pm = lat ? (lm >> 5) * TILES_B + (lm & 31) : lm; return true;
    }
    __device__ __forceinline__ void a_ready(const Unit&) const {}
    __device__ __forceinline__ void done(const Unit&) const {}
};

__device__ __forceinline__ float fast_sigmoid(float z) { return __builtin_amdgcn_rcpf(1.0f + __builtin_amdgcn_exp2f(-1.4426950408889634f * z)); }
__device__ __forceinline__ float bf_lo(unsigned w) { return __uint_as_float(w << 16); }
__device__ __forceinline__ float bf_hi(unsigned w) { return __uint_as_float(w & 0xffff0000u); }

struct EpiSwiglu {
    static constexpr bool PERM = true, AFTER_DRAIN = false;
    bf16_t* O; int ldc; const float* rss; const float* bias;
    __device__ __forceinline__ void operator()(const f32x4 (&acc)[2][2][4][2], const Unit& u, int wr, int wc, int fr, int fq) const {
        const int row0 = u.pm * BM + wr * 64 + fr, col0 = u.pn * HALF + wc * 32 + 8 * fq;
        f32x4 bv[2][2];
#pragma unroll
        for (int bj = 0; bj < 2; ++bj)
#pragma unroll
            for (int n = 0; n < 2; ++n) bv[bj][n] = rss ? *(const f32x4*)(bias + (u.pm / TILES_B) * 5632 + u.pn * BM + bj * HALF + wc * 32 + 8 * fq + 4 * n) : (f32x4){0.f, 0.f, 0.f, 0.f};
#pragma unroll
        for (int ai = 0; ai < 2; ++ai)
#pragma unroll
            for (int m = 0; m < 4; ++m) {
                bf16_t* rowp = O + (size_t)(row0 + ai * HALF + m * 16) * ldc + col0;
                float v[8];
                const float rstd = rss ? 1.0f / sqrtf(rss[row0 + ai * HALF + m * 16] * (1.0f / 1024.0f) + 1e-6f) : 1.0f;
#pragma unroll
                for (int n = 0; n < 2; ++n)
#pragma unroll
                    for (int e = 0; e < 4; ++e) { const float gt = acc[ai][0][m][n][e] * rstd + bv[0][n][e], up = acc[ai][1][m][n][e] * rstd + bv[1][n][e]; v[4 * n + e] = gt * fast_sigmoid(gt) * up; }
                u32x4 w; w.x = cvt_pk_bf16(v[0], v[1]); w.y = cvt_pk_bf16(v[2], v[3]); w.z = cvt_pk_bf16(v[4], v[5]); w.w = cvt_pk_bf16(v[6], v[7]);
                *(u32x4*)rowp = w;
            }
    }
};

struct EpiResid {
    static constexpr bool PERM = true, AFTER_DRAIN = false;
    const float* res_lat; const float* res_ctx; float* out_lat; float* out_ctx; const float* mod; int modoff; float scale;
    __device__ __forceinline__ void operator()(const f32x4 (&acc)[2][2][4][2], const Unit& u, int wr, int wc, int fr, int fq) const {
        const int b = u.pm / TILES_B, jt = u.pm - b * TILES_B;
        const float* rb; float* ob; const float* gv;
        if (jt < 32) { const size_t o = ((size_t)b * 8192 + (size_t)jt * 256) * 1024; rb = res_lat + o; ob = out_lat + o; gv = mod + b * 9216 + modoff; }
        else { const size_t o = (size_t)b * 256 * 1024; rb = res_ctx + o; ob = out_ctx + o; gv = mod + 8 * 9216 + modoff; }
        const int rl = wr * 64 + fr, col0 = u.pn * BM + wc * 32 + 8 * fq;
        const char* rbb = (const char*)rb; char* obb = (char*)ob;
#pragma unroll
        for (int bj = 0; bj < 2; ++bj) {
            const int c = col0 + bj * HALF;
            const f32x4 g0 = *(const f32x4*)(gv + c) * scale, g1 = *(const f32x4*)(gv + c + 4) * scale;
#pragma unroll
            for (int kb = 0; kb < 8; kb += 8) {
                f32x4 x0[8], x1[8];
#pragma unroll
                for (int k = 0; k < 8; ++k) { const int ai = (kb + k) >> 2, m = (kb + k) & 3; const unsigned pb = (unsigned)((rl + ai * HALF + m * 16) * 1024 + c) * 4u; x0[k] = *(const f32x4*)(rbb + pb); x1[k] = *(const f32x4*)(rbb + pb + 16); }
                asm volatile("" ::: "memory");
#pragma unroll
                for (int k = 0; k < 8; ++k) { const int ai = (kb + k) >> 2, m = (kb + k) & 3; const unsigned pb = (unsigned)((rl + ai * HALF + m * 16) * 1024 + c) * 4u;
                    *(f32x4*)(obb + pb) = x0[k] + g0 * acc[ai][bj][m][0]; *(f32x4*)(obb + pb + 16) = x1[k] + g1 * acc[ai][bj][m][1]; }
                asm volatile("" ::: "memory");
            }
        }
    }
};

struct EpiResidNorm {
    static constexpr bool PERM = true, AFTER_DRAIN = false;
    const float* res_lat; const float* res_ctx; float* out_lat; float* out_ctx; const float* mod; int gateoff; int half_gate; const float* ng; int scaleoff; bf16_t* XNo; float* rss;
    __device__ __forceinline__ void operator()(const f32x4 (&acc)[2][2][4][2], const Unit& u, int wr, int wc, int fr, int fq) const {
        const int b = u.pm / TILES_B, jt = u.pm - b * TILES_B;
        const float* rb; float* ob; const float* mv;
        if (jt < 32) { const size_t o = ((size_t)b * 8192 + (size_t)jt * 256) * 1024; rb = res_lat + o; ob = out_lat + o; mv = mod + b * 9216; }
        else { const size_t o = (size_t)b * 256 * 1024; rb = res_ctx + o; ob = out_ctx + o; mv = mod + 8 * 9216; }
        const int rl = wr * 64 + fr, col0 = u.pn * BM + wc * 32 + 8 * fq;
        const float scale = half_gate ? 0.5f : 1.0f;
#ifndef EPI_RB
#define EPI_RB 4
#endif
        const char* rbb = (const char*)rb; char* obb = (char*)ob;
        typedef __attribute__((address_space(1))) float gfloat_t;
#pragma unroll
        for (int bj = 0; bj < 2; ++bj) {
            const int c = col0 + bj * HALF;
            const f32x4 g0 = *(const f32x4*)(mv + gateoff + c) * scale, g1 = *(const f32x4*)(mv + gateoff + c + 4) * scale;
            const f32x4 gs0 = *(const f32x4*)(ng + c) * (*(const f32x4*)(mv + scaleoff + c) + 1.0f), gs1 = *(const f32x4*)(ng + c + 4) * (*(const f32x4*)(mv + scaleoff + c + 4) + 1.0f);
#pragma unroll
            for (int kb = 0; kb < 8; kb += EPI_RB) {
                f32x4 x0[EPI_RB], x1[EPI_RB];
#pragma unroll
                for (int k = 0; k < EPI_RB; ++k) { const int ai = (kb + k) >> 2, m = (kb + k) & 3; const unsigned pb = (unsigned)((rl + ai * HALF + m * 16) * 1024 + c) * 4u; x0[k] = *(const f32x4*)(rbb + pb); x1[k] = *(const f32x4*)(rbb + pb + 16); }
                asm volatile("" ::: "memory");
#pragma unroll
                for (int k = 0; k < EPI_RB; ++k) { const int ai = (kb + k) >> 2, m = (kb + k) & 3; const int rr = rl + ai * HALF + m * 16; const unsigned pb = (unsigned)(rr * 1024 + c) * 4u; const size_t prow = (size_t)u.pm * BM + rr;
                    const f32x4 y0 = x0[k] + g0 * acc[ai][bj][m][0], y1 = x1[k] + g1 * acc[ai][bj][m][1];
                    *(f32x4*)(obb + pb) = y0; *(f32x4*)(obb + pb + 16) = y1;
                    float t = (y0[0] * y0[0] + y0[1] * y0[1]) + (y0[2] * y0[2] + y0[3] * y0[3]) + (y1[0] * y1[0] + y1[1] * y1[1]) + (y1[2] * y1[2] + y1[3] * y1[3]);
                    const f32x4 z0 = y0 * gs0, z1 = y1 * gs1;
                    u32x4 w; w.x = cvt_pk_bf16(z0[0], z0[1]); w.y = cvt_pk_bf16(z0[2], z0[3]); w.z = cvt_pk_bf16(z1[0], z1[1]); w.w = cvt_pk_bf16(z1[2], z1[3]);
                    *(u32x4*)(XNo + prow * 1024 + c) = w;
                    t += __shfl_xor(t, 16); t += __shfl_xor(t, 32);
                    if (fq == 0) __hip_atomic_fetch_add((gfloat_t*)(rss + prow), t, __ATOMIC_RELAXED, __HIP_MEMORY_SCOPE_AGENT); }
                asm volatile("" ::: "memory");
            }
        }
    }
};

struct EpiInproj {
    static constexpr bool PERM = true, AFTER_DRAIN = false;
    bf16_t* U; bf16_t* Q; bf16_t* K; bf16_t* V; const float* rope; const float* rss; const float* bias;
    __device__ __forceinline__ void operator()(const f32x4 (&acc)[2][2][4][2], const Unit& u, int wr, int wc, int fr, int fq) const {
        const int sec = u.pn >> 1, jt = u.pm % TILES_B;
        bf16_t* base = sec == 0 ? U : sec == 1 ? Q : sec == 2 ? K : V;
        const bool dorope = (sec == 1 || sec == 2) && jt < 32;
        const float qs = sec == 1 ? 0.125f * 1.4426950408889634f : 1.0f;
        const int col0 = (u.pn & 1) * BM + wc * 32 + 8 * fq, axis = wc & 1;
        const float* bp = bias + (jt < 32 ? u.pm / TILES_B : 8) * 2048 + u.pn * BM + wc * 32 + 8 * fq;
        f32x4 bv[2][2];
#pragma unroll
        for (int bj = 0; bj < 2; ++bj)
#pragma unroll
            for (int n = 0; n < 2; ++n) bv[bj][n] = *(const f32x4*)(bp + bj * HALF + 4 * n);
#pragma unroll
        for (int ai = 0; ai < 2; ++ai)
#pragma unroll
            for (int m = 0; m < 4; ++m) {
                const int rowl = wr * 64 + fr + ai * HALF + m * 16;
                bf16_t* rowp = base + (size_t)(u.pm * BM + rowl) * 512 + col0;
                const float rstd = 1.0f / sqrtf(rss[u.pm * BM + rowl] * (1.0f / 1024.0f) + 1e-6f);
                f32x4 cs0 = {1.f, 0.f, 1.f, 0.f}, cs1 = {1.f, 0.f, 1.f, 0.f};
                if (dorope) { const int t = jt * 256 + rowl, pos = axis ? (t & 63) : (t >> 6); const float* rp = rope + (pos * 16 + 4 * fq) * 2; cs0 = *(const f32x4*)rp; cs1 = *(const f32x4*)(rp + 4); }
#pragma unroll
                for (int bj = 0; bj < 2; ++bj) {
                    const f32x4 a0 = acc[ai][bj][m][0] * rstd + bv[bj][0], a1 = acc[ai][bj][m][1] * rstd + bv[bj][1];
                    float o[8];
                    o[0] = a0[0] * cs0[0] - a0[1] * cs0[1]; o[1] = a0[1] * cs0[0] + a0[0] * cs0[1];
                    o[2] = a0[2] * cs0[2] - a0[3] * cs0[3]; o[3] = a0[3] * cs0[2] + a0[2] * cs0[3];
                    o[4] = a1[0] * cs1[0] - a1[1] * cs1[1]; o[5] = a1[1] * cs1[0] + a1[0] * cs1[1];
                    o[6] = a1[2] * cs1[2] - a1[3] * cs1[3]; o[7] = a1[3] * cs1[2] + a1[2] * cs1[3];
                    u32x4 w; w.x = cvt_pk_bf16(o[0] * qs, o[1] * qs); w.y = cvt_pk_bf16(o[2] * qs, o[3] * qs); w.z = cvt_pk_bf16(o[4] * qs, o[5] * qs); w.w = cvt_pk_bf16(o[6] * qs, o[7] * qs);
                    *(u32x4*)(rowp + bj * HALF) = w;
                }
            }
    }
};

struct EpiGlu {
    static constexpr bool PERM = true, AFTER_DRAIN = false;
    const bf16_t* Gb; const float* bglu; bf16_t* SA;
    __device__ __forceinline__ void operator()(const f32x4 (&acc)[2][2][4][2], const Unit& u, int wr, int wc, int fr, int fq) const {
        const int row0 = u.pm * BM + wr * 64 + fr, col0 = u.pn * BM + wc * 32 + 8 * fq;
        f32x4 bv[2][2];
#pragma unroll
        for (int bj = 0; bj < 2; ++bj)
#pragma unroll
            for (int n = 0; n < 2; ++n) bv[bj][n] = *(const f32x4*)(bglu + col0 + bj * HALF + 4 * n);
#pragma unroll
        for (int ai = 0; ai < 2; ++ai)
#pragma unroll
            for (int m = 0; m < 4; ++m) { const size_t row = (size_t)(row0 + ai * HALF + m * 16);
#pragma unroll
                for (int bj = 0; bj < 2; ++bj) {
                    const u32x4 gw = *(const u32x4*)(Gb + row * 512 + col0 + bj * HALF);
                    const f32x4 z0 = acc[ai][bj][m][0] + bv[bj][0], z1 = acc[ai][bj][m][1] + bv[bj][1];
                    u32x4 w;
                    w.x = cvt_pk_bf16(bf_lo(gw.x) * fast_sigmoid(z0[0]), bf_hi(gw.x) * fast_sigmoid(z0[1]));
                    w.y = cvt_pk_bf16(bf_lo(gw.y) * fast_sigmoid(z0[2]), bf_hi(gw.y) * fast_sigmoid(z0[3]));
                    w.z = cvt_pk_bf16(bf_lo(gw.z) * fast_sigmoid(z1[0]), bf_hi(gw.z) * fast_sigmoid(z1[1]));
                    w.w = cvt_pk_bf16(bf_lo(gw.w) * fast_sigmoid(z1[2]), bf_hi(gw.w) * fast_sigmoid(z1[3]));
                    *(u32x4*)(SA + row * 1024 + col0 + bj * HALF) = w;
                } }
    }
};

template <class Epi, class Sched, bool ALIGN_EPI = false, bool SP2 = false>
__device__ __forceinline__ void gemm_phase(PG8_LAS unsigned char* lds, const Gemm g, const Sched& S, const Epi& E) {
    int tid_ = threadIdx.x; asm volatile("" : "+v"(tid_));
    const int tid = tid_, wid = __builtin_amdgcn_readfirstlane(tid >> 6), lane = tid & 63, wr = wid >> 2, wc = wid & 3, fr = lane & 15, fq = lane >> 4;
    const int K = g.K, nt = K / BK;
    unsigned voffA[2], voffB[2];
#pragma unroll
    for (int i = 0; i < 2; ++i) { int R, C; stage_rc(tid * 16 + i * 8192, R, C); const int Rb = Epi::PERM ? ((R & ~31) + perm32(R & 31)) : R;
        voffA[i] = (unsigned)(R * K + C) * 2u; voffB[i] = (unsigned)(Rb * K + C) * 2u; }
    const size_t kstep = (size_t)(BK * 2);
    const size_t hstep = (size_t)HALF * K * 2;
    const size_t tstep = 2 * hstep;
    const unsigned ldsw = (unsigned)wid * 1024u;
    const int aoff = lds_byte(wr * 64 + fr, fq * 8), boff = lds_byte(wc * 32 + fr, fq * 8);
#define PG8_SA(b, h) (((b) * 2 + (h)) * HTB)
#define PG8_SB(b, h) ((4 + (b) * 2 + (h)) * HTB)
#define PG8_STAGE(bufoff, gbase, voff) do { _Pragma("unroll") for (int _i = 0; _i < 2; ++_i) \
        __builtin_amdgcn_global_load_lds((const unsigned*)((const char*)(gbase) + (voff)[_i]), (PG8_LAS unsigned*)(lds + (bufoff) + ldsw + _i * 8192), 16, 0, 0); } while (0)
#define PG8_LDA(dst, b, h) do { _Pragma("unroll") for (int m = 0; m < 4; ++m) _Pragma("unroll") for (int k = 0; k < 2; ++k) dst[m][k] = *(const PG8_LAS bf16x8*)(lds + PG8_SA(b, h) + aoff + m * 2048 + k * 1024); } while (0)
#define PG8_LDB(dst, b, h) do { _Pragma("unroll") for (int n = 0; n < 2; ++n) _Pragma("unroll") for (int k = 0; k < 2; ++k) dst[n][k] = *(const PG8_LAS bf16x8*)(lds + PG8_SB(b, h) + boff + n * 2048 + k * 1024); } while (0)
#define PG8_MMA(ai, bj, At, Bt) do { __builtin_amdgcn_s_setprio(1); _Pragma("unroll") for (int m = 0; m < 4; ++m) _Pragma("unroll") for (int n = 0; n < 2; ++n) _Pragma("unroll") for (int k = 0; k < 2; ++k) \
        acc[ai][bj][m][n] = __builtin_amdgcn_mfma_f32_16x16x32_bf16(Bt[n][k], At[m][k], acc[ai][bj][m][n], 0, 0, 0); __builtin_amdgcn_s_setprio(0); } while (0)
#define PG8_WAIT_V(n) asm volatile("s_waitcnt vmcnt(" #n ")" ::: "memory")
#define PG8_WAIT_L(n) asm volatile("s_waitcnt lgkmcnt(" #n ")" ::: "memory")
#define PG8_BAR __builtin_amdgcn_s_barrier()
#define PG8_SCHED __builtin_amdgcn_sched_barrier(0)
    Unit cur, nxt; int ui = 0;
    if (!S.next(0, cur)) return;
    f32x4 acc[2][2][4][2];
#pragma unroll
    for (int a = 0; a < 2; ++a)
#pragma unroll
        for (int b = 0; b < 2; ++b)
#pragma unroll
            for (int m = 0; m < 4; ++m)
#pragma unroll
                for (int n = 0; n < 2; ++n) acc[a][b][m][n] = (f32x4){0.f, 0.f, 0.f, 0.f};
    bf16x8 At[4][2], B0[2][2], B1[2][2];
    const char* cA = (const char*)g.A + (size_t)cur.pm * tstep; const char* cB = (const char*)g.Bt + (size_t)cur.pn * tstep;
    S.a_ready(cur);
    if constexpr (SP2) {
        PG8_STAGE(PG8_SB(0, 0), cB, voffB); PG8_STAGE(PG8_SB(0, 1), cB + hstep, voffB); PG8_STAGE(PG8_SA(0, 0), cA, voffA); PG8_STAGE(PG8_SA(0, 1), cA + hstep, voffA);
        if (wr == 1) PG8_BAR;
        PG8_WAIT_V(2); PG8_BAR;
        PG8_STAGE(PG8_SB(1, 0), cB + kstep, voffB); PG8_STAGE(PG8_SA(1, 0), cA + kstep, voffA); PG8_STAGE(PG8_SB(1, 1), cB + hstep + kstep, voffB);
        PG8_WAIT_V(6); PG8_BAR;
    } else {
        PG8_STAGE(PG8_SB(0, 0), cB, voffB); PG8_STAGE(PG8_SA(0, 0), cA, voffA); PG8_STAGE(PG8_SB(0, 1), cB + hstep, voffB); PG8_STAGE(PG8_SA(0, 1), cA + hstep, voffA);
        if (wr == 1) PG8_BAR;
        PG8_WAIT_V(4); PG8_BAR;
        PG8_STAGE(PG8_SB(1, 0), cB + kstep, voffB); PG8_STAGE(PG8_SA(1, 0), cA + kstep, voffA); PG8_STAGE(PG8_SB(1, 1), cB + hstep + kstep, voffB);
        PG8_WAIT_V(6); PG8_BAR;
    }
    for (;;) {
        const bool has_next = S.next(ui + 1, nxt);
        const char* nA = has_next ? (const char*)g.A + (size_t)nxt.pm * tstep : cA; const char* nB = has_next ? (const char*)g.Bt + (size_t)nxt.pn * tstep : cB;
        for (int t = 0; t < nt; t += 2) {
            const bool last = (t == nt - 2);
            const char* a1 = cA + (size_t)(t + 1) * kstep;
            const char* a2 = last ? nA : cA + (size_t)(t + 2) * kstep; const char* b2 = last ? nB : cB + (size_t)(t + 2) * kstep;
            const char* a3 = a2 + kstep; const char* b3 = b2 + kstep;
            if (last && has_next) S.a_ready(nxt);
            if constexpr (SP2) {
            PG8_LDB(B0, 0, 0); PG8_LDB(B1, 0, 1); PG8_SCHED; PG8_LDA(At, 0, 0); PG8_STAGE(PG8_SA(1, 1), a1 + hstep, voffA);
            PG8_WAIT_V(8); PG8_WAIT_L(0); PG8_BAR; PG8_MMA(0, 0, At, B0); PG8_MMA(0, 1, At, B1); PG8_BAR; PG8_SCHED;
            PG8_LDA(At, 0, 1); PG8_STAGE(PG8_SB(0, 0), b2, voffB); PG8_STAGE(PG8_SB(0, 1), b2 + hstep, voffB); PG8_STAGE(PG8_SA(0, 0), a2, voffA);
            PG8_WAIT_V(8); PG8_WAIT_L(0); PG8_BAR; PG8_MMA(1, 0, At, B0); PG8_MMA(1, 1, At, B1); PG8_BAR; PG8_SCHED;
            PG8_LDB(B0, 1, 0); PG8_LDB(B1, 1, 1); PG8_SCHED; PG8_LDA(At, 1, 0); PG8_STAGE(PG8_SA(0, 1), a2 + hstep, voffA);
            PG8_WAIT_V(8); PG8_WAIT_L(0); PG8_BAR; PG8_MMA(0, 0, At, B0); PG8_MMA(0, 1, At, B1); PG8_BAR; PG8_SCHED;
            PG8_LDA(At, 1, 1); PG8_STAGE(PG8_SB(1, 0), b3, voffB); PG8_STAGE(PG8_SB(1, 1), b3 + hstep, voffB); PG8_STAGE(PG8_SA(1, 0), a3, voffA);
            PG8_WAIT_V(8); PG8_WAIT_L(0); PG8_BAR; PG8_MMA(1, 0, At, B0); PG8_MMA(1, 1, At, B1); PG8_BAR; PG8_SCHED;
            } else {
            PG8_LDB(B0, 0, 0); PG8_SCHED; PG8_LDA(At, 0, 0); PG8_STAGE(PG8_SA(1, 1), a1 + hstep, voffA);
            PG8_WAIT_L(8); PG8_BAR; PG8_WAIT_L(0); PG8_MMA(0, 0, At, B0); PG8_BAR; PG8_SCHED;
            PG8_LDB(B1, 0, 1); PG8_STAGE(PG8_SB(0, 0), b2, voffB);
            PG8_BAR; PG8_WAIT_L(0); PG8_MMA(0, 1, At, B1); PG8_BAR;
            PG8_LDA(At, 0, 1); PG8_STAGE(PG8_SA(0, 0), a2, voffA);
            PG8_BAR; PG8_WAIT_L(0); PG8_MMA(1, 0, At, B0); PG8_BAR; PG8_SCHED;
            PG8_STAGE(PG8_SB(0, 1), b2 + hstep, voffB);
            PG8_WAIT_V(6); PG8_BAR; PG8_MMA(1, 1, At, B1); PG8_BAR;
            PG8_LDB(B0, 1, 0); PG8_SCHED; PG8_LDA(At, 1, 0); PG8_STAGE(PG8_SA(0, 1), a2 + hstep, voffA);
            PG8_WAIT_L(8); PG8_BAR; PG8_WAIT_L(0); PG8_MMA(0, 0, At, B0); PG8_BAR; PG8_SCHED;
            PG8_LDB(B1, 1, 1); PG8_STAGE(PG8_SB(1, 0), b3, voffB);
            PG8_BAR; PG8_WAIT_L(0); PG8_MMA(0, 1, At, B1); PG8_BAR;
            PG8_LDA(At, 1, 1); PG8_STAGE(PG8_SA(1, 0), a3, voffA);
            PG8_BAR; PG8_WAIT_L(0); PG8_MMA(1, 0, At, B0); PG8_BAR; PG8_SCHED;
            PG8_STAGE(PG8_SB(1, 1), b3 + hstep, voffB);
            PG8_WAIT_V(6); PG8_BAR; PG8_MMA(1, 1, At, B1); PG8_BAR;
            }
        }
        if constexpr (ALIGN_EPI) { if (wr == 0) PG8_BAR; }
        if constexpr (!Epi::AFTER_DRAIN) { E(acc, cur, wr, wc, fr, fq); S.done(cur); }
        if (!has_next) break;
#pragma unroll
        for (int a = 0; a < 2; ++a)
#pragma unroll
            for (int b = 0; b < 2; ++b)
#pragma unroll
                for (int m = 0; m < 4; ++m)
#pragma unroll
                    for (int n = 0; n < 2; ++n) acc[a][b][m][n] = (f32x4){0.f, 0.f, 0.f, 0.f};
        cur = nxt; cA = nA; cB = nB; ++ui;
        if constexpr (ALIGN_EPI) { if (wr == 1) PG8_BAR; }
    }
    PG8_WAIT_V(0);
    if constexpr (!ALIGN_EPI) { if (wr == 0) PG8_BAR; }
    PG8_BAR;
    if constexpr (Epi::AFTER_DRAIN) { E.fused(acc, cur, wr, wc, fr, fq, lds, wid, lane); S.done(cur); }
#undef PG8_SA
#undef PG8_SB
#undef PG8_STAGE
#undef PG8_LDA
#undef PG8_LDB
#undef PG8_MMA
#undef PG8_WAIT_V
#undef PG8_WAIT_L
#undef PG8_BAR
#undef PG8_SCHED
}
}

namespace attn {
typedef unsigned short bf16_t;
using bf16x8 = __attribute__((ext_vector_type(8))) short;
using s16x4  = __attribute__((ext_vector_type(4))) short;
using f32x16 = __attribute__((ext_vector_type(16))) float;
using u32x4  = __attribute__((ext_vector_type(4))) unsigned;
constexpr int NW = 8, QBLK = 32, KVBLK = 64;
constexpr float QSCALE = 0.125f * 1.4426950408889634f;
constexpr int LDQ = 512, LDK = 512, LDV = 512, LDO = 512;
constexpr int SHM_V = KVBLK * 128 * 2, SHM_K = KVBLK * 64 * 2, SHM_ATTN = 2 * SHM_V + 2 * SHM_K + NW * 64 * 4;
#define KSWZ64(row, colB) ((row) * 128 + ((colB) ^ ((((row) >> 1) & 7) << 4)))
#define SBAR() __builtin_amdgcn_sched_barrier(0)
__device__ __forceinline__ int crow(int r, int hi) { return (r & 3) + 8 * (r >> 2) + 4 * hi; }
__device__ __forceinline__ unsigned cvtpk(float lo, float hi) { unsigned r; asm volatile("v_cvt_pk_bf16_f32 %0, %1, %2" : "=v"(r) : "v"(lo), "v"(hi)); return r; }
constexpr float THR2 = 11.5f;
template <bool FIRST, bool GUARD>
__device__ __forceinline__ void partialSM(f32x16& p0, f32x16& p1, float& m_reg, float& alpha) {
  if (!GUARD) {
    alpha = 1.f;
    return;
  }
  if (!FIRST) { if (__builtin_expect(__any(m_reg != 0.f), 0)) {
#pragma unroll
      for (int r = 0; r < 16; ++r) { p0[r] -= m_reg; p1[r] -= m_reg; } } }
  float a = fmaxf(fmaxf(p0[0], p0[1]), p1[0]), b = fmaxf(fmaxf(p0[2], p0[3]), p1[1]); a = fmaxf(fmaxf(a, p1[2]), p1[3]);
#pragma unroll
  for (int r = 4; r < 16; r += 4) { a = fmaxf(fmaxf(a, p0[r]), p0[r + 1]); b = fmaxf(fmaxf(b, p0[r + 2]), p0[r + 3]); a = fmaxf(fmaxf(a, p1[r]), p1[r + 1]); b = fmaxf(fmaxf(b, p1[r + 2]), p1[r + 3]); }
  float pmax = fmaxf(a, b);
  { auto rr = __builtin_amdgcn_permlane32_swap(__float_as_uint(pmax), __float_as_uint(pmax), false, false);
    pmax = fmaxf(__uint_as_float(rr[0]), __uint_as_float(rr[1])); }
  alpha = 1.f;
  if (FIRST) {
    if (__builtin_expect(__any(fabsf(pmax) > THR2), 0)) { const float dl = fabsf(pmax) > THR2 ? pmax : 0.f; m_reg = dl;
#pragma unroll
      for (int r = 0; r < 16; ++r) { p0[r] -= dl; p1[r] -= dl; } }
  } else {
    if (__builtin_expect(__any(pmax > THR2), 0)) { const float dl = fmaxf(pmax, 0.f); m_reg += dl;
#pragma unroll
      for (int r = 0; r < 16; ++r) { p0[r] -= dl; p1[r] -= dl; }
      alpha = __builtin_amdgcn_exp2f(-dl); }
  }
#pragma unroll
  for (int r = 0; r < 16; ++r) p0[r] = __builtin_amdgcn_exp2f(p0[r]);
}
template <bool BOTH>
__device__ __forceinline__ void finishSM(f32x16& p0, f32x16& p1, bf16x8& pa0, bf16x8& pa1, bf16x8& pa2, bf16x8& pa3) {
  if (BOTH) {
#pragma unroll
    for (int r = 0; r < 16; ++r) p0[r] = __builtin_amdgcn_exp2f(p0[r]);
  }
#pragma unroll
  for (int r = 0; r < 16; ++r) p1[r] = __builtin_amdgcn_exp2f(p1[r]);
#define PK4(P, BASE, OUT) do { u32x4 w = {cvtpk(P[BASE + 0], P[BASE + 1]), cvtpk(P[BASE + 2], P[BASE + 3]), cvtpk(P[BASE + 4], P[BASE + 5]), cvtpk(P[BASE + 6], P[BASE + 7])}; \
    OUT = *reinterpret_cast<bf16x8*>(&w); } while (0)
  PK4(p0, 0, pa0); PK4(p0, 8, pa1); PK4(p1, 0, pa2); PK4(p1, 8, pa3);
#undef PK4
}
__device__ __forceinline__ void qkt(f32x16& p0, f32x16& p1, const char* Ks, const bf16x8* qr, int r32, int hi) {
  p0 = f32x16{}; p1 = f32x16{};
#pragma unroll
  for (int d0 = 0; d0 < 4; ++d0) { const int cb = (d0 * 16 + hi * 8) * 2;
    bf16x8 b0 = *reinterpret_cast<const bf16x8*>(Ks + KSWZ64(r32, cb));
    bf16x8 b1 = *reinterpret_cast<const bf16x8*>(Ks + KSWZ64(32 + r32, cb));
    p0 = __builtin_amdgcn_mfma_f32_32x32x16_bf16(b0, qr[d0], p0, 0, 0, 0);
    p1 = __builtin_amdgcn_mfma_f32_32x32x16_bf16(b1, qr[d0], p1, 0, 0, 0); }
}
__device__ __forceinline__ int v_st(int k, int c) { const int kk = k; return ((kk >> 3) * 4 + (c >> 5)) * 512 + ((kk & 7) * 32 + (c & 31)) * 2; }
__device__ __forceinline__ int v_rd_base(int lane) { return ((lane & 3) << 3) | (((lane >> 2) & 3) << 6) | (((lane >> 4) & 1) << 5) | (((lane >> 5) & 1) << 8); }
constexpr int v_rd_off(int d0, int ks, int half) { return d0 * 512 + ks * 4096 + half * 2048; }
template <int OFF> __device__ __forceinline__ s16x4 tr_read(int vb) {
  s16x4 r; asm volatile("ds_read_b64_tr_b16 %0, %1 offset:%2" : "=&v"(r) : "v"(vb), "i"(OFF) : "memory"); return r;
}
template <int D0> __device__ __forceinline__ void pv_one(f32x16& od, int vb, bf16x8 pa0, bf16x8 pa1, bf16x8 pa2, bf16x8 pa3) {
  const s16x4 l0 = tr_read<v_rd_off(D0, 0, 0)>(vb), h0 = tr_read<v_rd_off(D0, 0, 1)>(vb), l1 = tr_read<v_rd_off(D0, 1, 0)>(vb), h1 = tr_read<v_rd_off(D0, 1, 1)>(vb);
  const s16x4 l2 = tr_read<v_rd_off(D0, 2, 0)>(vb), h2 = tr_read<v_rd_off(D0, 2, 1)>(vb), l3 = tr_read<v_rd_off(D0, 3, 0)>(vb), h3 = tr_read<v_rd_off(D0, 3, 1)>(vb);
  asm volatile("s_waitcnt lgkmcnt(0)" ::: "memory"); SBAR();
#define PK(L, H) (bf16x8){L[0], L[1], L[2], L[3], H[0], H[1], H[2], H[3]}
  od = __builtin_amdgcn_mfma_f32_32x32x16_bf16(pa0, PK(l0, h0), od, 0, 0, 0);
  od = __builtin_amdgcn_mfma_f32_32x32x16_bf16(pa1, PK(l1, h1), od, 0, 0, 0);
  od = __builtin_amdgcn_mfma_f32_32x32x16_bf16(pa2, PK(l2, h2), od, 0, 0, 0);
  od = __builtin_amdgcn_mfma_f32_32x32x16_bf16(pa3, PK(l3, h3), od, 0, 0, 0);
#undef PK
}
__device__ __forceinline__ void pv_d0(f32x16* o, f32x16& osum, int vb, bf16x8 pa0, bf16x8 pa1, bf16x8 pa2, bf16x8 pa3) {
  { const bf16x8 ones = {16256, 16256, 16256, 16256, 16256, 16256, 16256, 16256};
    osum = __builtin_amdgcn_mfma_f32_32x32x16_bf16(pa0, ones, osum, 0, 0, 0); osum = __builtin_amdgcn_mfma_f32_32x32x16_bf16(pa1, ones, osum, 0, 0, 0);
    osum = __builtin_amdgcn_mfma_f32_32x32x16_bf16(pa2, ones, osum, 0, 0, 0); osum = __builtin_amdgcn_mfma_f32_32x32x16_bf16(pa3, ones, osum, 0, 0, 0); }
  pv_one<0>(o[0], vb, pa0, pa1, pa2, pa3); pv_one<1>(o[1], vb, pa0, pa1, pa2, pa3); pv_one<2>(o[2], vb, pa0, pa1, pa2, pa3); pv_one<3>(o[3], vb, pa0, pa1, pa2, pa3);
}
#define TRSET(L, D0) do { L[0] = tr_read<v_rd_off(D0, 0, 0)>(vb); L[1] = tr_read<v_rd_off(D0, 0, 1)>(vb); L[2] = tr_read<v_rd_off(D0, 1, 0)>(vb); L[3] = tr_read<v_rd_off(D0, 1, 1)>(vb); \
    L[4] = tr_read<v_rd_off(D0, 2, 0)>(vb); L[5] = tr_read<v_rd_off(D0, 2, 1)>(vb); L[6] = tr_read<v_rd_off(D0, 3, 0)>(vb); L[7] = tr_read<v_rd_off(D0, 3, 1)>(vb); } while (0)
#define PKV(L, k) (bf16x8){L[2 * (k)][0], L[2 * (k)][1], L[2 * (k)][2], L[2 * (k)][3], L[2 * (k) + 1][0], L[2 * (k) + 1][1], L[2 * (k) + 1][2], L[2 * (k) + 1][3]}
#define MM4(OD, L) do { OD = __builtin_amdgcn_mfma_f32_32x32x16_bf16(pa0, PKV(L, 0), OD, 0, 0, 0); OD = __builtin_amdgcn_mfma_f32_32x32x16_bf16(pa1, PKV(L, 1), OD, 0, 0, 0); \
    OD = __builtin_amdgcn_mfma_f32_32x32x16_bf16(pa2, PKV(L, 2), OD, 0, 0, 0); OD = __builtin_amdgcn_mfma_f32_32x32x16_bf16(pa3, PKV(L, 3), OD, 0, 0, 0); } while (0)
#define LWAIT() do { asm volatile("s_waitcnt lgkmcnt(0)" ::: "memory"); SBAR(); } while (0)
__device__ __forceinline__ void pv_d0_pipe(f32x16* o, f32x16& osum, int vb, bf16x8 pa0, bf16x8 pa1, bf16x8 pa2, bf16x8 pa3, f32x16& px) {
  s16x4 LA[8], LB[8];
  __builtin_amdgcn_s_setprio(1);
  TRSET(LA, 0); SBAR();
  { const bf16x8 ones = {16256, 16256, 16256, 16256, 16256, 16256, 16256, 16256};
    osum = __builtin_amdgcn_mfma_f32_32x32x16_bf16(pa0, ones, osum, 0, 0, 0); osum = __builtin_amdgcn_mfma_f32_32x32x16_bf16(pa1, ones, osum, 0, 0, 0);
    osum = __builtin_amdgcn_mfma_f32_32x32x16_bf16(pa2, ones, osum, 0, 0, 0); osum = __builtin_amdgcn_mfma_f32_32x32x16_bf16(pa3, ones, osum, 0, 0, 0); }
#define EX4(B) do { px[B] = __builtin_amdgcn_exp2f(px[B]); px[B + 1] = __builtin_amdgcn_exp2f(px[B + 1]); px[B + 2] = __builtin_amdgcn_exp2f(px[B + 2]); px[B + 3] = __builtin_amdgcn_exp2f(px[B + 3]); } while (0)
  LWAIT(); TRSET(LB, 1); SBAR(); MM4(o[0], LA); SBAR();
  LWAIT(); TRSET(LA, 2); SBAR(); MM4(o[1], LB); SBAR();
  LWAIT(); TRSET(LB, 3); SBAR(); MM4(o[2], LA); SBAR();
  LWAIT(); MM4(o[3], LB);
#undef EX4
}
#undef TRSET
#undef PKV
#undef MM4
#undef LWAIT
template <int COMP, bool GUARD>
__device__ __forceinline__ bool body(const bf16_t* __restrict__ Qb, const bf16_t* __restrict__ Kh, const bf16_t* __restrict__ Vh, float* Ob, bf16_t* __restrict__ SAo, float lam, const float* __restrict__ sg, int seq, char* lds) {
  int tid_ = threadIdx.x; asm volatile("" : "+v"(tid_));
  const int tid = tid_, wid = tid >> 6, lane = tid & 63, r32 = lane & 31, hi = lane >> 5;
  char* V_lds = lds; char* K_lds = lds + 4 * SHM_V;
  float* ws = (float*)(lds + 4 * SHM_V + 4 * SHM_K) + wid * 64; float* al_l = ws + 32;
  float m_reg = 0.f; f32x16 o[4] = {}; f32x16 osum = {}; bf16x8 qr[4];
  const bf16_t* Qw = Qb + (long)(wid * QBLK + r32) * LDQ + hi * 8;
#pragma unroll
  for (int d0 = 0; d0 < 4; ++d0) qr[d0] = *reinterpret_cast<const bf16x8*>(Qw + d0 * 16);
  const int sr = tid >> 4, sc = (tid & 15) * 8, vst0 = v_st(sr, sc), vst1 = v_st(32 + sr, sc);
  const int ksr = tid >> 3, ksc = (tid & 7) * 8, kst = KSWZ64(ksr, ksc * 2);
  const int vb0 = (int)(uintptr_t)V_lds + v_rd_base(lane);
  bf16x8 rvs0, rvs1, rks0;
#define SLOAD(k0) do { rvs0 = *reinterpret_cast<const bf16x8*>(&Vh[(long)((k0) + sr) * LDV + sc]); rvs1 = *reinterpret_cast<const bf16x8*>(&Vh[(long)((k0) + 32 + sr) * LDV + sc]); \
    rks0 = *reinterpret_cast<const bf16x8*>(&Kh[(long)((k0) + ksr) * LDK + ksc]); } while (0)
#define SWRITE(slot) do { *(bf16x8*)(V_lds + (slot) * SHM_V + vst0) = rvs0; *(bf16x8*)(V_lds + (slot) * SHM_V + vst1) = rvs1; *(bf16x8*)(K_lds + (slot) * SHM_K + kst) = rks0; } while (0)
#define RESC(a) do { if (__any((a) < 1.f)) { if (hi == 0) al_l[r32] = (a); asm volatile("s_waitcnt lgkmcnt(0)" ::: "memory"); \
    _Pragma("unroll") for (int r = 0; r < 16; ++r) { const float f_ = al_l[crow(r, hi)]; osum[r] *= f_; _Pragma("unroll") for (int d = 0; d < 4; ++d) o[d][r] *= f_; } } } while (0)
  f32x16 pA0, pA1, pB0, pB1; float alA, alB; bf16x8 pa0, pa1, pa2, pa3; const int NT = seq / KVBLK;
  SLOAD(0); SWRITE(0); SLOAD(KVBLK); __syncthreads();
  qkt(pA0, pA1, K_lds, qr, r32, hi); partialSM<true, GUARD>(pA0, pA1, m_reg, alA);
  SWRITE(1); SLOAD(2 * KVBLK); __syncthreads();
  const int grp = __builtin_amdgcn_readfirstlane(wid >> 2);
#define ITER(X0, X1, Y0, Y1, alX, i) do { const int scur = (i) & 3, sp = ((i) - 1) & 3, sn = ((i) + 1) & 3; \
    SBAR(); qkt(X0, X1, K_lds + scur * SHM_K, qr, r32, hi); \
    finishSM<!GUARD>(Y0, Y1, pa0, pa1, pa2, pa3); SBAR(); \
    if (grp) { SWRITE(sn); if ((i) + 2 < NT) SLOAD(((i) + 2) * KVBLK); __syncthreads(); } \
    if (GUARD) pv_d0(o, osum, vb0 + sp * SHM_V, pa0, pa1, pa2, pa3); else pv_d0_pipe(o, osum, vb0 + sp * SHM_V, pa0, pa1, pa2, pa3, X0); if (GUARD) partialSM<false, GUARD>(X0, X1, m_reg, alX); else { alX = 1.f; __builtin_amdgcn_s_setprio(0); } \
    if (GUARD) RESC(alX); \
    if (!grp) { SWRITE(sn); if ((i) + 2 < NT) SLOAD(((i) + 2) * KVBLK); __syncthreads(); } } while (0)
  int i = 1;
  for (; i + 1 < NT; i += 2) {
    ITER(pB0, pB1, pA0, pA1, alB, i);
    ITER(pA0, pA1, pB0, pB1, alA, i + 1);
  }
  { const int scur = i & 3, sp = (i - 1) & 3;
  SBAR(); qkt(pB0, pB1, K_lds + scur * SHM_K, qr, r32, hi);
  finishSM<!GUARD>(pA0, pA1, pa0, pa1, pa2, pa3); SBAR();
  pv_d0(o, osum, vb0 + sp * SHM_V, pa0, pa1, pa2, pa3); partialSM<false, GUARD>(pB0, pB1, m_reg, alB);
  if (GUARD) RESC(alB);
  finishSM<!GUARD>(pB0, pB1, pa0, pa1, pa2, pa3); SBAR();
  pv_d0(o, osum, vb0 + scur * SHM_V, pa0, pa1, pa2, pa3); }
#undef ITER
  if (!GUARD) {
    bool ok = true;
#pragma unroll
    for (int r = 0; r < 16; ++r) ok = ok && (osum[r] > 0.f) && (osum[r] < 3.0e38f);
    if (__syncthreads_or(ok ? 0 : 1)) return true;
  }
  float rli[16];
#pragma unroll
  for (int r = 0; r < 16; ++r) rli[r] = __builtin_amdgcn_rcpf(osum[r]);
  float* Ow = Ob + (long)(wid * QBLK) * LDO;
  if (COMP == 0) {
#pragma unroll
    for (int r = 0; r < 16; ++r) { const int orow = crow(r, hi);
#pragma unroll
      for (int d0 = 0; d0 < 4; ++d0) Ow[(long)orow * LDO + d0 * 32 + r32] = o[d0][r] * rli[r]; }
  } else {
    float ss[16];
#pragma unroll
    for (int r = 0; r < 16; ++r) { const int orow = crow(r, hi); float q = 0.f;
#pragma unroll
      for (int d0 = 0; d0 < 4; ++d0) { const float d = Ow[(long)orow * LDO + d0 * 32 + r32] - lam * (o[d0][r] * rli[r]); o[d0][r] = d; q = fmaf(d, d, q); }
      ss[r] = q; }
#pragma unroll
    for (int r = 0; r < 16; ++r) { float q = ss[r]; q += __shfl_xor(q, 1); q += __shfl_xor(q, 2); q += __shfl_xor(q, 4); q += __shfl_xor(q, 8); q += __shfl_xor(q, 16);
      ss[r] = 1.0f / sqrtf(q * (1.0f / 128.0f) + 1e-6f); }
    float gsub[4];
#pragma unroll
    for (int d0 = 0; d0 < 4; ++d0) gsub[d0] = sg[d0 * 32 + r32] * 0.8f;
    bf16_t* Sw = SAo + (long)(wid * QBLK) * 1024;
#pragma unroll
    for (int r = 0; r < 16; ++r) { const int orow = crow(r, hi);
#pragma unroll
      for (int d0 = 0; d0 < 4; ++d0) { const float y = o[d0][r] * ss[r] * gsub[d0]; unsigned u = __builtin_bit_cast(unsigned, y); u = (u + 0x7fffu + ((u >> 16) & 1u)) >> 16;
        Sw[(long)orow * 1024 + d0 * 32 + r32] = (bf16_t)u; } }
  }
  asm volatile("s_waitcnt vmcnt(0) lgkmcnt(0)" ::: "memory"); __syncthreads();
  return false;
#undef SLOAD
#undef SWRITE
#undef RESC
}
#undef SBAR
}

#define GAS __attribute__((address_space(1)))
#define LAS __attribute__((address_space(3)))
typedef unsigned short bf16;
typedef unsigned v4u __attribute__((ext_vector_type(4)));
typedef float f32x4 __attribute__((ext_vector_type(4)));
typedef float f32x16 __attribute__((ext_vector_type(16)));
typedef short bf16x8 __attribute__((ext_vector_type(8)));

constexpr int NWAVES = 8, NTHR = 512;
constexpr int DM = 1024, DFF = 2816, NB = 8, SEQ = 8192, CTXL = 256, NMODV = 9 * DM;
constexpr int ROWS_B = 8448, TILES_B = 33, NROWS = NB * ROWS_B;

constexpr size_t MiB = 1u << 20;
constexpr size_t WS_CTL = 0, CTL_ZERO_BYTES = 1 * MiB;
constexpr size_t WS_MOD = 4096;
constexpr size_t WS_BIAS1 = 352 * 1024, WS_BIAS2 = 640 * 1024;
constexpr size_t WS_RSS1 = 69 * MiB, WS_RSS2 = 69 * MiB + 512 * 1024;
constexpr size_t WS_BAR = 512 * 1024, BAR_ZERO_BYTES = 16384;
constexpr size_t WS_ABAR = 1 * MiB, WS_APOW = WS_ABAR + 32768, WS_BBT = WS_APOW + 32768, WS_CM = WS_BBT + 262144, WS_ROPE = WS_CM + 262144;
constexpr size_t WS_W1A = 2 * MiB, WS_W1B = 13 * MiB, WS_W2A = 19 * MiB, WS_W2B = 30 * MiB, WS_WIN = 36 * MiB, WS_WOUT = 40 * MiB, WS_WGLU = 42 * MiB;
constexpr size_t WS_E = 43 * MiB, WS_HIN = 52 * MiB, WS_XC = 61 * MiB;
constexpr size_t WS_XN = 70 * MiB;
constexpr size_t WS_ACT = 202 * MiB;
constexpr size_t WS_OATT = WS_ACT, WS_G = WS_ACT + 264 * MiB;
constexpr size_t WS_U = 565 * MiB, WS_Q = 631 * MiB, WS_K = 697 * MiB, WS_V = 763 * MiB, WS_END = 829 * MiB;
static_assert(WS_ROPE + 16384 <= WS_W1A && WS_W1A + (size_t)5632 * 1024 * 2 <= WS_W1B && WS_W1B + (size_t)1024 * 2816 * 2 <= WS_W2A && WS_W2A + (size_t)5632 * 1024 * 2 <= WS_W2B, "ws map 1");
static_assert(WS_W2B + (size_t)1024 * 2816 * 2 <= WS_WIN && WS_WIN + (size_t)2048 * 1024 * 2 <= WS_WOUT && WS_WOUT + (size_t)1024 * 1024 * 2 <= WS_WGLU && WS_WGLU + 512 * 512 * 2 <= WS_E, "ws map 2");
static_assert(WS_E + (size_t)8 * 33 * 64 * 64 * 8 <= WS_HIN && WS_HIN + (size_t)8 * 33 * 64 * 64 * 8 <= WS_XC && WS_XC + (size_t)2048 * 1024 * 4 <= WS_XN, "ws map 3");
static_assert(WS_XN + (size_t)NROWS * 1024 * 2 <= WS_ACT && WS_ACT + (size_t)NROWS * 2816 * 2 <= WS_U && WS_G + (size_t)NROWS * 512 * 2 <= WS_U && WS_OATT + (size_t)NROWS * 1024 * 4 <= WS_G, "ws map 4");
static_assert(WS_U + (size_t)NROWS * 512 * 2 <= WS_Q && WS_V + (size_t)NROWS * 512 * 2 <= WS_END, "ws map 5");

constexpr int LDS_BYTES = 139264;

#define LDS_WAIT() asm volatile("s_waitcnt lgkmcnt(0)" ::: "memory")
__device__ __forceinline__ unsigned f2bf(float f) { unsigned u = __builtin_bit_cast(unsigned, f); return (u + 0x7fffu + ((u >> 16) & 1u)) >> 16; }
__device__ __forceinline__ unsigned pk2(float lo, float hi) { return f2bf(lo) | (f2bf(hi) << 16); }
__device__ __forceinline__ float wave_sum(float v) {
#pragma unroll
    for (int o = 1; o < 64; o <<= 1) v += __shfl_xor(v, o);
    return v;
}

__device__ __forceinline__ double dexp(double x) {
    const double n = __builtin_rint(x * 1.4426950408889634074);
    const double r = __builtin_fma(-n, 1.9082149292705877e-10, __builtin_fma(-n, 0.693147180369123816490, x));
    double p = 1.0 / 87178291200.0;
    p = p * r + 1.0 / 6227020800.0; p = p * r + 1.0 / 479001600.0; p = p * r + 1.0 / 39916800.0; p = p * r + 1.0 / 3628800.0; p = p * r + 1.0 / 362880.0; p = p * r + 1.0 / 40320.0;
    p = p * r + 1.0 / 5040.0; p = p * r + 1.0 / 720.0; p = p * r + 1.0 / 120.0; p = p * r + 1.0 / 24.0; p = p * r + 1.0 / 6.0; p = p * r + 0.5; p = p * r + 1.0; p = p * r + 1.0;
    const long long e = (long long)n + 1023; const double s = __builtin_bit_cast(double, (unsigned long long)e << 52);
    return p * s;
}
__device__ __forceinline__ void dsincos(double y, double& s, double& c) {
    const double k = __builtin_rint(y * 0.15915494309189533577);
    double r = __builtin_fma(-k, 6.283185307179586232, y); r = __builtin_fma(-k, 2.4492935982947064e-16, r);
    const double q = r * 0.125, q2 = q * q;
    double sp = -1.0 / 1307674368000.0; sp = sp * q2 + 1.0 / 6227020800.0; sp = sp * q2 - 1.0 / 39916800.0; sp = sp * q2 + 1.0 / 362880.0; sp = sp * q2 - 1.0 / 5040.0; sp = sp * q2 + 1.0 / 120.0; sp = sp * q2 - 1.0 / 6.0; sp = sp * q2 + 1.0;
    double cp = 1.0 / 20922789888000.0; cp = cp * q2 - 1.0 / 87178291200.0; cp = cp * q2 + 1.0 / 479001600.0; cp = cp * q2 - 1.0 / 3628800.0; cp = cp * q2 + 1.0 / 40320.0; cp = cp * q2 - 1.0 / 720.0; cp = cp * q2 + 1.0 / 24.0; cp = cp * q2 - 0.5; cp = cp * q2 + 1.0;
    double ss = sp * q, cc = cp;
#pragma unroll
    for (int i = 0; i < 3; ++i) { const double s2 = 2.0 * ss * cc, c2 = cc * cc - ss * ss; ss = s2; cc = c2; }
    s = ss; c = cc;
}

__device__ __forceinline__ void transpose_item(const float* W, int K, int N, bf16* WT, int mode, LAS float* scr, int item, int lane) {
    const int nblk = N / 32, kb = item / nblk, nb = item % nblk, k0 = 64 * kb, n0 = 32 * nb;
    { const float* wp = W + (size_t)(k0 + (lane >> 5)) * N + n0 + (lane & 31); float v[32];
#pragma unroll
      for (int i = 0; i < 32; ++i) v[i] = wp[(size_t)(2 * i) * N];
#pragma unroll
      for (int i = 0; i < 32; ++i) scr[(2 * i + (lane >> 5)) * 33 + (lane & 31)] = v[i]; }
    LDS_WAIT(); asm volatile("" ::: "memory");
    const int c = lane & 7;
#pragma unroll
    for (int j = 0; j < 4; ++j) { const int n = (lane >> 3) + 8 * j; const LAS float* s = scr + (8 * c) * 33 + n;
        const int src = n0 + n; int drow = src;
        if (mode == 1) { const int up = src >= DFF ? 1 : 0, ff = src - up * DFF; drow = (ff >> 7) * 256 + up * 128 + (ff & 127); }
        else if (mode == 2) { if (src >= 512 && src < 1536) drow = n0 + 2 * (n & 15) + (n >> 4); }
        v4u o; o.x = pk2(s[0 * 33], s[1 * 33]); o.y = pk2(s[2 * 33], s[3 * 33]); o.z = pk2(s[4 * 33], s[5 * 33]); o.w = pk2(s[6 * 33], s[7 * 33]);
        *(v4u*)(WT + (size_t)drow * K + k0 + 8 * c) = o; }
    LDS_WAIT(); asm volatile("" ::: "memory");
}

template <int MODE>
__device__ __forceinline__ void norm_rows16(const float* src, bf16* dstb, float* dstf, const float* g, const float* shift, const float* scale, int lane) {
    f32x4 gs[4], sh[4];
#pragma unroll
    for (int j = 0; j < 4; ++j) { const int cidx = 4 * lane + 256 * j; const f32x4 gv = *(const f32x4*)(g + cidx);
        if (MODE == 0) { const f32x4 sc = *(const f32x4*)(scale + cidx); gs[j] = gv * (sc + 1.0f); sh[j] = *(const f32x4*)(shift + cidx); } else { gs[j] = gv; sh[j] = (f32x4){0.f, 0.f, 0.f, 0.f}; } }
#pragma unroll 2
    for (int r = 0; r < 16; ++r) {
        const f32x4* xr = (const f32x4*)(src + (size_t)r * DM) + lane;
        f32x4 v[4]; float s = 0.f;
#pragma unroll
        for (int j = 0; j < 4; ++j) { v[j] = xr[64 * j]; s += (v[j].x * v[j].x + v[j].y * v[j].y) + (v[j].z * v[j].z + v[j].w * v[j].w); }
        const float rstd = 1.0f / sqrtf(wave_sum(s) * (1.0f / DM) + 1e-6f);
        if (MODE == 0) {
            unsigned long long* o8 = (unsigned long long*)(dstb + (size_t)r * DM) + lane;
#pragma unroll
            for (int j = 0; j < 4; ++j) { const f32x4 y = v[j] * rstd * gs[j] + sh[j]; o8[64 * j] = (unsigned long long)pk2(y.x, y.y) | ((unsigned long long)pk2(y.z, y.w) << 32); }
        } else {
            f32x4* of = (f32x4*)(dstf + (size_t)r * DM) + lane;
#pragma unroll
            for (int j = 0; j < 4; ++j) of[64 * j] = v[j] * rstd * gs[j];
        }
    }
}

__device__ __forceinline__ int crow16(int r, int hi) { return (r & 3) + 8 * (r >> 2) + 4 * hi; }
typedef float f32x2_t __attribute__((ext_vector_type(2))); typedef __bf16 bf16x2_t __attribute__((ext_vector_type(2)));
__device__ __forceinline__ unsigned cvtpk2(float lo, float hi) { f32x2_t v = {lo, hi}; bf16x2_t b = __builtin_convertvector(v, bf16x2_t); return __builtin_bit_cast(unsigned, b); }

template <bool FULL>
__device__ __forceinline__ void s5_unit(LAS unsigned char* lds, int b, int c, int gq, const bf16* U, const float2* ABAR, const bf16* BBT, const bf16* CM,
                                        const float2* HIN, float2* E, const float* dskip, bf16* G, float* YF) {
    int tid_ = threadIdx.x; asm volatile("" : "+v"(tid_));
    const int lane = tid_ & 63, wave = __builtin_amdgcn_readfirstlane(tid_ >> 6);
    const int g = gq * 8 + wave, hi = lane >> 5, r32 = lane & 31;
    LAS unsigned* scr = (LAS unsigned*)(lds + wave * 8704);
    const size_t r0 = (size_t)b * ROWS_B + (size_t)c * 256;
    const bf16* ubase = U + (r0 + r32) * 512 + g * 16 + hi * 8;
    const int ch = lane & 15; const float dv = dskip[g * 16 + ch];
    const size_t obase = (r0 + (lane >> 4) * 4) * 512 + g * 16 + ch;
    LAS unsigned short* yt_l = (LAS unsigned short*)(lds + 69632 + wave * 8192) + ((lane >> 4) * 4) * 16 + ch;
#pragma unroll
    for (int dir = 0; dir < 2; ++dir) {
        const int dg = dir * 32 + g;
        const float2 ab = ABAR[dg * 64 + lane];
        bf16x8 bb[4], cm[4];
#pragma unroll
        for (int blk = 0; blk < 4; ++blk) bb[blk] = *(const bf16x8*)(BBT + ((size_t)(dg * 4 + blk) * 32 + r32) * 16 + hi * 8);
        if (FULL) {
#pragma unroll
            for (int ks = 0; ks < 4; ++ks) cm[ks] = *(const bf16x8*)(CM + ((size_t)dg * 16 + (lane & 15)) * 128 + ks * 32 + (lane >> 4) * 8);
        }
        const size_t sidx = ((((size_t)b * 33 + c) * 32 + g) * 2 + dir) * 64 + lane;
        float hr = 0.f, hm = 0.f;
        if (FULL) { const float2 h0 = HIN[sidx]; hr = h0.x; hm = h0.y; }
        bf16x8 a_nx = *(const bf16x8*)(ubase + (size_t)(dir == 0 ? 0 : 224) * 512);
#pragma unroll 1
        for (int sb = 0; sb < 8; ++sb) {
            const int tb = dir == 0 ? sb * 32 : (7 - sb) * 32;
            const bf16x8 a = a_nx;
            { const int tn = dir == 0 ? (sb < 7 ? tb + 32 : tb) : (sb < 7 ? tb - 32 : tb); a_nx = *(const bf16x8*)(ubase + (size_t)tn * 512); }
            unsigned short uvv[2][4];
            if (FULL && dir == 1) {
#pragma unroll
                for (int mt = 0; mt < 2; ++mt)
#pragma unroll
                    for (int j = 0; j < 4; ++j) { const size_t idx = obase + (size_t)(tb + mt * 16 + j) * 512; uvv[mt][j] = U[idx]; }
            }
            const f32x16 z = {};
#pragma unroll
            for (int hf = 0; hf < 2; ++hf) {
                const f32x16 c0 = __builtin_amdgcn_mfma_f32_32x32x16_bf16(a, bb[hf], z, 0, 0, 0), c2 = __builtin_amdgcn_mfma_f32_32x32x16_bf16(a, bb[2 + hf], z, 0, 0, 0);
#pragma unroll
                for (int r = 0; r < 16; ++r) { const int row = crow16(r, hi); scr[row * 68 + hf * 32 + r32] = cvtpk2(c0[r], c2[r]); }
            }
            LDS_WAIT(); asm volatile("" ::: "memory");
#pragma unroll
            for (int half = 0; half < 2; ++half) {
                unsigned v[16];
#pragma unroll
                for (int q = 0; q < 16; ++q) { const int t = dir == 0 ? half * 16 + q : 31 - (half * 16 + q); v[q] = scr[t * 68 + lane]; }
#pragma unroll
                for (int q = 0; q < 16; ++q) { const int t = dir == 0 ? half * 16 + q : 31 - (half * 16 + q);
                    const float re = __uint_as_float(v[q] << 16), im = __uint_as_float(v[q] & 0xffff0000u);
                    const float nr = fmaf(ab.x, hr, fmaf(-ab.y, hm, re)), ni = fmaf(ab.x, hm, fmaf(ab.y, hr, im)); hr = nr; hm = ni;
                    if (FULL) scr[t * 68 + lane] = cvtpk2(hr, hm); }
                asm volatile("" ::: "memory");
            }
            if (FULL) {
                LDS_WAIT(); asm volatile("" ::: "memory");
                f32x4 yt[2];
#pragma unroll
                for (int mt = 0; mt < 2; ++mt) { yt[mt] = (f32x4){0.f, 0.f, 0.f, 0.f};
#pragma unroll
                    for (int ks = 0; ks < 4; ++ks) { const bf16x8 hf8 = *(const LAS bf16x8*)((const LAS unsigned char*)scr + (mt * 16 + (lane & 15)) * 272 + ks * 64 + (lane >> 4) * 16);
                        yt[mt] = __builtin_amdgcn_mfma_f32_16x16x32_bf16(hf8, cm[ks], yt[mt], 0, 0, 0); } }
#pragma unroll
                for (int mt = 0; mt < 2; ++mt)
#pragma unroll
                    for (int j = 0; j < 4; ++j) { LAS unsigned short* yp = yt_l + (tb + mt * 16 + j) * 16;
                        if (dir == 0) *yp = (unsigned short)f2bf(yt[mt][j]);
                        else { const float uv = __uint_as_float((unsigned)uvv[mt][j] << 16); const float yv = __uint_as_float((unsigned)*yp << 16) + yt[mt][j] + dv * uv;
                            const float zz = 1.5957691216057308f * (yv + 0.044715f * yv * yv * yv); *yp = (unsigned short)f2bf(yv * pg8::fast_sigmoid(zz)); } }
                LDS_WAIT(); asm volatile("" ::: "memory");
            }
        }
        if (!FULL) E[sidx] = make_float2(hr, hm);
    }
    if (FULL) {
        LDS_WAIT(); asm volatile("" ::: "memory");
        const LAS unsigned char* yb = (const LAS unsigned char*)(lds + 69632 + wave * 8192);
#pragma unroll
        for (int it = 0; it < 8; ++it) { const int row = it * 32 + (lane >> 1), hf = lane & 1;
            const v4u w = *(const LAS v4u*)(yb + row * 32 + hf * 16);
            *(v4u*)(G + (r0 + row) * 512 + g * 16 + hf * 8) = w; }
        LDS_WAIT(); asm volatile("" ::: "memory");
    }
}

__device__ __forceinline__ void cmulf(float ar, float ai, float br, float bi, float& cr, float& ci) { cr = ar * br - ai * bi; ci = ar * bi + ai * br; }
__device__ __forceinline__ void s5_unit_a(LAS unsigned char* lds, int b, int c, int gq, const bf16* U, const float2* ABAR, const bf16* BBT, float2* E) {
    int tid_ = threadIdx.x; asm volatile("" : "+v"(tid_));
    const int lane = tid_ & 63, wave = __builtin_amdgcn_readfirstlane(tid_ >> 6);
    const int g = gq * 8 + wave, hi = lane >> 5, r32 = lane & 31;
    const size_t r0 = (size_t)b * ROWS_B + (size_t)c * 256;
    LAS unsigned char* ut = lds + wave * 8192;
    { v4u t8[8];
#pragma unroll
      for (int it = 0; it < 8; ++it) t8[it] = *(const v4u*)(U + (r0 + it * 32 + (lane >> 1)) * 512 + g * 16 + (lane & 1) * 8);
#pragma unroll
      for (int it = 0; it < 8; ++it) *(LAS v4u*)(ut + (it * 32 + (lane >> 1)) * 32 + (lane & 1) * 16) = t8[it]; }
    LDS_WAIT(); asm volatile("" ::: "memory");
    const LAS unsigned char* ua = ut + r32 * 32 + hi * 16;
#pragma unroll
    for (int dir = 0; dir < 2; ++dir) {
        const int dg = dir * 32 + g;
        bf16x8 bb[4];
#pragma unroll
        for (int blk = 0; blk < 4; ++blk) bb[blk] = *(const bf16x8*)(BBT + ((size_t)(dg * 4 + blk) * 32 + r32) * 16 + hi * 8);
        float wr[2][16], wi[2][16], a32r[2], a32i[2];
#pragma unroll
        for (int hf = 0; hf < 2; ++hf) {
            const float2 ab = ABAR[dg * 64 + hf * 32 + r32];
            float qr[4], qi[4], orr[4], oi[4];
            qr[0] = 1.f; qi[0] = 0.f; qr[1] = ab.x; qi[1] = ab.y; cmulf(qr[1], qi[1], ab.x, ab.y, qr[2], qi[2]); cmulf(qr[2], qi[2], ab.x, ab.y, qr[3], qi[3]);
            float a4r, a4i; cmulf(qr[2], qi[2], qr[2], qi[2], a4r, a4i);
            orr[0] = 1.f; oi[0] = 0.f; cmulf(a4r, a4i, a4r, a4i, orr[1], oi[1]); cmulf(orr[1], oi[1], orr[1], oi[1], orr[2], oi[2]); cmulf(orr[2], oi[2], orr[1], oi[1], orr[3], oi[3]);
            cmulf(orr[2], oi[2], orr[2], oi[2], a32r[hf], a32i[hf]);
            const bool use4 = dir == 0 ? (hi == 0) : (hi != 0);
            const float br = use4 ? a4r : 1.f, bi = use4 ? a4i : 0.f;
#pragma unroll
            for (int r = 0; r < 16; ++r) { const int jq = dir == 0 ? 3 - (r & 3) : (r & 3), jo = dir == 0 ? 3 - (r >> 2) : (r >> 2);
                float tr, ti; cmulf(qr[jq], qi[jq], orr[jo], oi[jo], tr, ti); cmulf(tr, ti, br, bi, wr[hf][r], wi[hf][r]); }
        }
        float hr[2] = {0.f, 0.f}, hm[2] = {0.f, 0.f};
#pragma unroll 1
        for (int sb = 0; sb < 8; ++sb) {
            const bf16x8 a = *(const LAS bf16x8*)(ua + (dir == 0 ? sb * 32 : (7 - sb) * 32) * 32);
            const f32x16 z = {};
#pragma unroll
            for (int hf = 0; hf < 2; ++hf) {
                const f32x16 cre = __builtin_amdgcn_mfma_f32_32x32x16_bf16(a, bb[hf], z, 0, 0, 0), cim = __builtin_amdgcn_mfma_f32_32x32x16_bf16(a, bb[2 + hf], z, 0, 0, 0);
                float er = 0.f, ei = 0.f;
#pragma unroll
                for (int r = 0; r < 16; ++r) { er = fmaf(wr[hf][r], cre[r], fmaf(-wi[hf][r], cim[r], er)); ei = fmaf(wr[hf][r], cim[r], fmaf(wi[hf][r], cre[r], ei)); }
                er += __shfl_xor(er, 32); ei += __shfl_xor(ei, 32);
                const float nr = fmaf(a32r[hf], hr[hf], fmaf(-a32i[hf], hm[hf], er)), ni = fmaf(a32r[hf], hm[hf], fmaf(a32i[hf], hr[hf], ei));
                hr[hf] = nr; hm[hf] = ni;
            }
        }
        const size_t sidx = ((((size_t)b * 33 + c) * 32 + g) * 2 + dir) * 64 + lane;
        E[sidx] = hi ? make_float2(hr[1], hm[1]) : make_float2(hr[0], hm[0]);
    }
    LDS_WAIT(); asm volatile("" ::: "memory");
}

typedef GAS unsigned gu32;
#define RLX_AGENT __ATOMIC_RELAXED, __HIP_MEMORY_SCOPE_AGENT
#define XB_TMO      128
#define XB_XCNT(j)  (256  + 64 * (j))
#define XB_XSUB(j)  (1280 + 64 * (j))
#define XB_XGEN(j)  (2304 + 64 * (j))
#define XB_TOP      3328
#define XB_TOPGEN   3392
#define XCD_BAR_WORDS 3456
#define XB_SPIN_CAP (1u << 18)

__device__ __forceinline__ unsigned xb_ld(unsigned* p)              { return __hip_atomic_load(p, __ATOMIC_RELAXED, __HIP_MEMORY_SCOPE_AGENT); }
__device__ __forceinline__ unsigned xb_add(unsigned* p, unsigned v) { return __hip_atomic_fetch_add(p, v, __ATOMIC_RELAXED, __HIP_MEMORY_SCOPE_AGENT); }
__device__ __forceinline__ unsigned xb_xcc_id() { return (unsigned)__builtin_amdgcn_s_getreg((3 << 11) | 20) & 0xFu; }
#define XB_SPIN(cond, bar) do { unsigned _sp = 0; while (cond) { __builtin_amdgcn_s_sleep(1); \
    if ((++_sp & 255u) == 0u) { if (xb_ld(&(bar)[XB_TMO])) break; if (_sp > XB_SPIN_CAP) { atomicAdd(&(bar)[XB_TMO], 1u); break; } } } } while (0)

struct XcdBarrier {
    unsigned* bar; unsigned x;
    volatile LAS unsigned* st;
};

__device__ __forceinline__ XcdBarrier xcd_barrier_post(unsigned* bar, volatile LAS unsigned* st) {
    XcdBarrier b; b.bar = bar; b.x = xb_xcc_id(); b.st = st;
    if (threadIdx.x == 0) (void)xb_add(&bar[XB_XCNT(b.x)], 1u);
    return b;
}
__device__ __forceinline__ void xcd_barrier_complete(unsigned* bar, unsigned x, unsigned& nloc, unsigned& nx) {
    const unsigned G = gridDim.x * gridDim.y * gridDim.z;
    unsigned sum, cnt, mine, sp = 0u;
    for (;;) {
        sum = 0u; cnt = 0u; mine = 0u;
#pragma unroll
        for (unsigned j = 0; j < 16; ++j) { const unsigned c = xb_ld(&bar[XB_XCNT(j)]); sum += c; cnt += (c > 0u) ? 1u : 0u; mine = (j == x) ? c : mine; }
        if (sum == G) break;
        __builtin_amdgcn_s_sleep(1);
        if ((++sp & 255u) == 0u) { if (xb_ld(&bar[XB_TMO])) break; if (sp > XB_SPIN_CAP) { atomicAdd(&bar[XB_TMO], 1u); break; } }
    }
    nloc = mine > 0u ? mine : 1u; nx = cnt > 0u ? cnt : 1u;
}

__device__ __forceinline__ void xcd_barrier(const XcdBarrier& b) {
    asm volatile("s_waitcnt vmcnt(0)" ::: "memory");
    __syncthreads();
    if (threadIdx.x == 0) {
        unsigned* bar = b.bar;
        __builtin_amdgcn_s_waitcnt(0);
        unsigned nloc = b.st[0], nx = b.st[1];
        if (nloc == 0u) { xcd_barrier_complete(bar, b.x, nloc, nx); b.st[0] = nloc; b.st[1] = nx; }
        const unsigned old = xb_add(&bar[XB_XSUB(b.x)], 1u);
        const unsigned gen = old / nloc;
        if (old + 1u == (gen + 1u) * nloc) {
            __builtin_amdgcn_fence(__ATOMIC_RELEASE, "agent");
            asm volatile("s_waitcnt vmcnt(0)" ::: "memory");
            const unsigned og = xb_add(&bar[XB_TOP], 1u);
            const unsigned tg = og / nx;
            if (og + 1u == (tg + 1u) * nx) xb_add(&bar[XB_TOPGEN], 1u);
            else XB_SPIN(xb_ld(&bar[XB_TOPGEN]) == tg, bar);
            __builtin_amdgcn_fence(__ATOMIC_ACQUIRE, "agent");
            xb_add(&bar[XB_XGEN(b.x)], 1u);
            asm volatile("s_waitcnt vmcnt(0)" ::: "memory");
        } else {
            XB_SPIN(xb_ld(&bar[XB_XGEN(b.x)]) == gen, bar);
            __builtin_amdgcn_fence(__ATOMIC_ACQUIRE, "agent");
            asm volatile("s_waitcnt vmcnt(0)" ::: "memory");
        }
    }
    __syncthreads();
}

#ifndef PHMASK
#define PHMASK 0xFFFFF
#endif
#define PH(k) if ((PHMASK >> (k)) & 1)
struct Args { const float* in[25]; float* out; unsigned char* ws; };
__device__ __forceinline__ const float* karg(int i) {
    unsigned off = (unsigned)i * 8u; asm volatile("" : "+s"(off));
    return *(const float* const __attribute__((address_space(4)))*)((const char __attribute__((address_space(4)))*)__builtin_amdgcn_kernarg_segment_ptr() + off);
}

__global__ void __launch_bounds__(NTHR, 2) hymba_fwd(Args a) {
    extern __shared__ __attribute__((aligned(16))) unsigned char lds[];
    cg::grid_group grid = cg::this_grid();
    const int tid = threadIdx.x, lane = tid & 63, wave = __builtin_amdgcn_readfirstlane(tid >> 6);
    const int G = gridDim.x, bx = blockIdx.x;
    const int vcu = (G % 8 == 0) ? (bx % 8) * (G / 8) + bx / 8 : bx;
    const int gw = vcu * NWAVES + wave, NGW = G * NWAVES;
    LAS unsigned char* ldsl = (LAS unsigned char*)lds;
#define KIN(i) karg(i)
#define ws_p ((unsigned char*)karg(26))
#define out_p ((float*)karg(25))
#define x_in KIN(0)
#define cvec KIN(1)
#define ctx KIN(2)
#define c_ctx KIN(3)
#define w_mod KIN(4)
#define b_mod KIN(5)
#define norm_g KIN(6)
#define ffn_w_in KIN(7)
#define ffn_w_out KIN(8)
#define w_in KIN(9)
#define w_out KIN(10)
#define ssm_a_re KIN(11)
#define ssm_a_im KIN(12)
#define ssm_log_dt KIN(13)
#define ssm_b_re KIN(14)
#define ssm_b_im KIN(15)
#define ssm_c_re KIN(16)
#define ssm_c_im KIN(17)
#define ssm_d KIN(18)
#define w_glu KIN(19)
#define b_glu KIN(20)
#define lam_q KIN(21)
#define lam_k KIN(22)
#define subln_g KIN(23)
#define final_g KIN(24)
#define MISC ((float*)(ws_p + WS_CTL))
#define MOD ((float*)(ws_p + WS_MOD))
#define ABAR ((float2*)(ws_p + WS_ABAR))
#define APOW ((float2*)(ws_p + WS_APOW))
#define BBT ((bf16*)(ws_p + WS_BBT))
#define CM ((bf16*)(ws_p + WS_CM))
#define ROPE ((float*)(ws_p + WS_ROPE))
#define W1A ((bf16*)(ws_p + WS_W1A))
#define W1B ((bf16*)(ws_p + WS_W1B))
#define W2A ((bf16*)(ws_p + WS_W2A))
#define W2B ((bf16*)(ws_p + WS_W2B))
#define WIN ((bf16*)(ws_p + WS_WIN))
#define WOUT ((bf16*)(ws_p + WS_WOUT))
#define WGLU ((bf16*)(ws_p + WS_WGLU))
#define EST ((float2*)(ws_p + WS_E))
#define HIN ((float2*)(ws_p + WS_HIN))
#define XC ((float*)(ws_p + WS_XC))
#define XN ((bf16*)(ws_p + WS_XN))
#define SA ((bf16*)(ws_p + WS_XN))
#define ACT ((bf16*)(ws_p + WS_ACT))
#define OATT ((float*)(ws_p + WS_OATT))
#define GB ((bf16*)(ws_p + WS_G))
#define YFB ((float*)(ws_p + WS_OATT + 132 * MiB))
#define BIAS1 ((float*)(ws_p + WS_BIAS1))
#define BIAS2 ((float*)(ws_p + WS_BIAS2))
#define RSS1 ((float*)(ws_p + WS_RSS1))
#define RSS2 ((float*)(ws_p + WS_RSS2))
#define XN2 ((bf16*)(ws_p + WS_U))
#define UB ((bf16*)(ws_p + WS_U))
#define QB ((bf16*)(ws_p + WS_Q))
#define KB ((bf16*)(ws_p + WS_K))
#define VB ((bf16*)(ws_p + WS_V))
    (void)a;
    { volatile LAS unsigned* st0 = (volatile LAS unsigned*)(ldsl + 138240); if (tid < 4) st0[tid] = 0u; }
    __syncthreads();
    XcdBarrier xbar = xcd_barrier_post((unsigned*)(ws_p + WS_BAR), (volatile LAS unsigned*)(ldsl + 138240));
#define GSYNC() xcd_barrier(xbar)

    PH(0) {
        if (bx < 288) {
            LAS float* sl = (LAS float*)ldsl; LAS float* part = (LAS float*)(ldsl + 36864);
            for (int i = tid; i < 9 * DM; i += NTHR) { const float v = i < 8 * DM ? cvec[i] : c_ctx[i - 8 * DM]; sl[i] = v / (1.0f + __expf(-v)); }
            __syncthreads();
            for (int unit = bx; unit < 288; unit += G) {
                const int cl = tid & 31, kg = tid >> 5, k0 = kg * 64; const float* wp = w_mod + (size_t)k0 * NMODV + unit * 32 + cl;
                float acc[9];
#pragma unroll
                for (int i = 0; i < 9; ++i) acc[i] = 0.f;
                float wv[64];
#pragma unroll
                for (int kk = 0; kk < 64; ++kk) wv[kk] = wp[(size_t)kk * NMODV];
#pragma unroll
                for (int kk = 0; kk < 64; kk += 4) {
#pragma unroll
                    for (int i = 0; i < 9; ++i) { const f32x4 sv = *(const LAS f32x4*)(sl + i * DM + k0 + kk); acc[i] = fmaf(sv.x, wv[kk], fmaf(sv.y, wv[kk + 1], fmaf(sv.z, wv[kk + 2], fmaf(sv.w, wv[kk + 3], acc[i])))); }
                }
#pragma unroll
                for (int i = 0; i < 9; ++i) part[(kg * 9 + i) * 32 + cl] = acc[i];
                __syncthreads();
                if (tid < 288) { const int i = tid >> 5; float sum = 0.f;
#pragma unroll
                    for (int k = 0; k < 16; ++k) sum += part[(k * 9 + i) * 32 + cl];
                    MOD[i * NMODV + unit * 32 + cl] = sum + b_mod[unit * 32 + cl]; }
                __syncthreads();
            }
        }
        __syncthreads();
        {
            LAS float* scr = (LAS float*)(ldsl + wave * 16384);
            constexpr int I_1A = (DM / 64) * (2 * DFF / 32);
            for (int it = gw; it < I_1A; it += NGW) transpose_item(ffn_w_in, DM, 2 * DFF, W1A, 1, scr, it, lane);
        }
        const int gt = bx * NTHR + tid, NT_ALL = G * NTHR;
        for (int i = gt; i < 2 * 32 * 64; i += NT_ALL) {
            const int p = i & 63, dg = i >> 6;
            const double dt = dexp((double)ssm_log_dt[dg]), are = (double)ssm_a_re[i], aim = (double)ssm_a_im[i];
            double s1, c1, s2, c2; dsincos(dt * aim, s1, c1); dsincos(256.0 * dt * aim, s2, c2);
            const double mag = dexp(dt * are), mag2 = dexp(256.0 * dt * are);
            const double abr = mag * c1, abi = mag * s1;
            ABAR[i] = make_float2((float)abr, (float)abi); APOW[i] = make_float2((float)(mag2 * c2), (float)(mag2 * s2));
            const double zr = abr - 1.0, zi = abi, den = are * are + aim * aim;
            const double cr = (zr * are + zi * aim) / den, ci = (zi * are - zr * aim) / den;
            const float* bre = ssm_b_re + (size_t)i * 16; const float* bim = ssm_b_im + (size_t)i * 16;
            bf16* dre = BBT + ((size_t)(dg * 4 + (p >> 5)) * 32 + (p & 31)) * 16; bf16* dim = BBT + ((size_t)(dg * 4 + 2 + (p >> 5)) * 32 + (p & 31)) * 16;
#pragma unroll
            for (int h = 0; h < 16; ++h) { const double br = (double)bre[h], bi = (double)bim[h]; dre[h] = (bf16)f2bf((float)(cr * br - ci * bi)); dim[h] = (bf16)f2bf((float)(cr * bi + ci * br)); }
        }
        for (int i = gt; i < 2 * 32 * 16 * 64; i += NT_ALL) {
            const int p = i & 63, dgh = i >> 6;
            ((unsigned*)CM)[(size_t)dgh * 64 + p] = pk2(ssm_c_re[i], -ssm_c_im[i]);
        }
        for (int i = gt; i < 128 * 16; i += NT_ALL) {
            const int f = i & 15, pos = i >> 4;
            const double inv = dexp(-(double)f * (9.210340371976182736 / 16.0)); double s, c; dsincos((double)pos * inv, s, c);
            ROPE[2 * i] = (float)c; ROPE[2 * i + 1] = (float)s;
        }
        for (int i = gt; i < NROWS; i += NT_ALL) { RSS1[i] = 0.f; RSS2[i] = 0.f; }
        if (gt == 0) { float s0 = 0.f, s1 = 0.f; for (int d = 0; d < 64; ++d) { s0 += lam_q[d] * lam_k[d]; s1 += lam_q[64 + d] * lam_k[64 + d]; } MISC[0] = expf(s0) - expf(s1) + 0.2f; }
    }
    grid.sync();

#define NORM_PASS(SRC_LAT, SRC_CTX, NIDX, LATONLY) do { int tid_l = threadIdx.x; asm volatile("" : "+v"(tid_l)); const int lane_l = tid_l & 63, gw_l = vcu * NWAVES + __builtin_amdgcn_readfirstlane(tid_l >> 6); \
        for (int it = gw_l; it < NROWS / 16; it += NGW) { const int r0 = it * 16, pm = r0 >> 8, b = pm / TILES_B, jt = pm - b * TILES_B, rl = r0 & 255; \
            if ((LATONLY) && jt == 32) continue; \
            const float* src = jt < 32 ? (SRC_LAT) + ((size_t)b * SEQ + jt * 256 + rl) * DM : (SRC_CTX) + ((size_t)b * CTXL + rl) * DM; \
            const float* mv = MOD + (jt < 32 ? b : 8) * NMODV + 3 * (NIDX) * DM; \
            norm_rows16<0>(src, XN + (size_t)r0 * DM, nullptr, norm_g + (NIDX) * DM, mv, mv + DM, lane_l); } } while (0)

    PH(1) {
        if (bx < 240) {
            const bool isin = bx < 64; const int unit = isin ? bx : bx - 64, N = isin ? 2048 : 2 * DFF, soff = isin ? 3 * DM : 6 * DM;
            const float* W = isin ? w_in : ffn_w_in + (size_t)DM * 2 * DFF; float* BO = isin ? BIAS1 : BIAS2;
            LAS float* sl = (LAS float*)ldsl; LAS float* part = (LAS float*)(ldsl + 36864);
            for (int i = tid; i < 9 * DM; i += NTHR) sl[i] = MOD[(i >> 10) * NMODV + soff + (i & 1023)];
            __syncthreads();
            const int cl = tid & 31, kg = tid >> 5, k0 = kg * 64; const float* wp = W + (size_t)k0 * N + unit * 32 + cl;
            float acc[9];
#pragma unroll
            for (int i = 0; i < 9; ++i) acc[i] = 0.f;
            float wv[64];
#pragma unroll
            for (int kk = 0; kk < 64; ++kk) wv[kk] = wp[(size_t)kk * N];
#pragma unroll
            for (int kk = 0; kk < 64; kk += 4) {
#pragma unroll
                for (int i = 0; i < 9; ++i) { const f32x4 sv = *(const LAS f32x4*)(sl + i * DM + k0 + kk); acc[i] = fmaf(sv.x, wv[kk], fmaf(sv.y, wv[kk + 1], fmaf(sv.z, wv[kk + 2], fmaf(sv.w, wv[kk + 3], acc[i])))); }
            }
#pragma unroll
            for (int i = 0; i < 9; ++i) part[(kg * 9 + i) * 32 + cl] = acc[i];
            __syncthreads();
            if (tid < 288) { const int i = tid >> 5; float sum = 0.f;
#pragma unroll
                for (int k = 0; k < 16; ++k) sum += part[(k * 9 + i) * 32 + cl];
                const int src = unit * 32 + cl; int drow = src;
                if (isin) { if (src >= 512 && src < 1536) drow = unit * 32 + 2 * (cl & 15) + (cl >> 4); }
                else { const int up = src >= DFF ? 1 : 0, ff = src - up * DFF; drow = (ff >> 7) * 256 + up * 128 + (ff & 127); }
                BO[i * N + drow] = sum; }
            __syncthreads();
        }
        NORM_PASS(x_in, ctx, 0, false);
    }
    GSYNC();
    PH(2) { pg8::Gemm g{XN, W1A, NROWS, 2 * DFF, DM}; pg8::TileOrder S; S.init(264, 22, G, bx, 0); pg8::EpiSwiglu E{ACT, DFF, nullptr, nullptr};
      pg8::gemm_phase<pg8::EpiSwiglu, pg8::TileOrder, true, true>(ldsl, g, S, E);
      if (bx >= 176) {
          int tid_l = threadIdx.x; asm volatile("" : "+v"(tid_l)); const int lane_l = tid_l & 63, wave_l = __builtin_amdgcn_readfirstlane(tid_l >> 6);
          LAS float* scr = (LAS float*)(ldsl + wave_l * 16384);
          constexpr int I_1B = (DFF / 64) * (DM / 32);
          for (int it = (bx - 176) * NWAVES + wave_l; it < I_1B; it += (G - 176) * NWAVES) transpose_item(ffn_w_out, DFF, DM, W1B, 0, scr, it, lane_l);
      } }
    GSYNC();
    PH(3) { pg8::Gemm g{ACT, W1B, NROWS, DM, DFF}; pg8::TileOrder S; S.init(264, 4, G, bx, 0); pg8::EpiResidNorm E{x_in, ctx, out_p, XC, MOD, 2 * DM, 1, norm_g + DM, 4 * DM, XN, RSS1};
      pg8::gemm_phase<pg8::EpiResidNorm, pg8::TileOrder, true, true>(ldsl, g, S, E);
      if (bx >= 32) {
          int tid_l = threadIdx.x; asm volatile("" : "+v"(tid_l)); const int lane_l = tid_l & 63, wave_l = __builtin_amdgcn_readfirstlane(tid_l >> 6);
          LAS float* scr = (LAS float*)(ldsl + wave_l * 16384);
          constexpr int I_1A = (DM / 64) * (2 * DFF / 32), I_1B = (DFF / 64) * (DM / 32), I_OUT = (DM / 64) * (DM / 32), I_GLU = (512 / 64) * (512 / 32), I_IN = (DM / 64) * (2048 / 32);
          for (int it = (bx - 32) * NWAVES + wave_l; it < I_IN + I_1A + I_1B + I_OUT + I_GLU; it += (G - 32) * NWAVES) {
              int r = it;
              if (r < I_IN) { transpose_item(w_in, DM, 2048, WIN, 2, scr, r, lane_l); continue; } r -= I_IN;
              if (r < I_1A) { transpose_item(ffn_w_in + (size_t)DM * 2 * DFF, DM, 2 * DFF, W2A, 1, scr, r, lane_l); continue; } r -= I_1A;
              if (r < I_1B) { transpose_item(ffn_w_out + (size_t)DFF * DM, DFF, DM, W2B, 0, scr, r, lane_l); continue; } r -= I_1B;
              if (r < I_OUT) { transpose_item(w_out, DM, DM, WOUT, 0, scr, r, lane_l); continue; } r -= I_OUT;
              transpose_item(w_glu, 512, 512, WGLU, 0, scr, r, lane_l);
          }
      } }
    GSYNC();
    PH(5) { pg8::Gemm g{XN, WIN, NROWS, 2048, DM}; pg8::TileOrder S; S.init(264, 8, G, bx, 0); pg8::EpiInproj E{UB, QB, KB, VB, ROPE, RSS1, BIAS1};
      pg8::gemm_phase<pg8::EpiInproj, pg8::TileOrder, true, true>(ldsl, g, S, E); }
    GSYNC();
    PH(6) for (int un = vcu; un < 8 * 33 * 4; un += G) { const int gq = un & 3, bc = un >> 2, b = bc / 33, c = bc - b * 33;
        s5_unit_a(ldsl, b, c, gq, UB, ABAR, BBT, EST); }
    GSYNC();
    PH(7) if (bx < 64) {
        int tid_c = threadIdx.x; asm volatile("" : "+v"(tid_c));
        const int i = bx * NTHR + tid_c;
        const int p = i & 63, dir = (i >> 6) & 1, g = (i >> 7) & 31, b = i >> 12;
        const float2 ap = APOW[(dir * 32 + g) * 64 + p];
#define SIDX(cc) (((((size_t)b * 33 + (cc)) * 32 + g) * 2 + dir) * 64 + p)
        float2 h = EST[SIDX(32)];
        if (dir == 0) { HIN[SIDX(0)] = h; for (int c = 0; c < 31; ++c) { const float2 e = EST[SIDX(c)]; const float nr = fmaf(ap.x, h.x, fmaf(-ap.y, h.y, e.x)), ni = fmaf(ap.x, h.y, fmaf(ap.y, h.x, e.y)); h = make_float2(nr, ni); HIN[SIDX(c + 1)] = h; } }
        else { HIN[SIDX(31)] = h; for (int c = 31; c > 0; --c) { const float2 e = EST[SIDX(c)]; const float nr = fmaf(ap.x, h.x, fmaf(-ap.y, h.y, e.x)), ni = fmaf(ap.x, h.y, fmaf(ap.y, h.x, e.y)); h = make_float2(nr, ni); HIN[SIDX(c - 1)] = h; } }
#undef SIDX
    }
    PH(8) {
        const float lam = MISC[0];
        unsigned redo_mask = 0u;
        {
        int k_ = 0;
        for (int un = vcu; un < 8 * 4 * 32; un += G, ++k_) {
            const int qb = un & 31, bh = un >> 5, b = bh >> 2, h = bh & 3;
            const size_t rb = (size_t)b * ROWS_B, rq = rb + (size_t)qb * 256;
            const attn::bf16_t* q0 = QB + rq * 512 + h * 128; const attn::bf16_t* k0 = KB + rb * 512 + h * 128; const attn::bf16_t* v0 = VB + rb * 512 + h * 128;
            float* st = OATT + rq * 512 + h * 128; attn::bf16_t* so = SA + rq * 1024 + 512 + h * 128;
            bool redo = attn::body<0, false>(q0, k0, v0, st, nullptr, lam, subln_g, ROWS_B, (char*)lds);
            if (!redo) redo = attn::body<1, false>(q0 + 64, k0 + 64, v0, st, so, lam, subln_g, ROWS_B, (char*)lds);
            if (redo) redo_mask |= 1u << k_;
        }
        }
        if (redo_mask) {
            int k_ = 0;
            for (int un = vcu; un < 8 * 4 * 32; un += G, ++k_) {
                if (!((redo_mask >> k_) & 1u)) continue;
                const int qb = un & 31, bh = un >> 5, b = bh >> 2, h = bh & 3;
                const size_t rb = (size_t)b * ROWS_B, rq = rb + (size_t)qb * 256;
                const attn::bf16_t* q0 = QB + rq * 512 + h * 128; const attn::bf16_t* k0 = KB + rb * 512 + h * 128; const attn::bf16_t* v0 = VB + rb * 512 + h * 128;
                float* st = OATT + rq * 512 + h * 128; attn::bf16_t* so = SA + rq * 1024 + 512 + h * 128;
                (void)attn::body<0, true>(q0, k0, v0, st, nullptr, lam, subln_g, ROWS_B, (char*)lds);
                (void)attn::body<1, true>(q0 + 64, k0 + 64, v0, st, so, lam, subln_g, ROWS_B, (char*)lds);
            }
        }
    }
    GSYNC();
    PH(9) for (int un = vcu; un < 8 * 32 * 4; un += G) { const int gq = un & 3, bc = un >> 2, b = bc >> 5, c = bc & 31;
        s5_unit<true>(ldsl, b, c, gq, UB, ABAR, BBT, CM, HIN, EST, ssm_d, GB, YFB); }
    GSYNC();
    PH(10) { pg8::Gemm g{GB, WGLU, NROWS, 512, 512}; pg8::TileOrder S; S.init(256, 2, G, bx, 1); pg8::EpiGlu E{GB, b_glu, SA};
      pg8::gemm_phase<pg8::EpiGlu, pg8::TileOrder, true, true>(ldsl, g, S, E); }
    GSYNC();
    PH(12) { pg8::Gemm g{SA, WOUT, NROWS, DM, DM}; pg8::TileOrder S; S.init(256, 4, G, bx, 1); pg8::EpiResidNorm E{out_p, XC, out_p, XC, MOD, 5 * DM, 0, norm_g + 2 * DM, 7 * DM, XN2, RSS2};
      pg8::gemm_phase<pg8::EpiResidNorm, pg8::TileOrder, true, true>(ldsl, g, S, E); }
    GSYNC();
    PH(14) { pg8::Gemm g{XN2, W2A, NROWS, 2 * DFF, DM}; pg8::TileOrder S; S.init(256, 22, G, bx, 1); pg8::EpiSwiglu E{ACT, DFF, RSS2, BIAS2};
      pg8::gemm_phase<pg8::EpiSwiglu, pg8::TileOrder, true, true>(ldsl, g, S, E); }
    GSYNC();
    PH(15) { pg8::Gemm g{ACT, W2B, NROWS, DM, DFF}; pg8::TileOrder S; S.init(256, 4, G, bx, 1); pg8::EpiResid E{out_p, XC, out_p, XC, MOD, 8 * DM, 0.5f};
      pg8::gemm_phase<pg8::EpiResid, pg8::TileOrder, true, true>(ldsl, g, S, E); }
    GSYNC();
    PH(16) { int tid_l = threadIdx.x; asm volatile("" : "+v"(tid_l)); const int lane_l = tid_l & 63, gw_l = vcu * NWAVES + __builtin_amdgcn_readfirstlane(tid_l >> 6);
        for (int it = gw_l; it < NB * SEQ / 16; it += NGW) norm_rows16<1>(out_p + (size_t)it * 16 * DM, nullptr, out_p + (size_t)it * 16 * DM, final_g, nullptr, nullptr, lane_l); }
#undef NORM_PASS
}

extern "C" void kernel_launch(void* const* d_in, const int* in_sizes, int n_in, void* d_out, int out_size, void* d_ws, size_t ws_size, hipStream_t stream) {
    static int grid = 0;
    if (grid == 0) {
        if (n_in != 25 || in_sizes[0] != NB * SEQ * DM || out_size != NB * SEQ * DM || ws_size < WS_END) {
            fprintf(stderr, "kernel_launch: shape mismatch (n_in %d, in0 %d, out %d, ws %zu, need %zu); nothing launched\n", n_in, n_in > 0 ? in_sizes[0] : -1, out_size, ws_size, (size_t)WS_END); grid = -1; return; }
        int dev = 0, cus = 0, per_cu = 0;
        if (hipGetDevice(&dev) != hipSuccess || hipDeviceGetAttribute(&cus, hipDeviceAttributeMultiprocessorCount, dev) != hipSuccess) { grid = -1; return; }
        if (hipFuncSetAttribute((const void*)hymba_fwd, hipFuncAttributeMaxDynamicSharedMemorySize, LDS_BYTES) != hipSuccess) { fprintf(stderr, "kernel_launch: hipFuncSetAttribute failed\n"); grid = -1; return; }
        if (hipOccupancyMaxActiveBlocksPerMultiprocessor(&per_cu, (const void*)hymba_fwd, NTHR, LDS_BYTES) != hipSuccess || per_cu < 1) { fprintf(stderr, "kernel_launch: occupancy query says %d\n", per_cu); per_cu = 1; }
        (void)hipGetLastError();
        grid = cus * (per_cu > 1 ? 1 : per_cu);
        if (grid != 256) fprintf(stderr, "kernel_launch: grid %d (expected 256)\n", grid);
    }
    if (grid < 0) return;
    (void)hipMemsetAsync((char*)d_ws + WS_BAR, 0, BAR_ZERO_BYTES, stream);
    Args a{};
    for (int i = 0; i < 25; ++i) a.in[i] = (const float*)d_in[i];
    a.out = (float*)d_out; a.ws = (unsigned char*)d_ws;
    void* args[] = {&a};
    const hipError_t e = hipLaunchCooperativeKernel((const void*)hymba_fwd, dim3(grid), dim3(NTHR), args, LDS_BYTES, stream);
    if (e != hipSuccess) fprintf(stderr, "kernel_launch: cooperative launch failed: %s (grid %d)\n", hipGetErrorString(e), grid);
}
```

```cpp
#include <hip/hip_runtime.h>
#include <hip/hip_cooperative_groups.h>
#include <cstdio>
#include <cstdint>
namespace cg = cooperative_groups;
namespace pg8 {
#define PG8_LAS __attribute__((address_space(3)))
typedef unsigned short bf16_t;
typedef short bf16x8 __attribute__((ext_vector_type(8)));
typedef float f32x4 __attribute__((ext_vector_type(4)));
typedef unsigned u32x4 __attribute__((ext_vector_type(4)));
constexpr int BM = 256, BK = 64, HALF = 128, HTB = HALF * BK * 2  , STAGE_BYTES = 8 * HTB, NXCD = 8, WGM = 8;

__host__ __device__ __forceinline__ int lds_byte(int r, int c) { const int st = (r >> 4) * 2 + (c >> 5), rr = r & 15, cc = c & 31, ob = rr * 64 + cc * 2; return st * 1024 + (ob ^ (((ob >> 9) & 1) << 5)); }
__host__ __device__ __forceinline__ void stage_rc(int b, int& R, int& C) { const int st = b / 1024, sb = b % 1024, swz = sb ^ (((sb >> 9) & 1) << 5); R = (st >> 1) * 16 + swz / 64; C = (st & 1) * 32 + (swz % 64) / 2; }
__host__ __device__ __forceinline__ int perm32(int rho) { const int n = rho >> 4, i = rho & 15; return 8 * (i >> 2) + 4 * n + (i & 3); }

struct Unit { int pm, pn; };
struct Gemm { const bf16_t* A; const bf16_t* Bt; int M, N, K; };

__device__ __forceinline__ unsigned cvt_pk_bf16(float lo, float hi) { unsigned r; asm volatile("v_cvt_pk_bf16_f32 %0, %1, %2" : "=v"(r) : "v"(lo), "v"(hi)); return r; }
typedef float f32x2 __attribute__((ext_vector_type(2)));
typedef unsigned u32x2 __attribute__((ext_vector_type(2)));
constexpr int ROWS_B = 8448, TILES_B = 33, NROWS = 8 * ROWS_B;

struct TileOrder {
    int nM, nN, nwg, G, c, lat;
    __device__ __forceinline__ void init(int nM_, int nN_, int G_, int c_, int lat_) { nM = nM_; nN = nN_; nwg = nM_ * nN_; G = G_; c = c_; lat = lat_; }
    __device__ __forceinline__ bool next(int i, Unit& u) const {
        const long L = (long)i * G + c; if (L >= nwg) return false;
        int wgid = (int)L; { const int q = nwg / NXCD, r = nwg % NXCD, xcd = wgid % NXCD, off = wgid / NXCD; wgid = (xcd < r ? xcd * (q + 1) : r * (q + 1) + (xcd - r) * q) + off; }
        const int nig = WGM * nN, gid = wgid / nig, fm = gid * WGM, gsz = (nM - fm) < WGM ? (nM - fm) : WGM;
        const int lm = fm + ((wgid % nig) % gsz); u.pn = (wgid % nig) / gsz; u.pm = lat ? (lm >> 5) * TILES_B + (lm & 31) : lm; return true;
    }
    __device__ __forceinline__ void a_ready(const Unit&) const {}
    __device__ __forceinline__ void done(const Unit&) const {}
};

__device__ __forceinline__ float fast_sigmoid(float z) { return __builtin_amdgcn_rcpf(1.0f + __builtin_amdgcn_exp2f(-1.4426950408889634f * z)); }
__device__ __forceinline__ float bf_lo(unsigned w) { return __uint_as_float(w << 16); }
__device__ __forceinline__ float bf_hi(unsigned w) { return __uint_as_float(w & 0xffff0000u); }

struct EpiSwiglu {
    static constexpr bool PERM = true, AFTER_DRAIN = false;
    bf16_t* O; int ldc; const float* rss; const float* bias;
    __device__ __forceinline__ void operator()(const f32x4 (&acc)[2][2][4][2], const Unit& u, int wr, int wc, int fr, int fq) const {
        const int row0 = u.pm * BM + wr * 64 + fr, col0 = u.pn * HALF + wc * 32 + 8 * fq;
        f32x4 bv[2][2];
#pragma unroll
        for (int bj = 0; bj < 2; ++bj)
#pragma unroll
            for (int n = 0; n < 2; ++n) bv[bj][n] = rss ? *(const f32x4*)(bias + (u.pm / TILES_B) * 5632 + u.pn * BM + bj * HALF + wc * 32 + 8 * fq + 4 * n) : (f32x4){0.f, 0.f, 0.f, 0.f};
#pragma unroll
        for (int ai = 0; ai < 2; ++ai)
#pragma unroll
            for (int m = 0; m < 4; ++m) {
                bf16_t* rowp = O + (size_t)(row0 + ai * HALF + m * 16) * ldc + col0;
                float v[8];
                const float rstd = rss ? 1.0f / sqrtf(rss[row0 + ai * HALF + m * 16] * (1.0f / 1024.0f) + 1e-6f) : 1.0f;
#pragma unroll
                for (int n = 0; n < 2; ++n)
#pragma unroll
                    for (int e = 0; e < 4; ++e) { const float gt = acc[ai][0][m][n][e] * rstd + bv[0][n][e], up = acc[ai][1][m][n][e] * rstd + bv[1][n][e]; v[4 * n + e] = gt * fast_sigmoid(gt) * up; }
                u32x4 w; w.x = cvt_pk_bf16(v[0], v[1]); w.y = cvt_pk_bf16(v[2], v[3]); w.z = cvt_pk_bf16(v[4], v[5]); w.w = cvt_pk_bf16(v[6], v[7]);
                *(u32x4*)rowp = w;
            }
    }
};

struct EpiResid {
    static constexpr bool PERM = true, AFTER_DRAIN = false;
    const float* res_lat; const float* res_ctx; float* out_lat; float* out_ctx; const float* mod; int modoff; float scale;
    __device__ __forceinline__ void operator()(const f32x4 (&acc)[2][2][4][2], const Unit& u, int wr, int wc, int fr, int fq) const {
        const int b = u.pm / TILES_B, jt = u.pm - b * TILES_B;
        const float* rb; float* ob; const float* gv;
        if (jt < 32) { const size_t o = ((size_t)b * 8192 + (size_t)jt * 256) * 1024; rb = res_lat + o; ob = out_lat + o; gv = mod + b * 9216 + modoff; }
        else { const size_t o = (size_t)b * 256 * 1024; rb = res_ctx + o; ob = out_ctx + o; gv = mod + 8 * 9216 + modoff; }
        const int rl = wr * 64 + fr, col0 = u.pn * BM + wc * 32 + 8 * fq;
        const char* rbb = (const char*)rb; char* obb = (char*)ob;
#pragma unroll
        for (int bj = 0; bj < 2; ++bj) {
            const int c = col0 + bj * HALF;
            const f32x4 g0 = *(const f32x4*)(gv + c) * scale, g1 = *(const f32x4*)(gv + c + 4) * scale;
#pragma unroll
            for (int kb = 0; kb < 8; kb += 8) {
                f32x4 x0[8], x1[8];
#pragma unroll
                for (int k = 0; k < 8; ++k) { const int ai = (kb + k) >> 2, m = (kb + k) & 3; const unsigned pb = (unsigned)((rl + ai * HALF + m * 16) * 1024 + c) * 4u; x0[k] = *(const f32x4*)(rbb + pb); x1[k] = *(const f32x4*)(rbb + pb + 16); }
                asm volatile("" ::: "memory");
#pragma unroll
                for (int k = 0; k < 8; ++k) { const int ai = (kb + k) >> 2, m = (kb + k) & 3; const unsigned pb = (unsigned)((rl + ai * HALF + m * 16) * 1024 + c) * 4u;
                    *(f32x4*)(obb + pb) = x0[k] + g0 * acc[ai][bj][m][0]; *(f32x4*)(obb + pb + 16) = x1[k] + g1 * acc[ai][bj][m][1]; }
                asm volatile("" ::: "memory");
            }
        }
    }
};

struct EpiResidNorm {
    static constexpr bool PERM = true, AFTER_DRAIN = false;
    const float* res_lat; const float* res_ctx; float* out_lat; float* out_ctx; const float* mod; int gateoff; int half_gate; const float* ng; int scaleoff; bf16_t* XNo; float* rss;
    __device__ __forceinline__ void operator()(const f32x4 (&acc)[2][2][4][2], const Unit& u, int wr, int wc, int fr, int fq) const {
        const int b = u.pm / TILES_B, jt = u.pm - b * TILES_B;
        const float* rb; float* ob; const float* mv;
        if (jt < 32) { const size_t o = ((size_t)b * 8192 + (size_t)jt * 256) * 1024; rb = res_lat + o; ob = out_lat + o; mv = mod + b * 9216; }
        else { const size_t o = (size_t)b * 256 * 1024; rb = res_ctx + o; ob = out_ctx + o; mv = mod + 8 * 9216; }
        const int rl = wr * 64 + fr, col0 = u.pn * BM + wc * 32 + 8 * fq;
        const float scale = half_gate ? 0.5f : 1.0f;
#ifndef EPI_RB
#define EPI_RB 4
#endif
        const char* rbb = (const char*)rb; char* obb = (char*)ob;
        typedef __attribute__((address_space(1))) float gfloat_t;
#pragma unroll
        for (int bj = 0; bj < 2; ++bj) {
            const int c = col0 + bj * HALF;
            const f32x4 g0 = *(const f32x4*)(mv + gateoff + c) * scale, g1 = *(const f32x4*)(mv + gateoff + c + 4) * scale;
            const f32x4 gs0 = *(const f32x4*)(ng + c) * (*(const f32x4*)(mv + scaleoff + c) + 1.0f), gs1 = *(const f32x4*)(ng + c + 4) * (*(const f32x4*)(mv + scaleoff + c + 4) + 1.0f);
#pragma unroll
            for (int kb = 0; kb < 8; kb += EPI_RB) {
                f32x4 x0[EPI_RB], x1[EPI_RB];
#pragma unroll
                for (int k = 0; k < EPI_RB; ++k) { const int ai = (kb + k) >> 2, m = (kb + k) & 3; const unsigned pb = (unsigned)((rl + ai * HALF + m * 16) * 1024 + c) * 4u; x0[k] = *(const f32x4*)(rbb + pb); x1[k] = *(const f32x4*)(rbb + pb + 16); }
                asm volatile("" ::: "memory");
#pragma unroll
                for (int k = 0; k < EPI_RB; ++k) { const int ai = (kb + k) >> 2, m = (kb + k) & 3; const int rr = rl + ai * HALF + m * 16; const unsigned pb = (unsigned)(rr * 1024 + c) * 4u; const size_t prow = (size_t)u.pm * BM + rr;
                    const f32x4 y0 = x0[k] + g0 * acc[ai][bj][m][0], y1 = x1[k] + g1 * acc[ai][bj][m][1];
                    *(f32x4*)(obb + pb) = y0; *(f32x4*)(obb + pb + 16) = y1;
                    float t = (y0[0] * y0[0] + y0[1] * y0[1]) + (y0[2] * y0[2] + y0[3] * y0[3]) + (y1[0] * y1[0] + y1[1] * y1[1]) + (y1[2] * y1[2] + y1[3] * y1[3]);
                    const f32x4 z0 = y0 * gs0, z1 = y1 * gs1;
                    u32x4 w; w.x = cvt_pk_bf16(z0[0], z0[1]); w.y = cvt_pk_bf16(z0[2], z0[3]); w.z = cvt_pk_bf16(z1[0], z1[1]); w.w = cvt_pk_bf16(z1[2], z1[3]);
                    *(u32x4*)(XNo + prow * 1024 + c) = w;
                    t += __shfl_xor(t, 16); t += __shfl_xor(t, 32);
                    if (fq == 0) __hip_atomic_fetch_add((gfloat_t*)(rss + prow), t, __ATOMIC_RELAXED, __HIP_MEMORY_SCOPE_AGENT); }
                asm volatile("" ::: "memory");
            }
        }
    }
};

struct EpiInproj {
    static constexpr bool PERM = true, AFTER_DRAIN = false;
    bf16_t* U; bf16_t* Q; bf16_t* K; bf16_t* V; const float* rope; const float* rss; const float* bias;
    __device__ __forceinline__ void operator()(const f32x4 (&acc)[2][2][4][2], const Unit& u, int wr, int wc, int fr, int fq) const {
        const int sec = u.pn >> 1, jt = u.pm % TILES_B;
        bf16_t* base = sec == 0 ? U : sec == 1 ? Q : sec == 2 ? K : V;
        const bool dorope = (sec == 1 || sec == 2) && jt < 32;
        const float qs = sec == 1 ? 0.125f * 1.4426950408889634f : 1.0f;
        const int col0 = (u.pn & 1) * BM + wc * 32 + 8 * fq, axis = wc & 1;
        const float* bp = bias + (jt < 32 ? u.pm / TILES_B : 8) * 2048 + u.pn * BM + wc * 32 + 8 * fq;
        f32x4 bv[2][2];
#pragma unroll
        for (int bj = 0; bj < 2; ++bj)
#pragma unroll
            for (int n = 0; n < 2; ++n) bv[bj][n] = *(const f32x4*)(bp + bj * HALF + 4 * n);
#pragma unroll
        for (int ai = 0; ai < 2; ++ai)
#pragma unroll
            for (int m = 0; m < 4; ++m) {
                const int rowl = wr * 64 + fr + ai * HALF + m * 16;
                bf16_t* rowp = base + (size_t)(u.pm * BM + rowl) * 512 + col0;
                const float rstd = 1.0f / sqrtf(rss[u.pm * BM + rowl] * (1.0f / 1024.0f) + 1e-6f);
                f32x4 cs0 = {1.f, 0.f, 1.f, 0.f}, cs1 = {1.f, 0.f, 1.f, 0.f};
                if (dorope) { const int t = jt * 256 + rowl, pos = axis ? (t & 63) : (t >> 6); const float* rp = rope + (pos * 16 + 4 * fq) * 2; cs0 = *(const f32x4*)rp; cs1 = *(const f32x4*)(rp + 4); }
#pragma unroll
                for (int bj = 0; bj < 2; ++bj) {
                    const f32x4 a0 = acc[ai][bj][m][0] * rstd + bv[bj][0], a1 = acc[ai][bj][m][1] * rstd + bv[bj][1];
                    float o[8];
                    o[0] = a0[0] * cs0[0] - a0[1] * cs0[1]; o[1] = a0[1] * cs0[0] + a0[0] * cs0[1];
                    o[2] = a0[2] * cs0[2] - a0[3] * cs0[3]; o[3] = a0[3] * cs0[2] + a0[2] * cs0[3];
                    o[4] = a1[0] * cs1[0] - a1[1] * cs1[1]; o[5] = a1[1] * cs1[0] + a1[0] * cs1[1];
                    o[6] = a1[2] * cs1[2] - a1[3] * cs1[3]; o[7] = a1[3] * cs1[2] + a1[2] * cs1[3];
                    u32x4 w; w.x = cvt_pk_bf16(o[0] * qs, o[1] * qs); w.y = cvt_pk_bf16(o[2] * qs, o[3] * qs); w.z = cvt_pk_bf16(o[4] * qs, o[5] * qs); w.w = cvt_pk_bf16(o[6] * qs, o[7] * qs);
                    *(u32x4*)(rowp + bj * HALF) = w;
                }
            }
    }
};

struct EpiGlu {
    static constexpr bool PERM = true, AFTER_DRAIN = false;
    const bf16_t* Gb; const float* bglu; bf16_t* SA;
    __device__ __forceinline__ void operator()(const f32x4 (&acc)[2][2][4][2], const Unit& u, int wr, int wc, int fr, int fq) const {
        const int row0 = u.pm * BM + wr * 64 + fr, col0 = u.pn * BM + wc * 32 + 8 * fq;
        f32x4 bv[2][2];
#pragma unroll
        for (int bj = 0; bj < 2; ++bj)
#pragma unroll
            for (int n = 0; n < 2; ++n) bv[bj][n] = *(const f32x4*)(bglu + col0 + bj * HALF + 4 * n);
#pragma unroll
        for (int ai = 0; ai < 2; ++ai)
#pragma unroll
            for (int m = 0; m < 4; ++m) { const size_t row = (size_t)(row0 + ai * HALF + m * 16);
#pragma unroll
                for (int bj = 0; bj < 2; ++bj) {
                    const u32x4 gw = *(const u32x4*)(Gb + row * 512 + col0 + bj * HALF);
                    const f32x4 z0 = acc[ai][bj][m][0] + bv[bj][0], z1 = acc[ai][bj][m][1] + bv[bj][1];
                    u32x4 w;
                    w.x = cvt_pk_bf16(bf_lo(gw.x) * fast_sigmoid(z0[0]), bf_hi(gw.x) * fast_sigmoid(z0[1]));
                    w.y = cvt_pk_bf16(bf_lo(gw.y) * fast_sigmoid(z0[2]), bf_hi(gw.y) * fast_sigmoid(z0[3]));
                    w.z = cvt_pk_bf16(bf_lo(gw.z) * fast_sigmoid(z1[0]), bf_hi(gw.z) * fast_sigmoid(z1[1]));
                    w.w = cvt_pk_bf16(bf_lo(gw.w) * fast_sigmoid(z1[2]), bf_hi(gw.w) * fast_sigmoid(z1[3]));
                    *(u32x4*)(SA + row * 1024 + col0 + bj * HALF) = w;
                } }
    }
};

template <class Epi, class Sched, bool ALIGN_EPI = false, bool SP2 = false>
__device__ __forceinline__ void gemm_phase(PG8_LAS unsigned char* lds, const Gemm g, const Sched& S, const Epi& E) {
    int tid_ = threadIdx.x; asm volatile("" : "+v"(tid_));
    const int tid = tid_, wid = __builtin_amdgcn_readfirstlane(tid >> 6), lane = tid & 63, wr = wid >> 2, wc = wid & 3, fr = lane & 15, fq = lane >> 4;
    const int K = g.K, nt = K / BK;
    unsigned voffA[2], voffB[2];
#pragma unroll
    for (int i = 0; i < 2; ++i) { int R, C; stage_rc(tid * 16 + i * 8192, R, C); const int Rb = Epi::PERM ? ((R & ~31) + perm32(R & 31)) : R;
        voffA[i] = (unsigned)(R * K + C) * 2u; voffB[i] = (unsigned)(Rb * K + C) * 2u; }
    const size_t kstep = (size_t)(BK * 2);
    const size_t hstep = (size_t)HALF * K * 2;
    const size_t tstep = 2 * hstep;
    const unsigned ldsw = (unsigned)wid * 1024u;
    const int aoff = lds_byte(wr * 64 + fr, fq * 8), boff = lds_byte(wc * 32 + fr, fq * 8);
#define PG8_SA(b, h) (((b) * 2 + (h)) * HTB)
#define PG8_SB(b, h) ((4 + (b) * 2 + (h)) * HTB)
#define PG8_STAGE(bufoff, gbase, voff) do { _Pragma("unroll") for (int _i = 0; _i < 2; ++_i) \
        __builtin_amdgcn_global_load_lds((const unsigned*)((const char*)(gbase) + (voff)[_i]), (PG8_LAS unsigned*)(lds + (bufoff) + ldsw + _i * 8192), 16, 0, 0); } while (0)
#define PG8_LDA(dst, b, h) do { _Pragma("unroll") for (int m = 0; m < 4; ++m) _Pragma("unroll") for (int k = 0; k < 2; ++k) dst[m][k] = *(const PG8_LAS bf16x8*)(lds + PG8_SA(b, h) + aoff + m * 2048 + k * 1024); } while (0)
#define PG8_LDB(dst, b, h) do { _Pragma("unroll") for (int n = 0; n < 2; ++n) _Pragma("unroll") for (int k = 0; k < 2; ++k) dst[n][k] = *(const PG8_LAS bf16x8*)(lds + PG8_SB(b, h) + boff + n * 2048 + k * 1024); } while (0)
#define PG8_MMA(ai, bj, At, Bt) do { __builtin_amdgcn_s_setprio(1); _Pragma("unroll") for (int m = 0; m < 4; ++m) _Pragma("unroll") for (int n = 0; n < 2; ++n) _Pragma("unroll") for (int k = 0; k < 2; ++k) \
        acc[ai][bj][m][n] = __builtin_amdgcn_mfma_f32_16x16x32_bf16(Bt[n][k], At[m][k], acc[ai][bj][m][n], 0, 0, 0); __builtin_amdgcn_s_setprio(0); } while (0)
#define PG8_WAIT_V(n) asm volatile("s_waitcnt vmcnt(" #n ")" ::: "memory")
#define PG8_WAIT_L(n) asm volatile("s_waitcnt lgkmcnt(" #n ")" ::: "memory")
#define PG8_BAR __builtin_amdgcn_s_barrier()
#define PG8_SCHED __builtin_amdgcn_sched_barrier(0)
    Unit cur, nxt; int ui = 0;
    if (!S.next(0, cur)) return;
    f32x4 acc[2][2][4][2];
#pragma unroll
    for (int a = 0; a < 2; ++a)
#pragma unroll
        for (int b = 0; b < 2; ++b)
#pragma unroll
            for (int m = 0; m < 4; ++m)
#pragma unroll
                for (int n = 0; n < 2; ++n) acc[a][b][m][n] = (f32x4){0.f, 0.f, 0.f, 0.f};
    bf16x8 At[4][2], B0[2][2], B1[2][2];
    const char* cA = (const char*)g.A + (size_t)cur.pm * tstep; const char* cB = (const char*)g.Bt + (size_t)cur.pn * tstep;
    S.a_ready(cur);
    if constexpr (SP2) {
        PG8_STAGE(PG8_SB(0, 0), cB, voffB); PG8_STAGE(PG8_SB(0, 1), cB + hstep, voffB); PG8_STAGE(PG8_SA(0, 0), cA, voffA); PG8_STAGE(PG8_SA(0, 1), cA + hstep, voffA);
        if (wr == 1) PG8_BAR;
        PG8_WAIT_V(2); PG8_BAR;
        PG8_STAGE(PG8_SB(1, 0), cB + kstep, voffB); PG8_STAGE(PG8_SA(1, 0), cA + kstep, voffA); PG8_STAGE(PG8_SB(1, 1), cB + hstep + kstep, voffB);
        PG8_WAIT_V(6); PG8_BAR;
    } else {
        PG8_STAGE(PG8_SB(0, 0), cB, voffB); PG8_STAGE(PG8_SA(0, 0), cA, voffA); PG8_STAGE(PG8_SB(0, 1), cB + hstep, voffB); PG8_STAGE(PG8_SA(0, 1), cA + hstep, voffA);
        if (wr == 1) PG8_BAR;
        PG8_WAIT_V(4); PG8_BAR;
        PG8_STAGE(PG8_SB(1, 0), cB + kstep, voffB); PG8_STAGE(PG8_SA(1, 0), cA + kstep, voffA); PG8_STAGE(PG8_SB(1, 1), cB + hstep + kstep, voffB);
        PG8_WAIT_V(6); PG8_BAR;
    }
    for (;;) {
        const bool has_next = S.next(ui + 1, nxt);
        const char* nA = has_next ? (const char*)g.A + (size_t)nxt.pm * tstep : cA; const char* nB = has_next ? (const char*)g.Bt + (size_t)nxt.pn * tstep : cB;
        for (int t = 0; t < nt; t += 2) {
            const bool last = (t == nt - 2);
            const char* a1 = cA + (size_t)(t + 1) * kstep;
            const char* a2 = last ? nA : cA + (size_t)(t + 2) * kstep; const char* b2 = last ? nB : cB + (size_t)(t + 2) * kstep;
            const char* a3 = a2 + kstep; const char* b3 = b2 + kstep;
            if (last && has_next) S.a_ready(nxt);
            if constexpr (SP2) {
            PG8_LDB(B0, 0, 0); PG8_LDB(B1, 0, 1); PG8_SCHED; PG8_LDA(At, 0, 0); PG8_STAGE(PG8_SA(1, 1), a1 + hstep, voffA);
            PG8_WAIT_V(8); PG8_WAIT_L(0); PG8_BAR; PG8_MMA(0, 0, At, B0); PG8_MMA(0, 1, At, B1); PG8_BAR; PG8_SCHED;
            PG8_LDA(At, 0, 1); PG8_STAGE(PG8_SB(0, 0), b2, voffB); PG8_STAGE(PG8_SB(0, 1), b2 + hstep, voffB); PG8_STAGE(PG8_SA(0, 0), a2, voffA);
            PG8_WAIT_V(8); PG8_WAIT_L(0); PG8_BAR; PG8_MMA(1, 0, At, B0); PG8_MMA(1, 1, At, B1); PG8_BAR; PG8_SCHED;
            PG8_LDB(B0, 1, 0); PG8_LDB(B1, 1, 1); PG8_SCHED; PG8_LDA(At, 1, 0); PG8_STAGE(PG8_SA(0, 1), a2 + hstep, voffA);
            PG8_WAIT_V(8); PG8_WAIT_L(0); PG8_BAR; PG8_MMA(0, 0, At, B0); PG8_MMA(0, 1, At, B1); PG8_BAR; PG8_SCHED;
            PG8_LDA(At, 1, 1); PG8_STAGE(PG8_SB(1, 0), b3, voffB); PG8_STAGE(PG8_SB(1, 1), b3 + hstep, voffB); PG8_STAGE(PG8_SA(1, 0), a3, voffA);
            PG8_WAIT_V(8); PG8_WAIT_L(0); PG8_BAR; PG8_MMA(1, 0, At, B0); PG8_MMA(1, 1, At, B1); PG8_BAR; PG8_SCHED;
            } else {
            PG8_LDB(B0, 0, 0); PG8_SCHED; PG8_LDA(At, 0, 0); PG8_STAGE(PG8_SA(1, 1), a1 + hstep, voffA);
            PG8_WAIT_L(8); PG8_BAR; PG8_WAIT_L(0); PG8_MMA(0, 0, At, B0); PG8_BAR; PG8_SCHED;
            PG8_LDB(B1, 0, 1); PG8_STAGE(PG8_SB(0, 0), b2, voffB);
            PG8_BAR; PG8_WAIT_L(0); PG8_MMA(0, 1, At, B1); PG8_BAR;
            PG8_LDA(At, 0, 1); PG8_STAGE(PG8_SA(0, 0), a2, voffA);
            PG8_BAR; PG8_WAIT_L(0); PG8_MMA(1, 0, At, B0); PG8_BAR; PG8_SCHED;
            PG8_STAGE(PG8_SB(0, 1), b2 + hstep, voffB);
            PG8_WAIT_V(6); PG8_BAR; PG8_MMA(1, 1, At, B1); PG8_BAR;
            PG8_LDB(B0, 1, 0); PG8_SCHED; PG8_LDA(At, 1, 0); PG8_STAGE(PG8_SA(0, 1), a2 + hstep, voffA);
            PG8_WAIT_L(8); PG8_BAR; PG8_WAIT_L(0); PG8_MMA(0, 0, At, B0); PG8_BAR; PG8_SCHED;
            PG8_LDB(B1, 1, 1); PG8_STAGE(PG8_SB(1, 0), b3, voffB);
            PG8_BAR; PG8_WAIT_L(0); PG8_MMA(0, 1, At, B1); PG8_BAR;
            PG8_LDA(At, 1, 1); PG8_STAGE(PG8_SA(1, 0), a3, voffA);
            PG8_BAR; PG8_WAIT_L(0); PG8_MMA(1, 0, At, B0); PG8_BAR; PG8_SCHED;
            PG8_STAGE(PG8_SB(1, 1), b3 + hstep, voffB);
            PG8_WAIT_V(6); PG8_BAR; PG8_MMA(1, 1, At, B1); PG8_BAR;
            }
        }
        if constexpr (ALIGN_EPI) { if (wr == 0) PG8_BAR; }
        if constexpr (!Epi::AFTER_DRAIN) { E(acc, cur, wr, wc, fr, fq); S.done(cur); }
        if (!has_next) break;
#pragma unroll
        for (int a = 0; a < 2; ++a)
#pragma unroll
            for (int b = 0; b < 2; ++b)
#pragma unroll
                for (int m = 0; m < 4; ++m)
#pragma unroll
                    for (int n = 0; n < 2; ++n) acc[a][b][m][n] = (f32x4){0.f, 0.f, 0.f, 0.f};
        cur = nxt; cA = nA; cB = nB; ++ui;
        if constexpr (ALIGN_EPI) { if (wr == 1) PG8_BAR; }
    }
    PG8_WAIT_V(0);
    if constexpr (!ALIGN_EPI) { if (wr == 0) PG8_BAR; }
    PG8_BAR;
    if constexpr (Epi::AFTER_DRAIN) { E.fused(acc, cur, wr, wc, fr, fq, lds, wid, lane); S.done(cur); }
#undef PG8_SA
#undef PG8_SB
#undef PG8_STAGE
#undef PG8_LDA
#undef PG8_LDB
#undef PG8_MMA
#undef PG8_WAIT_V
#undef PG8_WAIT_L
#undef PG8_BAR
#undef PG8_SCHED
}
}

namespace attn {
typedef unsigned short bf16_t;
using bf16x8 = __attribute__((ext_vector_type(8))) short;
using s16x4  = __attribute__((ext_vector_type(4))) short;
using f32x16 = __attribute__((ext_vector_type(16))) float;
using u32x4  = __attribute__((ext_vector_type(4))) unsigned;
constexpr int NW = 8, QBLK = 32, KVBLK = 64;
constexpr float QSCALE = 0.125f * 1.4426950408889634f;
constexpr int LDQ = 512, LDK = 512, LDV = 512, LDO = 512;
constexpr int SHM_V = KVBLK * 128 * 2, SHM_K = KVBLK * 64 * 2, SHM_ATTN = 2 * SHM_V + 2 * SHM_K + NW * 64 * 4;
#define KSWZ64(row, colB) ((row) * 128 + ((colB) ^ ((((row) >> 1) & 7) << 4)))
#define SBAR() __builtin_amdgcn_sched_barrier(0)
__device__ __forceinline__ int crow(int r, int hi) { return (r & 3) + 8 * (r >> 2) + 4 * hi; }
__device__ __forceinline__ unsigned cvtpk(float lo, float hi) { unsigned r; asm volatile("v_cvt_pk_bf16_f32 %0, %1, %2" : "=v"(r) : "v"(lo), "v"(hi)); return r; }
constexpr float THR2 = 11.5f;
template <bool FIRST, bool GUARD>
__device__ __forceinline__ void partialSM(f32x16& p0, f32x16& p1, float& m_reg, float& alpha) {
  if (!GUARD) {
    alpha = 1.f;
    return;
  }
  if (!FIRST) { if (__builtin_expect(__any(m_reg != 0.f), 0)) {
#pragma unroll
      for (int r = 0; r < 16; ++r) { p0[r] -= m_reg; p1[r] -= m_reg; } } }
  float a = fmaxf(fmaxf(p0[0], p0[1]), p1[0]), b = fmaxf(fmaxf(p0[2], p0[3]), p1[1]); a = fmaxf(fmaxf(a, p1[2]), p1[3]);
#pragma unroll
  for (int r = 4; r < 16; r += 4) { a = fmaxf(fmaxf(a, p0[r]), p0[r + 1]); b = fmaxf(fmaxf(b, p0[r + 2]), p0[r + 3]); a = fmaxf(fmaxf(a, p1[r]), p1[r + 1]); b = fmaxf(fmaxf(b, p1[r + 2]), p1[r + 3]); }
  float pmax = fmaxf(a, b);
  { auto rr = __builtin_amdgcn_permlane32_swap(__float_as_uint(pmax), __float_as_uint(pmax), false, false);
    pmax = fmaxf(__uint_as_float(rr[0]), __uint_as_float(rr[1])); }
  alpha = 1.f;
  if (FIRST) {
    if (__builtin_expect(__any(fabsf(pmax) > THR2), 0)) { const float dl = fabsf(pmax) > THR2 ? pmax : 0.f; m_reg = dl;
#pragma unroll
      for (int r = 0; r < 16; ++r) { p0[r] -= dl; p1[r] -= dl; } }
  } else {
    if (__builtin_expect(__any(pmax > THR2), 0)) { const float dl = fmaxf(pmax, 0.f); m_reg += dl;
#pragma unroll
      for (int r = 0; r < 16; ++r) { p0[r] -= dl; p1[r] -= dl; }
      alpha = __builtin_amdgcn_exp2f(-dl); }
  }
#pragma unroll
  for (int r = 0; r < 16; ++r) p0[r] = __builtin_amdgcn_exp2f(p0[r]);
}
template <bool BOTH>
__device__ __forceinline__ void finishSM(f32x16& p0, f32x16& p1, bf16x8& pa0, bf16x8& pa1, bf16x8& pa2, bf16x8& pa3, float& l_reg) {
  if (BOTH) {
#pragma unroll
    for (int r = 0; r < 16; ++r) p0[r] = __builtin_amdgcn_exp2f(p0[r]);
  }
#pragma unroll
  for (int r = 0; r < 16; ++r) p1[r] = __builtin_amdgcn_exp2f(p1[r]);
  if (BOTH) {
    float s0 = p0[0] + p0[1], s1 = p0[2] + p0[3], s2 = p1[0] + p1[1], s3 = p1[2] + p1[3];
#pragma unroll
    for (int r = 4; r < 16; r += 4) { s0 += p0[r]; s1 += p0[r + 1]; s2 += p0[r + 2]; s3 += p0[r + 3]; s0 += p1[r]; s1 += p1[r + 1]; s2 += p1[r + 2]; s3 += p1[r + 3]; }
    l_reg += (s0 + s1) + (s2 + s3);
  }
#define PK4(P, BASE, OUT) do { u32x4 w = {cvtpk(P[BASE + 0], P[BASE + 1]), cvtpk(P[BASE + 2], P[BASE + 3]), cvtpk(P[BASE + 4], P[BASE + 5]), cvtpk(P[BASE + 6], P[BASE + 7])}; \
    OUT = *reinterpret_cast<bf16x8*>(&w); } while (0)
  PK4(p0, 0, pa0); PK4(p0, 8, pa1); PK4(p1, 0, pa2); PK4(p1, 8, pa3);
#undef PK4
}
__device__ __forceinline__ void qkt(f32x16& p0, f32x16& p1, const char* Ks, const bf16x8* qr, int r32, int hi) {
  p0 = f32x16{}; p1 = f32x16{};
#pragma unroll
  for (int d0 = 0; d0 < 4; ++d0) { const int cb = (d0 * 16 + hi * 8) * 2;
    bf16x8 b0 = *reinterpret_cast<const bf16x8*>(Ks + KSWZ64(r32, cb));
    bf16x8 b1 = *reinterpret_cast<const bf16x8*>(Ks + KSWZ64(32 + r32, cb));
    p0 = __builtin_amdgcn_mfma_f32_32x32x16_bf16(b0, qr[d0], p0, 0, 0, 0);
    p1 = __builtin_amdgcn_mfma_f32_32x32x16_bf16(b1, qr[d0], p1, 0, 0, 0); }
}
__device__ __forceinline__ int v_st(int k, int c) { const int kk = k; return ((kk >> 3) * 4 + (c >> 5)) * 512 + ((kk & 7) * 32 + (c & 31)) * 2; }
__device__ __forceinline__ int v_rd_base(int lane) { return ((lane & 3) << 3) | (((lane >> 2) & 3) << 6) | (((lane >> 4) & 1) << 5) | (((lane >> 5) & 1) << 8); }
constexpr int v_rd_off(int d0, int ks, int half) { return d0 * 512 + ks * 4096 + half * 2048; }
template <int OFF> __device__ __forceinline__ s16x4 tr_read(int vb) {
  s16x4 r; asm volatile("ds_read_b64_tr_b16 %0, %1 offset:%2" : "=&v"(r) : "v"(vb), "i"(OFF) : "memory"); return r;
}
template <int D0> __device__ __forceinline__ void pv_one(f32x16& od, int vb, bf16x8 pa0, bf16x8 pa1, bf16x8 pa2, bf16x8 pa3) {
  const s16x4 l0 = tr_read<v_rd_off(D0, 0, 0)>(vb), h0 = tr_read<v_rd_off(D0, 0, 1)>(vb), l1 = tr_read<v_rd_off(D0, 1, 0)>(vb), h1 = tr_read<v_rd_off(D0, 1, 1)>(vb);
  const s16x4 l2 = tr_read<v_rd_off(D0, 2, 0)>(vb), h2 = tr_read<v_rd_off(D0, 2, 1)>(vb), l3 = tr_read<v_rd_off(D0, 3, 0)>(vb), h3 = tr_read<v_rd_off(D0, 3, 1)>(vb);
  asm volatile("s_waitcnt lgkmcnt(0)" ::: "memory"); SBAR();
#define PK(L, H) (bf16x8){L[0], L[1], L[2], L[3], H[0], H[1], H[2], H[3]}
  od = __builtin_amdgcn_mfma_f32_32x32x16_bf16(pa0, PK(l0, h0), od, 0, 0, 0);
  od = __builtin_amdgcn_mfma_f32_32x32x16_bf16(pa1, PK(l1, h1), od, 0, 0, 0);
  od = __builtin_amdgcn_mfma_f32_32x32x16_bf16(pa2, PK(l2, h2), od, 0, 0, 0);
  od = __builtin_amdgcn_mfma_f32_32x32x16_bf16(pa3, PK(l3, h3), od, 0, 0, 0);
#undef PK
}
template <bool SUM>
__device__ __forceinline__ void pv_d0(f32x16* o, f32x16& osum, int vb, bf16x8 pa0, bf16x8 pa1, bf16x8 pa2, bf16x8 pa3) {
  if (SUM) { const bf16x8 ones = {16256, 16256, 16256, 16256, 16256, 16256, 16256, 16256};
    osum = __builtin_amdgcn_mfma_f32_32x32x16_bf16(pa0, ones, osum, 0, 0, 0); osum = __builtin_amdgcn_mfma_f32_32x32x16_bf16(pa1, ones, osum, 0, 0, 0);
    osum = __builtin_amdgcn_mfma_f32_32x32x16_bf16(pa2, ones, osum, 0, 0, 0); osum = __builtin_amdgcn_mfma_f32_32x32x16_bf16(pa3, ones, osum, 0, 0, 0); }
  pv_one<0>(o[0], vb, pa0, pa1, pa2, pa3); pv_one<1>(o[1], vb, pa0, pa1, pa2, pa3); pv_one<2>(o[2], vb, pa0, pa1, pa2, pa3); pv_one<3>(o[3], vb, pa0, pa1, pa2, pa3);
}
#define TRSET(L, D0) do { L[0] = tr_read<v_rd_off(D0, 0, 0)>(vb); L[1] = tr_read<v_rd_off(D0, 0, 1)>(vb); L[2] = tr_read<v_rd_off(D0, 1, 0)>(vb); L[3] = tr_read<v_rd_off(D0, 1, 1)>(vb); \
    L[4] = tr_read<v_rd_off(D0, 2, 0)>(vb); L[5] = tr_read<v_rd_off(D0, 2, 1)>(vb); L[6] = tr_read<v_rd_off(D0, 3, 0)>(vb); L[7] = tr_read<v_rd_off(D0, 3, 1)>(vb); } while (0)
#define PKV(L, k) (bf16x8){L[2 * (k)][0], L[2 * (k)][1], L[2 * (k)][2], L[2 * (k)][3], L[2 * (k) + 1][0], L[2 * (k) + 1][1], L[2 * (k) + 1][2], L[2 * (k) + 1][3]}
#define MM4(OD, L) do { OD = __builtin_amdgcn_mfma_f32_32x32x16_bf16(pa0, PKV(L, 0), OD, 0, 0, 0); OD = __builtin_amdgcn_mfma_f32_32x32x16_bf16(pa1, PKV(L, 1), OD, 0, 0, 0); \
    OD = __builtin_amdgcn_mfma_f32_32x32x16_bf16(pa2, PKV(L, 2), OD, 0, 0, 0); OD = __builtin_amdgcn_mfma_f32_32x32x16_bf16(pa3, PKV(L, 3), OD, 0, 0, 0); } while (0)
#define LWAIT() do { asm volatile("s_waitcnt lgkmcnt(0)" ::: "memory"); SBAR(); } while (0)
__device__ __forceinline__ void pv_d0_pipe(f32x16* o, int vb, bf16x8 pa0, bf16x8 pa1, bf16x8 pa2, bf16x8 pa3) {
  s16x4 LA[8], LB[8];
  __builtin_amdgcn_s_setprio(1);
  TRSET(LA, 0); SBAR();
#define EX4(B) do { px[B] = __builtin_amdgcn_exp2f(px[B]); px[B + 1] = __builtin_amdgcn_exp2f(px[B + 1]); px[B + 2] = __builtin_amdgcn_exp2f(px[B + 2]); px[B + 3] = __builtin_amdgcn_exp2f(px[B + 3]); } while (0)
  LWAIT(); TRSET(LB, 1); SBAR(); MM4(o[0], LA); SBAR();
  LWAIT(); TRSET(LA, 2); SBAR(); MM4(o[1], LB); SBAR();
  LWAIT(); TRSET(LB, 3); SBAR(); MM4(o[2], LA); SBAR();
  LWAIT(); MM4(o[3], LB);
#undef EX4
}
#undef TRSET
#undef PKV
#undef MM4
#undef LWAIT
template <int COMP, bool GUARD>
__device__ __forceinline__ bool body(const bf16_t* __restrict__ Qb, const bf16_t* __restrict__ Kh, const bf16_t* __restrict__ Vh, float* Ob, bf16_t* __restrict__ SAo, float lam, const float* __restrict__ sg, int seq, char* lds) {
  int tid_ = threadIdx.x; asm volatile("" : "+v"(tid_));
  const int tid = tid_, wid = tid >> 6, lane = tid & 63, r32 = lane & 31, hi = lane >> 5;
  char* V_lds = lds; char* K_lds = lds + 4 * SHM_V;
  float* ws = (float*)(lds + 4 * SHM_V + 4 * SHM_K) + wid * 64; float* al_l = ws + 32;
  float m_reg = 0.f, l_reg = 0.f; f32x16 o[4] = {}; f32x16 osum = {}; bf16x8 qr[4];
  const bf16_t* Qw = Qb + (long)(wid * QBLK + r32) * LDQ + hi * 8;
#pragma unroll
  for (int d0 = 0; d0 < 4; ++d0) qr[d0] = *reinterpret_cast<const bf16x8*>(Qw + d0 * 16);
  const int sr = tid >> 4, sc = (tid & 15) * 8, vst0 = v_st(sr, sc), vst1 = v_st(32 + sr, sc);
  const int ksr = tid >> 3, ksc = (tid & 7) * 8, kst = KSWZ64(ksr, ksc * 2);
  const int vb0 = (int)(uintptr_t)V_lds + v_rd_base(lane);
  bf16x8 rvs0, rvs1, rks0;
#define SLOAD(k0) do { rvs0 = *reinterpret_cast<const bf16x8*>(&Vh[(long)((k0) + sr) * LDV + sc]); rvs1 = *reinterpret_cast<const bf16x8*>(&Vh[(long)((k0) + 32 + sr) * LDV + sc]); \
    rks0 = *reinterpret_cast<const bf16x8*>(&Kh[(long)((k0) + ksr) * LDK + ksc]); } while (0)
#define SWRITE(slot) do { *(bf16x8*)(V_lds + (slot) * SHM_V + vst0) = rvs0; *(bf16x8*)(V_lds + (slot) * SHM_V + vst1) = rvs1; *(bf16x8*)(K_lds + (slot) * SHM_K + kst) = rks0; } while (0)
#define RESC(a) do { if (__any((a) < 1.f)) { if (hi == 0) al_l[r32] = (a); asm volatile("s_waitcnt lgkmcnt(0)" ::: "memory"); \
    _Pragma("unroll") for (int r = 0; r < 16; ++r) { const float f_ = al_l[crow(r, hi)]; osum[r] *= f_; _Pragma("unroll") for (int d = 0; d < 4; ++d) o[d][r] *= f_; } } } while (0)
  f32x16 pA0, pA1, pB0, pB1; float alA, alB; bf16x8 pa0, pa1, pa2, pa3; const int NT = seq / KVBLK;
  SLOAD(0); SWRITE(0); SLOAD(KVBLK); __syncthreads();
  qkt(pA0, pA1, K_lds, qr, r32, hi); partialSM<true, GUARD>(pA0, pA1, m_reg, alA);
  SWRITE(1); SLOAD(2 * KVBLK); __syncthreads();
  const int grp = __builtin_amdgcn_readfirstlane(wid >> 2);
#define ITER(X0, X1, Y0, Y1, alX, i) do { const int scur = (i) & 3, sp = ((i) - 1) & 3, sn = ((i) + 1) & 3; \
    SBAR(); qkt(X0, X1, K_lds + scur * SHM_K, qr, r32, hi); \
    finishSM<!GUARD>(Y0, Y1, pa0, pa1, pa2, pa3, l_reg); SBAR(); \
    if (grp) { SWRITE(sn); if ((i) + 2 < NT) SLOAD(((i) + 2) * KVBLK); __syncthreads(); } \
    if (GUARD) pv_d0<true>(o, osum, vb0 + sp * SHM_V, pa0, pa1, pa2, pa3); else { __builtin_amdgcn_s_setprio(1); pv_d0<false>(o, osum, vb0 + sp * SHM_V, pa0, pa1, pa2, pa3); } if (GUARD) partialSM<false, GUARD>(X0, X1, m_reg, alX); else { alX = 1.f; __builtin_amdgcn_s_setprio(0); } \
    if (GUARD) RESC(alX); \
    if (!grp) { SWRITE(sn); if ((i) + 2 < NT) SLOAD(((i) + 2) * KVBLK); __syncthreads(); } } while (0)
  int i = 1;
  for (; i + 1 < NT; i += 2) {
    ITER(pB0, pB1, pA0, pA1, alB, i);
    ITER(pA0, pA1, pB0, pB1, alA, i + 1);
  }
  { const int scur = i & 3, sp = (i - 1) & 3;
  SBAR(); qkt(pB0, pB1, K_lds + scur * SHM_K, qr, r32, hi);
  finishSM<!GUARD>(pA0, pA1, pa0, pa1, pa2, pa3, l_reg); SBAR();
  pv_d0<GUARD>(o, osum, vb0 + sp * SHM_V, pa0, pa1, pa2, pa3); partialSM<false, GUARD>(pB0, pB1, m_reg, alB);
  if (GUARD) RESC(alB);
  finishSM<!GUARD>(pB0, pB1, pa0, pa1, pa2, pa3, l_reg); SBAR();
  pv_d0<GUARD>(o, osum, vb0 + scur * SHM_V, pa0, pa1, pa2, pa3); }
#undef ITER
  int tid_e = threadIdx.x; asm volatile("" : "+v"(tid_e));
  const int wid_e = tid_e >> 6, r32_e = tid_e & 31, hi_e = (tid_e >> 5) & 1;
  float* ws_e = (float*)(lds + 4 * SHM_V + 4 * SHM_K) + wid_e * 64;
  float rli[16];
  if (!GUARD) {
    { auto rr = __builtin_amdgcn_permlane32_swap(__float_as_uint(l_reg), __float_as_uint(l_reg), false, false); l_reg = __uint_as_float(rr[0]) + __uint_as_float(rr[1]); }
    const bool ok = (l_reg > 0.f) && (l_reg < 3.0e38f);
    if (__syncthreads_or(ok ? 0 : 1)) return true;
    if (hi_e == 0) ws_e[r32_e] = l_reg; asm volatile("s_waitcnt lgkmcnt(0)" ::: "memory");
#pragma unroll
    for (int r = 0; r < 16; ++r) rli[r] = __builtin_amdgcn_rcpf(ws_e[crow(r, hi_e)]);
  } else {
#pragma unroll
    for (int r = 0; r < 16; ++r) rli[r] = __builtin_amdgcn_rcpf(osum[r]);
  }
  float* Ow = Ob + (long)(wid_e * QBLK) * LDO;
  if (COMP == 0) {
#pragma unroll
    for (int r = 0; r < 16; ++r) { const int orow = crow(r, hi_e);
#pragma unroll
      for (int d0 = 0; d0 < 4; ++d0) Ow[(long)orow * LDO + d0 * 32 + r32_e] = o[d0][r] * rli[r]; }
  } else {
    float ss[16];
#pragma unroll
    for (int r = 0; r < 16; ++r) { const int orow = crow(r, hi_e); float q = 0.f;
#pragma unroll
      for (int d0 = 0; d0 < 4; ++d0) { const float d = Ow[(long)orow * LDO + d0 * 32 + r32_e] - lam * (o[d0][r] * rli[r]); o[d0][r] = d; q = fmaf(d, d, q); }
      ss[r] = q; }
#pragma unroll
    for (int r = 0; r < 16; ++r) { float q = ss[r]; q += __shfl_xor(q, 1); q += __shfl_xor(q, 2); q += __shfl_xor(q, 4); q += __shfl_xor(q, 8); q += __shfl_xor(q, 16);
      ss[r] = 1.0f / sqrtf(q * (1.0f / 128.0f) + 1e-6f); }
    float gsub[4];
#pragma unroll
    for (int d0 = 0; d0 < 4; ++d0) gsub[d0] = sg[d0 * 32 + r32_e] * 0.8f;
    bf16_t* Sw = SAo + (long)(wid_e * QBLK) * 1024;
#pragma unroll
    for (int r = 0; r < 16; ++r) { const int orow = crow(r, hi_e);
#pragma unroll
      for (int d0 = 0; d0 < 4; ++d0) { const float y = o[d0][r] * ss[r] * gsub[d0]; unsigned u = __builtin_bit_cast(unsigned, y); u = (u + 0x7fffu + ((u >> 16) & 1u)) >> 16;
        Sw[(long)orow * 1024 + d0 * 32 + r32_e] = (bf16_t)u; } }
  }
  asm volatile("s_waitcnt vmcnt(0) lgkmcnt(0)" ::: "memory"); __syncthreads();
  return false;
#undef SLOAD
#undef SWRITE
#undef RESC
}
#undef SBAR
}

#define GAS __attribute__((address_space(1)))
#define LAS __attribute__((address_space(3)))
typedef unsigned short bf16;
typedef unsigned v4u __attribute__((ext_vector_type(4)));
typedef float f32x4 __attribute__((ext_vector_type(4)));
typedef float f32x16 __attribute__((ext_vector_type(16)));
typedef short bf16x8 __attribute__((ext_vector_type(8)));

constexpr int NWAVES = 8, NTHR = 512;
constexpr int DM = 1024, DFF = 2816, NB = 8, SEQ = 8192, CTXL = 256, NMODV = 9 * DM;
constexpr int ROWS_B = 8448, TILES_B = 33, NROWS = NB * ROWS_B;

constexpr size_t MiB = 1u << 20;
constexpr size_t WS_CTL = 0, CTL_ZERO_BYTES = 1 * MiB;
constexpr size_t WS_MOD = 4096;
constexpr size_t WS_BIAS1 = 352 * 1024, WS_BIAS2 = 640 * 1024;
constexpr size_t WS_RSS1 = 69 * MiB, WS_RSS2 = 69 * MiB + 512 * 1024;
constexpr size_t WS_BAR = 512 * 1024, BAR_ZERO_BYTES = 16384;
constexpr size_t WS_ABAR = 1 * MiB, WS_APOW = WS_ABAR + 32768, WS_BBT = WS_APOW + 32768, WS_CM = WS_BBT + 262144, WS_ROPE = WS_CM + 262144;
constexpr size_t WS_W1A = 2 * MiB, WS_W1B = 13 * MiB, WS_W2A = 19 * MiB, WS_W2B = 30 * MiB, WS_WIN = 36 * MiB, WS_WOUT = 40 * MiB, WS_WGLU = 42 * MiB;
constexpr size_t WS_E = 43 * MiB, WS_HIN = 52 * MiB, WS_XC = 61 * MiB;
constexpr size_t WS_XN = 70 * MiB;
constexpr size_t WS_ACT = 202 * MiB;
constexpr size_t WS_OATT = WS_ACT, WS_G = WS_ACT + 264 * MiB;
constexpr size_t WS_U = 565 * MiB, WS_Q = 631 * MiB, WS_K = 697 * MiB, WS_V = 763 * MiB, WS_END = 829 * MiB;
static_assert(WS_ROPE + 16384 <= WS_W1A && WS_W1A + (size_t)5632 * 1024 * 2 <= WS_W1B && WS_W1B + (size_t)1024 * 2816 * 2 <= WS_W2A && WS_W2A + (size_t)5632 * 1024 * 2 <= WS_W2B, "ws map 1");
static_assert(WS_W2B + (size_t)1024 * 2816 * 2 <= WS_WIN && WS_WIN + (size_t)2048 * 1024 * 2 <= WS_WOUT && WS_WOUT + (size_t)1024 * 1024 * 2 <= WS_WGLU && WS_WGLU + 512 * 512 * 2 <= WS_E, "ws map 2");
static_assert(WS_E + (size_t)8 * 33 * 64 * 64 * 8 <= WS_HIN && WS_HIN + (size_t)8 * 33 * 64 * 64 * 8 <= WS_XC && WS_XC + (size_t)2048 * 1024 * 4 <= WS_XN, "ws map 3");
static_assert(WS_XN + (size_t)NROWS * 1024 * 2 <= WS_ACT && WS_ACT + (size_t)NROWS * 2816 * 2 <= WS_U && WS_G + (size_t)NROWS * 512 * 2 <= WS_U && WS_OATT + (size_t)NROWS * 1024 * 4 <= WS_G, "ws map 4");
static_assert(WS_U + (size_t)NROWS * 512 * 2 <= WS_Q && WS_V + (size_t)NROWS * 512 * 2 <= WS_END, "ws map 5");

constexpr int LDS_BYTES = 139264;

#define LDS_WAIT() asm volatile("s_waitcnt lgkmcnt(0)" ::: "memory")
__device__ __forceinline__ unsigned f2bf(float f) { unsigned u = __builtin_bit_cast(unsigned, f); return (u + 0x7fffu + ((u >> 16) & 1u)) >> 16; }
__device__ __forceinline__ unsigned pk2(float lo, float hi) { return f2bf(lo) | (f2bf(hi) << 16); }
__device__ __forceinline__ float wave_sum(float v) {
#pragma unroll
    for (int o = 1; o < 64; o <<= 1) v += __shfl_xor(v, o);
    return v;
}

__device__ __forceinline__ double dexp(double x) {
    const double n = __builtin_rint(x * 1.4426950408889634074);
    const double r = __builtin_fma(-n, 1.9082149292705877e-10, __builtin_fma(-n, 0.693147180369123816490, x));
    double p = 1.0 / 87178291200.0;
    p = p * r + 1.0 / 6227020800.0; p = p * r + 1.0 / 479001600.0; p = p * r + 1.0 / 39916800.0; p = p * r + 1.0 / 3628800.0; p = p * r + 1.0 / 362880.0; p = p * r + 1.0 / 40320.0;
    p = p * r + 1.0 / 5040.0; p = p * r + 1.0 / 720.0; p = p * r + 1.0 / 120.0; p = p * r + 1.0 / 24.0; p = p * r + 1.0 / 6.0; p = p * r + 0.5; p = p * r + 1.0; p = p * r + 1.0;
    const long long e = (long long)n + 1023; const double s = __builtin_bit_cast(double, (unsigned long long)e << 52);
    return p * s;
}
__device__ __forceinline__ void dsincos(double y, double& s, double& c) {
    const double k = __builtin_rint(y * 0.15915494309189533577);
    double r = __builtin_fma(-k, 6.283185307179586232, y); r = __builtin_fma(-k, 2.4492935982947064e-16, r);
    const double q = r * 0.125, q2 = q * q;
    double sp = -1.0 / 1307674368000.0; sp = sp * q2 + 1.0 / 6227020800.0; sp = sp * q2 - 1.0 / 39916800.0; sp = sp * q2 + 1.0 / 362880.0; sp = sp * q2 - 1.0 / 5040.0; sp = sp * q2 + 1.0 / 120.0; sp = sp * q2 - 1.0 / 6.0; sp = sp * q2 + 1.0;
    double cp = 1.0 / 20922789888000.0; cp = cp * q2 - 1.0 / 87178291200.0; cp = cp * q2 + 1.0 / 479001600.0; cp = cp * q2 - 1.0 / 3628800.0; cp = cp * q2 + 1.0 / 40320.0; cp = cp * q2 - 1.0 / 720.0; cp = cp * q2 + 1.0 / 24.0; cp = cp * q2 - 0.5; cp = cp * q2 + 1.0;
    double ss = sp * q, cc = cp;
#pragma unroll
    for (int i = 0; i < 3; ++i) { const double s2 = 2.0 * ss * cc, c2 = cc * cc - ss * ss; ss = s2; cc = c2; }
    s = ss; c = cc;
}

__device__ __forceinline__ void transpose_item(const float* W, int K, int N, bf16* WT, int mode, LAS float* scr, int item, int lane) {
    const int nblk = N / 32, kb = item / nblk, nb = item % nblk, k0 = 64 * kb, n0 = 32 * nb;
    { const float* wp = W + (size_t)(k0 + (lane >> 5)) * N + n0 + (lane & 31); float v[32];
#pragma unroll
      for (int i = 0; i < 32; ++i) v[i] = wp[(size_t)(2 * i) * N];
#pragma unroll
      for (int i = 0; i < 32; ++i) scr[(2 * i + (lane >> 5)) * 33 + (lane & 31)] = v[i]; }
    LDS_WAIT(); asm volatile("" ::: "memory");
    const int c = lane & 7;
#pragma unroll
    for (int j = 0; j < 4; ++j) { const int n = (lane >> 3) + 8 * j; const LAS float* s = scr + (8 * c) * 33 + n;
        const int src = n0 + n; int drow = src;
        if (mode == 1) { const int up = src >= DFF ? 1 : 0, ff = src - up * DFF; drow = (ff >> 7) * 256 + up * 128 + (ff & 127); }
        else if (mode == 2) { if (src >= 512 && src < 1536) drow = n0 + 2 * (n & 15) + (n >> 4); }
        v4u o; o.x = pk2(s[0 * 33], s[1 * 33]); o.y = pk2(s[2 * 33], s[3 * 33]); o.z = pk2(s[4 * 33], s[5 * 33]); o.w = pk2(s[6 * 33], s[7 * 33]);
        *(v4u*)(WT + (size_t)drow * K + k0 + 8 * c) = o; }
    LDS_WAIT(); asm volatile("" ::: "memory");
}

template <int MODE>
__device__ __forceinline__ void norm_rows16(const float* src, bf16* dstb, float* dstf, const float* g, const float* shift, const float* scale, int lane) {
    f32x4 gs[4], sh[4];
#pragma unroll
    for (int j = 0; j < 4; ++j) { const int cidx = 4 * lane + 256 * j; const f32x4 gv = *(const f32x4*)(g + cidx);
        if (MODE == 0) { const f32x4 sc = *(const f32x4*)(scale + cidx); gs[j] = gv * (sc + 1.0f); sh[j] = *(const f32x4*)(shift + cidx); } else { gs[j] = gv; sh[j] = (f32x4){0.f, 0.f, 0.f, 0.f}; } }
#pragma unroll 2
    for (int r = 0; r < 16; ++r) {
        const f32x4* xr = (const f32x4*)(src + (size_t)r * DM) + lane;
        f32x4 v[4]; float s = 0.f;
#pragma unroll
        for (int j = 0; j < 4; ++j) { v[j] = xr[64 * j]; s += (v[j].x * v[j].x + v[j].y * v[j].y) + (v[j].z * v[j].z + v[j].w * v[j].w); }
        const float rstd = 1.0f / sqrtf(wave_sum(s) * (1.0f / DM) + 1e-6f);
        if (MODE == 0) {
            unsigned long long* o8 = (unsigned long long*)(dstb + (size_t)r * DM) + lane;
#pragma unroll
            for (int j = 0; j < 4; ++j) { const f32x4 y = v[j] * rstd * gs[j] + sh[j]; o8[64 * j] = (unsigned long long)pk2(y.x, y.y) | ((unsigned long long)pk2(y.z, y.w) << 32); }
        } else {
            f32x4* of = (f32x4*)(dstf + (size_t)r * DM) + lane;
#pragma unroll
            for (int j = 0; j < 4; ++j) of[64 * j] = v[j] * rstd * gs[j];
        }
    }
}

__device__ __forceinline__ int crow16(int r, int hi) { return (r & 3) + 8 * (r >> 2) + 4 * hi; }
typedef float f32x2_t __attribute__((ext_vector_type(2))); typedef __bf16 bf16x2_t __attribute__((ext_vector_type(2)));
__device__ __forceinline__ unsigned cvtpk2(float lo, float hi) { f32x2_t v = {lo, hi}; bf16x2_t b = __builtin_convertvector(v, bf16x2_t); return __builtin_bit_cast(unsigned, b); }

template <bool FULL>
__device__ __forceinline__ void s5_unit(LAS unsigned char* lds, int b, int c, int gq, const bf16* U, const float2* ABAR, const bf16* BBT, const bf16* CM,
                                        const float2* HIN, float2* E, const float* dskip, bf16* G, float* YF) {
    int tid_ = threadIdx.x; asm volatile("" : "+v"(tid_));
    const int lane = tid_ & 63, wave = __builtin_amdgcn_readfirstlane(tid_ >> 6);
    const int g = gq * 8 + wave, hi = lane >> 5, r32 = lane & 31;
    LAS unsigned* scr = (LAS unsigned*)(lds + wave * 8704);
    const size_t r0 = (size_t)b * ROWS_B + (size_t)c * 256;
    const bf16* ubase = U + (r0 + r32) * 512 + g * 16 + hi * 8;
    const int ch = lane & 15; const float dv = dskip[g * 16 + ch];
    const size_t obase = (r0 + (lane >> 4) * 4) * 512 + g * 16 + ch;
    LAS unsigned short* yt_l = (LAS unsigned short*)(lds + 69632 + wave * 8192) + ((lane >> 4) * 4) * 16 + ch;
#pragma unroll
    for (int dir = 0; dir < 2; ++dir) {
        const int dg = dir * 32 + g;
        const float2 ab = ABAR[dg * 64 + lane];
        bf16x8 bb[4], cm[4];
#pragma unroll
        for (int blk = 0; blk < 4; ++blk) bb[blk] = *(const bf16x8*)(BBT + ((size_t)(dg * 4 + blk) * 32 + r32) * 16 + hi * 8);
        if (FULL) {
#pragma unroll
            for (int ks = 0; ks < 4; ++ks) cm[ks] = *(const bf16x8*)(CM + ((size_t)dg * 16 + (lane & 15)) * 128 + ks * 32 + (lane >> 4) * 8);
        }
        const size_t sidx = ((((size_t)b * 33 + c) * 32 + g) * 2 + dir) * 64 + lane;
        float hr = 0.f, hm = 0.f;
        if (FULL) { const float2 h0 = HIN[sidx]; hr = h0.x; hm = h0.y; }
        bf16x8 a_nx = *(const bf16x8*)(ubase + (size_t)(dir == 0 ? 0 : 224) * 512);
#pragma unroll 1
        for (int sb = 0; sb < 8; ++sb) {
            const int tb = dir == 0 ? sb * 32 : (7 - sb) * 32;
            const bf16x8 a = a_nx;
            { const int tn = dir == 0 ? (sb < 7 ? tb + 32 : tb) : (sb < 7 ? tb - 32 : tb); a_nx = *(const bf16x8*)(ubase + (size_t)tn * 512); }
            unsigned short uvv[2][4];
            if (FULL && dir == 1) {
#pragma unroll
                for (int mt = 0; mt < 2; ++mt)
#pragma unroll
                    for (int j = 0; j < 4; ++j) { const size_t idx = obase + (size_t)(tb + mt * 16 + j) * 512; uvv[mt][j] = U[idx]; }
            }
            const f32x16 z = {};
#pragma unroll
            for (int hf = 0; hf < 2; ++hf) {
                const f32x16 c0 = __builtin_amdgcn_mfma_f32_32x32x16_bf16(a, bb[hf], z, 0, 0, 0), c2 = __builtin_amdgcn_mfma_f32_32x32x16_bf16(a, bb[2 + hf], z, 0, 0, 0);
#pragma unroll
                for (int r = 0; r < 16; ++r) { const int row = crow16(r, hi); scr[row * 68 + hf * 32 + r32] = cvtpk2(c0[r], c2[r]); }
            }
            LDS_WAIT(); asm volatile("" ::: "memory");
#pragma unroll
            for (int half = 0; half < 2; ++half) {
                unsigned v[16];
#pragma unroll
                for (int q = 0; q < 16; ++q) { const int t = dir == 0 ? half * 16 + q : 31 - (half * 16 + q); v[q] = scr[t * 68 + lane]; }
#pragma unroll
                for (int q = 0; q < 16; ++q) { const int t = dir == 0 ? half * 16 + q : 31 - (half * 16 + q);
                    const float re = __uint_as_float(v[q] << 16), im = __uint_as_float(v[q] & 0xffff0000u);
                    const float nr = fmaf(ab.x, hr, fmaf(-ab.y, hm, re)), ni = fmaf(ab.x, hm, fmaf(ab.y, hr, im)); hr = nr; hm = ni;
                    if (FULL) scr[t * 68 + lane] = cvtpk2(hr, hm); }
                asm volatile("" ::: "memory");
            }
            if (FULL) {
                LDS_WAIT(); asm volatile("" ::: "memory");
                f32x4 yt[2];
#pragma unroll
                for (int mt = 0; mt < 2; ++mt) { yt[mt] = (f32x4){0.f, 0.f, 0.f, 0.f};
#pragma unroll
                    for (int ks = 0; ks < 4; ++ks) { const bf16x8 hf8 = *(const LAS bf16x8*)((const LAS unsigned char*)scr + (mt * 16 + (lane & 15)) * 272 + ks * 64 + (lane >> 4) * 16);
                        yt[mt] = __builtin_amdgcn_mfma_f32_16x16x32_bf16(hf8, cm[ks], yt[mt], 0, 0, 0); } }
#pragma unroll
                for (int mt = 0; mt < 2; ++mt)
#pragma unroll
                    for (int j = 0; j < 4; ++j) { LAS unsigned short* yp = yt_l + (tb + mt * 16 + j) * 16;
                        if (dir == 0) *yp = (unsigned short)f2bf(yt[mt][j]);
                        else { const float uv = __uint_as_float((unsigned)uvv[mt][j] << 16); const float yv = __uint_as_float((unsigned)*yp << 16) + yt[mt][j] + dv * uv;
                            const float zz = 1.5957691216057308f * (yv + 0.044715f * yv * yv * yv); *yp = (unsigned short)f2bf(yv * pg8::fast_sigmoid(zz)); } }
                LDS_WAIT(); asm volatile("" ::: "memory");
            }
        }
        if (!FULL) E[sidx] = make_float2(hr, hm);
    }
    if (FULL) {
        LDS_WAIT(); asm volatile("" ::: "memory");
        const LAS unsigned char* yb = (const LAS unsigned char*)(lds + 69632 + wave * 8192);
#pragma unroll
        for (int it = 0; it < 8; ++it) { const int row = it * 32 + (lane >> 1), hf = lane & 1;
            const v4u w = *(const LAS v4u*)(yb + row * 32 + hf * 16);
            *(v4u*)(G + (r0 + row) * 512 + g * 16 + hf * 8) = w; }
        LDS_WAIT(); asm volatile("" ::: "memory");
    }
}

__device__ __forceinline__ void cmulf(float ar, float ai, float br, float bi, float& cr, float& ci) { cr = ar * br - ai * bi; ci = ar * bi + ai * br; }
__device__ __forceinline__ void s5_unit_a(LAS unsigned char* lds, int b, int c, int gq, const bf16* U, const float2* ABAR, const bf16* BBT, float2* E) {
    int tid_ = threadIdx.x; asm volatile("" : "+v"(tid_));
    const int lane = tid_ & 63, wave = __builtin_amdgcn_readfirstlane(tid_ >> 6);
    const int g = gq * 8 + wave, hi = lane >> 5, r32 = lane & 31;
    const size_t r0 = (size_t)b * ROWS_B + (size_t)c * 256;
    LAS unsigned char* ut = lds + wave * 8192;
    { v4u t8[8];
#pragma unroll
      for (int it = 0; it < 8; ++it) t8[it] = *(const v4u*)(U + (r0 + it * 32 + (lane >> 1)) * 512 + g * 16 + (lane & 1) * 8);
#pragma unroll
      for (int it = 0; it < 8; ++it) *(LAS v4u*)(ut + (it * 32 + (lane >> 1)) * 32 + (lane & 1) * 16) = t8[it]; }
    LDS_WAIT(); asm volatile("" ::: "memory");
    const LAS unsigned char* ua = ut + r32 * 32 + hi * 16;
#pragma unroll
    for (int dir = 0; dir < 2; ++dir) {
        const int dg = dir * 32 + g;
        bf16x8 bb[4];
#pragma unroll
        for (int blk = 0; blk < 4; ++blk) bb[blk] = *(const bf16x8*)(BBT + ((size_t)(dg * 4 + blk) * 32 + r32) * 16 + hi * 8);
        float wr[2][16], wi[2][16], a32r[2], a32i[2];
#pragma unroll
        for (int hf = 0; hf < 2; ++hf) {
            const float2 ab = ABAR[dg * 64 + hf * 32 + r32];
            float qr[4], qi[4], orr[4], oi[4];
            qr[0] = 1.f; qi[0] = 0.f; qr[1] = ab.x; qi[1] = ab.y; cmulf(qr[1], qi[1], ab.x, ab.y, qr[2], qi[2]); cmulf(qr[2], qi[2], ab.x, ab.y, qr[3], qi[3]);
            float a4r, a4i; cmulf(qr[2], qi[2], qr[2], qi[2], a4r, a4i);
            orr[0] = 1.f; oi[0] = 0.f; cmulf(a4r, a4i, a4r, a4i, orr[1], oi[1]); cmulf(orr[1], oi[1], orr[1], oi[1], orr[2], oi[2]); cmulf(orr[2], oi[2], orr[1], oi[1], orr[3], oi[3]);
            cmulf(orr[2], oi[2], orr[2], oi[2], a32r[hf], a32i[hf]);
            const bool use4 = dir == 0 ? (hi == 0) : (hi != 0);
            const float br = use4 ? a4r : 1.f, bi = use4 ? a4i : 0.f;
#pragma unroll
            for (int r = 0; r < 16; ++r) { const int jq = dir == 0 ? 3 - (r & 3) : (r & 3), jo = dir == 0 ? 3 - (r >> 2) : (r >> 2);
                float tr, ti; cmulf(qr[jq], qi[jq], orr[jo], oi[jo], tr, ti); cmulf(tr, ti, br, bi, wr[hf][r], wi[hf][r]); }
        }
        float hr[2] = {0.f, 0.f}, hm[2] = {0.f, 0.f};
#pragma unroll 1
        for (int sb = 0; sb < 8; ++sb) {
            const bf16x8 a = *(const LAS bf16x8*)(ua + (dir == 0 ? sb * 32 : (7 - sb) * 32) * 32);
            const f32x16 z = {};
#pragma unroll
            for (int hf = 0; hf < 2; ++hf) {
                const f32x16 cre = __builtin_amdgcn_mfma_f32_32x32x16_bf16(a, bb[hf], z, 0, 0, 0), cim = __builtin_amdgcn_mfma_f32_32x32x16_bf16(a, bb[2 + hf], z, 0, 0, 0);
                float er = 0.f, ei = 0.f;
#pragma unroll
                for (int r = 0; r < 16; ++r) { er = fmaf(wr[hf][r], cre[r], fmaf(-wi[hf][r], cim[r], er)); ei = fmaf(wr[hf][r], cim[r], fmaf(wi[hf][r], cre[r], ei)); }
                er += __shfl_xor(er, 32); ei += __shfl_xor(ei, 32);
                const float nr = fmaf(a32r[hf], hr[hf], fmaf(-a32i[hf], hm[hf], er)), ni = fmaf(a32r[hf], hm[hf], fmaf(a32i[hf], hr[hf], ei));
                hr[hf] = nr; hm[hf] = ni;
            }
        }
        const size_t sidx = ((((size_t)b * 33 + c) * 32 + g) * 2 + dir) * 64 + lane;
        E[sidx] = hi ? make_float2(hr[1], hm[1]) : make_float2(hr[0], hm[0]);
    }
    LDS_WAIT(); asm volatile("" ::: "memory");
}

typedef GAS unsigned gu32;
#define RLX_AGENT __ATOMIC_RELAXED, __HIP_MEMORY_SCOPE_AGENT
#define XB_TMO      128
#define XB_XCNT(j)  (256  + 64 * (j))
#define XB_XSUB(j)  (1280 + 64 * (j))
#define XB_XGEN(j)  (2304 + 64 * (j))
#define XB_TOP      3328
#define XB_TOPGEN   3392
#define XCD_BAR_WORDS 3456
#define XB_SPIN_CAP (1u << 18)

__device__ __forceinline__ unsigned xb_ld(unsigned* p)              { return __hip_atomic_load(p, __ATOMIC_RELAXED, __HIP_MEMORY_SCOPE_AGENT); }
__device__ __forceinline__ unsigned xb_add(unsigned* p, unsigned v) { return __hip_atomic_fetch_add(p, v, __ATOMIC_RELAXED, __HIP_MEMORY_SCOPE_AGENT); }
__device__ __forceinline__ unsigned xb_xcc_id() { return (unsigned)__builtin_amdgcn_s_getreg((3 << 11) | 20) & 0xFu; }
#define XB_SPIN(cond, bar) do { unsigned _sp = 0; while (cond) { __builtin_amdgcn_s_sleep(1); \
    if ((++_sp & 255u) == 0u) { if (xb_ld(&(bar)[XB_TMO])) break; if (_sp > XB_SPIN_CAP) { atomicAdd(&(bar)[XB_TMO], 1u); break; } } } } while (0)

struct XcdBarrier {
    unsigned* bar; unsigned x;
    volatile LAS unsigned* st;
};

__device__ __forceinline__ XcdBarrier xcd_barrier_post(unsigned* bar, volatile LAS unsigned* st) {
    XcdBarrier b; b.bar = bar; b.x = xb_xcc_id(); b.st = st;
    if (threadIdx.x == 0) (void)xb_add(&bar[XB_XCNT(b.x)], 1u);
    return b;
}
__device__ __forceinline__ void xcd_barrier_complete(unsigned* bar, unsigned x, unsigned& nloc, unsigned& nx) {
    const unsigned G = gridDim.x * gridDim.y * gridDim.z;
    unsigned sum, cnt, mine, sp = 0u;
    for (;;) {
        sum = 0u; cnt = 0u; mine = 0u;
#pragma unroll
        for (unsigned j = 0; j < 16; ++j) { const unsigned c = xb_ld(&bar[XB_XCNT(j)]); sum += c; cnt += (c > 0u) ? 1u : 0u; mine = (j == x) ? c : mine; }
        if (sum == G) break;
        __builtin_amdgcn_s_sleep(1);
        if ((++sp & 255u) == 0u) { if (xb_ld(&bar[XB_TMO])) break; if (sp > XB_SPIN_CAP) { atomicAdd(&bar[XB_TMO], 1u); break; } }
    }
    nloc = mine > 0u ? mine : 1u; nx = cnt > 0u ? cnt : 1u;
}

__device__ __forceinline__ void xcd_barrier(const XcdBarrier& b) {
    asm volatile("s_waitcnt vmcnt(0)" ::: "memory");
    __syncthreads();
    if (threadIdx.x == 0) {
        unsigned* bar = b.bar;
        __builtin_amdgcn_s_waitcnt(0);
        unsigned nloc = b.st[0], nx = b.st[1];
        if (nloc == 0u) { xcd_barrier_complete(bar, b.x, nloc, nx); b.st[0] = nloc; b.st[1] = nx; }
        const unsigned old = xb_add(&bar[XB_XSUB(b.x)], 1u);
        const unsigned gen = old / nloc;
        if (old + 1u == (gen + 1u) * nloc) {
            __builtin_amdgcn_fence(__ATOMIC_RELEASE, "agent");
            asm volatile("s_waitcnt vmcnt(0)" ::: "memory");
            const unsigned og = xb_add(&bar[XB_TOP], 1u);
            const unsigned tg = og / nx;
            if (og + 1u == (tg + 1u) * nx) xb_add(&bar[XB_TOPGEN], 1u);
            else XB_SPIN(xb_ld(&bar[XB_TOPGEN]) == tg, bar);
            __builtin_amdgcn_fence(__ATOMIC_ACQUIRE, "agent");
            xb_add(&bar[XB_XGEN(b.x)], 1u);
            asm volatile("s_waitcnt vmcnt(0)" ::: "memory");
        } else {
            XB_SPIN(xb_ld(&bar[XB_XGEN(b.x)]) == gen, bar);
            __builtin_amdgcn_fence(__ATOMIC_ACQUIRE, "agent");
            asm volatile("s_waitcnt vmcnt(0)" ::: "memory");
        }
    }
    __syncthreads();
}

#ifndef PHMASK
#define PHMASK 0xFFFFF
#endif
#define PH(k) if ((PHMASK >> (k)) & 1)
struct Args { const float* in[25]; float* out; unsigned char* ws; };
__device__ __forceinline__ const float* karg(int i) {
    unsigned off = (unsigned)i * 8u; asm volatile("" : "+s"(off));
    return *(const float* const __attribute__((address_space(4)))*)((const char __attribute__((address_space(4)))*)__builtin_amdgcn_kernarg_segment_ptr() + off);
}

__global__ void __launch_bounds__(NTHR, 2) hymba_fwd(Args a) {
    extern __shared__ __attribute__((aligned(16))) unsigned char lds[];
    cg::grid_group grid = cg::this_grid();
    const int tid = threadIdx.x, lane = tid & 63, wave = __builtin_amdgcn_readfirstlane(tid >> 6);
    const int G = gridDim.x, bx = blockIdx.x;
    const int vcu = (G % 8 == 0) ? (bx % 8) * (G / 8) + bx / 8 : bx;
    const int gw = vcu * NWAVES + wave, NGW = G * NWAVES;
    LAS unsigned char* ldsl = (LAS unsigned char*)lds;
#define KIN(i) karg(i)
#define ws_p ((unsigned char*)karg(26))
#define out_p ((float*)karg(25))
#define x_in KIN(0)
#define cvec KIN(1)
#define ctx KIN(2)
#define c_ctx KIN(3)
#define w_mod KIN(4)
#define b_mod KIN(5)
#define norm_g KIN(6)
#define ffn_w_in KIN(7)
#define ffn_w_out KIN(8)
#define w_in KIN(9)
#define w_out KIN(10)
#define ssm_a_re KIN(11)
#define ssm_a_im KIN(12)
#define ssm_log_dt KIN(13)
#define ssm_b_re KIN(14)
#define ssm_b_im KIN(15)
#define ssm_c_re KIN(16)
#define ssm_c_im KIN(17)
#define ssm_d KIN(18)
#define w_glu KIN(19)
#define b_glu KIN(20)
#define lam_q KIN(21)
#define lam_k KIN(22)
#define subln_g KIN(23)
#define final_g KIN(24)
#define MISC ((float*)(ws_p + WS_CTL))
#define MOD ((float*)(ws_p + WS_MOD))
#define ABAR ((float2*)(ws_p + WS_ABAR))
#define APOW ((float2*)(ws_p + WS_APOW))
#define BBT ((bf16*)(ws_p + WS_BBT))
#define CM ((bf16*)(ws_p + WS_CM))
#define ROPE ((float*)(ws_p + WS_ROPE))
#define W1A ((bf16*)(ws_p + WS_W1A))
#define W1B ((bf16*)(ws_p + WS_W1B))
#define W2A ((bf16*)(ws_p + WS_W2A))
#define W2B ((bf16*)(ws_p + WS_W2B))
#define WIN ((bf16*)(ws_p + WS_WIN))
#define WOUT ((bf16*)(ws_p + WS_WOUT))
#define WGLU ((bf16*)(ws_p + WS_WGLU))
#define EST ((float2*)(ws_p + WS_E))
#define HIN ((float2*)(ws_p + WS_HIN))
#define XC ((float*)(ws_p + WS_XC))
#define XN ((bf16*)(ws_p + WS_XN))
#define SA ((bf16*)(ws_p + WS_XN))
#define ACT ((bf16*)(ws_p + WS_ACT))
#define OATT ((float*)(ws_p + WS_OATT))
#define GB ((bf16*)(ws_p + WS_G))
#define YFB ((float*)(ws_p + WS_OATT + 132 * MiB))
#define BIAS1 ((float*)(ws_p + WS_BIAS1))
#define BIAS2 ((float*)(ws_p + WS_BIAS2))
#define RSS1 ((float*)(ws_p + WS_RSS1))
#define RSS2 ((float*)(ws_p + WS_RSS2))
#define XN2 ((bf16*)(ws_p + WS_U))
#define UB ((bf16*)(ws_p + WS_U))
#define QB ((bf16*)(ws_p + WS_Q))
#define KB ((bf16*)(ws_p + WS_K))
#define VB ((bf16*)(ws_p + WS_V))
    (void)a;
    { volatile LAS unsigned* st0 = (volatile LAS unsigned*)(ldsl + 138240); if (tid < 4) st0[tid] = 0u; }
    __syncthreads();
    XcdBarrier xbar = xcd_barrier_post((unsigned*)(ws_p + WS_BAR), (volatile LAS unsigned*)(ldsl + 138240));
#define GSYNC() xcd_barrier(xbar)

    PH(0) {
        if (bx < 288) {
            LAS float* sl = (LAS float*)ldsl; LAS float* part = (LAS float*)(ldsl + 36864);
            for (int i = tid; i < 9 * DM; i += NTHR) { const float v = i < 8 * DM ? cvec[i] : c_ctx[i - 8 * DM]; sl[i] = v / (1.0f + __expf(-v)); }
            __syncthreads();
            for (int unit = bx; unit < 288; unit += G) {
                const int cl = tid & 31, kg = tid >> 5, k0 = kg * 64; const float* wp = w_mod + (size_t)k0 * NMODV + unit * 32 + cl;
                float acc[9];
#pragma unroll
                for (int i = 0; i < 9; ++i) acc[i] = 0.f;
                float wv[64];
#pragma unroll
                for (int kk = 0; kk < 64; ++kk) wv[kk] = wp[(size_t)kk * NMODV];
#pragma unroll
                for (int kk = 0; kk < 64; kk += 4) {
#pragma unroll
                    for (int i = 0; i < 9; ++i) { const f32x4 sv = *(const LAS f32x4*)(sl + i * DM + k0 + kk); acc[i] = fmaf(sv.x, wv[kk], fmaf(sv.y, wv[kk + 1], fmaf(sv.z, wv[kk + 2], fmaf(sv.w, wv[kk + 3], acc[i])))); }
                }
#pragma unroll
                for (int i = 0; i < 9; ++i) part[(kg * 9 + i) * 32 + cl] = acc[i];
                __syncthreads();
                if (tid < 288) { const int i = tid >> 5; float sum = 0.f;
#pragma unroll
                    for (int k = 0; k < 16; ++k) sum += part[(k * 9 + i) * 32 + cl];
                    MOD[i * NMODV + unit * 32 + cl] = sum + b_mod[unit * 32 + cl]; }
                __syncthreads();
            }
        }
        __syncthreads();
        {
            LAS float* scr = (LAS float*)(ldsl + wave * 16384);
            constexpr int I_1A = (DM / 64) * (2 * DFF / 32);
            for (int it = gw; it < I_1A; it += NGW) transpose_item(ffn_w_in, DM, 2 * DFF, W1A, 1, scr, it, lane);
        }
        const int gt = bx * NTHR + tid, NT_ALL = G * NTHR;
        for (int i = gt; i < 2 * 32 * 64; i += NT_ALL) {
            const int p = i & 63, dg = i >> 6;
            const double dt = dexp((double)ssm_log_dt[dg]), are = (double)ssm_a_re[i], aim = (double)ssm_a_im[i];
            double s1, c1, s2, c2; dsincos(dt * aim, s1, c1); dsincos(256.0 * dt * aim, s2, c2);
            const double mag = dexp(dt * are), mag2 = dexp(256.0 * dt * are);
            const double abr = mag * c1, abi = mag * s1;
            ABAR[i] = make_float2((float)abr, (float)abi); APOW[i] = make_float2((float)(mag2 * c2), (float)(mag2 * s2));
            const double zr = abr - 1.0, zi = abi, den = are * are + aim * aim;
            const double cr = (zr * are + zi * aim) / den, ci = (zi * are - zr * aim) / den;
            const float* bre = ssm_b_re + (size_t)i * 16; const float* bim = ssm_b_im + (size_t)i * 16;
            bf16* dre = BBT + ((size_t)(dg * 4 + (p >> 5)) * 32 + (p & 31)) * 16; bf16* dim = BBT + ((size_t)(dg * 4 + 2 + (p >> 5)) * 32 + (p & 31)) * 16;
#pragma unroll
            for (int h = 0; h < 16; ++h) { const double br = (double)bre[h], bi = (double)bim[h]; dre[h] = (bf16)f2bf((float)(cr * br - ci * bi)); dim[h] = (bf16)f2bf((float)(cr * bi + ci * br)); }
        }
        for (int i = gt; i < 2 * 32 * 16 * 64; i += NT_ALL) {
            const int p = i & 63, dgh = i >> 6;
            ((unsigned*)CM)[(size_t)dgh * 64 + p] = pk2(ssm_c_re[i], -ssm_c_im[i]);
        }
        for (int i = gt; i < 128 * 16; i += NT_ALL) {
            const int f = i & 15, pos = i >> 4;
            const double inv = dexp(-(double)f * (9.210340371976182736 / 16.0)); double s, c; dsincos((double)pos * inv, s, c);
            ROPE[2 * i] = (float)c; ROPE[2 * i + 1] = (float)s;
        }
        for (int i = gt; i < NROWS; i += NT_ALL) { RSS1[i] = 0.f; RSS2[i] = 0.f; }
        if (gt == 0) { float s0 = 0.f, s1 = 0.f; for (int d = 0; d < 64; ++d) { s0 += lam_q[d] * lam_k[d]; s1 += lam_q[64 + d] * lam_k[64 + d]; } MISC[0] = expf(s0) - expf(s1) + 0.2f; }
    }
    grid.sync();

#define NORM_PASS(SRC_LAT, SRC_CTX, NIDX, LATONLY) do { int tid_l = threadIdx.x; asm volatile("" : "+v"(tid_l)); const int lane_l = tid_l & 63, gw_l = vcu * NWAVES + __builtin_amdgcn_readfirstlane(tid_l >> 6); \
        for (int it = gw_l; it < NROWS / 16; it += NGW) { const int r0 = it * 16, pm = r0 >> 8, b = pm / TILES_B, jt = pm - b * TILES_B, rl = r0 & 255; \
            if ((LATONLY) && jt == 32) continue; \
            const float* src = jt < 32 ? (SRC_LAT) + ((size_t)b * SEQ + jt * 256 + rl) * DM : (SRC_CTX) + ((size_t)b * CTXL + rl) * DM; \
            const float* mv = MOD + (jt < 32 ? b : 8) * NMODV + 3 * (NIDX) * DM; \
            norm_rows16<0>(src, XN + (size_t)r0 * DM, nullptr, norm_g + (NIDX) * DM, mv, mv + DM, lane_l); } } while (0)

    PH(1) {
        if (bx < 240) {
            const bool isin = bx < 64; const int unit = isin ? bx : bx - 64, N = isin ? 2048 : 2 * DFF, soff = isin ? 3 * DM : 6 * DM;
            const float* W = isin ? w_in : ffn_w_in + (size_t)DM * 2 * DFF; float* BO = isin ? BIAS1 : BIAS2;
            LAS float* sl = (LAS float*)ldsl; LAS float* part = (LAS float*)(ldsl + 36864);
            for (int i = tid; i < 9 * DM; i += NTHR) sl[i] = MOD[(i >> 10) * NMODV + soff + (i & 1023)];
            __syncthreads();
            const int cl = tid & 31, kg = tid >> 5, k0 = kg * 64; const float* wp = W + (size_t)k0 * N + unit * 32 + cl;
            float acc[9];
#pragma unroll
            for (int i = 0; i < 9; ++i) acc[i] = 0.f;
            float wv[64];
#pragma unroll
            for (int kk = 0; kk < 64; ++kk) wv[kk] = wp[(size_t)kk * N];
#pragma unroll
            for (int kk = 0; kk < 64; kk += 4) {
#pragma unroll
                for (int i = 0; i < 9; ++i) { const f32x4 sv = *(const LAS f32x4*)(sl + i * DM + k0 + kk); acc[i] = fmaf(sv.x, wv[kk], fmaf(sv.y, wv[kk + 1], fmaf(sv.z, wv[kk + 2], fmaf(sv.w, wv[kk + 3], acc[i])))); }
            }
#pragma unroll
            for (int i = 0; i < 9; ++i) part[(kg * 9 + i) * 32 + cl] = acc[i];
            __syncthreads();
            if (tid < 288) { const int i = tid >> 5; float sum = 0.f;
#pragma unroll
                for (int k = 0; k < 16; ++k) sum += part[(k * 9 + i) * 32 + cl];
                const int src = unit * 32 + cl; int drow = src;
                if (isin) { if (src >= 512 && src < 1536) drow = unit * 32 + 2 * (cl & 15) + (cl >> 4); }
                else { const int up = src >= DFF ? 1 : 0, ff = src - up * DFF; drow = (ff >> 7) * 256 + up * 128 + (ff & 127); }
                BO[i * N + drow] = sum; }
            __syncthreads();
        }
        NORM_PASS(x_in, ctx, 0, false);
    }
    GSYNC();
    PH(2) { pg8::Gemm g{XN, W1A, NROWS, 2 * DFF, DM}; pg8::TileOrder S; S.init(264, 22, G, bx, 0); pg8::EpiSwiglu E{ACT, DFF, nullptr, nullptr};
      pg8::gemm_phase<pg8::EpiSwiglu, pg8::TileOrder, true, true>(ldsl, g, S, E);
      if (bx >= 176) {
          int tid_l = threadIdx.x; asm volatile("" : "+v"(tid_l)); const int lane_l = tid_l & 63, wave_l = __builtin_amdgcn_readfirstlane(tid_l >> 6);
          LAS float* scr = (LAS float*)(ldsl + wave_l * 16384);
          constexpr int I_1B = (DFF / 64) * (DM / 32);
          for (int it = (bx - 176) * NWAVES + wave_l; it < I_1B; it += (G - 176) * NWAVES) transpose_item(ffn_w_out, DFF, DM, W1B, 0, scr, it, lane_l);
      } }
    GSYNC();
    PH(3) { pg8::Gemm g{ACT, W1B, NROWS, DM, DFF}; pg8::TileOrder S; S.init(264, 4, G, bx, 0); pg8::EpiResidNorm E{x_in, ctx, out_p, XC, MOD, 2 * DM, 1, norm_g + DM, 4 * DM, XN, RSS1};
      pg8::gemm_phase<pg8::EpiResidNorm, pg8::TileOrder, true, true>(ldsl, g, S, E);
      if (bx >= 32) {
          int tid_l = threadIdx.x; asm volatile("" : "+v"(tid_l)); const int lane_l = tid_l & 63, wave_l = __builtin_amdgcn_readfirstlane(tid_l >> 6);
          LAS float* scr = (LAS float*)(ldsl + wave_l * 16384);
          constexpr int I_1A = (DM / 64) * (2 * DFF / 32), I_1B = (DFF / 64) * (DM / 32), I_OUT = (DM / 64) * (DM / 32), I_GLU = (512 / 64) * (512 / 32), I_IN = (DM / 64) * (2048 / 32);
          for (int it = (bx - 32) * NWAVES + wave_l; it < I_IN + I_1A + I_1B + I_OUT + I_GLU; it += (G - 32) * NWAVES) {
              int r = it;
              if (r < I_IN) { transpose_item(w_in, DM, 2048, WIN, 2, scr, r, lane_l); continue; } r -= I_IN;
              if (r < I_1A) { transpose_item(ffn_w_in + (size_t)DM * 2 * DFF, DM, 2 * DFF, W2A, 1, scr, r, lane_l); continue; } r -= I_1A;
              if (r < I_1B) { transpose_item(ffn_w_out + (size_t)DFF * DM, DFF, DM, W2B, 0, scr, r, lane_l); continue; } r -= I_1B;
              if (r < I_OUT) { transpose_item(w_out, DM, DM, WOUT, 0, scr, r, lane_l); continue; } r -= I_OUT;
              transpose_item(w_glu, 512, 512, WGLU, 0, scr, r, lane_l);
          }
      } }
    GSYNC();
    PH(5) { pg8::Gemm g{XN, WIN, NROWS, 2048, DM}; pg8::TileOrder S; S.init(264, 8, G, bx, 0); pg8::EpiInproj E{UB, QB, KB, VB, ROPE, RSS1, BIAS1};
      pg8::gemm_phase<pg8::EpiInproj, pg8::TileOrder, true, true>(ldsl, g, S, E); }
    GSYNC();
    PH(6) for (int un = vcu; un < 8 * 33 * 4; un += G) { const int gq = un & 3, bc = un >> 2, b = bc / 33, c = bc - b * 33;
        s5_unit_a(ldsl, b, c, gq, UB, ABAR, BBT, EST); }
    GSYNC();
    PH(7) if (bx < 64) {
        int tid_c = threadIdx.x; asm volatile("" : "+v"(tid_c));
        const int i = bx * NTHR + tid_c;
        const int p = i & 63, dir = (i >> 6) & 1, g = (i >> 7) & 31, b = i >> 12;
        const float2 ap = APOW[(dir * 32 + g) * 64 + p];
#define SIDX(cc) (((((size_t)b * 33 + (cc)) * 32 + g) * 2 + dir) * 64 + p)
        float2 h = EST[SIDX(32)];
        if (dir == 0) { HIN[SIDX(0)] = h; for (int c = 0; c < 31; ++c) { const float2 e = EST[SIDX(c)]; const float nr = fmaf(ap.x, h.x, fmaf(-ap.y, h.y, e.x)), ni = fmaf(ap.x, h.y, fmaf(ap.y, h.x, e.y)); h = make_float2(nr, ni); HIN[SIDX(c + 1)] = h; } }
        else { HIN[SIDX(31)] = h; for (int c = 31; c > 0; --c) { const float2 e = EST[SIDX(c)]; const float nr = fmaf(ap.x, h.x, fmaf(-ap.y, h.y, e.x)), ni = fmaf(ap.x, h.y, fmaf(ap.y, h.x, e.y)); h = make_float2(nr, ni); HIN[SIDX(c - 1)] = h; } }
#undef SIDX
    }
    PH(8) {
        const float lam = MISC[0];
        unsigned redo_mask = 0u;
        {
        int k_ = 0;
        for (int un = vcu; un < 8 * 4 * 32; un += G, ++k_) {
            const int qb = un & 31, bh = un >> 5, b = bh >> 2, h = bh & 3;
            const size_t rb = (size_t)b * ROWS_B, rq = rb + (size_t)qb * 256;
            const attn::bf16_t* q0 = QB + rq * 512 + h * 128; const attn::bf16_t* k0 = KB + rb * 512 + h * 128; const attn::bf16_t* v0 = VB + rb * 512 + h * 128;
            float* st = OATT + rq * 512 + h * 128; attn::bf16_t* so = SA + rq * 1024 + 512 + h * 128;
            bool redo = attn::body<0, false>(q0, k0, v0, st, nullptr, lam, subln_g, ROWS_B, (char*)lds);
            if (!redo) redo = attn::body<1, false>(q0 + 64, k0 + 64, v0, st, so, lam, subln_g, ROWS_B, (char*)lds);
            if (redo) redo_mask |= 1u << k_;
        }
        }
        if (redo_mask) {
            int k_ = 0;
            for (int un = vcu; un < 8 * 4 * 32; un += G, ++k_) {
                if (!((redo_mask >> k_) & 1u)) continue;
                const int qb = un & 31, bh = un >> 5, b = bh >> 2, h = bh & 3;
                const size_t rb = (size_t)b * ROWS_B, rq = rb + (size_t)qb * 256;
                const attn::bf16_t* q0 = QB + rq * 512 + h * 128; const attn::bf16_t* k0 = KB + rb * 512 + h * 128; const attn::bf16_t* v0 = VB + rb * 512 + h * 128;
                float* st = OATT + rq * 512 + h * 128; attn::bf16_t* so = SA + rq * 1024 + 512 + h * 128;
                (void)attn::body<0, true>(q0, k0, v0, st, nullptr, lam, subln_g, ROWS_B, (char*)lds);
                (void)attn::body<1, true>(q0 + 64, k0 + 64, v0, st, so, lam, subln_g, ROWS_B, (char*)lds);
            }
        }
    }
    GSYNC();
    PH(9) for (int un = vcu; un < 8 * 32 * 4; un += G) { const int gq = un & 3, bc = un >> 2, b = bc >> 5, c = bc & 31;
        s5_unit<true>(ldsl, b, c, gq, UB, ABAR, BBT, CM, HIN, EST, ssm_d, GB, YFB); }
    GSYNC();
    PH(10) { pg8::Gemm g{GB, WGLU, NROWS, 512, 512}; pg8::TileOrder S; S.init(256, 2, G, bx, 1); pg8::EpiGlu E{GB, b_glu, SA};
      pg8::gemm_phase<pg8::EpiGlu, pg8::TileOrder, true, true>(ldsl, g, S, E); }
    GSYNC();
    PH(12) { pg8::Gemm g{SA, WOUT, NROWS, DM, DM}; pg8::TileOrder S; S.init(256, 4, G, bx, 1); pg8::EpiResidNorm E{out_p, XC, out_p, XC, MOD, 5 * DM, 0, norm_g + 2 * DM, 7 * DM, XN2, RSS2};
      pg8::gemm_phase<pg8::EpiResidNorm, pg8::TileOrder, true, true>(ldsl, g, S, E); }
    GSYNC();
    PH(14) { pg8::Gemm g{XN2, W2A, NROWS, 2 * DFF, DM}; pg8::TileOrder S; S.init(256, 22, G, bx, 1); pg8::EpiSwiglu E{ACT, DFF, RSS2, BIAS2};
      pg8::gemm_phase<pg8::EpiSwiglu, pg8::TileOrder, true, true>(ldsl, g, S, E); }
    GSYNC();
    PH(15) { pg8::Gemm g{ACT, W2B, NROWS, DM, DFF}; pg8::TileOrder S; S.init(256, 4, G, bx, 1); pg8::EpiResid E{out_p, XC, out_p, XC, MOD, 8 * DM, 0.5f};
      pg8::gemm_phase<pg8::EpiResid, pg8::TileOrder, true, true>(ldsl, g, S, E); }
    GSYNC();
    PH(16) { int tid_l = threadIdx.x; asm volatile("" : "+v"(tid_l)); const int lane_l = tid_l & 63, gw_l = vcu * NWAVES + __builtin_amdgcn_readfirstlane(tid_l >> 6);
        for (int it = gw_l; it < NB * SEQ / 16; it += NGW) norm_rows16<1>(out_p + (size_t)it * 16 * DM, nullptr, out_p + (size_t)it * 16 * DM, final_g, nullptr, nullptr, lane_l); }
#undef NORM_PASS
}

extern "C" void kernel_launch(void* const* d_in, const int* in_sizes, int n_in, void* d_out, int out_size, void* d_ws, size_t ws_size, hipStream_t stream) {
    static int grid = 0;
    if (grid == 0) {
        if (n_in != 25 || in_sizes[0] != NB * SEQ * DM || out_size != NB * SEQ * DM || ws_size < WS_END) {
            fprintf(stderr, "kernel_launch: shape mismatch (n_in %d, in0 %d, out %d, ws %zu, need %zu); nothing launched\n", n_in, n_in > 0 ? in_sizes[0] : -1, out_size, ws_size, (size_t)WS_END); grid = -1; return; }
        int dev = 0, cus = 0, per_cu = 0;
        if (hipGetDevice(&dev) != hipSuccess || hipDeviceGetAttribute(&cus, hipDeviceAttributeMultiprocessorCount, dev) != hipSuccess) { grid = -1; return; }
        if (hipFuncSetAttribute((const void*)hymba_fwd, hipFuncAttributeMaxDynamicSharedMemorySize, LDS_BYTES) != hipSuccess) { fprintf(stderr, "kernel_launch: hipFuncSetAttribute failed\n"); grid = -1; return; }
        if (hipOccupancyMaxActiveBlocksPerMultiprocessor(&per_cu, (const void*)hymba_fwd, NTHR, LDS_BYTES) != hipSuccess || per_cu < 1) { fprintf(stderr, "kernel_launch: occupancy query says %d\n", per_cu); per_cu = 1; }
        (void)hipGetLastError();
        grid = cus * (per_cu > 1 ? 1 : per_cu);
        if (grid != 256) fprintf(stderr, "kernel_launch: grid %d (expected 256)\n", grid);
    }
    if (grid < 0) return;
    (void)hipMemsetAsync((char*)d_ws + WS_BAR, 0, BAR_ZERO_BYTES, stream);
    Args a{};
    for (int i = 0; i < 25; ++i) a.in[i] = (const float*)d_in[i];
    a.out = (float*)d_out; a.ws = (unsigned char*)d_ws;
    void* args[] = {&a};
    const hipError_t e = hipLaunchCooperativeKernel((const void*)hymba_fwd, dim3(grid), dim3(NTHR), args, LDS_BYTES, stream);
    if (e != hipSuccess) fprintf(stderr, "kernel_launch: cooperative launch failed: %s (grid %d)\n", hipGetErrorString(e), grid);
}
```

```cpp
#include <hip/hip_runtime.h>
#include <hip/hip_cooperative_groups.h>
#include <cstdio>
#include <cstdint>
namespace cg = cooperative_groups;
namespace pg8 {
#define PG8_LAS __attribute__((address_space(3)))
typedef unsigned short bf16_t;
typedef short bf16x8 __attribute__((ext_vector_type(8)));
typedef float f32x4 __attribute__((ext_vector_type(4)));
typedef unsigned u32x4 __attribute__((ext_vector_type(4)));
constexpr int BM = 256, BK = 64, HALF = 128, HTB = HALF * BK * 2  , STAGE_BYTES = 8 * HTB, NXCD = 8, WGM = 8;

__host__ __device__ __forceinline__ int lds_byte(int r, int c) { const int st = (r >> 4) * 2 + (c >> 5), rr = r & 15, cc = c & 31, ob = rr * 64 + cc * 2; return st * 1024 + (ob ^ (((ob >> 9) & 1) << 5)); }
__host__ __device__ __forceinline__ void stage_rc(int b, int& R, int& C) { const int st = b / 1024, sb = b % 1024, swz = sb ^ (((sb >> 9) & 1) << 5); R = (st >> 1) * 16 + swz / 64; C = (st & 1) * 32 + (swz % 64) / 2; }
__host__ __device__ __forceinline__ int perm32(int rho) { const int n = rho >> 4, i = rho & 15; return 8 * (i >> 2) + 4 * n + (i & 3); }

struct Unit { int pm, pn; };
struct Gemm { const bf16_t* A; const bf16_t* Bt; int M, N, K; };

__device__ __forceinline__ unsigned cvt_pk_bf16(float lo, float hi) { unsigned r; asm volatile("v_cvt_pk_bf16_f32 %0, %1, %2" : "=v"(r) : "v"(lo), "v"(hi)); return r; }
typedef float f32x2 __attribute__((ext_vector_type(2)));
typedef unsigned u32x2 __attribute__((ext_vector_type(2)));
constexpr int ROWS_B = 8448, TILES_B = 33, NROWS = 8 * ROWS_B;

struct TileOrder {
    int nM, nN, nwg, G, c, lat;
    __device__ __forceinline__ void init(int nM_, int nN_, int G_, int c_, int lat_) { nM = nM_; nN = nN_; nwg = nM_ * nN_; G = G_; c = c_; lat = lat_; }
    __device__ __forceinline__ bool next(int i, Unit& u) const {
        const long L = (long)i * G + c; if (L >= nwg) return false;
        int wgid = (int)L; { const int q = nwg / NXCD, r = nwg % NXCD, xcd = wgid % NXCD, off = wgid / NXCD; wgid = (xcd < r ? xcd * (q + 1) : r * (q + 1) + (xcd - r) * q) + off; }
        const int nig = WGM * nN, gid = wgid / nig, fm = gid * WGM, gsz = (nM - fm) < WGM ? (nM - fm) : WGM;
        const int lm = fm + ((wgid % nig) % gsz); u.pn = (wgid % nig) / gsz; u.pm = lat ? (lm >> 5) * TILES_B + (lm & 31) : lm; return true;
    }
    __device__ __forceinline__ void a_ready(const Unit&) const {}
    __device__ __forceinline__ void done(const Unit&) const {}
};

__device__ __forceinline__ float fast_sigmoid(float z) { return __builtin_amdgcn_rcpf(1.0f + __builtin_amdgcn_exp2f(-1.4426950408889634f * z)); }
__device__ __forceinline__ float bf_lo(unsigned w) { return __uint_as_float(w << 16); }
__device__ __forceinline__ float bf_hi(unsigned w) { return __uint_as_float(w & 0xffff0000u); }

struct EpiSwiglu {
    static constexpr bool PERM = true, AFTER_DRAIN = false;
    bf16_t* O; int ldc; const float* rss; const float* bias;
    __device__ __forceinline__ void operator()(const f32x4 (&acc)[2][2][4][2], const Unit& u, int wr, int wc, int fr, int fq) const {
        const int row0 = u.pm * BM + wr * 64 + fr, col0 = u.pn * HALF + wc * 32 + 8 * fq;
        f32x4 bv[2][2];
#pragma unroll
        for (int bj = 0; bj < 2; ++bj)
#pragma unroll
            for (int n = 0; n < 2; ++n) bv[bj][n] = rss ? *(const f32x4*)(bias + (u.pm / TILES_B) * 5632 + u.pn * BM + bj * HALF + wc * 32 + 8 * fq + 4 * n) : (f32x4){0.f, 0.f, 0.f, 0.f};
#pragma unroll
        for (int ai = 0; ai < 2; ++ai)
#pragma unroll
            for (int m = 0; m < 4; ++m) {
                bf16_t* rowp = O + (size_t)(row0 + ai * HALF + m * 16) * ldc + col0;
                float v[8];
                const float rstd = rss ? 1.0f / sqrtf(rss[row0 + ai * HALF + m * 16] * (1.0f / 1024.0f) + 1e-6f) : 1.0f;
#pragma unroll
                for (int n = 0; n < 2; ++n)
#pragma unroll
                    for (int e = 0; e < 4; ++e) { const float gt = acc[ai][0][m][n][e] * rstd + bv[0][n][e], up = acc[ai][1][m][n][e] * rstd + bv[1][n][e]; v[4 * n + e] = gt * fast_sigmoid(gt) * up; }
                u32x4 w; w.x = cvt_pk_bf16(v[0], v[1]); w.y = cvt_pk_bf16(v[2], v[3]); w.z = cvt_pk_bf16(v[4], v[5]); w.w = cvt_pk_bf16(v[6], v[7]);
                *(u32x4*)rowp = w;
            }
    }
};

struct EpiResid {
    static constexpr bool PERM = true, AFTER_DRAIN = false;
    const float* res_lat; const float* res_ctx; float* out_lat; float* out_ctx; const float* mod; int modoff; float scale; bf16_t* obf;
    __device__ __forceinline__ void operator()(const f32x4 (&acc)[2][2][4][2], const Unit& u, int wr, int wc, int fr, int fq) const {
        const int b = u.pm / TILES_B, jt = u.pm - b * TILES_B;
        const float* rb; float* ob; const float* gv;
        if (jt < 32) { const size_t o = ((size_t)b * 8192 + (size_t)jt * 256) * 1024; rb = res_lat + o; ob = out_lat + o; gv = mod + b * 9216 + modoff; }
        else { const size_t o = (size_t)b * 256 * 1024; rb = res_ctx + o; ob = out_ctx + o; gv = mod + 8 * 9216 + modoff; }
        const int rl = wr * 64 + fr, col0 = u.pn * BM + wc * 32 + 8 * fq;
        const char* rbb = (const char*)rb; char* obb = (char*)ob;
#pragma unroll
        for (int bj = 0; bj < 2; ++bj) {
            const int c = col0 + bj * HALF;
            const f32x4 g0 = *(const f32x4*)(gv + c) * scale, g1 = *(const f32x4*)(gv + c + 4) * scale;
#pragma unroll
            for (int kb = 0; kb < 8; kb += 8) {
                f32x4 x0[8], x1[8];
#pragma unroll
                for (int k = 0; k < 8; ++k) { const int ai = (kb + k) >> 2, m = (kb + k) & 3; const unsigned pb = (unsigned)((rl + ai * HALF + m * 16) * 1024 + c) * 4u; x0[k] = *(const f32x4*)(rbb + pb); x1[k] = *(const f32x4*)(rbb + pb + 16); }
                asm volatile("" ::: "memory");
#pragma unroll
                for (int k = 0; k < 8; ++k) { const int ai = (kb + k) >> 2, m = (kb + k) & 3; const unsigned pb = (unsigned)((rl + ai * HALF + m * 16) * 1024 + c) * 4u;
                    const f32x4 y0 = x0[k] + g0 * acc[ai][bj][m][0], y1 = x1[k] + g1 * acc[ai][bj][m][1];
                    if (obf) { u32x4 w; w.x = cvt_pk_bf16(y0[0], y0[1]); w.y = cvt_pk_bf16(y0[2], y0[3]); w.z = cvt_pk_bf16(y1[0], y1[1]); w.w = cvt_pk_bf16(y1[2], y1[3]);
                        *(u32x4*)(obf + ((size_t)u.pm * BM + rl + ai * HALF + m * 16) * 1024 + c) = w; }
                    else { *(f32x4*)(obb + pb) = y0; *(f32x4*)(obb + pb + 16) = y1; } }
                asm volatile("" ::: "memory");
            }
        }
    }
};

struct EpiResidNorm {
    static constexpr bool PERM = true, AFTER_DRAIN = false;
    const float* res_lat; const float* res_ctx; float* out_lat; float* out_ctx; const float* mod; int gateoff; int half_gate; const float* ng; int scaleoff; bf16_t* XNo; float* rss;
    __device__ __forceinline__ void operator()(const f32x4 (&acc)[2][2][4][2], const Unit& u, int wr, int wc, int fr, int fq) const {
        const int b = u.pm / TILES_B, jt = u.pm - b * TILES_B;
        const float* rb; float* ob; const float* mv;
        if (jt < 32) { const size_t o = ((size_t)b * 8192 + (size_t)jt * 256) * 1024; rb = res_lat + o; ob = out_lat + o; mv = mod + b * 9216; }
        else { const size_t o = (size_t)b * 256 * 1024; rb = res_ctx + o; ob = out_ctx + o; mv = mod + 8 * 9216; }
        const int rl = wr * 64 + fr, col0 = u.pn * BM + wc * 32 + 8 * fq;
        const float scale = half_gate ? 0.5f : 1.0f;
#ifndef EPI_RB
#define EPI_RB 4
#endif
        const char* rbb = (const char*)rb; char* obb = (char*)ob;
        typedef __attribute__((address_space(1))) float gfloat_t;
#pragma unroll
        for (int bj = 0; bj < 2; ++bj) {
            const int c = col0 + bj * HALF;
            const f32x4 g0 = *(const f32x4*)(mv + gateoff + c) * scale, g1 = *(const f32x4*)(mv + gateoff + c + 4) * scale;
            const f32x4 gs0 = *(const f32x4*)(ng + c) * (*(const f32x4*)(mv + scaleoff + c) + 1.0f), gs1 = *(const f32x4*)(ng + c + 4) * (*(const f32x4*)(mv + scaleoff + c + 4) + 1.0f);
#pragma unroll
            for (int kb = 0; kb < 8; kb += EPI_RB) {
                f32x4 x0[EPI_RB], x1[EPI_RB];
#pragma unroll
                for (int k = 0; k < EPI_RB; ++k) { const int ai = (kb + k) >> 2, m = (kb + k) & 3; const unsigned pb = (unsigned)((rl + ai * HALF + m * 16) * 1024 + c) * 4u; x0[k] = *(const f32x4*)(rbb + pb); x1[k] = *(const f32x4*)(rbb + pb + 16); }
                asm volatile("" ::: "memory");
#pragma unroll
                for (int k = 0; k < EPI_RB; ++k) { const int ai = (kb + k) >> 2, m = (kb + k) & 3; const int rr = rl + ai * HALF + m * 16; const unsigned pb = (unsigned)(rr * 1024 + c) * 4u; const size_t prow = (size_t)u.pm * BM + rr;
                    const f32x4 y0 = x0[k] + g0 * acc[ai][bj][m][0], y1 = x1[k] + g1 * acc[ai][bj][m][1];
                    *(f32x4*)(obb + pb) = y0; *(f32x4*)(obb + pb + 16) = y1;
                    float t = (y0[0] * y0[0] + y0[1] * y0[1]) + (y0[2] * y0[2] + y0[3] * y0[3]) + (y1[0] * y1[0] + y1[1] * y1[1]) + (y1[2] * y1[2] + y1[3] * y1[3]);
                    const f32x4 z0 = y0 * gs0, z1 = y1 * gs1;
                    u32x4 w; w.x = cvt_pk_bf16(z0[0], z0[1]); w.y = cvt_pk_bf16(z0[2], z0[3]); w.z = cvt_pk_bf16(z1[0], z1[1]); w.w = cvt_pk_bf16(z1[2], z1[3]);
                    *(u32x4*)(XNo + prow * 1024 + c) = w;
                    t += __shfl_xor(t, 16); t += __shfl_xor(t, 32);
                    if (fq == 0) __hip_atomic_fetch_add((gfloat_t*)(rss + prow), t, __ATOMIC_RELAXED, __HIP_MEMORY_SCOPE_AGENT); }
                asm volatile("" ::: "memory");
            }
        }
    }
};

struct EpiInproj {
    static constexpr bool PERM = true, AFTER_DRAIN = false;
    bf16_t* U; bf16_t* Q; bf16_t* K; bf16_t* V; const float* rope; const float* rss; const float* bias;
    __device__ __forceinline__ void operator()(const f32x4 (&acc)[2][2][4][2], const Unit& u, int wr, int wc, int fr, int fq) const {
        const int sec = u.pn >> 1, jt = u.pm % TILES_B;
        bf16_t* base = sec == 0 ? U : sec == 1 ? Q : sec == 2 ? K : V;
        const bool dorope = (sec == 1 || sec == 2) && jt < 32;
        const float qs = sec == 1 ? 0.125f * 1.4426950408889634f : 1.0f;
        const int col0 = (u.pn & 1) * BM + wc * 32 + 8 * fq, axis = wc & 1;
        const float* bp = bias + (jt < 32 ? u.pm / TILES_B : 8) * 2048 + u.pn * BM + wc * 32 + 8 * fq;
        f32x4 bv[2][2];
#pragma unroll
        for (int bj = 0; bj < 2; ++bj)
#pragma unroll
            for (int n = 0; n < 2; ++n) bv[bj][n] = *(const f32x4*)(bp + bj * HALF + 4 * n);
#pragma unroll
        for (int ai = 0; ai < 2; ++ai)
#pragma unroll
            for (int m = 0; m < 4; ++m) {
                const int rowl = wr * 64 + fr + ai * HALF + m * 16;
                bf16_t* rowp = base + (size_t)(u.pm * BM + rowl) * 512 + col0;
                const float rstd = 1.0f / sqrtf(rss[u.pm * BM + rowl] * (1.0f / 1024.0f) + 1e-6f);
                f32x4 cs0 = {1.f, 0.f, 1.f, 0.f}, cs1 = {1.f, 0.f, 1.f, 0.f};
                if (dorope) { const int t = jt * 256 + rowl, pos = axis ? (t & 63) : (t >> 6); const float* rp = rope + (pos * 16 + 4 * fq) * 2; cs0 = *(const f32x4*)rp; cs1 = *(const f32x4*)(rp + 4); }
#pragma unroll
                for (int bj = 0; bj < 2; ++bj) {
                    const f32x4 a0 = acc[ai][bj][m][0] * rstd + bv[bj][0], a1 = acc[ai][bj][m][1] * rstd + bv[bj][1];
                    float o[8];
                    o[0] = a0[0] * cs0[0] - a0[1] * cs0[1]; o[1] = a0[1] * cs0[0] + a0[0] * cs0[1];
                    o[2] = a0[2] * cs0[2] - a0[3] * cs0[3]; o[3] = a0[3] * cs0[2] + a0[2] * cs0[3];
                    o[4] = a1[0] * cs1[0] - a1[1] * cs1[1]; o[5] = a1[1] * cs1[0] + a1[0] * cs1[1];
                    o[6] = a1[2] * cs1[2] - a1[3] * cs1[3]; o[7] = a1[3] * cs1[2] + a1[2] * cs1[3];
                    u32x4 w; w.x = cvt_pk_bf16(o[0] * qs, o[1] * qs); w.y = cvt_pk_bf16(o[2] * qs, o[3] * qs); w.z = cvt_pk_bf16(o[4] * qs, o[5] * qs); w.w = cvt_pk_bf16(o[6] * qs, o[7] * qs);
                    *(u32x4*)(rowp + bj * HALF) = w;
                }
            }
    }
};

struct EpiGlu {
    static constexpr bool PERM = true, AFTER_DRAIN = false;
    const bf16_t* Gb; const float* bglu; bf16_t* SA;
    __device__ __forceinline__ void operator()(const f32x4 (&acc)[2][2][4][2], const Unit& u, int wr, int wc, int fr, int fq) const {
        const int row0 = u.pm * BM + wr * 64 + fr, col0 = u.pn * BM + wc * 32 + 8 * fq;
        f32x4 bv[2][2];
#pragma unroll
        for (int bj = 0; bj < 2; ++bj)
#pragma unroll
            for (int n = 0; n < 2; ++n) bv[bj][n] = *(const f32x4*)(bglu + col0 + bj * HALF + 4 * n);
#pragma unroll
        for (int ai = 0; ai < 2; ++ai)
#pragma unroll
            for (int m = 0; m < 4; ++m) { const size_t row = (size_t)(row0 + ai * HALF + m * 16);
#pragma unroll
                for (int bj = 0; bj < 2; ++bj) {
                    const u32x4 gw = *(const u32x4*)(Gb + row * 512 + col0 + bj * HALF);
                    const f32x4 z0 = acc[ai][bj][m][0] + bv[bj][0], z1 = acc[ai][bj][m][1] + bv[bj][1];
                    u32x4 w;
                    w.x = cvt_pk_bf16(bf_lo(gw.x) * fast_sigmoid(z0[0]), bf_hi(gw.x) * fast_sigmoid(z0[1]));
                    w.y = cvt_pk_bf16(bf_lo(gw.y) * fast_sigmoid(z0[2]), bf_hi(gw.y) * fast_sigmoid(z0[3]));
                    w.z = cvt_pk_bf16(bf_lo(gw.z) * fast_sigmoid(z1[0]), bf_hi(gw.z) * fast_sigmoid(z1[1]));
                    w.w = cvt_pk_bf16(bf_lo(gw.w) * fast_sigmoid(z1[2]), bf_hi(gw.w) * fast_sigmoid(z1[3]));
                    *(u32x4*)(SA + row * 1024 + col0 + bj * HALF) = w;
                } }
    }
};

template <class Epi, class Sched, bool ALIGN_EPI = false, bool SP2 = false>
__device__ __forceinline__ void gemm_phase(PG8_LAS unsigned char* lds, const Gemm g, const Sched& S, const Epi& E) {
    int tid_ = threadIdx.x; asm volatile("" : "+v"(tid_));
    const int tid = tid_, wid = __builtin_amdgcn_readfirstlane(tid >> 6), lane = tid & 63, wr = wid >> 2, wc = wid & 3, fr = lane & 15, fq = lane >> 4;
    const int K = g.K, nt = K / BK;
    unsigned voffA[2], voffB[2];
#pragma unroll
    for (int i = 0; i < 2; ++i) { int R, C; stage_rc(tid * 16 + i * 8192, R, C); const int Rb = Epi::PERM ? ((R & ~31) + perm32(R & 31)) : R;
        voffA[i] = (unsigned)(R * K + C) * 2u; voffB[i] = (unsigned)(Rb * K + C) * 2u; }
    const size_t kstep = (size_t)(BK * 2);
    const size_t hstep = (size_t)HALF * K * 2;
    const size_t tstep = 2 * hstep;
    const unsigned ldsw = (unsigned)wid * 1024u;
    const int aoff = lds_byte(wr * 64 + fr, fq * 8), boff = lds_byte(wc * 32 + fr, fq * 8);
#define PG8_SA(b, h) (((b) * 2 + (h)) * HTB)
#define PG8_SB(b, h) ((4 + (b) * 2 + (h)) * HTB)
#define PG8_STAGE(bufoff, gbase, voff) do { _Pragma("unroll") for (int _i = 0; _i < 2; ++_i) \
        __builtin_amdgcn_global_load_lds((const unsigned*)((const char*)(gbase) + (voff)[_i]), (PG8_LAS unsigned*)(lds + (bufoff) + ldsw + _i * 8192), 16, 0, 0); } while (0)
#define PG8_LDA(dst, b, h) do { _Pragma("unroll") for (int m = 0; m < 4; ++m) _Pragma("unroll") for (int k = 0; k < 2; ++k) dst[m][k] = *(const PG8_LAS bf16x8*)(lds + PG8_SA(b, h) + aoff + m * 2048 + k * 1024); } while (0)
#define PG8_LDB(dst, b, h) do { _Pragma("unroll") for (int n = 0; n < 2; ++n) _Pragma("unroll") for (int k = 0; k < 2; ++k) dst[n][k] = *(const PG8_LAS bf16x8*)(lds + PG8_SB(b, h) + boff + n * 2048 + k * 1024); } while (0)
#define PG8_MMA(ai, bj, At, Bt) do { __builtin_amdgcn_s_setprio(1); _Pragma("unroll") for (int m = 0; m < 4; ++m) _Pragma("unroll") for (int n = 0; n < 2; ++n) _Pragma("unroll") for (int k = 0; k < 2; ++k) \
        acc[ai][bj][m][n] = __builtin_amdgcn_mfma_f32_16x16x32_bf16(Bt[n][k], At[m][k], acc[ai][bj][m][n], 0, 0, 0); __builtin_amdgcn_s_setprio(0); } while (0)
#define PG8_WAIT_V(n) asm volatile("s_waitcnt vmcnt(" #n ")" ::: "memory")
#define PG8_WAIT_L(n) asm volatile("s_waitcnt lgkmcnt(" #n ")" ::: "memory")
#define PG8_BAR __builtin_amdgcn_s_barrier()
#define PG8_SCHED __builtin_amdgcn_sched_barrier(0)
    Unit cur, nxt; int ui = 0;
    if (!S.next(0, cur)) return;
    f32x4 acc[2][2][4][2];
#pragma unroll
    for (int a = 0; a < 2; ++a)
#pragma unroll
        for (int b = 0; b < 2; ++b)
#pragma unroll
            for (int m = 0; m < 4; ++m)
#pragma unroll
                for (int n = 0; n < 2; ++n) acc[a][b][m][n] = (f32x4){0.f, 0.f, 0.f, 0.f};
    bf16x8 At[4][2], B0[2][2], B1[2][2];
    const char* cA = (const char*)g.A + (size_t)cur.pm * tstep; const char* cB = (const char*)g.Bt + (size_t)cur.pn * tstep;
    S.a_ready(cur);
    if constexpr (SP2) {
        PG8_STAGE(PG8_SB(0, 0), cB, voffB); PG8_STAGE(PG8_SB(0, 1), cB + hstep, voffB); PG8_STAGE(PG8_SA(0, 0), cA, voffA); PG8_STAGE(PG8_SA(0, 1), cA + hstep, voffA);
        if (wr == 1) PG8_BAR;
        PG8_WAIT_V(2); PG8_BAR;
        PG8_STAGE(PG8_SB(1, 0), cB + kstep, voffB); PG8_STAGE(PG8_SA(1, 0), cA + kstep, voffA); PG8_STAGE(PG8_SB(1, 1), cB + hstep + kstep, voffB);
        PG8_WAIT_V(6); PG8_BAR;
    } else {
        PG8_STAGE(PG8_SB(0, 0), cB, voffB); PG8_STAGE(PG8_SA(0, 0), cA, voffA); PG8_STAGE(PG8_SB(0, 1), cB + hstep, voffB); PG8_STAGE(PG8_SA(0, 1), cA + hstep, voffA);
        if (wr == 1) PG8_BAR;
        PG8_WAIT_V(4); PG8_BAR;
        PG8_STAGE(PG8_SB(1, 0), cB + kstep, voffB); PG8_STAGE(PG8_SA(1, 0), cA + kstep, voffA); PG8_STAGE(PG8_SB(1, 1), cB + hstep + kstep, voffB);
        PG8_WAIT_V(6); PG8_BAR;
    }
    for (;;) {
        const bool has_next = S.next(ui + 1, nxt);
        const char* nA = has_next ? (const char*)g.A + (size_t)nxt.pm * tstep : cA; const char* nB = has_next ? (const char*)g.Bt + (size_t)nxt.pn * tstep : cB;
        for (int t = 0; t < nt; t += 2) {
            const bool last = (t == nt - 2);
            const char* a1 = cA + (size_t)(t + 1) * kstep;
            const char* a2 = last ? nA : cA + (size_t)(t + 2) * kstep; const char* b2 = last ? nB : cB + (size_t)(t + 2) * kstep;
            const char* a3 = a2 + kstep; const char* b3 = b2 + kstep;
            if (last && has_next) S.a_ready(nxt);
            if constexpr (SP2) {
            PG8_LDB(B0, 0, 0); PG8_LDB(B1, 0, 1); PG8_SCHED; PG8_LDA(At, 0, 0); PG8_STAGE(PG8_SA(1, 1), a1 + hstep, voffA);
            PG8_WAIT_V(8); PG8_WAIT_L(0); PG8_BAR; PG8_MMA(0, 0, At, B0); PG8_MMA(0, 1, At, B1); PG8_BAR; PG8_SCHED;
            PG8_LDA(At, 0, 1); PG8_STAGE(PG8_SB(0, 0), b2, voffB); PG8_STAGE(PG8_SB(0, 1), b2 + hstep, voffB); PG8_STAGE(PG8_SA(0, 0), a2, voffA);
            PG8_WAIT_V(8); PG8_WAIT_L(0); PG8_BAR; PG8_MMA(1, 0, At, B0); PG8_MMA(1, 1, At, B1); PG8_BAR; PG8_SCHED;
            PG8_LDB(B0, 1, 0); PG8_LDB(B1, 1, 1); PG8_SCHED; PG8_LDA(At, 1, 0); PG8_STAGE(PG8_SA(0, 1), a2 + hstep, voffA);
            PG8_WAIT_V(8); PG8_WAIT_L(0); PG8_BAR; PG8_MMA(0, 0, At, B0); PG8_MMA(0, 1, At, B1); PG8_BAR; PG8_SCHED;
            PG8_LDA(At, 1, 1); PG8_STAGE(PG8_SB(1, 0), b3, voffB); PG8_STAGE(PG8_SB(1, 1), b3 + hstep, voffB); PG8_STAGE(PG8_SA(1, 0), a3, voffA);
            PG8_WAIT_V(8); PG8_WAIT_L(0); PG8_BAR; PG8_MMA(1, 0, At, B0); PG8_MMA(1, 1, At, B1); PG8_BAR; PG8_SCHED;
            } else {
            PG8_LDB(B0, 0, 0); PG8_SCHED; PG8_LDA(At, 0, 0); PG8_STAGE(PG8_SA(1, 1), a1 + hstep, voffA);
            PG8_WAIT_L(8); PG8_BAR; PG8_WAIT_L(0); PG8_MMA(0, 0, At, B0); PG8_BAR; PG8_SCHED;
            PG8_LDB(B1, 0, 1); PG8_STAGE(PG8_SB(0, 0), b2, voffB);
            PG8_BAR; PG8_WAIT_L(0); PG8_MMA(0, 1, At, B1); PG8_BAR;
            PG8_LDA(At, 0, 1); PG8_STAGE(PG8_SA(0, 0), a2, voffA);
            PG8_BAR; PG8_WAIT_L(0); PG8_MMA(1, 0, At, B0); PG8_BAR; PG8_SCHED;
            PG8_STAGE(PG8_SB(0, 1), b2 + hstep, voffB);
            PG8_WAIT_V(6); PG8_BAR; PG8_MMA(1, 1, At, B1); PG8_BAR;
            PG8_LDB(B0, 1, 0); PG8_SCHED; PG8_LDA(At, 1, 0); PG8_STAGE(PG8_SA(0, 1), a2 + hstep, voffA);
            PG8_WAIT_L(8); PG8_BAR; PG8_WAIT_L(0); PG8_MMA(0, 0, At, B0); PG8_BAR; PG8_SCHED;
            PG8_LDB(B1, 1, 1); PG8_STAGE(PG8_SB(1, 0), b3, voffB);
            PG8_BAR; PG8_WAIT_L(0); PG8_MMA(0, 1, At, B1); PG8_BAR;
            PG8_LDA(At, 1, 1); PG8_STAGE(PG8_SA(1, 0), a3, voffA);
            PG8_BAR; PG8_WAIT_L(0); PG8_MMA(1, 0, At, B0); PG8_BAR; PG8_SCHED;
            PG8_STAGE(PG8_SB(1, 1), b3 + hstep, voffB);
            PG8_WAIT_V(6); PG8_BAR; PG8_MMA(1, 1, At, B1); PG8_BAR;
            }
        }
        if constexpr (ALIGN_EPI) { if (wr == 0) PG8_BAR; }
        if constexpr (!Epi::AFTER_DRAIN) { E(acc, cur, wr, wc, fr, fq); S.done(cur); }
        if (!has_next) break;
#pragma unroll
        for (int a = 0; a < 2; ++a)
#pragma unroll
            for (int b = 0; b < 2; ++b)
#pragma unroll
                for (int m = 0; m < 4; ++m)
#pragma unroll
                    for (int n = 0; n < 2; ++n) acc[a][b][m][n] = (f32x4){0.f, 0.f, 0.f, 0.f};
        cur = nxt; cA = nA; cB = nB; ++ui;
        if constexpr (ALIGN_EPI) { if (wr == 1) PG8_BAR; }
    }
    PG8_WAIT_V(0);
    if constexpr (!ALIGN_EPI) { if (wr == 0) PG8_BAR; }
    PG8_BAR;
    if constexpr (Epi::AFTER_DRAIN) { E.fused(acc, cur, wr, wc, fr, fq, lds, wid, lane); S.done(cur); }
#undef PG8_SA
#undef PG8_SB
#undef PG8_STAGE
#undef PG8_LDA
#undef PG8_LDB
#undef PG8_MMA
#undef PG8_WAIT_V
#undef PG8_WAIT_L
#undef PG8_BAR
#undef PG8_SCHED
}
}

namespace attn {
typedef unsigned short bf16_t;
using bf16x8 = __attribute__((ext_vector_type(8))) short;
using s16x4  = __attribute__((ext_vector_type(4))) short;
using f32x16 = __attribute__((ext_vector_type(16))) float;
using u32x4  = __attribute__((ext_vector_type(4))) unsigned;
constexpr int NW = 8, QBLK = 32, KVBLK = 64;
constexpr float QSCALE = 0.125f * 1.4426950408889634f;
constexpr int LDQ = 512, LDK = 512, LDV = 512, LDO = 512;
constexpr int SHM_V = KVBLK * 128 * 2, SHM_K = KVBLK * 64 * 2, SHM_ATTN = 2 * SHM_V + 2 * SHM_K + NW * 64 * 4;
#define KSWZ64(row, colB) ((row) * 128 + ((colB) ^ ((((row) >> 1) & 7) << 4)))
#define SBAR() __builtin_amdgcn_sched_barrier(0)
__device__ __forceinline__ int crow(int r, int hi) { return (r & 3) + 8 * (r >> 2) + 4 * hi; }
__device__ __forceinline__ unsigned cvtpk(float lo, float hi) { unsigned r; asm volatile("v_cvt_pk_bf16_f32 %0, %1, %2" : "=v"(r) : "v"(lo), "v"(hi)); return r; }
constexpr float THR2 = 11.5f;
template <bool FIRST, bool GUARD>
__device__ __forceinline__ void partialSM(f32x16& p0, f32x16& p1, float& m_reg, float& alpha) {
  if (!GUARD) {
    alpha = 1.f;
    return;
  }
  if (!FIRST) { if (__builtin_expect(__any(m_reg != 0.f), 0)) {
#pragma unroll
      for (int r = 0; r < 16; ++r) { p0[r] -= m_reg; p1[r] -= m_reg; } } }
  float a = fmaxf(fmaxf(p0[0], p0[1]), p1[0]), b = fmaxf(fmaxf(p0[2], p0[3]), p1[1]); a = fmaxf(fmaxf(a, p1[2]), p1[3]);
#pragma unroll
  for (int r = 4; r < 16; r += 4) { a = fmaxf(fmaxf(a, p0[r]), p0[r + 1]); b = fmaxf(fmaxf(b, p0[r + 2]), p0[r + 3]); a = fmaxf(fmaxf(a, p1[r]), p1[r + 1]); b = fmaxf(fmaxf(b, p1[r + 2]), p1[r + 3]); }
  float pmax = fmaxf(a, b);
  { auto rr = __builtin_amdgcn_permlane32_swap(__float_as_uint(pmax), __float_as_uint(pmax), false, false);
    pmax = fmaxf(__uint_as_float(rr[0]), __uint_as_float(rr[1])); }
  alpha = 1.f;
  if (FIRST) {
    if (__builtin_expect(__any(fabsf(pmax) > THR2), 0)) { const float dl = fabsf(pmax) > THR2 ? pmax : 0.f; m_reg = dl;
#pragma unroll
      for (int r = 0; r < 16; ++r) { p0[r] -= dl; p1[r] -= dl; } }
  } else {
    if (__builtin_expect(__any(pmax > THR2), 0)) { const float dl = fmaxf(pmax, 0.f); m_reg += dl;
#pragma unroll
      for (int r = 0; r < 16; ++r) { p0[r] -= dl; p1[r] -= dl; }
      alpha = __builtin_amdgcn_exp2f(-dl); }
  }
#pragma unroll
  for (int r = 0; r < 16; ++r) p0[r] = __builtin_amdgcn_exp2f(p0[r]);
}
template <bool BOTH>
__device__ __forceinline__ void finishSM(f32x16& p0, f32x16& p1, bf16x8& pa0, bf16x8& pa1, bf16x8& pa2, bf16x8& pa3, float& l_reg) {
  if (BOTH) {
#pragma unroll
    for (int r = 0; r < 16; ++r) p0[r] = __builtin_amdgcn_exp2f(p0[r]);
  }
#pragma unroll
  for (int r = 0; r < 16; ++r) p1[r] = __builtin_amdgcn_exp2f(p1[r]);
  if (BOTH) {
    float s0 = p0[0] + p0[1], s1 = p0[2] + p0[3], s2 = p1[0] + p1[1], s3 = p1[2] + p1[3];
#pragma unroll
    for (int r = 4; r < 16; r += 4) { s0 += p0[r]; s1 += p0[r + 1]; s2 += p0[r + 2]; s3 += p0[r + 3]; s0 += p1[r]; s1 += p1[r + 1]; s2 += p1[r + 2]; s3 += p1[r + 3]; }
    l_reg += (s0 + s1) + (s2 + s3);
  }
#define PK4(P, BASE, OUT) do { u32x4 w = {cvtpk(P[BASE + 0], P[BASE + 1]), cvtpk(P[BASE + 2], P[BASE + 3]), cvtpk(P[BASE + 4], P[BASE + 5]), cvtpk(P[BASE + 6], P[BASE + 7])}; \
    OUT = *reinterpret_cast<bf16x8*>(&w); } while (0)
  PK4(p0, 0, pa0); PK4(p0, 8, pa1); PK4(p1, 0, pa2); PK4(p1, 8, pa3);
#undef PK4
}
__device__ __forceinline__ void qkt(f32x16& p0, f32x16& p1, const char* Ks, const bf16x8* qr, int r32, int hi) {
  p0 = f32x16{}; p1 = f32x16{};
#pragma unroll
  for (int d0 = 0; d0 < 4; ++d0) { const int cb = (d0 * 16 + hi * 8) * 2;
    bf16x8 b0 = *reinterpret_cast<const bf16x8*>(Ks + KSWZ64(r32, cb));
    bf16x8 b1 = *reinterpret_cast<const bf16x8*>(Ks + KSWZ64(32 + r32, cb));
    p0 = __builtin_amdgcn_mfma_f32_32x32x16_bf16(b0, qr[d0], p0, 0, 0, 0);
    p1 = __builtin_amdgcn_mfma_f32_32x32x16_bf16(b1, qr[d0], p1, 0, 0, 0); }
}
__device__ __forceinline__ int v_st(int k, int c) { const int kk = k; return ((kk >> 3) * 4 + (c >> 5)) * 512 + ((kk & 7) * 32 + (c & 31)) * 2; }
__device__ __forceinline__ int v_rd_base(int lane) { return ((lane & 3) << 3) | (((lane >> 2) & 3) << 6) | (((lane >> 4) & 1) << 5) | (((lane >> 5) & 1) << 8); }
constexpr int v_rd_off(int d0, int ks, int half) { return d0 * 512 + ks * 4096 + half * 2048; }
template <int OFF> __device__ __forceinline__ s16x4 tr_read(int vb) {
  s16x4 r; asm volatile("ds_read_b64_tr_b16 %0, %1 offset:%2" : "=&v"(r) : "v"(vb), "i"(OFF) : "memory"); return r;
}
template <int D0> __device__ __forceinline__ void pv_one(f32x16& od, int vb, bf16x8 pa0, bf16x8 pa1, bf16x8 pa2, bf16x8 pa3) {
  const s16x4 l0 = tr_read<v_rd_off(D0, 0, 0)>(vb), h0 = tr_read<v_rd_off(D0, 0, 1)>(vb), l1 = tr_read<v_rd_off(D0, 1, 0)>(vb), h1 = tr_read<v_rd_off(D0, 1, 1)>(vb);
  const s16x4 l2 = tr_read<v_rd_off(D0, 2, 0)>(vb), h2 = tr_read<v_rd_off(D0, 2, 1)>(vb), l3 = tr_read<v_rd_off(D0, 3, 0)>(vb), h3 = tr_read<v_rd_off(D0, 3, 1)>(vb);
  asm volatile("s_waitcnt lgkmcnt(0)" ::: "memory"); SBAR();
#define PK(L, H) (bf16x8){L[0], L[1], L[2], L[3], H[0], H[1], H[2], H[3]}
  od = __builtin_amdgcn_mfma_f32_32x32x16_bf16(pa0, PK(l0, h0), od, 0, 0, 0);
  od = __builtin_amdgcn_mfma_f32_32x32x16_bf16(pa1, PK(l1, h1), od, 0, 0, 0);
  od = __builtin_amdgcn_mfma_f32_32x32x16_bf16(pa2, PK(l2, h2), od, 0, 0, 0);
  od = __builtin_amdgcn_mfma_f32_32x32x16_bf16(pa3, PK(l3, h3), od, 0, 0, 0);
#undef PK
}
template <bool SUM>
__device__ __forceinline__ void pv_d0(f32x16* o, f32x16& osum, int vb, bf16x8 pa0, bf16x8 pa1, bf16x8 pa2, bf16x8 pa3) {
  if (SUM) { const bf16x8 ones = {16256, 16256, 16256, 16256, 16256, 16256, 16256, 16256};
    osum = __builtin_amdgcn_mfma_f32_32x32x16_bf16(pa0, ones, osum, 0, 0, 0); osum = __builtin_amdgcn_mfma_f32_32x32x16_bf16(pa1, ones, osum, 0, 0, 0);
    osum = __builtin_amdgcn_mfma_f32_32x32x16_bf16(pa2, ones, osum, 0, 0, 0); osum = __builtin_amdgcn_mfma_f32_32x32x16_bf16(pa3, ones, osum, 0, 0, 0); }
  pv_one<0>(o[0], vb, pa0, pa1, pa2, pa3); pv_one<1>(o[1], vb, pa0, pa1, pa2, pa3); pv_one<2>(o[2], vb, pa0, pa1, pa2, pa3); pv_one<3>(o[3], vb, pa0, pa1, pa2, pa3);
}
#define TRSET(L, D0) do { L[0] = tr_read<v_rd_off(D0, 0, 0)>(vb); L[1] = tr_read<v_rd_off(D0, 0, 1)>(vb); L[2] = tr_read<v_rd_off(D0, 1, 0)>(vb); L[3] = tr_read<v_rd_off(D0, 1, 1)>(vb); \
    L[4] = tr_read<v_rd_off(D0, 2, 0)>(vb); L[5] = tr_read<v_rd_off(D0, 2, 1)>(vb); L[6] = tr_read<v_rd_off(D0, 3, 0)>(vb); L[7] = tr_read<v_rd_off(D0, 3, 1)>(vb); } while (0)
#define PKV(L, k) (bf16x8){L[2 * (k)][0], L[2 * (k)][1], L[2 * (k)][2], L[2 * (k)][3], L[2 * (k) + 1][0], L[2 * (k) + 1][1], L[2 * (k) + 1][2], L[2 * (k) + 1][3]}
#define MM4(OD, L) do { OD = __builtin_amdgcn_mfma_f32_32x32x16_bf16(pa0, PKV(L, 0), OD, 0, 0, 0); OD = __builtin_amdgcn_mfma_f32_32x32x16_bf16(pa1, PKV(L, 1), OD, 0, 0, 0); \
    OD = __builtin_amdgcn_mfma_f32_32x32x16_bf16(pa2, PKV(L, 2), OD, 0, 0, 0); OD = __builtin_amdgcn_mfma_f32_32x32x16_bf16(pa3, PKV(L, 3), OD, 0, 0, 0); } while (0)
#define LWAIT() do { asm volatile("s_waitcnt lgkmcnt(0)" ::: "memory"); SBAR(); } while (0)
__device__ __forceinline__ void pv_d0_pipe(f32x16* o, int vb, bf16x8 pa0, bf16x8 pa1, bf16x8 pa2, bf16x8 pa3) {
  s16x4 LA[8], LB[8];
  __builtin_amdgcn_s_setprio(1);
  TRSET(LA, 0); SBAR();
#define EX4(B) do { px[B] = __builtin_amdgcn_exp2f(px[B]); px[B + 1] = __builtin_amdgcn_exp2f(px[B + 1]); px[B + 2] = __builtin_amdgcn_exp2f(px[B + 2]); px[B + 3] = __builtin_amdgcn_exp2f(px[B + 3]); } while (0)
  LWAIT(); TRSET(LB, 1); SBAR(); MM4(o[0], LA); SBAR();
  LWAIT(); TRSET(LA, 2); SBAR(); MM4(o[1], LB); SBAR();
  LWAIT(); TRSET(LB, 3); SBAR(); MM4(o[2], LA); SBAR();
  LWAIT(); MM4(o[3], LB);
#undef EX4
}
#undef TRSET
#undef PKV
#undef MM4
#undef LWAIT
template <int COMP, bool GUARD>
__device__ __forceinline__ bool body(const bf16_t* __restrict__ Qb, const bf16_t* __restrict__ Kh, const bf16_t* __restrict__ Vh, float* Ob, bf16_t* __restrict__ SAo, float lam, const float* __restrict__ sg, int seq, char* lds) {
  int tid_ = threadIdx.x; asm volatile("" : "+v"(tid_));
  const int tid = tid_, wid = tid >> 6, lane = tid & 63, r32 = lane & 31, hi = lane >> 5;
  char* V_lds = lds; char* K_lds = lds + 4 * SHM_V;
  float* ws = (float*)(lds + 4 * SHM_V + 4 * SHM_K) + wid * 64; float* al_l = ws + 32;
  float m_reg = 0.f, l_reg = 0.f; f32x16 o[4] = {}; f32x16 osum = {}; bf16x8 qr[4];
  const bf16_t* Qw = Qb + (long)(wid * QBLK + r32) * LDQ + hi * 8;
#pragma unroll
  for (int d0 = 0; d0 < 4; ++d0) qr[d0] = *reinterpret_cast<const bf16x8*>(Qw + d0 * 16);
  const int sr = tid >> 4, sc = (tid & 15) * 8, vst0 = v_st(sr, sc), vst1 = v_st(32 + sr, sc);
  const int ksr = tid >> 3, ksc = (tid & 7) * 8, kst = KSWZ64(ksr, ksc * 2);
  const int vb0 = (int)(uintptr_t)V_lds + v_rd_base(lane);
  bf16x8 rvs0, rvs1, rks0;
#define SLOAD(k0) do { rvs0 = *reinterpret_cast<const bf16x8*>(&Vh[(long)((k0) + sr) * LDV + sc]); rvs1 = *reinterpret_cast<const bf16x8*>(&Vh[(long)((k0) + 32 + sr) * LDV + sc]); \
    rks0 = *reinterpret_cast<const bf16x8*>(&Kh[(long)((k0) + ksr) * LDK + ksc]); } while (0)
#define SWRITE(slot) do { *(bf16x8*)(V_lds + (slot) * SHM_V + vst0) = rvs0; *(bf16x8*)(V_lds + (slot) * SHM_V + vst1) = rvs1; *(bf16x8*)(K_lds + (slot) * SHM_K + kst) = rks0; } while (0)
#define RESC(a) do { if (__any((a) < 1.f)) { if (hi == 0) al_l[r32] = (a); asm volatile("s_waitcnt lgkmcnt(0)" ::: "memory"); \
    _Pragma("unroll") for (int r = 0; r < 16; ++r) { const float f_ = al_l[crow(r, hi)]; osum[r] *= f_; _Pragma("unroll") for (int d = 0; d < 4; ++d) o[d][r] *= f_; } } } while (0)
  f32x16 pA0, pA1, pB0, pB1; float alA, alB; bf16x8 pa0, pa1, pa2, pa3; const int NT = seq / KVBLK;
  SLOAD(0); SWRITE(0); SLOAD(KVBLK); __syncthreads();
  qkt(pA0, pA1, K_lds, qr, r32, hi); partialSM<true, GUARD>(pA0, pA1, m_reg, alA);
  SWRITE(1); SLOAD(2 * KVBLK); __syncthreads();
  const int grp = __builtin_amdgcn_readfirstlane(wid >> 2);
#define ITER(X0, X1, Y0, Y1, alX, i) do { const int scur = (i) & 3, sp = ((i) - 1) & 3, sn = ((i) + 1) & 3; \
    SBAR(); qkt(X0, X1, K_lds + scur * SHM_K, qr, r32, hi); \
    finishSM<!GUARD>(Y0, Y1, pa0, pa1, pa2, pa3, l_reg); SBAR(); \
    if (grp) { SWRITE(sn); if ((i) + 2 < NT) SLOAD(((i) + 2) * KVBLK); __syncthreads(); } \
    if (GUARD) pv_d0<true>(o, osum, vb0 + sp * SHM_V, pa0, pa1, pa2, pa3); else { __builtin_amdgcn_s_setprio(1); pv_d0<false>(o, osum, vb0 + sp * SHM_V, pa0, pa1, pa2, pa3); } if (GUARD) partialSM<false, GUARD>(X0, X1, m_reg, alX); else { alX = 1.f; __builtin_amdgcn_s_setprio(0); } \
    if (GUARD) RESC(alX); \
    if (!grp) { SWRITE(sn); if ((i) + 2 < NT) SLOAD(((i) + 2) * KVBLK); __syncthreads(); } } while (0)
  int i = 1;
  for (; i + 1 < NT; i += 2) {
    ITER(pB0, pB1, pA0, pA1, alB, i);
    ITER(pA0, pA1, pB0, pB1, alA, i + 1);
  }
  { const int scur = i & 3, sp = (i - 1) & 3;
  SBAR(); qkt(pB0, pB1, K_lds + scur * SHM_K, qr, r32, hi);
  finishSM<!GUARD>(pA0, pA1, pa0, pa1, pa2, pa3, l_reg); SBAR();
  pv_d0<GUARD>(o, osum, vb0 + sp * SHM_V, pa0, pa1, pa2, pa3); partialSM<false, GUARD>(pB0, pB1, m_reg, alB);
  if (GUARD) RESC(alB);
  finishSM<!GUARD>(pB0, pB1, pa0, pa1, pa2, pa3, l_reg); SBAR();
  pv_d0<GUARD>(o, osum, vb0 + scur * SHM_V, pa0, pa1, pa2, pa3); }
#undef ITER
  int tid_e = threadIdx.x; asm volatile("" : "+v"(tid_e));
  const int wid_e = tid_e >> 6, r32_e = tid_e & 31, hi_e = (tid_e >> 5) & 1;
  float* ws_e = (float*)(lds + 4 * SHM_V + 4 * SHM_K) + wid_e * 64;
  float rli[16];
  if (!GUARD) {
    { auto rr = __builtin_amdgcn_permlane32_swap(__float_as_uint(l_reg), __float_as_uint(l_reg), false, false); l_reg = __uint_as_float(rr[0]) + __uint_as_float(rr[1]); }
    const bool ok = (l_reg > 0.f) && (l_reg < 3.0e38f);
    if (__syncthreads_or(ok ? 0 : 1)) return true;
    if (hi_e == 0) ws_e[r32_e] = l_reg; asm volatile("s_waitcnt lgkmcnt(0)" ::: "memory");
#pragma unroll
    for (int r = 0; r < 16; ++r) rli[r] = __builtin_amdgcn_rcpf(ws_e[crow(r, hi_e)]);
  } else {
#pragma unroll
    for (int r = 0; r < 16; ++r) rli[r] = __builtin_amdgcn_rcpf(osum[r]);
  }
  float* Ow = Ob + (long)(wid_e * QBLK) * LDO;
  if (COMP == 0) {
#pragma unroll
    for (int r = 0; r < 16; ++r) { const int orow = crow(r, hi_e);
#pragma unroll
      for (int d0 = 0; d0 < 4; ++d0) Ow[(long)orow * LDO + d0 * 32 + r32_e] = o[d0][r] * rli[r]; }
  } else {
    float ss[16];
#pragma unroll
    for (int r = 0; r < 16; ++r) { const int orow = crow(r, hi_e); float q = 0.f;
#pragma unroll
      for (int d0 = 0; d0 < 4; ++d0) { const float d = Ow[(long)orow * LDO + d0 * 32 + r32_e] - lam * (o[d0][r] * rli[r]); o[d0][r] = d; q = fmaf(d, d, q); }
      ss[r] = q; }
#pragma unroll
    for (int r = 0; r < 16; ++r) { float q = ss[r]; q += __shfl_xor(q, 1); q += __shfl_xor(q, 2); q += __shfl_xor(q, 4); q += __shfl_xor(q, 8); q += __shfl_xor(q, 16);
      ss[r] = 1.0f / sqrtf(q * (1.0f / 128.0f) + 1e-6f); }
    float gsub[4];
#pragma unroll
    for (int d0 = 0; d0 < 4; ++d0) gsub[d0] = sg[d0 * 32 + r32_e] * 0.8f;
    bf16_t* Sw = SAo + (long)(wid_e * QBLK) * 1024;
#pragma unroll
    for (int r = 0; r < 16; ++r) { const int orow = crow(r, hi_e);
#pragma unroll
      for (int d0 = 0; d0 < 4; ++d0) { const float y = o[d0][r] * ss[r] * gsub[d0]; unsigned u = __builtin_bit_cast(unsigned, y); u = (u + 0x7fffu + ((u >> 16) & 1u)) >> 16;
        Sw[(long)orow * 1024 + d0 * 32 + r32_e] = (bf16_t)u; } }
  }
  asm volatile("s_waitcnt vmcnt(0) lgkmcnt(0)" ::: "memory"); __syncthreads();
  return false;
#undef SLOAD
#undef SWRITE
#undef RESC
}
#undef SBAR
}

#define GAS __attribute__((address_space(1)))
#define LAS __attribute__((address_space(3)))
typedef unsigned short bf16;
typedef unsigned v4u __attribute__((ext_vector_type(4)));
typedef float f32x4 __attribute__((ext_vector_type(4)));
typedef float f32x16 __attribute__((ext_vector_type(16)));
typedef short bf16x8 __attribute__((ext_vector_type(8)));

constexpr int NWAVES = 8, NTHR = 512;
constexpr int DM = 1024, DFF = 2816, NB = 8, SEQ = 8192, CTXL = 256, NMODV = 9 * DM;
constexpr int ROWS_B = 8448, TILES_B = 33, NROWS = NB * ROWS_B;

constexpr size_t MiB = 1u << 20;
constexpr size_t WS_CTL = 0, CTL_ZERO_BYTES = 1 * MiB;
constexpr size_t WS_MOD = 4096;
constexpr size_t WS_BIAS1 = 352 * 1024, WS_BIAS2 = 640 * 1024;
constexpr size_t WS_RSS1 = 69 * MiB, WS_RSS2 = 69 * MiB + 512 * 1024;
constexpr size_t WS_BAR = 512 * 1024, BAR_ZERO_BYTES = 16384;
constexpr size_t WS_ABAR = 1 * MiB, WS_APOW = WS_ABAR + 32768, WS_BBT = WS_APOW + 32768, WS_CM = WS_BBT + 262144, WS_ROPE = WS_CM + 262144;
constexpr size_t WS_W1A = 2 * MiB, WS_W1B = 13 * MiB, WS_W2A = 19 * MiB, WS_W2B = 30 * MiB, WS_WIN = 36 * MiB, WS_WOUT = 40 * MiB, WS_WGLU = 42 * MiB;
constexpr size_t WS_E = 43 * MiB, WS_HIN = 52 * MiB, WS_XC = 61 * MiB;
constexpr size_t WS_XN = 70 * MiB;
constexpr size_t WS_ACT = 202 * MiB;
constexpr size_t WS_OATT = WS_ACT, WS_G = WS_ACT + 264 * MiB;
constexpr size_t WS_U = 565 * MiB, WS_Q = 631 * MiB, WS_K = 697 * MiB, WS_V = 763 * MiB, WS_END = 829 * MiB;
static_assert(WS_ROPE + 16384 <= WS_W1A && WS_W1A + (size_t)5632 * 1024 * 2 <= WS_W1B && WS_W1B + (size_t)1024 * 2816 * 2 <= WS_W2A && WS_W2A + (size_t)5632 * 1024 * 2 <= WS_W2B, "ws map 1");
static_assert(WS_W2B + (size_t)1024 * 2816 * 2 <= WS_WIN && WS_WIN + (size_t)2048 * 1024 * 2 <= WS_WOUT && WS_WOUT + (size_t)1024 * 1024 * 2 <= WS_WGLU && WS_WGLU + 512 * 512 * 2 <= WS_E, "ws map 2");
static_assert(WS_E + (size_t)8 * 33 * 64 * 64 * 8 <= WS_HIN && WS_HIN + (size_t)8 * 33 * 64 * 64 * 8 <= WS_XC && WS_XC + (size_t)2048 * 1024 * 4 <= WS_XN, "ws map 3");
static_assert(WS_XN + (size_t)NROWS * 1024 * 2 <= WS_ACT && WS_ACT + (size_t)NROWS * 2816 * 2 <= WS_U && WS_G + (size_t)NROWS * 512 * 2 <= WS_U && WS_OATT + (size_t)NROWS * 1024 * 4 <= WS_G, "ws map 4");
static_assert(WS_U + (size_t)NROWS * 512 * 2 <= WS_Q && WS_V + (size_t)NROWS * 512 * 2 <= WS_END, "ws map 5");

constexpr int LDS_BYTES = 139264;

#define LDS_WAIT() asm volatile("s_waitcnt lgkmcnt(0)" ::: "memory")
__device__ __forceinline__ unsigned f2bf(float f) { unsigned u = __builtin_bit_cast(unsigned, f); return (u + 0x7fffu + ((u >> 16) & 1u)) >> 16; }
__device__ __forceinline__ unsigned pk2(float lo, float hi) { return f2bf(lo) | (f2bf(hi) << 16); }
__device__ __forceinline__ float wave_sum(float v) {
#pragma unroll
    for (int o = 1; o < 64; o <<= 1) v += __shfl_xor(v, o);
    return v;
}

__device__ __forceinline__ double dexp(double x) {
    const double n = __builtin_rint(x * 1.4426950408889634074);
    const double r = __builtin_fma(-n, 1.9082149292705877e-10, __builtin_fma(-n, 0.693147180369123816490, x));
    double p = 1.0 / 87178291200.0;
    p = p * r + 1.0 / 6227020800.0; p = p * r + 1.0 / 479001600.0; p = p * r + 1.0 / 39916800.0; p = p * r + 1.0 / 3628800.0; p = p * r + 1.0 / 362880.0; p = p * r + 1.0 / 40320.0;
    p = p * r + 1.0 / 5040.0; p = p * r + 1.0 / 720.0; p = p * r + 1.0 / 120.0; p = p * r + 1.0 / 24.0; p = p * r + 1.0 / 6.0; p = p * r + 0.5; p = p * r + 1.0; p = p * r + 1.0;
    const long long e = (long long)n + 1023; const double s = __builtin_bit_cast(double, (unsigned long long)e << 52);
    return p * s;
}
__device__ __forceinline__ void dsincos(double y, double& s, double& c) {
    const double k = __builtin_rint(y * 0.15915494309189533577);
    double r = __builtin_fma(-k, 6.283185307179586232, y); r = __builtin_fma(-k, 2.4492935982947064e-16, r);
    const double q = r * 0.125, q2 = q * q;
    double sp = -1.0 / 1307674368000.0; sp = sp * q2 + 1.0 / 6227020800.0; sp = sp * q2 - 1.0 / 39916800.0; sp = sp * q2 + 1.0 / 362880.0; sp = sp * q2 - 1.0 / 5040.0; sp = sp * q2 + 1.0 / 120.0; sp = sp * q2 - 1.0 / 6.0; sp = sp * q2 + 1.0;
    double cp = 1.0 / 20922789888000.0; cp = cp * q2 - 1.0 / 87178291200.0; cp = cp * q2 + 1.0 / 479001600.0; cp = cp * q2 - 1.0 / 3628800.0; cp = cp * q2 + 1.0 / 40320.0; cp = cp * q2 - 1.0 / 720.0; cp = cp * q2 + 1.0 / 24.0; cp = cp * q2 - 0.5; cp = cp * q2 + 1.0;
    double ss = sp * q, cc = cp;
#pragma unroll
    for (int i = 0; i < 3; ++i) { const double s2 = 2.0 * ss * cc, c2 = cc * cc - ss * ss; ss = s2; cc = c2; }
    s = ss; c = cc;
}

__device__ __forceinline__ void transpose_item(const float* W, int K, int N, bf16* WT, int mode, LAS float* scr, int item, int lane) {
    const int nblk = N / 32, kb = item / nblk, nb = item % nblk, k0 = 64 * kb, n0 = 32 * nb;
    { const float* wp = W + (size_t)(k0 + (lane >> 5)) * N + n0 + (lane & 31); float v[32];
#pragma unroll
      for (int i = 0; i < 32; ++i) v[i] = wp[(size_t)(2 * i) * N];
#pragma unroll
      for (int i = 0; i < 32; ++i) scr[(2 * i + (lane >> 5)) * 33 + (lane & 31)] = v[i]; }
    LDS_WAIT(); asm volatile("" ::: "memory");
    const int c = lane & 7;
#pragma unroll
    for (int j = 0; j < 4; ++j) { const int n = (lane >> 3) + 8 * j; const LAS float* s = scr + (8 * c) * 33 + n;
        const int src = n0 + n; int drow = src;
        if (mode == 1) { const int up = src >= DFF ? 1 : 0, ff = src - up * DFF; drow = (ff >> 7) * 256 + up * 128 + (ff & 127); }
        else if (mode == 2) { if (src >= 512 && src < 1536) drow = n0 + 2 * (n & 15) + (n >> 4); }
        v4u o; o.x = pk2(s[0 * 33], s[1 * 33]); o.y = pk2(s[2 * 33], s[3 * 33]); o.z = pk2(s[4 * 33], s[5 * 33]); o.w = pk2(s[6 * 33], s[7 * 33]);
        *(v4u*)(WT + (size_t)drow * K + k0 + 8 * c) = o; }
    LDS_WAIT(); asm volatile("" ::: "memory");
}

template <int MODE>
__device__ __forceinline__ void norm_rows16(const float* src, bf16* dstb, float* dstf, const float* g, const float* shift, const float* scale, int lane) {
    f32x4 gs[4], sh[4];
#pragma unroll
    for (int j = 0; j < 4; ++j) { const int cidx = 4 * lane + 256 * j; const f32x4 gv = *(const f32x4*)(g + cidx);
        if (MODE == 0) { const f32x4 sc = *(const f32x4*)(scale + cidx); gs[j] = gv * (sc + 1.0f); sh[j] = *(const f32x4*)(shift + cidx); } else { gs[j] = gv; sh[j] = (f32x4){0.f, 0.f, 0.f, 0.f}; } }
#pragma unroll 2
    for (int r = 0; r < 16; ++r) {
        const f32x4* xr = (const f32x4*)(src + (size_t)r * DM) + lane;
        const unsigned long long* xb = (const unsigned long long*)((const bf16*)src + (size_t)r * DM) + lane;
        f32x4 v[4]; float s = 0.f;
#pragma unroll
        for (int j = 0; j < 4; ++j) { if (MODE == 2) { const unsigned long long w = xb[64 * j]; const unsigned lo = (unsigned)w, hi2 = (unsigned)(w >> 32); v[j] = (f32x4){__uint_as_float(lo << 16), __uint_as_float(lo & 0xffff0000u), __uint_as_float(hi2 << 16), __uint_as_float(hi2 & 0xffff0000u)}; } else v[j] = xr[64 * j]; s += (v[j].x * v[j].x + v[j].y * v[j].y) + (v[j].z * v[j].z + v[j].w * v[j].w); }
        const float rstd = 1.0f / sqrtf(wave_sum(s) * (1.0f / DM) + 1e-6f);
        if (MODE == 0) {
            unsigned long long* o8 = (unsigned long long*)(dstb + (size_t)r * DM) + lane;
#pragma unroll
            for (int j = 0; j < 4; ++j) { const f32x4 y = v[j] * rstd * gs[j] + sh[j]; o8[64 * j] = (unsigned long long)pk2(y.x, y.y) | ((unsigned long long)pk2(y.z, y.w) << 32); }
        } else {
            f32x4* of = (f32x4*)(dstf + (size_t)r * DM) + lane;
#pragma unroll
            for (int j = 0; j < 4; ++j) of[64 * j] = v[j] * rstd * gs[j];
        }
    }
}

__device__ __forceinline__ int crow16(int r, int hi) { return (r & 3) + 8 * (r >> 2) + 4 * hi; }
typedef float f32x2_t __attribute__((ext_vector_type(2))); typedef __bf16 bf16x2_t __attribute__((ext_vector_type(2)));
__device__ __forceinline__ unsigned cvtpk2(float lo, float hi) { f32x2_t v = {lo, hi}; bf16x2_t b = __builtin_convertvector(v, bf16x2_t); return __builtin_bit_cast(unsigned, b); }

template <bool FULL>
__device__ __forceinline__ void s5_unit(LAS unsigned char* lds, int b, int c, int gq, const bf16* U, const float2* ABAR, const bf16* BBT, const bf16* CM,
                                        const float2* HIN, float2* E, const float* dskip, bf16* G, float* YF) {
    int tid_ = threadIdx.x; asm volatile("" : "+v"(tid_));
    const int lane = tid_ & 63, wave = __builtin_amdgcn_readfirstlane(tid_ >> 6);
    const int g = gq * 8 + wave, hi = lane >> 5, r32 = lane & 31;
    LAS unsigned* scr = (LAS unsigned*)(lds + wave * 8704);
    const size_t r0 = (size_t)b * ROWS_B + (size_t)c * 256;
    const bf16* ubase = U + (r0 + r32) * 512 + g * 16 + hi * 8;
    const int ch = lane & 15; const float dv = dskip[g * 16 + ch];
    const size_t obase = (r0 + (lane >> 4) * 4) * 512 + g * 16 + ch;
    LAS unsigned short* yt_l = (LAS unsigned short*)(lds + 69632 + wave * 8192) + ((lane >> 4) * 4) * 16 + ch;
#pragma unroll
    for (int dir = 0; dir < 2; ++dir) {
        const int dg = dir * 32 + g;
        const float2 ab = ABAR[dg * 64 + lane];
        bf16x8 bb[4], cm[4];
#pragma unroll
        for (int blk = 0; blk < 4; ++blk) bb[blk] = *(const bf16x8*)(BBT + ((size_t)(dg * 4 + blk) * 32 + r32) * 16 + hi * 8);
        if (FULL) {
#pragma unroll
            for (int ks = 0; ks < 4; ++ks) cm[ks] = *(const bf16x8*)(CM + ((size_t)dg * 16 + (lane & 15)) * 128 + ks * 32 + (lane >> 4) * 8);
        }
        const size_t sidx = ((((size_t)b * 33 + c) * 32 + g) * 2 + dir) * 64 + lane;
        float hr = 0.f, hm = 0.f;
        if (FULL) { const float2 h0 = HIN[sidx]; hr = h0.x; hm = h0.y; }
        bf16x8 a_nx = *(const bf16x8*)(ubase + (size_t)(dir == 0 ? 0 : 224) * 512);
#pragma unroll 1
        for (int sb = 0; sb < 8; ++sb) {
            const int tb = dir == 0 ? sb * 32 : (7 - sb) * 32;
            const bf16x8 a = a_nx;
            { const int tn = dir == 0 ? (sb < 7 ? tb + 32 : tb) : (sb < 7 ? tb - 32 : tb); a_nx = *(const bf16x8*)(ubase + (size_t)tn * 512); }
            unsigned short uvv[2][4];
            if (FULL && dir == 1) {
#pragma unroll
                for (int mt = 0; mt < 2; ++mt)
#pragma unroll
                    for (int j = 0; j < 4; ++j) { const size_t idx = obase + (size_t)(tb + mt * 16 + j) * 512; uvv[mt][j] = U[idx]; }
            }
            const f32x16 z = {};
#pragma unroll
            for (int hf = 0; hf < 2; ++hf) {
                const f32x16 c0 = __builtin_amdgcn_mfma_f32_32x32x16_bf16(a, bb[hf], z, 0, 0, 0), c2 = __builtin_amdgcn_mfma_f32_32x32x16_bf16(a, bb[2 + hf], z, 0, 0, 0);
#pragma unroll
                for (int r = 0; r < 16; ++r) { const int row = crow16(r, hi); scr[row * 68 + hf * 32 + r32] = cvtpk2(c0[r], c2[r]); }
            }
            LDS_WAIT(); asm volatile("" ::: "memory");
#pragma unroll
            for (int half = 0; half < 2; ++half) {
                unsigned v[16];
#pragma unroll
                for (int q = 0; q < 16; ++q) { const int t = dir == 0 ? half * 16 + q : 31 - (half * 16 + q); v[q] = scr[t * 68 + lane]; }
#pragma unroll
                for (int q = 0; q < 16; ++q) { const int t = dir == 0 ? half * 16 + q : 31 - (half * 16 + q);
                    const float re = __uint_as_float(v[q] << 16), im = __uint_as_float(v[q] & 0xffff0000u);
                    const float nr = fmaf(ab.x, hr, fmaf(-ab.y, hm, re)), ni = fmaf(ab.x, hm, fmaf(ab.y, hr, im)); hr = nr; hm = ni;
                    if (FULL) scr[t * 68 + lane] = cvtpk2(hr, hm); }
                asm volatile("" ::: "memory");
            }
            if (FULL) {
                LDS_WAIT(); asm volatile("" ::: "memory");
                f32x4 yt[2];
#pragma unroll
                for (int mt = 0; mt < 2; ++mt) { yt[mt] = (f32x4){0.f, 0.f, 0.f, 0.f};
#pragma unroll
                    for (int ks = 0; ks < 4; ++ks) { const bf16x8 hf8 = *(const LAS bf16x8*)((const LAS unsigned char*)scr + (mt * 16 + (lane & 15)) * 272 + ks * 64 + (lane >> 4) * 16);
                        yt[mt] = __builtin_amdgcn_mfma_f32_16x16x32_bf16(hf8, cm[ks], yt[mt], 0, 0, 0); } }
#pragma unroll
                for (int mt = 0; mt < 2; ++mt)
#pragma unroll
                    for (int j = 0; j < 4; ++j) { LAS unsigned short* yp = yt_l + (tb + mt * 16 + j) * 16;
                        if (dir == 0) *yp = (unsigned short)f2bf(yt[mt][j]);
                        else { const float uv = __uint_as_float((unsigned)uvv[mt][j] << 16); const float yv = __uint_as_float((unsigned)*yp << 16) + yt[mt][j] + dv * uv;
                            const float zz = 1.5957691216057308f * (yv + 0.044715f * yv * yv * yv); *yp = (unsigned short)f2bf(yv * pg8::fast_sigmoid(zz)); } }
                LDS_WAIT(); asm volatile("" ::: "memory");
            }
        }
        if (!FULL) E[sidx] = make_float2(hr, hm);
    }
    if (FULL) {
        LDS_WAIT(); asm volatile("" ::: "memory");
        const LAS unsigned char* yb = (const LAS unsigned char*)(lds + 69632 + wave * 8192);
#pragma unroll
        for (int it = 0; it < 8; ++it) { const int row = it * 32 + (lane >> 1), hf = lane & 1;
            const v4u w = *(const LAS v4u*)(yb + row * 32 + hf * 16);
            *(v4u*)(G + (r0 + row) * 512 + g * 16 + hf * 8) = w; }
        LDS_WAIT(); asm volatile("" ::: "memory");
    }
}

__device__ __forceinline__ void cmulf(float ar, float ai, float br, float bi, float& cr, float& ci) { cr = ar * br - ai * bi; ci = ar * bi + ai * br; }
__device__ __forceinline__ void s5_unit_a(LAS unsigned char* lds, int b, int c, int gq, const bf16* U, const float2* ABAR, const bf16* BBT, float2* E) {
    int tid_ = threadIdx.x; asm volatile("" : "+v"(tid_));
    const int lane = tid_ & 63, wave = __builtin_amdgcn_readfirstlane(tid_ >> 6);
    const int g = gq * 8 + wave, hi = lane >> 5, r32 = lane & 31;
    const size_t r0 = (size_t)b * ROWS_B + (size_t)c * 256;
    LAS unsigned char* ut = lds + wave * 8192;
    { v4u t8[8];
#pragma unroll
      for (int it = 0; it < 8; ++it) t8[it] = *(const v4u*)(U + (r0 + it * 32 + (lane >> 1)) * 512 + g * 16 + (lane & 1) * 8);
#pragma unroll
      for (int it = 0; it < 8; ++it) *(LAS v4u*)(ut + (it * 32 + (lane >> 1)) * 32 + (lane & 1) * 16) = t8[it]; }
    LDS_WAIT(); asm volatile("" ::: "memory");
    const LAS unsigned char* ua = ut + r32 * 32 + hi * 16;
#pragma unroll
    for (int dir = 0; dir < 2; ++dir) {
        const int dg = dir * 32 + g;
        bf16x8 bb[4];
#pragma unroll
        for (int blk = 0; blk < 4; ++blk) bb[blk] = *(const bf16x8*)(BBT + ((size_t)(dg * 4 + blk) * 32 + r32) * 16 + hi * 8);
        float wr[2][16], wi[2][16], a32r[2], a32i[2];
#pragma unroll
        for (int hf = 0; hf < 2; ++hf) {
            const float2 ab = ABAR[dg * 64 + hf * 32 + r32];
            float qr[4], qi[4], orr[4], oi[4];
            qr[0] = 1.f; qi[0] = 0.f; qr[1] = ab.x; qi[1] = ab.y; cmulf(qr[1], qi[1], ab.x, ab.y, qr[2], qi[2]); cmulf(qr[2], qi[2], ab.x, ab.y, qr[3], qi[3]);
            float a4r, a4i; cmulf(qr[2], qi[2], qr[2], qi[2], a4r, a4i);
            orr[0] = 1.f; oi[0] = 0.f; cmulf(a4r, a4i, a4r, a4i, orr[1], oi[1]); cmulf(orr[1], oi[1], orr[1], oi[1], orr[2], oi[2]); cmulf(orr[2], oi[2], orr[1], oi[1], orr[3], oi[3]);
            cmulf(orr[2], oi[2], orr[2], oi[2], a32r[hf], a32i[hf]);
            const bool use4 = dir == 0 ? (hi == 0) : (hi != 0);
            const float br = use4 ? a4r : 1.f, bi = use4 ? a4i : 0.f;
#pragma unroll
            for (int r = 0; r < 16; ++r) { const int jq = dir == 0 ? 3 - (r & 3) : (r & 3), jo = dir == 0 ? 3 - (r >> 2) : (r >> 2);
                float tr, ti; cmulf(qr[jq], qi[jq], orr[jo], oi[jo], tr, ti); cmulf(tr, ti, br, bi, wr[hf][r], wi[hf][r]); }
        }
        float hr[2] = {0.f, 0.f}, hm[2] = {0.f, 0.f};
#pragma unroll 1
        for (int sb = 0; sb < 8; ++sb) {
            const bf16x8 a = *(const LAS bf16x8*)(ua + (dir == 0 ? sb * 32 : (7 - sb) * 32) * 32);
            const f32x16 z = {};
#pragma unroll
            for (int hf = 0; hf < 2; ++hf) {
                const f32x16 cre = __builtin_amdgcn_mfma_f32_32x32x16_bf16(a, bb[hf], z, 0, 0, 0), cim = __builtin_amdgcn_mfma_f32_32x32x16_bf16(a, bb[2 + hf], z, 0, 0, 0);
                float er = 0.f, ei = 0.f;
#pragma unroll
                for (int r = 0; r < 16; ++r) { er = fmaf(wr[hf][r], cre[r], fmaf(-wi[hf][r], cim[r], er)); ei = fmaf(wr[hf][r], cim[r], fmaf(wi[hf][r], cre[r], ei)); }
                er += __shfl_xor(er, 32); ei += __shfl_xor(ei, 32);
                const float nr = fmaf(a32r[hf], hr[hf], fmaf(-a32i[hf], hm[hf], er)), ni = fmaf(a32r[hf], hm[hf], fmaf(a32i[hf], hr[hf], ei));
                hr[hf] = nr; hm[hf] = ni;
            }
        }
        const size_t sidx = ((((size_t)b * 33 + c) * 32 + g) * 2 + dir) * 64 + lane;
        E[sidx] = hi ? make_float2(hr[1], hm[1]) : make_float2(hr[0], hm[0]);
    }
    LDS_WAIT(); asm volatile("" ::: "memory");
}

typedef GAS unsigned gu32;
#define RLX_AGENT __ATOMIC_RELAXED, __HIP_MEMORY_SCOPE_AGENT
#define XB_TMO      128
#define XB_XCNT(j)  (256  + 64 * (j))
#define XB_XSUB(j)  (1280 + 64 * (j))
#define XB_XGEN(j)  (2304 + 64 * (j))
#define XB_TOP      3328
#define XB_TOPGEN   3392
#define XCD_BAR_WORDS 3456
#define XB_SPIN_CAP (1u << 18)

__device__ __forceinline__ unsigned xb_ld(unsigned* p)              { return __hip_atomic_load(p, __ATOMIC_RELAXED, __HIP_MEMORY_SCOPE_AGENT); }
__device__ __forceinline__ unsigned xb_add(unsigned* p, unsigned v) { return __hip_atomic_fetch_add(p, v, __ATOMIC_RELAXED, __HIP_MEMORY_SCOPE_AGENT); }
__device__ __forceinline__ unsigned xb_xcc_id() { return (unsigned)__builtin_amdgcn_s_getreg((3 << 11) | 20) & 0xFu; }
#define XB_SPIN(cond, bar) do { unsigned _sp = 0; while (cond) { __builtin_amdgcn_s_sleep(1); \
    if ((++_sp & 255u) == 0u) { if (xb_ld(&(bar)[XB_TMO])) break; if (_sp > XB_SPIN_CAP) { atomicAdd(&(bar)[XB_TMO], 1u); break; } } } } while (0)

struct XcdBarrier {
    unsigned* bar; unsigned x;
    volatile LAS unsigned* st;
};

__device__ __forceinline__ XcdBarrier xcd_barrier_post(unsigned* bar, volatile LAS unsigned* st) {
    XcdBarrier b; b.bar = bar; b.x = xb_xcc_id(); b.st = st;
    if (threadIdx.x == 0) (void)xb_add(&bar[XB_XCNT(b.x)], 1u);
    return b;
}
__device__ __forceinline__ void xcd_barrier_complete(unsigned* bar, unsigned x, unsigned& nloc, unsigned& nx) {
    const unsigned G = gridDim.x * gridDim.y * gridDim.z;
    unsigned sum, cnt, mine, sp = 0u;
    for (;;) {
        sum = 0u; cnt = 0u; mine = 0u;
#pragma unroll
        for (unsigned j = 0; j < 16; ++j) { const unsigned c = xb_ld(&bar[XB_XCNT(j)]); sum += c; cnt += (c > 0u) ? 1u : 0u; mine = (j == x) ? c : mine; }
        if (sum == G) break;
        __builtin_amdgcn_s_sleep(1);
        if ((++sp & 255u) == 0u) { if (xb_ld(&bar[XB_TMO])) break; if (sp > XB_SPIN_CAP) { atomicAdd(&bar[XB_TMO], 1u); break; } }
    }
    nloc = mine > 0u ? mine : 1u; nx = cnt > 0u ? cnt : 1u;
}

__device__ __forceinline__ void xcd_barrier(const XcdBarrier& b) {
    asm volatile("s_waitcnt vmcnt(0)" ::: "memory");
    __syncthreads();
    if (threadIdx.x == 0) {
        unsigned* bar = b.bar;
        __builtin_amdgcn_s_waitcnt(0);
        unsigned nloc = b.st[0], nx = b.st[1];
        if (nloc == 0u) { xcd_barrier_complete(bar, b.x, nloc, nx); b.st[0] = nloc; b.st[1] = nx; }
        const unsigned old = xb_add(&bar[XB_XSUB(b.x)], 1u);
        const unsigned gen = old / nloc;
        if (old + 1u == (gen + 1u) * nloc) {
            __builtin_amdgcn_fence(__ATOMIC_RELEASE, "agent");
            asm volatile("s_waitcnt vmcnt(0)" ::: "memory");
            const unsigned og = xb_add(&bar[XB_TOP], 1u);
            const unsigned tg = og / nx;
            if (og + 1u == (tg + 1u) * nx) xb_add(&bar[XB_TOPGEN], 1u);
            else XB_SPIN(xb_ld(&bar[XB_TOPGEN]) == tg, bar);
            __builtin_amdgcn_fence(__ATOMIC_ACQUIRE, "agent");
            xb_add(&bar[XB_XGEN(b.x)], 1u);
            asm volatile("s_waitcnt vmcnt(0)" ::: "memory");
        } else {
            XB_SPIN(xb_ld(&bar[XB_XGEN(b.x)]) == gen, bar);
            __builtin_amdgcn_fence(__ATOMIC_ACQUIRE, "agent");
            asm volatile("s_waitcnt vmcnt(0)" ::: "memory");
        }
    }
    __syncthreads();
}

#ifndef PHMASK
#define PHMASK 0xFFFFF
#endif
#define PH(k) if ((PHMASK >> (k)) & 1)
struct Args { const float* in[25]; float* out; unsigned char* ws; };
__device__ __forceinline__ const float* karg(int i) {
    unsigned off = (unsigned)i * 8u; asm volatile("" : "+s"(off));
    return *(const float* const __attribute__((address_space(4)))*)((const char __attribute__((address_space(4)))*)__builtin_amdgcn_kernarg_segment_ptr() + off);
}

__global__ void __launch_bounds__(NTHR, 2) hymba_fwd(Args a) {
    extern __shared__ __attribute__((aligned(16))) unsigned char lds[];
    cg::grid_group grid = cg::this_grid();
    const int tid = threadIdx.x, lane = tid & 63, wave = __builtin_amdgcn_readfirstlane(tid >> 6);
    const int G = gridDim.x, bx = blockIdx.x;
    const int vcu = (G % 8 == 0) ? (bx % 8) * (G / 8) + bx / 8 : bx;
    const int gw = vcu * NWAVES + wave, NGW = G * NWAVES;
    LAS unsigned char* ldsl = (LAS unsigned char*)lds;
#define KIN(i) karg(i)
#define ws_p ((unsigned char*)karg(26))
#define out_p ((float*)karg(25))
#define x_in KIN(0)
#define cvec KIN(1)
#define ctx KIN(2)
#define c_ctx KIN(3)
#define w_mod KIN(4)
#define b_mod KIN(5)
#define norm_g KIN(6)
#define ffn_w_in KIN(7)
#define ffn_w_out KIN(8)
#define w_in KIN(9)
#define w_out KIN(10)
#define ssm_a_re KIN(11)
#define ssm_a_im KIN(12)
#define ssm_log_dt KIN(13)
#define ssm_b_re KIN(14)
#define ssm_b_im KIN(15)
#define ssm_c_re KIN(16)
#define ssm_c_im KIN(17)
#define ssm_d KIN(18)
#define w_glu KIN(19)
#define b_glu KIN(20)
#define lam_q KIN(21)
#define lam_k KIN(22)
#define subln_g KIN(23)
#define final_g KIN(24)
#define MISC ((float*)(ws_p + WS_CTL))
#define MOD ((float*)(ws_p + WS_MOD))
#define ABAR ((float2*)(ws_p + WS_ABAR))
#define APOW ((float2*)(ws_p + WS_APOW))
#define BBT ((bf16*)(ws_p + WS_BBT))
#define CM ((bf16*)(ws_p + WS_CM))
#define ROPE ((float*)(ws_p + WS_ROPE))
#define W1A ((bf16*)(ws_p + WS_W1A))
#define W1B ((bf16*)(ws_p + WS_W1B))
#define W2A ((bf16*)(ws_p + WS_W2A))
#define W2B ((bf16*)(ws_p + WS_W2B))
#define WIN ((bf16*)(ws_p + WS_WIN))
#define WOUT ((bf16*)(ws_p + WS_WOUT))
#define WGLU ((bf16*)(ws_p + WS_WGLU))
#define EST ((float2*)(ws_p + WS_E))
#define HIN ((float2*)(ws_p + WS_HIN))
#define XC ((float*)(ws_p + WS_XC))
#define XN ((bf16*)(ws_p + WS_XN))
#define SA ((bf16*)(ws_p + WS_XN))
#define ACT ((bf16*)(ws_p + WS_ACT))
#define OATT ((float*)(ws_p + WS_OATT))
#define GB ((bf16*)(ws_p + WS_G))
#define YFB ((float*)(ws_p + WS_OATT + 132 * MiB))
#define BIAS1 ((float*)(ws_p + WS_BIAS1))
#define BIAS2 ((float*)(ws_p + WS_BIAS2))
#define RSS1 ((float*)(ws_p + WS_RSS1))
#define RSS2 ((float*)(ws_p + WS_RSS2))
#define XN2 ((bf16*)(ws_p + WS_U))
#define X3B ((bf16*)(ws_p + WS_XN))
#define UB ((bf16*)(ws_p + WS_U))
#define QB ((bf16*)(ws_p + WS_Q))
#define KB ((bf16*)(ws_p + WS_K))
#define VB ((bf16*)(ws_p + WS_V))
    (void)a;
    { volatile LAS unsigned* st0 = (volatile LAS unsigned*)(ldsl + 138240); if (tid < 4) st0[tid] = 0u; }
    __syncthreads();
    XcdBarrier xbar = xcd_barrier_post((unsigned*)(ws_p + WS_BAR), (volatile LAS unsigned*)(ldsl + 138240));
#define GSYNC() xcd_barrier(xbar)

    PH(0) {
        if (bx < 288) {
            LAS float* sl = (LAS float*)ldsl; LAS float* part = (LAS float*)(ldsl + 36864);
            for (int i = tid; i < 9 * DM; i += NTHR) { const float v = i < 8 * DM ? cvec[i] : c_ctx[i - 8 * DM]; sl[i] = v / (1.0f + __expf(-v)); }
            __syncthreads();
            for (int unit = bx; unit < 288; unit += G) {
                const int cl = tid & 31, kg = tid >> 5, k0 = kg * 64; const float* wp = w_mod + (size_t)k0 * NMODV + unit * 32 + cl;
                float acc[9];
#pragma unroll
                for (int i = 0; i < 9; ++i) acc[i] = 0.f;
                float wv[64];
#pragma unroll
                for (int kk = 0; kk < 64; ++kk) wv[kk] = wp[(size_t)kk * NMODV];
#pragma unroll
                for (int kk = 0; kk < 64; kk += 4) {
#pragma unroll
                    for (int i = 0; i < 9; ++i) { const f32x4 sv = *(const LAS f32x4*)(sl + i * DM + k0 + kk); acc[i] = fmaf(sv.x, wv[kk], fmaf(sv.y, wv[kk + 1], fmaf(sv.z, wv[kk + 2], fmaf(sv.w, wv[kk + 3], acc[i])))); }
                }
#pragma unroll
                for (int i = 0; i < 9; ++i) part[(kg * 9 + i) * 32 + cl] = acc[i];
                __syncthreads();
                if (tid < 288) { const int i = tid >> 5; float sum = 0.f;
#pragma unroll
                    for (int k = 0; k < 16; ++k) sum += part[(k * 9 + i) * 32 + cl];
                    MOD[i * NMODV + unit * 32 + cl] = sum + b_mod[unit * 32 + cl]; }
                __syncthreads();
            }
        }
        __syncthreads();
        {
            LAS float* scr = (LAS float*)(ldsl + wave * 16384);
            constexpr int I_1A = (DM / 64) * (2 * DFF / 32);
            for (int it = gw; it < I_1A; it += NGW) transpose_item(ffn_w_in, DM, 2 * DFF, W1A, 1, scr, it, lane);
        }
        const int gt = bx * NTHR + tid, NT_ALL = G * NTHR;
        for (int i = gt; i < 2 * 32 * 64; i += NT_ALL) {
            const int p = i & 63, dg = i >> 6;
            const double dt = dexp((double)ssm_log_dt[dg]), are = (double)ssm_a_re[i], aim = (double)ssm_a_im[i];
            double s1, c1, s2, c2; dsincos(dt * aim, s1, c1); dsincos(256.0 * dt * aim, s2, c2);
            const double mag = dexp(dt * are), mag2 = dexp(256.0 * dt * are);
            const double abr = mag * c1, abi = mag * s1;
            ABAR[i] = make_float2((float)abr, (float)abi); APOW[i] = make_float2((float)(mag2 * c2), (float)(mag2 * s2));
            const double zr = abr - 1.0, zi = abi, den = are * are + aim * aim;
            const double cr = (zr * are + zi * aim) / den, ci = (zi * are - zr * aim) / den;
            const float* bre = ssm_b_re + (size_t)i * 16; const float* bim = ssm_b_im + (size_t)i * 16;
            bf16* dre = BBT + ((size_t)(dg * 4 + (p >> 5)) * 32 + (p & 31)) * 16; bf16* dim = BBT + ((size_t)(dg * 4 + 2 + (p >> 5)) * 32 + (p & 31)) * 16;
#pragma unroll
            for (int h = 0; h < 16; ++h) { const double br = (double)bre[h], bi = (double)bim[h]; dre[h] = (bf16)f2bf((float)(cr * br - ci * bi)); dim[h] = (bf16)f2bf((float)(cr * bi + ci * br)); }
        }
        for (int i = gt; i < 2 * 32 * 16 * 64; i += NT_ALL) {
            const int p = i & 63, dgh = i >> 6;
            ((unsigned*)CM)[(size_t)dgh * 64 + p] = pk2(ssm_c_re[i], -ssm_c_im[i]);
        }
        for (int i = gt; i < 128 * 16; i += NT_ALL) {
            const int f = i & 15, pos = i >> 4;
            const double inv = dexp(-(double)f * (9.210340371976182736 / 16.0)); double s, c; dsincos((double)pos * inv, s, c);
            ROPE[2 * i] = (float)c; ROPE[2 * i + 1] = (float)s;
        }
        for (int i = gt; i < NROWS; i += NT_ALL) { RSS1[i] = 0.f; RSS2[i] = 0.f; }
        if (gt == 0) { float s0 = 0.f, s1 = 0.f; for (int d = 0; d < 64; ++d) { s0 += lam_q[d] * lam_k[d]; s1 += lam_q[64 + d] * lam_k[64 + d]; } MISC[0] = expf(s0) - expf(s1) + 0.2f; }
    }
    grid.sync();

#define NORM_PASS(SRC_LAT, SRC_CTX, NIDX, LATONLY) do { int tid_l = threadIdx.x; asm volatile("" : "+v"(tid_l)); const int lane_l = tid_l & 63, gw_l = vcu * NWAVES + __builtin_amdgcn_readfirstlane(tid_l >> 6); \
        for (int it = gw_l; it < NROWS / 16; it += NGW) { const int r0 = it * 16, pm = r0 >> 8, b = pm / TILES_B, jt = pm - b * TILES_B, rl = r0 & 255; \
            if ((LATONLY) && jt == 32) continue; \
            const float* src = jt < 32 ? (SRC_LAT) + ((size_t)b * SEQ + jt * 256 + rl) * DM : (SRC_CTX) + ((size_t)b * CTXL + rl) * DM; \
            const float* mv = MOD + (jt < 32 ? b : 8) * NMODV + 3 * (NIDX) * DM; \
            norm_rows16<0>(src, XN + (size_t)r0 * DM, nullptr, norm_g + (NIDX) * DM, mv, mv + DM, lane_l); } } while (0)

    PH(1) {
        if (bx < 240) {
            const bool isin = bx < 64; const int unit = isin ? bx : bx - 64, N = isin ? 2048 : 2 * DFF, soff = isin ? 3 * DM : 6 * DM;
            const float* W = isin ? w_in : ffn_w_in + (size_t)DM * 2 * DFF; float* BO = isin ? BIAS1 : BIAS2;
            LAS float* sl = (LAS float*)ldsl; LAS float* part = (LAS float*)(ldsl + 36864);
            for (int i = tid; i < 9 * DM; i += NTHR) sl[i] = MOD[(i >> 10) * NMODV + soff + (i & 1023)];
            __syncthreads();
            const int cl = tid & 31, kg = tid >> 5, k0 = kg * 64; const float* wp = W + (size_t)k0 * N + unit * 32 + cl;
            float acc[9];
#pragma unroll
            for (int i = 0; i < 9; ++i) acc[i] = 0.f;
            float wv[64];
#pragma unroll
            for (int kk = 0; kk < 64; ++kk) wv[kk] = wp[(size_t)kk * N];
#pragma unroll
            for (int kk = 0; kk < 64; kk += 4) {
#pragma unroll
                for (int i = 0; i < 9; ++i) { const f32x4 sv = *(const LAS f32x4*)(sl + i * DM + k0 + kk); acc[i] = fmaf(sv.x, wv[kk], fmaf(sv.y, wv[kk + 1], fmaf(sv.z, wv[kk + 2], fmaf(sv.w, wv[kk + 3], acc[i])))); }
            }
#pragma unroll
            for (int i = 0; i < 9; ++i) part[(kg * 9 + i) * 32 + cl] = acc[i];
            __syncthreads();
            if (tid < 288) { const int i = tid >> 5; float sum = 0.f;
#pragma unroll
                for (int k = 0; k < 16; ++k) sum += part[(k * 9 + i) * 32 + cl];
                const int src = unit * 32 + cl; int drow = src;
                if (isin) { if (src >= 512 && src < 1536) drow = unit * 32 + 2 * (cl & 15) + (cl >> 4); }
                else { const int up = src >= DFF ? 1 : 0, ff = src - up * DFF; drow = (ff >> 7) * 256 + up * 128 + (ff & 127); }
                BO[i * N + drow] = sum; }
            __syncthreads();
        }
        NORM_PASS(x_in, ctx, 0, false);
    }
    GSYNC();
    PH(2) { pg8::Gemm g{XN, W1A, NROWS, 2 * DFF, DM}; pg8::TileOrder S; S.init(264, 22, G, bx, 0); pg8::EpiSwiglu E{ACT, DFF, nullptr, nullptr};
      pg8::gemm_phase<pg8::EpiSwiglu, pg8::TileOrder, true, true>(ldsl, g, S, E);
      if (bx >= 176) {
          int tid_l = threadIdx.x; asm volatile("" : "+v"(tid_l)); const int lane_l = tid_l & 63, wave_l = __builtin_amdgcn_readfirstlane(tid_l >> 6);
          LAS float* scr = (LAS float*)(ldsl + wave_l * 16384);
          constexpr int I_1B = (DFF / 64) * (DM / 32);
          for (int it = (bx - 176) * NWAVES + wave_l; it < I_1B; it += (G - 176) * NWAVES) transpose_item(ffn_w_out, DFF, DM, W1B, 0, scr, it, lane_l);
      } }
    GSYNC();
    PH(3) { pg8::Gemm g{ACT, W1B, NROWS, DM, DFF}; pg8::TileOrder S; S.init(264, 4, G, bx, 0); pg8::EpiResidNorm E{x_in, ctx, out_p, XC, MOD, 2 * DM, 1, norm_g + DM, 4 * DM, XN, RSS1};
      pg8::gemm_phase<pg8::EpiResidNorm, pg8::TileOrder, true, true>(ldsl, g, S, E);
      if (bx >= 32) {
          int tid_l = threadIdx.x; asm volatile("" : "+v"(tid_l)); const int lane_l = tid_l & 63, wave_l = __builtin_amdgcn_readfirstlane(tid_l >> 6);
          LAS float* scr = (LAS float*)(ldsl + wave_l * 16384);
          constexpr int I_1A = (DM / 64) * (2 * DFF / 32), I_1B = (DFF / 64) * (DM / 32), I_OUT = (DM / 64) * (DM / 32), I_GLU = (512 / 64) * (512 / 32), I_IN = (DM / 64) * (2048 / 32);
          for (int it = (bx - 32) * NWAVES + wave_l; it < I_IN + I_1A + I_1B + I_OUT + I_GLU; it += (G - 32) * NWAVES) {
              int r = it;
              if (r < I_IN) { transpose_item(w_in, DM, 2048, WIN, 2, scr, r, lane_l); continue; } r -= I_IN;
              if (r < I_1A) { transpose_item(ffn_w_in + (size_t)DM * 2 * DFF, DM, 2 * DFF, W2A, 1, scr, r, lane_l); continue; } r -= I_1A;
              if (r < I_1B) { transpose_item(ffn_w_out + (size_t)DFF * DM, DFF, DM, W2B, 0, scr, r, lane_l); continue; } r -= I_1B;
              if (r < I_OUT) { transpose_item(w_out, DM, DM, WOUT, 0, scr, r, lane_l); continue; } r -= I_OUT;
              transpose_item(w_glu, 512, 512, WGLU, 0, scr, r, lane_l);
          }
      } }
    GSYNC();
    PH(5) { pg8::Gemm g{XN, WIN, NROWS, 2048, DM}; pg8::TileOrder S; S.init(264, 8, G, bx, 0); pg8::EpiInproj E{UB, QB, KB, VB, ROPE, RSS1, BIAS1};
      pg8::gemm_phase<pg8::EpiInproj, pg8::TileOrder, true, true>(ldsl, g, S, E); }
    GSYNC();
    PH(6) for (int un = vcu; un < 8 * 33 * 4; un += G) { const int gq = un & 3, bc = un >> 2, b = bc / 33, c = bc - b * 33;
        s5_unit_a(ldsl, b, c, gq, UB, ABAR, BBT, EST); }
    GSYNC();
    PH(7) if (bx < 64) {
        int tid_c = threadIdx.x; asm volatile("" : "+v"(tid_c));
        const int i = bx * NTHR + tid_c;
        const int p = i & 63, dir = (i >> 6) & 1, g = (i >> 7) & 31, b = i >> 12;
        const float2 ap = APOW[(dir * 32 + g) * 64 + p];
#define SIDX(cc) (((((size_t)b * 33 + (cc)) * 32 + g) * 2 + dir) * 64 + p)
        float2 h = EST[SIDX(32)];
        if (dir == 0) { HIN[SIDX(0)] = h; for (int c = 0; c < 31; ++c) { const float2 e = EST[SIDX(c)]; const float nr = fmaf(ap.x, h.x, fmaf(-ap.y, h.y, e.x)), ni = fmaf(ap.x, h.y, fmaf(ap.y, h.x, e.y)); h = make_float2(nr, ni); HIN[SIDX(c + 1)] = h; } }
        else { HIN[SIDX(31)] = h; for (int c = 31; c > 0; --c) { const float2 e = EST[SIDX(c)]; const float nr = fmaf(ap.x, h.x, fmaf(-ap.y, h.y, e.x)), ni = fmaf(ap.x, h.y, fmaf(ap.y, h.x, e.y)); h = make_float2(nr, ni); HIN[SIDX(c - 1)] = h; } }
#undef SIDX
    }
    PH(8) {
        const float lam = MISC[0];
        unsigned redo_mask = 0u;
        {
        int k_ = 0;
        for (int un = vcu; un < 8 * 4 * 32; un += G, ++k_) {
            const int qb = un & 31, bh = un >> 5, b = bh >> 2, h = bh & 3;
            const size_t rb = (size_t)b * ROWS_B, rq = rb + (size_t)qb * 256;
            const attn::bf16_t* q0 = QB + rq * 512 + h * 128; const attn::bf16_t* k0 = KB + rb * 512 + h * 128; const attn::bf16_t* v0 = VB + rb * 512 + h * 128;
            float* st = OATT + rq * 512 + h * 128; attn::bf16_t* so = SA + rq * 1024 + 512 + h * 128;
            bool redo = attn::body<0, false>(q0, k0, v0, st, nullptr, lam, subln_g, ROWS_B, (char*)lds);
            if (!redo) redo = attn::body<1, false>(q0 + 64, k0 + 64, v0, st, so, lam, subln_g, ROWS_B, (char*)lds);
            if (redo) redo_mask |= 1u << k_;
        }
        }
        if (redo_mask) {
            int k_ = 0;
            for (int un = vcu; un < 8 * 4 * 32; un += G, ++k_) {
                if (!((redo_mask >> k_) & 1u)) continue;
                const int qb = un & 31, bh = un >> 5, b = bh >> 2, h = bh & 3;
                const size_t rb = (size_t)b * ROWS_B, rq = rb + (size_t)qb * 256;
                const attn::bf16_t* q0 = QB + rq * 512 + h * 128; const attn::bf16_t* k0 = KB + rb * 512 + h * 128; const attn::bf16_t* v0 = VB + rb * 512 + h * 128;
                float* st = OATT + rq * 512 + h * 128; attn::bf16_t* so = SA + rq * 1024 + 512 + h * 128;
                (void)attn::body<0, true>(q0, k0, v0, st, nullptr, lam, subln_g, ROWS_B, (char*)lds);
                (void)attn::body<1, true>(q0 + 64, k0 + 64, v0, st, so, lam, subln_g, ROWS_B, (char*)lds);
            }
        }
    }
    GSYNC();
    PH(9) for (int un = vcu; un < 8 * 32 * 4; un += G) { const int gq = un & 3, bc = un >> 2, b = bc >> 5, c = bc & 31;
        s5_unit<true>(ldsl, b, c, gq, UB, ABAR, BBT, CM, HIN, EST, ssm_d, GB, YFB); }
    GSYNC();
    PH(10) { pg8::Gemm g{GB, WGLU, NROWS, 512, 512}; pg8::TileOrder S; S.init(256, 2, G, bx, 1); pg8::EpiGlu E{GB, b_glu, SA};
      pg8::gemm_phase<pg8::EpiGlu, pg8::TileOrder, true, true>(ldsl, g, S, E); }
    GSYNC();
    PH(12) { pg8::Gemm g{SA, WOUT, NROWS, DM, DM}; pg8::TileOrder S; S.init(256, 4, G, bx, 1); pg8::EpiResidNorm E{out_p, XC, out_p, XC, MOD, 5 * DM, 0, norm_g + 2 * DM, 7 * DM, XN2, RSS2};
      pg8::gemm_phase<pg8::EpiResidNorm, pg8::TileOrder, true, true>(ldsl, g, S, E); }
    GSYNC();
    PH(14) { pg8::Gemm g{XN2, W2A, NROWS, 2 * DFF, DM}; pg8::TileOrder S; S.init(256, 22, G, bx, 1); pg8::EpiSwiglu E{ACT, DFF, RSS2, BIAS2};
      pg8::gemm_phase<pg8::EpiSwiglu, pg8::TileOrder, true, true>(ldsl, g, S, E); }
    GSYNC();
    PH(15) { pg8::Gemm g{ACT, W2B, NROWS, DM, DFF}; pg8::TileOrder S; S.init(256, 4, G, bx, 1); pg8::EpiResid E{out_p, XC, out_p, XC, MOD, 8 * DM, 0.5f, X3B};
      pg8::gemm_phase<pg8::EpiResid, pg8::TileOrder, true, true>(ldsl, g, S, E); }
    GSYNC();
    PH(16) { int tid_l = threadIdx.x; asm volatile("" : "+v"(tid_l)); const int lane_l = tid_l & 63, gw_l = vcu * NWAVES + __builtin_amdgcn_readfirstlane(tid_l >> 6);
        for (int it = gw_l; it < NB * SEQ / 16; it += NGW) { const int lr0 = it * 16; const size_t prow0 = (size_t)(lr0 >> 13) * ROWS_B + (lr0 & 8191);
            norm_rows16<2>((const float*)(X3B + prow0 * DM), nullptr, out_p + (size_t)lr0 * DM, final_g, nullptr, nullptr, lane_l); } }
#undef NORM_PASS
}

extern "C" void kernel_launch(void* const* d_in, const int* in_sizes, int n_in, void* d_out, int out_size, void* d_ws, size_t ws_size, hipStream_t stream) {
    static int grid = 0;
    if (grid == 0) {
        if (n_in != 25 || in_sizes[0] != NB * SEQ * DM || out_size != NB * SEQ * DM || ws_size < WS_END) {
            fprintf(stderr, "kernel_launch: shape mismatch (n_in %d, in0 %d, out %d, ws %zu, need %zu); nothing launched\n", n_in, n_in > 0 ? in_sizes[0] : -1, out_size, ws_size, (size_t)WS_END); grid = -1; return; }
        int dev = 0, cus = 0, per_cu = 0;
        if (hipGetDevice(&dev) != hipSuccess || hipDeviceGetAttribute(&cus, hipDeviceAttributeMultiprocessorCount, dev) != hipSuccess) { grid = -1; return; }
        if (hipFuncSetAttribute((const void*)hymba_fwd, hipFuncAttributeMaxDynamicSharedMemorySize, LDS_BYTES) != hipSuccess) { fprintf(stderr, "kernel_launch: hipFuncSetAttribute failed\n"); grid = -1; return; }
        if (hipOccupancyMaxActiveBlocksPerMultiprocessor(&per_cu, (const void*)hymba_fwd, NTHR, LDS_BYTES) != hipSuccess || per_cu < 1) { fprintf(stderr, "kernel_launch: occupancy query says %d\n", per_cu); per_cu = 1; }
        (void)hipGetLastError();
        grid = cus * (per_cu > 1 ? 1 : per_cu);
        if (grid != 256) fprintf(stderr, "kernel_launch: grid %d (expected 256)\n", grid);
    }
    if (grid < 0) return;
    (void)hipMemsetAsync((char*)d_ws + WS_BAR, 0, BAR_ZERO_BYTES, stream);
    Args a{};
    for (int i = 0; i < 25; ++i) a.in[i] = (const float*)d_in[i];
    a.out = (float*)d_out; a.ws = (unsigned char*)d_ws;
    void* args[] = {&a};
    const hipError_t e = hipLaunchCooperativeKernel((const void*)hymba_fwd, dim3(grid), dim3(NTHR), args, LDS_BYTES, stream);
    if (e != hipSuccess) fprintf(stderr, "kernel_launch: cooperative launch failed: %s (grid %d)\n", hipGetErrorString(e), grid);
}
```
